# Optimizing an MI355X kernel written in HIP

```python
import math
import jax, jax.numpy as jnp
from jax import lax
import numpy as np

D_MODEL = 1024
BATCH = 8
SEQ = 2048
DEPTH = 2

EPS = 1e-6
MEM_LEN = 256
N_BRANCH = 4

A_WIDTH = 256
A_GROUPS = 4
A_GROUP_DIM = A_WIDTH // A_GROUPS
A_CHUNK = 128

B_HEADS = 8
B_NOPE = 64
B_ROPE = 32
B_QK_DIM = B_NOPE + B_ROPE
B_VDIM = 64
B_Q_RANK = 768
B_KV_RANK = 256
B_WIDTH = B_HEADS * B_VDIM
ATTN_BLOCK = 128
ROPE_THETA = 10000.0

C_WIDTH = 256
C_GROUP = 16
C_GROUPS = C_WIDTH // C_GROUP
C_STATE = 64

M_HEADS = 4
M_HEAD_DIM = 64
M_WIDTH = M_HEADS * M_HEAD_DIM

IN_SIZES = (A_WIDTH, A_WIDTH, A_WIDTH,
            B_Q_RANK, B_KV_RANK, B_ROPE, B_WIDTH,
            C_WIDTH, C_WIDTH,
            M_WIDTH, M_WIDTH,
            N_BRANCH * D_MODEL)
IN_WIDTH = sum(IN_SIZES)

kernel_name = "hybrid_gated_gmlp_mla_s5_memxattn"


def rms_norm(x, g):
    xf = x.astype(jnp.float32)
    y = xf * lax.rsqrt(jnp.mean(xf * xf, axis=-1, keepdims=True) + EPS)
    return (y * g.astype(jnp.float32)).astype(x.dtype)


def apply_rope(x, positions):
    half = x.shape[-1] // 2
    inv_freq = ROPE_THETA ** (-jnp.arange(half, dtype=jnp.float32) / half)
    ang = positions.astype(jnp.float32)[..., None] * inv_freq
    cos = jnp.cos(ang)[:, :, None, :]
    sin = jnp.sin(ang)[:, :, None, :]
    xf = x.astype(jnp.float32)
    x1, x2 = xf[..., :half], xf[..., half:]
    out = jnp.concatenate([x1 * cos - x2 * sin, x2 * cos + x1 * sin], axis=-1)
    return out.astype(x.dtype)


def chunked_spatial_gating(u, v, g_v, w_s, b_s):
    bsz, seq, _ = v.shape
    n_chunks = seq // A_CHUNK
    v = rms_norm(v, g_v)
    vc = v.reshape(bsz, n_chunks, A_CHUNK, A_GROUPS, A_GROUP_DIM)
    causal = jnp.tril(jnp.ones((A_CHUNK, A_CHUNK), dtype=bool))
    w = jnp.where(causal, w_s, jnp.zeros((), w_s.dtype))
    s = jnp.einsum('gts,bnsgc->bntgc', w, vc) + b_s.T[None, None, :, :, None]
    return u * s.reshape(bsz, seq, A_WIDTH)


def causal_block_attention(q, k, v):
    bsz, seq, n_heads, dqk = q.shape
    dv = v.shape[-1]
    n_blocks = seq // ATTN_BLOCK
    scale = dqk ** -0.5
    qb = q.reshape(bsz, n_blocks, ATTN_BLOCK, n_heads, dqk).transpose(1, 0, 3, 2, 4)
    key_pos = jnp.arange(seq)

    def one_block(args):
        q_blk, blk = args
        s = jnp.einsum('bhtd,bshd->bhts', q_blk, k).astype(jnp.float32) * scale
        query_pos = blk * ATTN_BLOCK + jnp.arange(ATTN_BLOCK)
        s = jnp.where(key_pos[None, :] <= query_pos[:, None], s, -jnp.inf)
        p = jax.nn.softmax(s, axis=-1).astype(v.dtype)
        return jnp.einsum('bhts,bshd->bthd', p, v)

    out = lax.map(one_block, (qb, jnp.arange(n_blocks)))
    return out.transpose(1, 0, 2, 3, 4).reshape(bsz, seq, n_heads * dv)


def latent_attention(c_q, c_kv, k_rope, positions, q_norm_g, kv_norm_g, w_uq, w_ukv,
                     qk_g_q, qk_g_k):
    bsz, seq, _ = c_q.shape
    q = (rms_norm(c_q, q_norm_g) @ w_uq).reshape(bsz, seq, B_HEADS, B_QK_DIM)
    kv = (rms_norm(c_kv, kv_norm_g) @ w_ukv).reshape(bsz, seq, B_HEADS, B_NOPE + B_VDIM)
    k_nope, v = kv[..., :B_NOPE], kv[..., B_NOPE:]
    k_pe = jnp.broadcast_to(k_rope[:, :, None, :], (bsz, seq, B_HEADS, B_ROPE))
    k = jnp.concatenate([k_nope, k_pe], axis=-1)
    q = rms_norm(q, qk_g_q)
    k = rms_norm(k, qk_g_k)
    q = jnp.concatenate([q[..., :B_NOPE], apply_rope(q[..., B_NOPE:], positions)], axis=-1)
    k = jnp.concatenate([k[..., :B_NOPE], apply_rope(k[..., B_NOPE:], positions)], axis=-1)
    return causal_block_attention(q, k, v)


def s5_layer(u, a_re, a_im, log_dt, b_re, b_im, c_re, c_im, d_skip, w_glu, b_glu):
    bsz, seq, _ = u.shape
    f32 = jnp.float32
    uf = u.astype(f32).reshape(bsz, seq, C_GROUPS, C_GROUP)
    lam = lax.complex(a_re.astype(f32), a_im.astype(f32))
    dt = jnp.exp(log_dt.astype(f32))[:, None]
    a_bar = jnp.exp(lam * dt)
    b_mat = lax.complex(b_re.astype(f32), b_im.astype(f32))
    b_bar = ((a_bar - 1.0) / lam)[..., None] * b_mat
    bu = jnp.einsum('gpc,bsgc->bsgp', b_bar, uf.astype(jnp.complex64))
    a_elems = jnp.broadcast_to(a_bar, bu.shape)

    def combine(left, right):
        a_l, b_l = left
        a_r, b_r = right
        return a_r * a_l, a_r * b_l + b_r

    _, states = lax.associative_scan(combine, (a_elems, bu), axis=1)
    c_mat = lax.complex(c_re.astype(f32), c_im.astype(f32))
    y = jnp.einsum('gcp,bsgp->bsgc', c_mat, states).real
    y = y + d_skip.astype(f32).reshape(C_GROUPS, C_GROUP) * uf
    y = jax.nn.gelu(y.reshape(bsz, seq, C_WIDTH))
    y = y * jax.nn.sigmoid(y @ w_glu.astype(f32) + b_glu.astype(f32))
    return y.astype(u.dtype)


def memory_attention(q, mem_h, w_kv, qk_g_q, qk_g_k):
    bsz, seq, _ = q.shape
    kv = mem_h @ w_kv
    k = kv[..., :M_WIDTH].reshape(bsz, -1, M_HEADS, M_HEAD_DIM)
    v = kv[..., M_WIDTH:].reshape(bsz, -1, M_HEADS, M_HEAD_DIM)
    q = rms_norm(q.reshape(bsz, seq, M_HEADS, M_HEAD_DIM), qk_g_q)
    k = rms_norm(k, qk_g_k)
    s = jnp.einsum('bshd,bmhd->bhsm', q, k).astype(jnp.float32) * (M_HEAD_DIM ** -0.5)
    p = jax.nn.softmax(s, axis=-1).astype(v.dtype)
    return jnp.einsum('bhsm,bmhd->bshd', p, v).reshape(bsz, seq, M_WIDTH)


def hybrid_layer(x, mem, positions, norm_g, w_in, b_merge, a_norm_g, a_w_s, a_b_s,
                 b_q_norm_g, b_kv_norm_g, b_w_uq, b_w_ukv, b_qk_g_q, b_qk_g_k,
                 c_a_re, c_a_im, c_log_dt, c_b_re, c_b_im, c_c_re, c_c_im, c_d,
                 c_w_glu, c_b_glu, m_norm_g, m_w_kv, m_qk_g_q, m_qk_g_k,
                 w_br_a, w_br_b, w_br_c, w_br_m, w_out):
    bsz, seq, _ = x.shape
    h = rms_norm(x, norm_g)
    z = h @ w_in
    splits = [int(s) for s in np.cumsum(IN_SIZES)[:-1]]
    (a_u, a_v, a_gate, b_cq, b_ckv, b_krope, b_gate, c_in, c_gate,
     m_q, m_gate, merge_logits) = jnp.split(z, splits, axis=-1)

    y_a = chunked_spatial_gating(jax.nn.gelu(a_u), jax.nn.gelu(a_v), a_norm_g, a_w_s, a_b_s)
    y_a = y_a * jax.nn.silu(a_gate)
    y_b = latent_attention(b_cq, b_ckv, b_krope, positions, b_q_norm_g, b_kv_norm_g,
                           b_w_uq, b_w_ukv, b_qk_g_q, b_qk_g_k) * jax.nn.silu(b_gate)
    y_c = s5_layer(c_in, c_a_re, c_a_im, c_log_dt, c_b_re, c_b_im, c_c_re, c_c_im,
                   c_d, c_w_glu, c_b_glu) * jax.nn.silu(c_gate)
    y_m = memory_attention(m_q, rms_norm(mem, m_norm_g), m_w_kv, m_qk_g_q, m_qk_g_k)
    y_m = y_m * jax.nn.silu(m_gate)

    gates = jax.nn.sigmoid(merge_logits + b_merge).reshape(bsz, seq, N_BRANCH, D_MODEL)
    merged = (gates[:, :, 0] * (y_a @ w_br_a) + gates[:, :, 1] * (y_b @ w_br_b)
              + gates[:, :, 2] * (y_c @ w_br_c) + gates[:, :, 3] * (y_m @ w_br_m))
    return x + merged @ w_out


def setup_inputs(seed: int = 0) -> dict:
    key = jax.random.key(seed)
    ks = iter(jax.random.split(key, 40))
    L, D = DEPTH, D_MODEL

    def nrm(shape, scale):
        return jax.random.normal(next(ks), shape, jnp.float32) * scale

    def gain(shape):
        return 1.0 + nrm(shape, 0.02)

    x = nrm((BATCH, SEQ, D), 1.0)
    mem = nrm((BATCH, MEM_LEN, D), 1.0)
    offsets = jax.random.randint(next(ks), (BATCH, 1), 0, 4096, dtype=jnp.int32)
    positions = jnp.arange(SEQ, dtype=jnp.int32)[None, :] + offsets

    state_idx = jnp.arange(C_STATE, dtype=jnp.float32)
    return {
        "x": x,
        "mem": mem,
        "positions": positions,
        "norm_g": gain((L, D)),
        "w_in": nrm((L, D, IN_WIDTH), D ** -0.5),
        "b_merge": nrm((L, N_BRANCH * D), 0.02),
        "a_norm_g": gain((L, A_WIDTH)),
        "a_w_s": nrm((L, A_GROUPS, A_CHUNK, A_CHUNK), A_CHUNK ** -0.5),
        "a_b_s": 1.0 + nrm((L, A_GROUPS, A_CHUNK), 0.1),
        "b_q_norm_g": gain((L, B_Q_RANK)),
        "b_kv_norm_g": gain((L, B_KV_RANK)),
        "b_w_uq": nrm((L, B_Q_RANK, B_HEADS * B_QK_DIM), B_Q_RANK ** -0.5),
        "b_w_ukv": nrm((L, B_KV_RANK, B_HEADS * (B_NOPE + B_VDIM)), B_KV_RANK ** -0.5),
        "b_qk_g_q": gain((L, B_QK_DIM)),
        "b_qk_g_k": gain((L, B_QK_DIM)),
        "c_a_re": -0.5 + nrm((L, C_GROUPS, C_STATE), 0.01),
        "c_a_im": jnp.broadcast_to(math.pi * state_idx, (L, C_GROUPS, C_STATE)),
        "c_log_dt": jax.random.uniform(next(ks), (L, C_GROUPS), jnp.float32,
                                       math.log(1e-3), math.log(1e-1)),
        "c_b_re": nrm((L, C_GROUPS, C_STATE, C_GROUP), (2.0 * C_GROUP) ** -0.5),
        "c_b_im": nrm((L, C_GROUPS, C_STATE, C_GROUP), (2.0 * C_GROUP) ** -0.5),
        "c_c_re": nrm((L, C_GROUPS, C_GROUP, C_STATE), (2.0 * C_STATE) ** -0.5),
        "c_c_im": nrm((L, C_GROUPS, C_GROUP, C_STATE), (2.0 * C_STATE) ** -0.5),
        "c_d": nrm((L, C_WIDTH), 1.0),
        "c_w_glu": nrm((L, C_WIDTH, C_WIDTH), C_WIDTH ** -0.5),
        "c_b_glu": nrm((L, C_WIDTH), 0.02),
        "m_norm_g": gain((L, D)),
        "m_w_kv": nrm((L, D, 2 * M_WIDTH), D ** -0.5),
        "m_qk_g_q": gain((L, M_HEAD_DIM)),
        "m_qk_g_k": gain((L, M_HEAD_DIM)),
        "w_br_a": nrm((L, A_WIDTH, D), A_WIDTH ** -0.5),
        "w_br_b": nrm((L, B_WIDTH, D), B_WIDTH ** -0.5),
        "w_br_c": nrm((L, C_WIDTH, D), C_WIDTH ** -0.5),
        "w_br_m": nrm((L, M_WIDTH, D), M_WIDTH ** -0.5),
        "w_out": nrm((L, D, D), D ** -0.5),
    }


def reference(x, mem, positions, norm_g, w_in, b_merge, a_norm_g, a_w_s, a_b_s,
              b_q_norm_g, b_kv_norm_g, b_w_uq, b_w_ukv, b_qk_g_q, b_qk_g_k,
              c_a_re, c_a_im, c_log_dt, c_b_re, c_b_im, c_c_re, c_c_im, c_d,
              c_w_glu, c_b_glu, m_norm_g, m_w_kv, m_qk_g_q, m_qk_g_k,
              w_br_a, w_br_b, w_br_c, w_br_m, w_out):
    for l in range(DEPTH):
        x = hybrid_layer(x, mem, positions, norm_g[l], w_in[l], b_merge[l],
                         a_norm_g[l], a_w_s[l], a_b_s[l],
                         b_q_norm_g[l], b_kv_norm_g[l], b_w_uq[l], b_w_ukv[l],
                         b_qk_g_q[l], b_qk_g_k[l],
                         c_a_re[l], c_a_im[l], c_log_dt[l], c_b_re[l], c_b_im[l],
                         c_c_re[l], c_c_im[l], c_d[l], c_w_glu[l], c_b_glu[l],
                         m_norm_g[l], m_w_kv[l], m_qk_g_q[l], m_qk_g_k[l],
                         w_br_a[l], w_br_b[l], w_br_c[l], w_br_m[l], w_out[l])
    return x
```

```cpp
#include <hip/hip_runtime.h>
#include <hip/hip_cooperative_groups.h>
#include <stdint.h>
#include <stdio.h>
#include <type_traits>
namespace cg = cooperative_groups;

#ifndef MK_MULTI
#define MK_MULTI 0
#endif

typedef unsigned short bf16_t;
typedef short bf16x8 __attribute__((ext_vector_type(8)));
typedef short s16x4 __attribute__((ext_vector_type(4)));
typedef float f32x16 __attribute__((ext_vector_type(16)));
typedef float f32x4 __attribute__((ext_vector_type(4)));
typedef float f32x2 __attribute__((ext_vector_type(2)));
typedef unsigned u32x4 __attribute__((ext_vector_type(4)));
typedef unsigned u32x2 __attribute__((ext_vector_type(2)));
#define DI __device__ __forceinline__
#define MFMA(a, b, c) __builtin_amdgcn_mfma_f32_32x32x16_bf16((a), (b), (c), 0, 0, 0)

constexpr int T_ = 16384, S_ = 2048;
constexpr int INW = 7456;
constexpr int Z1W = 2304, Z2W = 1152;
constexpr int NWIN = 7552;
constexpr float EPS = 1e-6f;
constexpr float LOG2E = 1.4426950408889634f;
constexpr int LDT = 72;
constexpr int EPW = 132;
constexpr int SM_MAIN = 4 * 128 * LDT * 2;
constexpr int SM_RS = SM_MAIN;
constexpr int SM_SS = SM_MAIN + 512;
constexpr int SM_MISC = SM_MAIN + 1024;
constexpr int SM_TOTAL = SM_MAIN + 1024 + 64;

struct P {
  const float* x; const float* mem; const int* pos;
  const float* norm_g; const float* w_in; const float* b_merge; const float* a_norm_g; const float* a_w_s; const float* a_b_s;
  const float* b_q_norm_g; const float* b_kv_norm_g; const float* b_w_uq; const float* b_w_ukv; const float* b_qk_g_q; const float* b_qk_g_k;
  const float* c_a_re; const float* c_a_im; const float* c_log_dt; const float* c_b_re; const float* c_b_im; const float* c_c_re; const float* c_c_im;
  const float* c_d; const float* c_w_glu; const float* c_b_glu;
  const float* m_norm_g; const float* m_w_kv; const float* m_qk_g_q; const float* m_qk_g_k;
  const float* w_br_a; const float* w_br_b; const float* w_br_c; const float* w_br_m; const float* w_out;
  float* out;
  bf16_t* z1; bf16_t* z2; bf16_t* xb; bf16_t* qf; bf16_t* kf; bf16_t* mg; bf16_t* vt; bf16_t* hm; bf16_t* memk; bf16_t* memvt;
  bf16_t* WinT; bf16_t* WuqT; bf16_t* WukvT; bf16_t* WgluT; bf16_t* WbrT; bf16_t* WoutT; bf16_t* WmkvT;
  float* ssp; float* ssq; float* rope; float* carry; unsigned* ctr; unsigned* bar;
  long dry;
};

DI int tid() { int t = threadIdx.x; asm volatile("" : "+v"(t)); return t; }
DI float bf2f(bf16_t b) { return __uint_as_float(((unsigned)b) << 16); }
DI unsigned pk2(float lo, float hi) { unsigned r; asm("v_cvt_pk_bf16_f32 %0, %1, %2" : "=v"(r) : "v"(lo), "v"(hi)); return r; }
DI unsigned pk2n(float lo, float hi) { unsigned r; asm("s_nop 1\n\tv_cvt_pk_bf16_f32 %0, %1, %2" : "=v"(r) : "v"(lo), "v"(hi)); return r; }
DI bf16_t f2bf(float x) { return (bf16_t)(pk2(x, 0.f) & 0xffffu); }
DI void unpack8(u32x4 v, float (&f)[8]) {
  f[0] = __uint_as_float(v.x << 16); f[1] = __uint_as_float(v.x & 0xffff0000u);
  f[2] = __uint_as_float(v.y << 16); f[3] = __uint_as_float(v.y & 0xffff0000u);
  f[4] = __uint_as_float(v.z << 16); f[5] = __uint_as_float(v.z & 0xffff0000u);
  f[6] = __uint_as_float(v.w << 16); f[7] = __uint_as_float(v.w & 0xffff0000u);
}
DI void unpack4(u32x2 v, float (&f)[4]) {
  f[0] = __uint_as_float(v.x << 16); f[1] = __uint_as_float(v.x & 0xffff0000u);
  f[2] = __uint_as_float(v.y << 16); f[3] = __uint_as_float(v.y & 0xffff0000u);
}
DI u32x4 pack8(const float (&f)[8]) { u32x4 r; r.x = pk2(f[0], f[1]); r.y = pk2(f[2], f[3]); r.z = pk2(f[4], f[5]); r.w = pk2(f[6], f[7]); return r; }
DI float sigm(float x) { return __builtin_amdgcn_rcpf(1.f + __expf(-x)); }
DI float silu(float x) { return x * sigm(x); }
DI float gelu_t(float x) { return x * sigm(1.5957691216057308f * (x + 0.044715f * x * x * x)); }
DI float sum16(float v) { v += __shfl_xor(v, 1); v += __shfl_xor(v, 2); v += __shfl_xor(v, 4); v += __shfl_xor(v, 8); return v; }
DI float sum8(float v) { v += __shfl_xor(v, 1); v += __shfl_xor(v, 2); v += __shfl_xor(v, 4); return v; }
DI float sum64(float v) { v = sum16(v); v += __shfl_xor(v, 16); v += __shfl_xor(v, 32); return v; }
DI int crow(int i, int h) { return (i & 3) + 8 * (i >> 2) + 4 * h; }
#define MFMA16(a, b, c) __builtin_amdgcn_mfma_f32_16x16x32_bf16((a), (b), (c), 0, 0, 0)
DI void zero_acc4(f32x4 (&acc)[4][4]) {
#pragma unroll
  for (int a = 0; a < 4; a++)
#pragma unroll
    for (int b = 0; b < 4; b++) { acc[a][b].x = 0.f; acc[a][b].y = 0.f; acc[a][b].z = 0.f; acc[a][b].w = 0.f; }
}
DI void zero_acc(f32x16 (&acc)[2][2]) {
#pragma unroll
  for (int a = 0; a < 2; a++)
#pragma unroll
    for (int b = 0; b < 2; b++)
#pragma unroll
      for (int i = 0; i < 16; i++) acc[a][b][i] = 0.f;
}

template <bool SS>
DI void gemm_loop(const bf16_t* __restrict__ A, long lda, const bf16_t* __restrict__ B, long ldb, int K,
                  f32x16 (&acc)[2][2], bf16_t* sm, float* ssS) {
  const int t = tid(), lane = t & 63, w = t >> 6, wm = w >> 1, wn = w & 1, l31 = lane & 31, h = lane >> 5;
  const int lr = t >> 3, lc = (t & 7) * 8;
  const bf16_t* ap = A + (long)lr * lda + lc;
  const bf16_t* bp = B + (long)lr * ldb + lc;
  bf16_t* wp = sm + lr * LDT + lc;
  const bf16_t* rA = sm + (wm * 64 + l31) * LDT + h * 8;
  const bf16_t* rB = sm + 2 * 128 * LDT + (wn * 64 + l31) * LDT + h * 8;
  u32x4 ra[4], rb[4];
  float ss[4] = {0.f, 0.f, 0.f, 0.f};
  const int nk = K >> 6;
  auto gl = [&](int ko) {
#pragma unroll
    for (int i = 0; i < 4; i++) { ra[i] = *(const u32x4*)(ap + (long)(32 * i) * lda + ko); rb[i] = *(const u32x4*)(bp + (long)(32 * i) * ldb + ko); }
  };
  auto st = [&](auto BUF) {
    constexpr int buf = decltype(BUF)::value;
#pragma unroll
    for (int i = 0; i < 4; i++) {
      *(u32x4*)(wp + buf * 128 * LDT + 32 * i * LDT) = ra[i];
      *(u32x4*)(wp + 2 * 128 * LDT + buf * 128 * LDT + 32 * i * LDT) = rb[i];
      if (SS) { float f[8]; unpack8(ra[i], f);
#pragma unroll
        for (int j = 0; j < 8; j++) ss[i] += f[j] * f[j]; }
    }
  };
  auto comp = [&](auto BUF) {
    constexpr int buf = decltype(BUF)::value;
#pragma unroll
    for (int kk = 0; kk < 4; kk++) {
      bf16x8 af[2], bfr[2];
#pragma unroll
      for (int mb = 0; mb < 2; mb++) af[mb] = *(const bf16x8*)(rA + buf * 128 * LDT + mb * 32 * LDT + kk * 16);
#pragma unroll
      for (int nb = 0; nb < 2; nb++) bfr[nb] = *(const bf16x8*)(rB + buf * 128 * LDT + nb * 32 * LDT + kk * 16);
#pragma unroll
      for (int mb = 0; mb < 2; mb++)
#pragma unroll
        for (int nb = 0; nb < 2; nb++) acc[mb][nb] = MFMA(af[mb], bfr[nb], acc[mb][nb]);
    }
  };
  using B0 = std::integral_constant<int, 0>; using B1 = std::integral_constant<int, 1>;
  gl(0);
  st(B0{});
  gl(64);
  __syncthreads();
  for (int ks = 0; ks < nk; ks += 2) {
    st(B1{});
    __builtin_amdgcn_sched_barrier(0);
    if (ks + 2 < nk) gl((ks + 2) * 64);
    __builtin_amdgcn_sched_barrier(0);
    comp(B0{});
    __syncthreads();
    if (ks + 2 < nk) st(B0{});
    __builtin_amdgcn_sched_barrier(0);
    if (ks + 3 < nk) gl((ks + 3) * 64);
    __builtin_amdgcn_sched_barrier(0);
    comp(B1{});
    __syncthreads();
  }
  if (SS) {
    const float inv = 1.0f / (float)K;
#pragma unroll
    for (int i = 0; i < 4; i++) { float s = sum8(ss[i]); if ((t & 7) == 0) ssS[lr + 32 * i] = rsqrtf(s * inv + EPS); }
  }
}

#define LAS3 __attribute__((address_space(3)))
struct GDesc { const bf16_t* A; long lda; const bf16_t* B; long ldb; };
DI void gemm_dma_stage0(const GDesc& d, char* smc) {
  const int t = tid(), lane = t & 63, w = t >> 6;
  const unsigned wdst = (unsigned)(uintptr_t)smc + (unsigned)w * 4096u;
#pragma unroll
  for (int i = 0; i < 4; i++) {
    const int row = 32 * w + 8 * i + (lane >> 3), c = (lane & 7) ^ ((row >> 1) & 7);
    __builtin_amdgcn_global_load_lds((const unsigned*)(d.A + row * d.lda + c * 8), (LAS3 unsigned*)(uintptr_t)(wdst + i * 1024), 16, 0, 0);
    __builtin_amdgcn_global_load_lds((const unsigned*)(d.B + row * d.ldb + c * 8), (LAS3 unsigned*)(uintptr_t)(wdst + 16384 + i * 1024), 16, 0, 0);
  }
}
DI void gemm_loop_dma(const bf16_t* __restrict__ A, long lda, const bf16_t* __restrict__ B, long ldb, int K, f32x16 (&acc)[2][2], char* smc,
                      bool started = false, bool has_next = false, GDesc next = GDesc{nullptr, 0, nullptr, 0}) {
  const int t = tid(), lane = t & 63, w = t >> 6, wm = w >> 1, wn = w & 1, l31 = lane & 31, h = lane >> 5;
  unsigned aoff[4], boff[4];
#pragma unroll
  for (int i = 0; i < 4; i++) {
    const int row = 32 * w + 8 * i + (lane >> 3), c = (lane & 7) ^ ((row >> 1) & 7);
    aoff[i] = (unsigned)((row * lda + c * 8) * 2); boff[i] = (unsigned)((row * ldb + c * 8) * 2);
  }
  const char* Ab = (const char*)A; const char* Bb = (const char*)B;
  const unsigned lbase = (unsigned)(uintptr_t)smc;
  const unsigned wdst = lbase + (unsigned)w * 4096u;
  const int swz = (l31 >> 1) & 7;
  unsigned fo[4];
#pragma unroll
  for (int kk = 0; kk < 4; kk++) fo[kk] = (unsigned)(((2 * kk + h) ^ swz) * 16);
  const char* rA = smc + (wm * 64 + l31) * 128;
  const char* rB = smc + 16384 + (wn * 64 + l31) * 128;
  const int nk = K >> 6;
  auto issue = [&](auto BUF, int ko) {
    constexpr int buf = decltype(BUF)::value;
#pragma unroll
    for (int i = 0; i < 4; i++) {
      __builtin_amdgcn_global_load_lds((const unsigned*)(Ab + (size_t)ko * 2 + aoff[i]), (LAS3 unsigned*)(uintptr_t)(wdst + buf * 32768 + i * 1024), 16, 0, 0);
      __builtin_amdgcn_global_load_lds((const unsigned*)(Bb + (size_t)ko * 2 + boff[i]), (LAS3 unsigned*)(uintptr_t)(wdst + buf * 32768 + 16384 + i * 1024), 16, 0, 0);
    }
  };
  auto comp = [&](auto BUF) {
    constexpr int buf = decltype(BUF)::value;
#pragma unroll
    for (int kk = 0; kk < 4; kk++) {
      bf16x8 af[2], bfr[2];
#pragma unroll
      for (int mb = 0; mb < 2; mb++) af[mb] = *(const bf16x8*)(rA + buf * 32768 + mb * 32 * 128 + fo[kk]);
#pragma unroll
      for (int nb = 0; nb < 2; nb++) bfr[nb] = *(const bf16x8*)(rB + buf * 32768 + nb * 32 * 128 + fo[kk]);
#pragma unroll
      for (int mb = 0; mb < 2; mb++)
#pragma unroll
        for (int nb = 0; nb < 2; nb++) acc[mb][nb] = MFMA(af[mb], bfr[nb], acc[mb][nb]);
    }
  };
  using B0 = std::integral_constant<int, 0>; using B1 = std::integral_constant<int, 1>;
  if (!started) issue(B0{}, 0);
  __syncthreads();
  for (int ks = 0; ks < nk; ks += 2) {
    issue(B1{}, (ks + 1) * 64);
    __builtin_amdgcn_sched_barrier(0);
    comp(B0{});
    __syncthreads();
    if (ks + 2 < nk) issue(B0{}, (ks + 2) * 64);
    else if (has_next) gemm_dma_stage0(next, smc);
    __builtin_amdgcn_sched_barrier(0);
    comp(B1{});
    __syncthreads();
  }
}

DI void gemm_loop_dma16(const bf16_t* __restrict__ A, long lda, const bf16_t* __restrict__ B, long ldb, int K, f32x4 (&acc)[4][4], char* smc,
                      bool started = false, bool has_next = false, GDesc next = GDesc{nullptr, 0, nullptr, 0}) {
  const int t = tid(), lane = t & 63, w = t >> 6, wm = w >> 1, wn = w & 1, r16 = lane & 15, q = lane >> 4;
  unsigned aoff[4], boff[4];
#pragma unroll
  for (int i = 0; i < 4; i++) {
    const int row = 32 * w + 8 * i + (lane >> 3), c = (lane & 7) ^ ((row >> 1) & 7);
    aoff[i] = (unsigned)((row * lda + c * 8) * 2); boff[i] = (unsigned)((row * ldb + c * 8) * 2);
  }
  const char* Ab = (const char*)A; const char* Bb = (const char*)B;
  const unsigned wdst = (unsigned)(uintptr_t)smc + (unsigned)w * 4096u;
  const int swz = (r16 >> 1) & 7;
  unsigned fo[2];
#pragma unroll
  for (int k32 = 0; k32 < 2; k32++) fo[k32] = (unsigned)(((4 * k32 + q) ^ swz) * 16);
  const char* rA = smc + (wm * 64 + r16) * 128;
  const char* rB = smc + 16384 + (wn * 64 + r16) * 128;
  const int nk = K >> 6;
  auto issue = [&](auto BUF, int ko) {
    constexpr int buf = decltype(BUF)::value;
#pragma unroll
    for (int i = 0; i < 4; i++) {
      __builtin_amdgcn_global_load_lds((const unsigned*)(Ab + (size_t)ko * 2 + aoff[i]), (LAS3 unsigned*)(uintptr_t)(wdst + buf * 32768 + i * 1024), 16, 0, 0);
      __builtin_amdgcn_global_load_lds((const unsigned*)(Bb + (size_t)ko * 2 + boff[i]), (LAS3 unsigned*)(uintptr_t)(wdst + buf * 32768 + 16384 + i * 1024), 16, 0, 0);
    }
  };
  auto comp = [&](auto BUF) {
    constexpr int buf = decltype(BUF)::value;
#pragma unroll
    for (int k32 = 0; k32 < 2; k32++) {
      bf16x8 af[4], bq[4];
#pragma unroll
      for (int mb = 0; mb < 4; mb++) af[mb] = *(const bf16x8*)(rA + buf * 32768 + mb * 16 * 128 + fo[k32]);
#pragma unroll
      for (int nb = 0; nb < 4; nb++) bq[nb] = *(const bf16x8*)(rB + buf * 32768 + nb * 16 * 128 + fo[k32]);
#pragma unroll
      for (int mb = 0; mb < 4; mb++)
#pragma unroll
        for (int nb = 0; nb < 4; nb++) acc[mb][nb] = MFMA16(af[mb], bq[nb], acc[mb][nb]);
    }
  };
  using B0 = std::integral_constant<int, 0>; using B1 = std::integral_constant<int, 1>;
  if (!started) issue(B0{}, 0);
  __syncthreads();
  for (int ks = 0; ks < nk; ks += 2) {
    issue(B1{}, (ks + 1) * 64); __builtin_amdgcn_sched_barrier(0);
    comp(B0{});
    __syncthreads();
    if (ks + 2 < nk) issue(B0{}, (ks + 2) * 64);
    else if (has_next) gemm_dma_stage0(next, smc);
    __builtin_amdgcn_sched_barrier(0);
    comp(B1{});
    __syncthreads();
  }
}

DI void gemm_loop_dma2(const bf16_t* __restrict__ A, long lda, const bf16_t* __restrict__ B0, const bf16_t* __restrict__ B1, long ldb, int K,
                       f32x16 (&accP)[2][2], f32x16 (&accQ)[2][2], char* smc) {
  const int t = tid(), lane = t & 63, w = t >> 6, wm = w >> 1, wn = w & 1, l31 = lane & 31, h = lane >> 5;
  unsigned aoff[2], boff[2];
#pragma unroll
  for (int i = 0; i < 2; i++) {
    const int row = 16 * (2 * w + i) + (lane >> 2), c = (lane & 3) ^ ((row >> 2) & 3);
    aoff[i] = (unsigned)((row * lda + c * 8) * 2); boff[i] = (unsigned)((row * ldb + c * 8) * 2);
  }
  const char* Ab = (const char*)A; const char* B0b = (const char*)B0; const char* B1b = (const char*)B1;
  const unsigned wdst = (unsigned)(uintptr_t)smc + (unsigned)w * 2048u;
  const int swz = (l31 >> 2) & 3;
  unsigned fo[2];
#pragma unroll
  for (int kk = 0; kk < 2; kk++) fo[kk] = (unsigned)(((2 * kk + h) ^ swz) * 16);
  const char* rA = smc + (wm * 64 + l31) * 64;
  const char* rB0 = smc + 8192 + (wn * 64 + l31) * 64;
  const char* rB1 = smc + 16384 + (wn * 64 + l31) * 64;
  const int nk = K >> 5;
  auto issue = [&](auto BUF, int ko) {
    constexpr int buf = decltype(BUF)::value;
#pragma unroll
    for (int i = 0; i < 2; i++) {
      __builtin_amdgcn_global_load_lds((const unsigned*)(Ab + (size_t)ko * 2 + aoff[i]), (LAS3 unsigned*)(uintptr_t)(wdst + buf * 24576 + i * 1024), 16, 0, 0);
      __builtin_amdgcn_global_load_lds((const unsigned*)(B0b + (size_t)ko * 2 + boff[i]), (LAS3 unsigned*)(uintptr_t)(wdst + buf * 24576 + 8192 + i * 1024), 16, 0, 0);
      __builtin_amdgcn_global_load_lds((const unsigned*)(B1b + (size_t)ko * 2 + boff[i]), (LAS3 unsigned*)(uintptr_t)(wdst + buf * 24576 + 16384 + i * 1024), 16, 0, 0);
    }
  };
  auto comp = [&](auto BUF) {
    constexpr int buf = decltype(BUF)::value;
#pragma unroll
    for (int kk = 0; kk < 2; kk++) {
      bf16x8 af[2], b0[2], b1[2];
#pragma unroll
      for (int mb = 0; mb < 2; mb++) af[mb] = *(const bf16x8*)(rA + buf * 24576 + mb * 32 * 64 + fo[kk]);
#pragma unroll
      for (int nb = 0; nb < 2; nb++) { b0[nb] = *(const bf16x8*)(rB0 + buf * 24576 + nb * 32 * 64 + fo[kk]); b1[nb] = *(const bf16x8*)(rB1 + buf * 24576 + nb * 32 * 64 + fo[kk]); }
#pragma unroll
      for (int mb = 0; mb < 2; mb++)
#pragma unroll
        for (int nb = 0; nb < 2; nb++) { accP[mb][nb] = MFMA(af[mb], b0[nb], accP[mb][nb]); accQ[mb][nb] = MFMA(af[mb], b1[nb], accQ[mb][nb]); }
    }
  };
  using S0 = std::integral_constant<int, 0>; using S1 = std::integral_constant<int, 1>;
  issue(S0{}, 0);
  __syncthreads();
  for (int ks = 0; ks < nk; ks += 2) {
    issue(S1{}, (ks + 1) * 32);
    __builtin_amdgcn_sched_barrier(0);
    comp(S0{});
    __syncthreads();
    if (ks + 2 < nk) issue(S0{}, (ks + 2) * 32);
    __builtin_amdgcn_sched_barrier(0);
    comp(S1{});
    __syncthreads();
  }
}

DI void acc_to_lds(const f32x16 (&acc)[2][2], float* ep) {
  const int t = tid(), lane = t & 63, w = t >> 6, wm = w >> 1, wn = w & 1, l31 = lane & 31, h = lane >> 5;
#pragma unroll
  for (int mb = 0; mb < 2; mb++)
#pragma unroll
    for (int nb = 0; nb < 2; nb++)
#pragma unroll
      for (int i = 0; i < 16; i++) ep[(wm * 64 + mb * 32 + crow(i, h)) * EPW + wn * 64 + nb * 32 + l31] = acc[mb][nb][i];
}
DI void acc_to_lds4(const f32x4 (&acc)[4][4], float* ep) {
  const int t = tid(), lane = t & 63, w = t >> 6, wm = w >> 1, wn = w & 1, r16 = lane & 15, q = lane >> 4;
#pragma unroll
  for (int mb = 0; mb < 4; mb++)
#pragma unroll
    for (int nb = 0; nb < 4; nb++) {
      float* d = ep + (wm * 64 + mb * 16 + q * 4) * EPW + wn * 64 + nb * 16 + r16;
      d[0] = acc[mb][nb].x; d[EPW] = acc[mb][nb].y; d[2 * EPW] = acc[mb][nb].z; d[3 * EPW] = acc[mb][nb].w;
    }
}
template <class F>
DI void rowwise(const float* ep, F f) {
  const int t = tid();
#pragma unroll 1
  for (int ps = 0; ps < 8; ps++) {
    const int row = ps * 16 + (t >> 4), c8 = (t & 15) * 8;
    float v[8];
    const f32x4 a = *(const f32x4*)(ep + row * EPW + c8), b = *(const f32x4*)(ep + row * EPW + c8 + 4);
    v[0] = a.x; v[1] = a.y; v[2] = a.z; v[3] = a.w; v[4] = b.x; v[5] = b.y; v[6] = b.z; v[7] = b.w;
    f(row, c8, v);
  }
}
template <class L, class F>
DI void rowwise2(const float* ep, L pre, F f) {
  const int t = tid();
  const int c8 = (t & 15) * 8;
#pragma unroll 1
  for (int g = 0; g < 2; g++) {
    decltype(pre(0, 0)) ld[4];
#pragma unroll
    for (int q = 0; q < 4; q++) ld[q] = pre((g * 4 + q) * 16 + (t >> 4), c8);
#pragma unroll
    for (int q = 0; q < 4; q++) {
      const int row = (g * 4 + q) * 16 + (t >> 4);
      float v[8];
      const f32x4 a = *(const f32x4*)(ep + row * EPW + c8), b = *(const f32x4*)(ep + row * EPW + c8 + 4);
      v[0] = a.x; v[1] = a.y; v[2] = a.z; v[3] = a.w; v[4] = b.x; v[5] = b.y; v[6] = b.z; v[7] = b.w;
      f(row, c8, v, ld[q]);
    }
  }
}
struct LdRope { f32x4 r[4]; };
struct LdKv { unsigned k2; u32x4 x1, x2; f32x4 r[4]; };
struct LdX { f32x4 a, b; };
struct LdGlu { u32x4 yg, gt; };
template <class F>
DI void tstore(const float* ep, int cb, int nc, const float* rowscale, F dst) {
  const int t = tid();
  const int ntask = nc * 16;
  for (int e = t; e < ntask; e += 256) {
    const int col = e % nc, rg = e / nc;
    float v[8];
#pragma unroll
    for (int j = 0; j < 8; j++) { float x = ep[(rg * 8 + j) * EPW + cb + col]; if (rowscale) x *= rowscale[rg * 8 + j]; v[j] = x; }
    *(u32x4*)(dst(col) + rg * 8) = pack8(v);
  }
}

DI void tile_from_linear(int L, int nN, int& tm, int& tn) { const int band = L / (8 * nN), rr = L % (8 * nN); tn = rr >> 3; tm = band * 8 + (rr & 7); }
DI int static_L(int round, int vb) { const int Gx = gridDim.x >> 3; return (round * 8 + (vb & 7)) * Gx + (vb >> 3); }
DI int next_item(unsigned* ctr, int* slot) {
  __syncthreads();
  if (threadIdx.x == 0) *slot = (int)atomicAdd(ctr, 1u);
  __syncthreads();
  return *slot;
}

DI int colmap(int mode, int n) {
  if (mode == 0) return n;
  if (mode == 1) { if (n < 768) return n; if (n < 2304) return n + 1056; if (n < 3360) return n - 1536; if (n < 3456) return -1; return n - 96; }
  { const int hh = n >> 7, j = n & 127; return j < 96 ? hh * 96 + j : -1; }
}
struct CDesc { const float* src; const float* g; bf16_t* dst; int ld, K, mode, it; };
DI void conv_load(const CDesc& d, f32x4 (&v)[8]) {
  const int t = tid();
  const int nkt = d.K >> 6, kt = d.it % nkt, nt = d.it / nkt, k0 = kt * 64, n0 = nt * 128;
  const int n4 = (t & 31) * 4, c = colmap(d.mode, n0 + n4);
#pragma unroll
  for (int i = 0; i < 8; i++) {
    const int kk = (t >> 5) + 8 * i;
    if (c >= 0) v[i] = *(const f32x4*)(d.src + (long)(k0 + kk) * d.ld + c); else { v[i].x = 0.f; v[i].y = 0.f; v[i].z = 0.f; v[i].w = 0.f; }
  }
}
DI void conv_finish(const CDesc& d, f32x4 (&v)[8], float* sm) {
  const int t = tid();
  const int nkt = d.K >> 6, kt = d.it % nkt, nt = d.it / nkt, k0 = kt * 64, n0 = nt * 128;
  const int n4 = (t & 31) * 4;
#pragma unroll
  for (int i = 0; i < 8; i++) {
    const int kk = (t >> 5) + 8 * i;
    if (d.g) { const float gg = d.g[k0 + kk]; v[i].x *= gg; v[i].y *= gg; v[i].z *= gg; v[i].w *= gg; }
    *(f32x4*)(sm + kk * 132 + n4) = v[i];
  }
  __syncthreads();
#pragma unroll
  for (int i = 0; i < 2; i++) {
    const int nn = (t >> 2) + 64 * i, ks = (t & 3) * 16;
    float f[16];
#pragma unroll
    for (int j = 0; j < 16; j++) f[j] = sm[(ks + j) * 132 + nn];
    u32x4 o0, o1;
    o0.x = pk2(f[0], f[1]); o0.y = pk2(f[2], f[3]); o0.z = pk2(f[4], f[5]); o0.w = pk2(f[6], f[7]);
    o1.x = pk2(f[8], f[9]); o1.y = pk2(f[10], f[11]); o1.z = pk2(f[12], f[13]); o1.w = pk2(f[14], f[15]);
    bf16_t* dd = d.dst + (long)(n0 + nn) * d.K + k0 + ks;
    *(u32x4*)dd = o0; *(u32x4*)(dd + 8) = o1;
  }
  __syncthreads();
}
constexpr int NCONV = 944 + 96 + 32 + 8 + 32 + 64 + 32 + 32 + 128 + 64;
constexpr int NAUX = NCONV + 512;
DI CDesc conv_desc(const P& p, int l, int it) {
  CDesc d; d.g = nullptr; d.mode = 0;
  if (it < 944) { d.src = p.w_in + (long)l * 1024 * INW; d.ld = INW; d.K = 1024; d.mode = 1; d.g = p.norm_g + l * 1024; d.dst = p.WinT; d.it = it; return d; }
  it -= 944;
  if (it < 96) { d.src = p.b_w_uq + (long)l * 768 * 768; d.ld = 768; d.K = 768; d.mode = 2; d.g = p.b_q_norm_g + l * 768; d.dst = p.WuqT; d.it = it; return d; }
  it -= 96;
  if (it < 32) { d.src = p.b_w_ukv + (long)l * 256 * 1024; d.ld = 1024; d.K = 256; d.g = p.b_kv_norm_g + l * 256; d.dst = p.WukvT; d.it = it; return d; }
  it -= 32;
  if (it < 8) { d.src = p.c_w_glu + (long)l * 256 * 256; d.ld = 256; d.K = 256; d.dst = p.WgluT; d.it = it; return d; }
  it -= 8;
  if (it < 32) { d.src = p.w_br_a + (long)l * 256 * 1024; d.ld = 1024; d.K = 256; d.dst = p.WbrT; d.it = it; return d; }
  it -= 32;
  if (it < 64) { d.src = p.w_br_b + (long)l * 512 * 1024; d.ld = 1024; d.K = 512; d.dst = p.WbrT + 1024 * 256; d.it = it; return d; }
  it -= 64;
  if (it < 32) { d.src = p.w_br_c + (long)l * 256 * 1024; d.ld = 1024; d.K = 256; d.dst = p.WbrT + 1024 * 768; d.it = it; return d; }
  it -= 32;
  if (it < 32) { d.src = p.w_br_m + (long)l * 256 * 1024; d.ld = 1024; d.K = 256; d.dst = p.WbrT + 1024 * 1024; d.it = it; return d; }
  it -= 32;
  if (it < 128) { d.src = p.w_out + (long)l * 1024 * 1024; d.ld = 1024; d.K = 1024; d.dst = p.WoutT + (long)l * 1024 * 1024; d.it = it; return d; }
  it -= 128;
  d.src = p.m_w_kv + (long)l * 1024 * 512; d.ld = 512; d.K = 1024; d.dst = p.WmkvT; d.it = it; return d;
}
DI void conv_all(const P& p, int l, char* smem) {
  const int G = gridDim.x, bid = blockIdx.x;
  float* sm = (float*)smem;
  if (bid >= NCONV) return;
  f32x4 va[8], vb[8];
  CDesc da = conv_desc(p, l, bid), db = da;
  conv_load(da, va);
#pragma unroll 1
  for (int it = bid; it < NCONV; it += 2 * G) {
    const bool h1 = it + G < NCONV;
    if (h1) { db = conv_desc(p, l, it + G); conv_load(db, vb); }
    conv_finish(da, va, sm);
    const bool h2 = it + 2 * G < NCONV;
    if (h2) { da = conv_desc(p, l, it + 2 * G); conv_load(da, va); }
    if (h1) conv_finish(db, vb, sm);
  }
}
DI void aux_item(const P& p, int l, int it, char* smem) {
  it -= NCONV;
  {
    const int t = tid(), lane = t & 63, row = it * 4 + (t >> 6);
    const float* src = p.mem + (long)row * 1024; const float* g = p.m_norm_g + l * 1024;
    f32x4 v[4]; float ss = 0.f;
#pragma unroll
    for (int i = 0; i < 4; i++) { v[i] = *(const f32x4*)(src + (lane + 64 * i) * 4); ss += v[i].x * v[i].x + v[i].y * v[i].y + v[i].z * v[i].z + v[i].w * v[i].w; }
    ss = sum64(ss);
    const float r = rsqrtf(ss * (1.f / 1024.f) + EPS);
#pragma unroll
    for (int i = 0; i < 4; i++) {
      const f32x4 gg = *(const f32x4*)(g + (lane + 64 * i) * 4);
      u32x2 o; o.x = pk2(v[i].x * r * gg.x, v[i].y * r * gg.y); o.y = pk2(v[i].z * r * gg.z, v[i].w * r * gg.w);
      *(u32x2*)(p.hm + (long)row * 1024 + (lane + 64 * i) * 4) = o;
    }
  }
}

DI void p0_xrow_item(const P& p, int it) {
  const int t = tid(), lane = t & 63;
  f32x4 v[2][4];
#pragma unroll
  for (int r = 0; r < 2; r++) {
    const float* src = p.x + (long)(it * 8 + (t >> 6) * 2 + r) * 1024;
#pragma unroll
    for (int i = 0; i < 4; i++) v[r][i] = *(const f32x4*)(src + (lane + 64 * i) * 4);
  }
#pragma unroll
  for (int r = 0; r < 2; r++) {
    const int row = it * 8 + (t >> 6) * 2 + r;
    float ss = 0.f;
#pragma unroll
    for (int i = 0; i < 4; i++) ss += v[r][i].x * v[r][i].x + v[r][i].y * v[r][i].y + v[r][i].z * v[r][i].z + v[r][i].w * v[r][i].w;
    ss = sum64(ss);
#pragma unroll
    for (int i = 0; i < 4; i++) { u32x2 o; o.x = pk2(v[r][i].x, v[r][i].y); o.y = pk2(v[r][i].z, v[r][i].w); *(u32x2*)(p.xb + (long)row * 1024 + (lane + 64 * i) * 4) = o; }
    if (lane < 8) p.ssp[(long)lane * T_ + row] = (lane == 0) ? ss : 0.f;
  }
}
DI void p0_rope_item(const P& p, int it) {
  const int e = it * 256 + threadIdx.x, tok = e >> 4, i = e & 15;
  const float inv_freq = exp2f(-(float)i * (13.287712379549449f / 16.f));
  const float ang = (float)p.pos[tok] * inv_freq;
  const double rev = (double)ang * 0.15915494309189535;
  const float fr = (float)(rev - rint(rev));
  p.rope[(long)e * 2] = __builtin_amdgcn_cosf(fr);
  p.rope[(long)e * 2 + 1] = __builtin_amdgcn_sinf(fr);
}

DI void load_rs(const P& p, int r0, float* rsS) {
  const int t = tid();
  if (t < 128) { float s = 0.f;
#pragma unroll
    for (int j = 0; j < 8; j++) s += p.ssp[(long)j * T_ + r0 + t];
    rsS[t] = rsqrtf(s * (1.f / 1024.f) + EPS); }
}
DI void g1_tile(const P& p, int l, int tm, int tn, char* smem) {
  bf16_t* sm = (bf16_t*)smem; float* ep = (float*)smem; float* rsS = (float*)(smem + SM_RS);
  const int r0 = tm * 128, c0 = tn * 128;
  load_rs(p, r0, rsS);
  f32x4 acc[4][4]; zero_acc4(acc);
  gemm_loop_dma16(p.xb + (long)r0 * 1024, 1024, p.WinT + (long)c0 * 1024, 1024, 1024, acc, smem);
  acc_to_lds4(acc, ep);
  __syncthreads();
  int type; bf16_t* dst; int ld;
  if (c0 < 2304) { dst = p.z1 + c0; ld = Z1W;
    if (c0 < 512) type = 1; else if (c0 < 1280) type = 2; else if (c0 < 1536) type = 0; else if (c0 < 1792) type = 2; else if (c0 < 2048) type = 3; else type = 2;
  } else { dst = p.z2 + (c0 - 2304); ld = Z2W; type = 0; }
  const float* gq = p.m_qk_g_q + l * 64;
  rowwise(ep, [&](int row, int c8, float (&v)[8]) {
    const float r = rsS[row];
#pragma unroll
    for (int j = 0; j < 8; j++) v[j] *= r;
    if (type == 1) {
#pragma unroll
      for (int j = 0; j < 8; j++) v[j] = gelu_t(v[j]);
    } else if (type == 2) {
#pragma unroll
      for (int j = 0; j < 8; j++) v[j] = silu(v[j]);
    } else if (type == 3) {
      float ss = 0.f;
#pragma unroll
      for (int j = 0; j < 8; j++) ss += v[j] * v[j];
      ss = sum8(ss);
      const float rq = rsqrtf(ss * (1.f / 64.f) + EPS) * (0.125f * LOG2E);
#pragma unroll
      for (int j = 0; j < 8; j++) v[j] *= rq * gq[(c8 & 63) + j];
    }
    *(u32x4*)(dst + (long)(r0 + row) * ld + c8) = pack8(v);
    if (c0 >= 2304) {
      float ss = 0.f;
#pragma unroll
      for (int j = 0; j < 8; j++) ss += v[j] * v[j];
      ss = sum16(ss);
      if ((c8 >> 3) == 0) p.ssq[(long)((c0 - 2304) >> 7) * T_ + r0 + row] = ss;
    }
  });
  __syncthreads();
}
DI void g1m_tile(const P& p, int l, int tm, int tn, char* smem) {
  bf16_t* sm = (bf16_t*)smem; float* ep = (float*)smem;
  const int r0 = tm * 128, c0 = tn * 128;
  f32x4 acc[4][4]; zero_acc4(acc);
  gemm_loop_dma16(p.hm + (long)r0 * 1024, 1024, p.WmkvT + (long)c0 * 1024, 1024, 1024, acc, smem);
  acc_to_lds4(acc, ep);
  __syncthreads();
  if (tn < 2) {
    const float* gk = p.m_qk_g_k + l * 64;
    rowwise(ep, [&](int row, int c8, float (&v)[8]) {
      float ss = 0.f;
#pragma unroll
      for (int j = 0; j < 8; j++) ss += v[j] * v[j];
      ss = sum8(ss);
      const float rq = rsqrtf(ss * (1.f / 64.f) + EPS);
#pragma unroll
      for (int j = 0; j < 8; j++) v[j] *= rq * gk[(c8 & 63) + j];
      *(u32x4*)(p.memk + (long)(r0 + row) * 256 + c0 + c8) = pack8(v);
    });
  } else {
    const int b = r0 >> 8, m0 = r0 & 255, cv0 = c0 - 256;
    tstore(ep, 0, 128, nullptr, [&](int col) { const int cv = cv0 + col; return p.memvt + ((long)((b * 4 + (cv >> 6)) * 64 + (cv & 63))) * 256 + m0; });
  }
  __syncthreads();
}

DI void g2q_tile(const P& p, int l, int tm, int hh, char* smem) {
  bf16_t* sm = (bf16_t*)smem; float* ep = (float*)smem; float* ssS = (float*)(smem + SM_SS);
  const int r0 = tm * 128;
  f32x4 acc[4][4]; zero_acc4(acc);
  { const int t = tid(); if (t < 128) { float q = 0.f;
#pragma unroll
      for (int j = 0; j < 6; j++) q += p.ssq[(long)j * T_ + r0 + t];
      ssS[t] = rsqrtf(q * (1.f / 768.f) + EPS); } }
  gemm_loop_dma16(p.z2 + (long)r0 * Z2W, Z2W, p.WuqT + (long)hh * 128 * 768, 768, 768, acc, smem);
  acc_to_lds4(acc, ep);
  __syncthreads();
  const float* gq = p.b_qk_g_q + l * 96;
  const float QSC = 0.10206207261596575f * LOG2E;
  rowwise2(ep, [&](int row, int c8) {
    LdRope L;
    const int tc = c8 >> 3;
    if (tc >= 8 && tc < 12) {
      const float* rp = p.rope + ((long)(r0 + row) * 16 + (tc & 1) * 8) * 2;
#pragma unroll
      for (int j = 0; j < 4; j++) L.r[j] = *(const f32x4*)(rp + 4 * j);
    } else {
#pragma unroll
      for (int j = 0; j < 4; j++) { L.r[j].x = 0.f; L.r[j].y = 0.f; L.r[j].z = 0.f; L.r[j].w = 0.f; }
    }
    return L;
  }, [&](int row, int c8, float (&v)[8], const LdRope& L) {
    const float rs = ssS[row];
    float ss = 0.f;
#pragma unroll
    for (int j = 0; j < 8; j++) { v[j] *= rs; ss += v[j] * v[j]; }
    ss = sum16(ss);
    const float rq = rsqrtf(ss * (1.f / 96.f) + EPS);
    const int tc = c8 >> 3;
    bf16_t* qd = p.qf + (long)(r0 + row) * 768 + hh * 96;
    if (tc < 8) {
#pragma unroll
      for (int j = 0; j < 8; j++) v[j] *= rq * gq[c8 + j] * QSC;
      *(u32x4*)(qd + c8) = pack8(v);
    } else if (tc < 12) {
      const int i0 = (tc & 1) * 8; const bool first = tc < 10;
      const int pc = first ? 80 + i0 : 64 + i0;
      const float csn[16] = {L.r[0].x, L.r[0].y, L.r[0].z, L.r[0].w, L.r[1].x, L.r[1].y, L.r[1].z, L.r[1].w,
                             L.r[2].x, L.r[2].y, L.r[2].z, L.r[2].w, L.r[3].x, L.r[3].y, L.r[3].z, L.r[3].w};
      float o[8];
#pragma unroll
      for (int j = 0; j < 8; j++) {
        const float own = v[j] * rq * gq[c8 + j];
        const float oth = ep[row * EPW + pc + j] * rs * rq * gq[pc + j];
        const float cs = csn[2 * j], sn = csn[2 * j + 1];
        o[j] = (first ? (own * cs - oth * sn) : (own * cs + oth * sn)) * QSC;
      }
      *(u32x4*)(qd + c8) = pack8(o);
    }
  });
  __syncthreads();
}
DI void g2kv_tile(const P& p, int l, int tm, int hh, char* smem) {
  bf16_t* sm = (bf16_t*)smem; float* ep = (float*)smem; float* ssS = (float*)(smem + SM_SS);
  const int r0 = tm * 128;
  f32x4 acc[4][4]; zero_acc4(acc);
  { const int t = tid(); if (t < 128) { const float q = p.ssq[(long)6 * T_ + r0 + t] + p.ssq[(long)7 * T_ + r0 + t];
      ssS[t] = rsqrtf(q * (1.f / 256.f) + EPS); } }
  gemm_loop_dma16(p.z2 + (long)r0 * Z2W + 768, Z2W, p.WukvT + (long)hh * 128 * 256, 256, 256, acc, smem);
  acc_to_lds4(acc, ep);
  __syncthreads();
  const float* gk = p.b_qk_g_k + l * 96;
  rowwise2(ep, [&](int row, int c8) {
    LdKv L;
    const int tc = c8 >> 3;
    const bf16_t* krp = p.z2 + (long)(r0 + row) * Z2W + 1024;
    L.k2 = *(const unsigned*)(krp + 2 * tc);
    if (tc >= 8 && tc < 12) {
      const int i0 = (tc & 1) * 8;
      L.x1 = *(const u32x4*)(krp + i0); L.x2 = *(const u32x4*)(krp + 16 + i0);
      const float* rp = p.rope + ((long)(r0 + row) * 16 + i0) * 2;
#pragma unroll
      for (int j = 0; j < 4; j++) L.r[j] = *(const f32x4*)(rp + 4 * j);
    } else {
      L.x1.x = 0; L.x1.y = 0; L.x1.z = 0; L.x1.w = 0; L.x2 = L.x1;
#pragma unroll
      for (int j = 0; j < 4; j++) { L.r[j].x = 0.f; L.r[j].y = 0.f; L.r[j].z = 0.f; L.r[j].w = 0.f; }
    }
    return L;
  }, [&](int row, int c8, float (&v)[8], const LdKv& L) {
    const float rs = ssS[row];
    const int tc = c8 >> 3;
    const unsigned k2 = L.k2;
    const float ka = __uint_as_float(k2 << 16), kb = __uint_as_float(k2 & 0xffff0000u);
    float ss = ka * ka + kb * kb;
    if (tc < 8) {
#pragma unroll
      for (int j = 0; j < 8; j++) { v[j] *= rs; ss += v[j] * v[j]; }
    }
    ss = sum16(ss);
    const float kn = rsqrtf(ss * (1.f / 96.f) + EPS);
    bf16_t* kd = p.kf + (long)(r0 + row) * 768 + hh * 96;
    if (tc < 8) {
#pragma unroll
      for (int j = 0; j < 8; j++) v[j] *= kn * gk[c8 + j];
      *(u32x4*)(kd + c8) = pack8(v);
    } else if (tc < 12) {
      const int i0 = (tc & 1) * 8; const bool first = tc < 10;
      float x1[8], x2[8], o[8];
      unpack8(L.x1, x1);
      unpack8(L.x2, x2);
      const float csn[16] = {L.r[0].x, L.r[0].y, L.r[0].z, L.r[0].w, L.r[1].x, L.r[1].y, L.r[1].z, L.r[1].w,
                             L.r[2].x, L.r[2].y, L.r[2].z, L.r[2].w, L.r[3].x, L.r[3].y, L.r[3].z, L.r[3].w};
#pragma unroll
      for (int j = 0; j < 8; j++) {
        const float a = x1[j] * kn * gk[64 + i0 + j], b = x2[j] * kn * gk[80 + i0 + j];
        const float cs = csn[2 * j], sn = csn[2 * j + 1];
        o[j] = first ? (a * cs - b * sn) : (b * cs + a * sn);
      }
      *(u32x4*)(kd + (first ? 64 : 80) + i0) = pack8(o);
    }
  });
  {
    const int b = r0 >> 11, s0 = r0 & 2047;
    tstore(ep, 64, 64, ssS, [&](int col) { return p.vt + ((long)((b * 8 + hh) * 64 + col)) * S_ + s0; });
  }
  __syncthreads();
}

template <int DQK, bool CAUSAL>
DI void attn_item(const bf16_t* __restrict__ q, long q_ld, const bf16_t* __restrict__ k, long k_ld, const bf16_t* __restrict__ vt, long vt_ld,
                  bf16_t* og, long o_ld, int q0, int nkt, char* smem, bool dry) {
  constexpr int KS = DQK + 8, NKC = DQK / 8, NKL = (64 * NKC) / 256, NKK = DQK / 16, VS = 68;
  bf16_t* sK = (bf16_t*)smem;
  bf16_t* sV = (bf16_t*)smem + 2 * 64 * KS;
  const int t = tid(), lane = t & 63, w = t >> 6, l31 = lane & 31, h = lane >> 5;
  bf16x8 qfr[NKK];
  {
    const bf16_t* qp = q + (long)(w * 32 + l31) * q_ld + h * 8;
#pragma unroll
    for (int kk = 0; kk < NKK; kk++) qfr[kk] = *(const bf16x8*)(qp + kk * 16);
  }
  u32x4 rk[NKL], rv[2];
  auto gload = [&](int kt) {
#pragma unroll
    for (int i = 0; i < NKL; i++) { const int c = t + 256 * i, key = c / NKC, kc = c % NKC; rk[i] = *(const u32x4*)(k + (long)(kt * 64 + key) * k_ld + kc * 8); }
#pragma unroll
    for (int i = 0; i < 2; i++) { const int c = t + 256 * i, d = c >> 3, kc = c & 7; rv[i] = *(const u32x4*)(vt + (long)d * vt_ld + kt * 64 + kc * 8); }
  };
  auto lstore = [&](int buf) {
    bf16_t* dK = sK + buf * 64 * KS; bf16_t* dV = sV + buf * 64 * VS;
#pragma unroll
    for (int i = 0; i < NKL; i++) { const int c = t + 256 * i, key = c / NKC, kc = c % NKC; *(u32x4*)(dK + key * KS + kc * 8) = rk[i]; }
#pragma unroll
    for (int i = 0; i < 2; i++) { const int c = t + 256 * i, d = c >> 3, kc = c & 7;
      u32x2 lo, hi; lo.x = rv[i].x; lo.y = rv[i].y; hi.x = rv[i].z; hi.y = rv[i].w;
      *(u32x2*)(dV + d * VS + kc * 8) = lo; *(u32x2*)(dV + d * VS + kc * 8 + 4) = hi; }
  };
  f32x16 o[2];
#pragma unroll
  for (int i = 0; i < 16; i++) { o[0][i] = 0.f; o[1][i] = 0.f; }
  float m = -1e30f, lsum = 0.f;
  const int qpos = q0 + w * 32 + l31;
  gload(0); lstore(0);
  if (nkt > 1) gload(1);
  __syncthreads();
  for (int kt = 0; kt < nkt; kt++) {
    if (kt + 1 < nkt) lstore((kt + 1) & 1);
    __builtin_amdgcn_sched_barrier(0);
    if (kt + 2 < nkt) gload(kt + 2);
    __builtin_amdgcn_sched_barrier(0);
    const bool active = !CAUSAL || (kt * 64 <= q0 + w * 32 + 31);
    if (active) {
      const bf16_t* cK = sK + (kt & 1) * 64 * KS; const bf16_t* cV = sV + (kt & 1) * 64 * VS;
      f32x16 s[2];
#pragma unroll
      for (int i = 0; i < 16; i++) { s[0][i] = 0.f; s[1][i] = 0.f; }
#pragma unroll
      for (int kb = 0; kb < 2; kb++)
#pragma unroll
        for (int kk = 0; kk < NKK; kk++) {
          const bf16x8 kf_ = *(const bf16x8*)(cK + (kb * 32 + l31) * KS + kk * 16 + h * 8);
          s[kb] = MFMA(kf_, qfr[kk], s[kb]);
        }
      if (CAUSAL && (kt * 64 + 63 > q0 + w * 32)) {
#pragma unroll
        for (int kb = 0; kb < 2; kb++)
#pragma unroll
          for (int i = 0; i < 16; i++) { const int key = kt * 64 + kb * 32 + crow(i, h); if (key > qpos) s[kb][i] = -1e30f; }
      }
      float mx = s[0][0];
#pragma unroll
      for (int kb = 0; kb < 2; kb++)
#pragma unroll
        for (int i = 0; i < 16; i++) mx = fmaxf(mx, s[kb][i]);
      mx = fmaxf(mx, __shfl_xor(mx, 32));
      const float mnew = fmaxf(m, mx);
      const float alpha = __builtin_amdgcn_exp2f(m - mnew);
      m = mnew;
      float ps = 0.f;
#pragma unroll
      for (int kb = 0; kb < 2; kb++)
#pragma unroll
        for (int i = 0; i < 16; i++) { const float pv = __builtin_amdgcn_exp2f(s[kb][i] - mnew); s[kb][i] = pv; ps += pv; }
      lsum = lsum * alpha + ps;
#pragma unroll
      for (int i = 0; i < 16; i++) { o[0][i] *= alpha; o[1][i] *= alpha; }
#pragma unroll
      for (int kb = 0; kb < 2; kb++)
#pragma unroll
        for (int st = 0; st < 2; st++) {
          u32x4 pp; pp.x = pk2(s[kb][8 * st + 0], s[kb][8 * st + 1]); pp.y = pk2(s[kb][8 * st + 2], s[kb][8 * st + 3]);
          pp.z = pk2(s[kb][8 * st + 4], s[kb][8 * st + 5]); pp.w = pk2(s[kb][8 * st + 6], s[kb][8 * st + 7]);
          const bf16x8 pf = __builtin_bit_cast(bf16x8, pp);
#pragma unroll
          for (int db = 0; db < 2; db++) {
            const bf16_t* vp = cV + (db * 32 + l31) * VS + kb * 32 + st * 16 + 4 * h;
            const u32x2 lo = *(const u32x2*)vp, hi = *(const u32x2*)(vp + 8);
            u32x4 vv; vv.x = lo.x; vv.y = lo.y; vv.z = hi.x; vv.w = hi.y;
            o[db] = MFMA(__builtin_bit_cast(bf16x8, vv), pf, o[db]);
          }
        }
    }
    __syncthreads();
  }
  lsum += __shfl_xor(lsum, 32);
  const float inv = 1.f / lsum;
  bf16_t* op = og + (long)(w * 32 + l31) * o_ld;
#pragma unroll
  for (int db = 0; db < 2; db++)
#pragma unroll
    for (int ig = 0; ig < 4; ig++) {
      const int d = db * 32 + ig * 8 + 4 * h;
      float gt[4]; unpack4(*(const u32x2*)(op + d), gt);
      u32x2 r; r.x = pk2(o[db][4 * ig + 0] * inv * gt[0], o[db][4 * ig + 1] * inv * gt[1]); r.y = pk2(o[db][4 * ig + 2] * inv * gt[2], o[db][4 * ig + 3] * inv * gt[3]);
      if (!dry) *(u32x2*)(op + d) = r;
    }
}
DI void mattn_item(const P& p, int idx, char* smem) {
  const int b = idx >> 6, hh = (idx >> 4) & 3, qt = idx & 15;
  const long tok0 = (long)b * S_ + qt * 128;
  attn_item<64, false>(p.z1 + tok0 * Z1W + 1792 + hh * 64, Z1W, p.memk + (long)b * 256 * 256 + hh * 64, 256,
                       p.memvt + (long)(b * 4 + hh) * 64 * 256, 256, p.z1 + tok0 * Z1W + 2048 + hh * 64, Z1W, 0, 4, smem, p.dry != 0);
}
DI void battn_item(const P& p, int idx, char* smem) {
  const int qt = 15 - (idx >> 6), bh = idx & 63, b = bh >> 3, hh = bh & 7;
  const long tok0 = (long)b * S_ + qt * 128;
  attn_item<96, true>(p.qf + tok0 * 768 + hh * 96, 768, p.kf + (long)b * S_ * 768 + hh * 96, 768,
                      p.vt + (long)(b * 8 + hh) * 64 * S_, S_, p.z1 + tok0 * Z1W + 768 + hh * 64, Z1W, qt * 128, 2 * qt + 2, smem, p.dry != 0);
}

DI void a_item(const P& p, int l, int idx, char* smem) {
  bf16_t* vnT = (bf16_t*)smem;
  float* part = (float*)(smem + 256 * 136 * 2);
  const int t = tid(); const long r0 = (long)idx * 128;
  {
    const int row = t & 127, half = t >> 7;
    const bf16_t* src = p.z1 + (r0 + row) * Z1W + 256 + half * 128;
    float ss = 0.f;
#pragma unroll 4
    for (int i = 0; i < 16; i++) { float f[8]; unpack8(*(const u32x4*)(src + i * 8), f);
#pragma unroll
      for (int j = 0; j < 8; j++) ss += f[j] * f[j]; }
    part[half * 128 + row] = ss;
    __syncthreads();
    const float r = rsqrtf((part[row] + part[128 + row]) * (1.f / 256.f) + EPS);
    const float* gv = p.a_norm_g + l * 256 + half * 128;
#pragma unroll 4
    for (int i = 0; i < 16; i++) { float f[8]; unpack8(*(const u32x4*)(src + i * 8), f);
#pragma unroll
      for (int j = 0; j < 8; j++) vnT[(half * 128 + i * 8 + j) * 136 + row] = f2bf(f[j] * r * gv[i * 8 + j]); }
  }
  __syncthreads();
  const int lane = t & 63, g = t >> 6, l31 = lane & 31, h = lane >> 5;
  const float* W = p.a_w_s + (long)(l * 4 + g) * 128 * 128;
  const float* bs = p.a_b_s + (l * 4 + g) * 128;
#pragma unroll 1
  for (int mh = 0; mh < 2; mh++) {
    f32x16 acc[2][2]; zero_acc(acc);
#pragma unroll 2
    for (int kk = 0; kk < 8; kk++) {
      bf16x8 af[2], bfr[2];
#pragma unroll
      for (int mb = 0; mb < 2; mb++) {
        const int tt = mh * 64 + mb * 32 + l31, s0 = kk * 16 + h * 8;
        const f32x4 w0 = *(const f32x4*)(W + tt * 128 + s0), w1 = *(const f32x4*)(W + tt * 128 + s0 + 4);
        float f[8] = {w0.x, w0.y, w0.z, w0.w, w1.x, w1.y, w1.z, w1.w};
#pragma unroll
        for (int j = 0; j < 8; j++) if (s0 + j > tt) f[j] = 0.f;
        af[mb] = __builtin_bit_cast(bf16x8, pack8(f));
      }
#pragma unroll
      for (int nb = 0; nb < 2; nb++) bfr[nb] = *(const bf16x8*)(vnT + (g * 64 + nb * 32 + l31) * 136 + kk * 16 + h * 8);
#pragma unroll
      for (int mb = 0; mb < 2; mb++)
#pragma unroll
        for (int nb = 0; nb < 2; nb++) acc[mb][nb] = MFMA(af[mb], bfr[nb], acc[mb][nb]);
    }
#pragma unroll
    for (int mb = 0; mb < 2; mb++)
#pragma unroll
      for (int nb = 0; nb < 2; nb++)
#pragma unroll
        for (int i = 0; i < 16; i++) {
          const int tt = mh * 64 + mb * 32 + crow(i, h), col = g * 64 + nb * 32 + l31;
          bf16_t* zp = p.z1 + (r0 + tt) * Z1W;
          const float u = bf2f(zp[col]), gt = bf2f(zp[512 + col]);
          if (!p.dry) zp[col] = f2bf(u * (acc[mb][nb][i] + bs[tt]) * gt);
        }
  }
  __syncthreads();
}

DI void c_setup(const P& p, int l, int g, int lane, float& ar, float& ai, float (&Br)[16], float (&Bi)[16]) {
  const int gi = (l * 16 + g) * 64 + lane;
  const float lre = p.c_a_re[gi], lim = p.c_a_im[gi];
  const float dt = expf(p.c_log_dt[l * 16 + g]);
  const float mag = expf(lre * dt);
  const float angf = lim * dt;
  const double rev = (double)angf * 0.15915494309189535;
  const float rf = (float)((rev - rint(rev)) * 6.283185307179586);
  const float sn = sinf(rf), cs = cosf(rf);
  ar = mag * cs; ai = mag * sn;
  const float xr = ar - 1.f, xi = ai, den = 1.f / (lre * lre + lim * lim);
  const float cr = (xr * lre + xi * lim) * den, ci = (xi * lre - xr * lim) * den;
  const float* bre = p.c_b_re + (long)gi * 16; const float* bim = p.c_b_im + (long)gi * 16;
#pragma unroll
  for (int c4 = 0; c4 < 4; c4++) {
    const f32x4 r4 = *(const f32x4*)(bre + c4 * 4), i4 = *(const f32x4*)(bim + c4 * 4);
    const float rr[4] = {r4.x, r4.y, r4.z, r4.w}, ii[4] = {i4.x, i4.y, i4.z, i4.w};
#pragma unroll
    for (int j = 0; j < 4; j++) { Br[c4 * 4 + j] = cr * rr[j] - ci * ii[j]; Bi[c4 * 4 + j] = cr * ii[j] + ci * rr[j]; }
  }
}
DI void c_load_u(const P& p, long tok0, int g, int lane, float* ub) {
  const bf16_t* up = p.z1 + (tok0 + lane) * Z1W + 1280 + g * 16;
  float f0[8], f1[8];
  unpack8(*(const u32x4*)up, f0); unpack8(*(const u32x4*)(up + 8), f1);
  f32x4 a; a.x = f0[0]; a.y = f0[1]; a.z = f0[2]; a.w = f0[3]; *(f32x4*)(ub + lane * 16) = a;
  a.x = f0[4]; a.y = f0[5]; a.z = f0[6]; a.w = f0[7]; *(f32x4*)(ub + lane * 16 + 4) = a;
  a.x = f1[0]; a.y = f1[1]; a.z = f1[2]; a.w = f1[3]; *(f32x4*)(ub + lane * 16 + 8) = a;
  a.x = f1[4]; a.y = f1[5]; a.z = f1[6]; a.w = f1[7]; *(f32x4*)(ub + lane * 16 + 12) = a;
}
DI void c_step(const float* ub, int s, const float (&Br)[16], const float (&Bi)[16], float ar, float ai, float& sr, float& si) {
  float bur = 0.f, bui = 0.f;
#pragma unroll
  for (int c4 = 0; c4 < 4; c4++) {
    const f32x4 u = *(const f32x4*)(ub + s * 16 + c4 * 4);
    bur += Br[c4 * 4] * u.x + Br[c4 * 4 + 1] * u.y + Br[c4 * 4 + 2] * u.z + Br[c4 * 4 + 3] * u.w;
    bui += Bi[c4 * 4] * u.x + Bi[c4 * 4 + 1] * u.y + Bi[c4 * 4 + 2] * u.z + Bi[c4 * 4 + 3] * u.w;
  }
  const float nr = ar * sr - ai * si + bur, ni = ar * si + ai * sr + bui;
  sr = nr; si = ni;
}
DI void c1_item(const P& p, int l, int idx, char* smem) {
  const int t = tid(), lane = t & 63, w = t >> 6;
  const int b = idx >> 7, g = (idx >> 3) & 15, k = (idx & 7) * 4 + w;
  float* ub = (float*)smem + w * 1024;
  float ar, ai, Br[16], Bi[16];
  c_setup(p, l, g, lane, ar, ai, Br, Bi);
  const long tok0 = (long)b * S_ + k * 64;
  c_load_u(p, tok0, g, lane, ub);
  __syncthreads();
  float sr = 0.f, si = 0.f;
#pragma unroll 2
  for (int s = 0; s < 64; s++) c_step(ub, s, Br, Bi, ar, ai, sr, si);
  f32x2 e; e.x = sr; e.y = si;
  *(f32x2*)(p.carry + ((long)((b * 16 + g) * 32 + k) * 64 + lane) * 2) = e;
  __syncthreads();
}
DI void c3_item(const P& p, int l, int idx, char* smem) {
  const int t = tid(), lane = t & 63, w = t >> 6;
  const int b = idx >> 7, g = (idx >> 3) & 15, k = (idx & 7) * 4 + w;
  float* ub = (float*)(smem + w * 12288);
  bf16_t* stb = (bf16_t*)(smem + w * 12288 + 4096);
  const int c = lane & 15, sq = lane >> 4;
  bf16x8 cfr[4];
  {
    const float* cre = p.c_c_re + (long)(l * 16 + g) * 1024 + c * 64; const float* cim = p.c_c_im + (long)(l * 16 + g) * 1024 + c * 64;
#pragma unroll
    for (int ks = 0; ks < 4; ks++) {
      const f32x4 r4 = *(const f32x4*)(cre + ks * 16 + sq * 4), i4 = *(const f32x4*)(cim + ks * 16 + sq * 4);
      u32x4 pk; pk.x = pk2(r4.x, -i4.x); pk.y = pk2(r4.y, -i4.y); pk.z = pk2(r4.z, -i4.z); pk.w = pk2(r4.w, -i4.w);
      cfr[ks] = __builtin_bit_cast(bf16x8, pk);
    }
  }
  float ar, ai, Br[16], Bi[16];
  c_setup(p, l, g, lane, ar, ai, Br, Bi);
  const long tok0 = (long)b * S_ + k * 64;
  c_load_u(p, tok0, g, lane, ub);
  float lr = ar, li = ai;
#pragma unroll
  for (int i = 0; i < 6; i++) { const float nr = lr * lr - li * li, ni = 2.f * lr * li; lr = nr; li = ni; }
  float sr = 0.f, si = 0.f;
  {
    const float* cp = p.carry + ((long)((b * 16 + g) * 32) * 64 + lane) * 2;
    for (int j0 = 0; j0 < k; j0 += 8) {
      f32x2 e[8];
#pragma unroll
      for (int jj = 0; jj < 8; jj++) { e[jj].x = 0.f; e[jj].y = 0.f; if (j0 + jj < k) e[jj] = *(const f32x2*)(cp + (long)(j0 + jj) * 128); }
#pragma unroll
      for (int jj = 0; jj < 8; jj++) if (j0 + jj < k) { const float nr = lr * sr - li * si + e[jj].x, ni = lr * si + li * sr + e[jj].y; sr = nr; si = ni; }
    }
  }
  __syncthreads();
  const float dsk = p.c_d[l * 256 + g * 16 + c];
#pragma unroll 1
  for (int sb = 0; sb < 4; sb++) {
#pragma unroll 2
    for (int s2 = 0; s2 < 16; s2++) {
      c_step(ub, sb * 16 + s2, Br, Bi, ar, ai, sr, si);
      *(unsigned*)(stb + s2 * 136 + 2 * lane) = pk2(sr, si);
    }
    asm volatile("s_waitcnt lgkmcnt(0)" ::: "memory");
    __builtin_amdgcn_wave_barrier();
    f32x4 y; y.x = 0.f; y.y = 0.f; y.z = 0.f; y.w = 0.f;
#pragma unroll
    for (int ks = 0; ks < 4; ks++) {
      const bf16x8 af = *(const bf16x8*)(stb + c * 136 + ks * 32 + sq * 8);
      y = __builtin_amdgcn_mfma_f32_16x16x32_bf16(af, cfr[ks], y, 0, 0, 0);
    }
    const float yy[4] = {y.x, y.y, y.z, y.w};
#pragma unroll
    for (int qq = 0; qq < 4; qq++) {
      const int sa = sb * 16 + sq * 4 + qq;
      const float yv = gelu_t(yy[qq] + dsk * ub[sa * 16 + c]);
      if (!p.dry) p.z1[(tok0 + sa) * Z1W + 1280 + g * 16 + c] = f2bf(yv);
    }
    asm volatile("s_waitcnt lgkmcnt(0)" ::: "memory");
    __builtin_amdgcn_wave_barrier();
  }
  __syncthreads();
}

DI void glu_tile(const P& p, int l, int tm, int tn, char* smem) {
  bf16_t* sm = (bf16_t*)smem; float* ep = (float*)smem;
  const int r0 = tm * 128, c0 = tn * 128;
  f32x4 acc[4][4]; zero_acc4(acc);
  gemm_loop_dma16(p.z1 + (long)r0 * Z1W + 1280, Z1W, p.WgluT + (long)c0 * 256, 256, 256, acc, smem);
  acc_to_lds4(acc, ep);
  __syncthreads();
  const float* bg = p.c_b_glu + l * 256 + c0;
  rowwise2(ep, [&](int row, int c8) {
    LdGlu L;
    const bf16_t* zp = p.z1 + (long)(r0 + row) * Z1W + c0 + c8;
    L.yg = *(const u32x4*)(zp + 1280); L.gt = *(const u32x4*)(zp + 1536);
    return L;
  }, [&](int row, int c8, float (&v)[8], const LdGlu& L) {
    bf16_t* zp = p.z1 + (long)(r0 + row) * Z1W + c0 + c8;
    float yg[8], gt[8];
    unpack8(L.yg, yg); unpack8(L.gt, gt);
#pragma unroll
    for (int j = 0; j < 8; j++) v[j] = yg[j] * sigm(v[j] + bg[c8 + j]) * gt[j];
    if (!p.dry) *(u32x4*)(zp + 1536) = pack8(v);
  });
  __syncthreads();
}

DI void pf_tile(const P& p, int l, int tm, int tn, char* smem) {
  float* ep = (float*)smem; float* rsS = (float*)(smem + SM_RS);
  const int t = tid(), lane = t & 63, w = t >> 6, wm = w >> 1, wn = w & 1, l31 = lane & 31, h = lane >> 5;
  const int r0 = tm * 128, c0 = tn * 128;
  load_rs(p, r0, rsS);
  unsigned mrgp[2][2][8];
#pragma unroll
  for (int a = 0; a < 2; a++)
#pragma unroll
    for (int b = 0; b < 2; b++)
#pragma unroll
      for (int i = 0; i < 8; i++) mrgp[a][b][i] = 0u;
#pragma unroll 1
  for (int pr = 0; pr < 2; pr++) {
    unsigned gp[2][2][2][8];
    {
      f32x16 accP[2][2], accQ[2][2]; zero_acc(accP); zero_acc(accQ);
      const bf16_t* wg = p.WinT + (long)(3456 + (2 * pr) * 1024 + c0) * 1024;
      gemm_loop_dma2(p.xb + (long)r0 * 1024, 1024, wg, wg + (long)1024 * 1024, 1024, 1024, accP, accQ, smem);
      const float* bm = p.b_merge + l * 4096 + (2 * pr) * 1024 + c0;
#pragma unroll
      for (int mb = 0; mb < 2; mb++)
#pragma unroll
        for (int nb = 0; nb < 2; nb++) {
          const float bias0 = bm[wn * 64 + nb * 32 + l31], bias1 = bm[1024 + wn * 64 + nb * 32 + l31];
#pragma unroll
          for (int i = 0; i < 16; i += 2) {
            const float ra = rsS[wm * 64 + mb * 32 + crow(i, h)], rb = rsS[wm * 64 + mb * 32 + crow(i + 1, h)];
            gp[0][mb][nb][i >> 1] = pk2n(sigm(accP[mb][nb][i] * ra + bias0), sigm(accP[mb][nb][i + 1] * rb + bias0));
            gp[1][mb][nb][i >> 1] = pk2n(sigm(accQ[mb][nb][i] * ra + bias1), sigm(accQ[mb][nb][i + 1] * rb + bias1));
          }
        }
    }
#pragma unroll
    for (int j = 0; j < 2; j++) {
      const int br = 2 * pr + j;
      const int yoff = br == 0 ? 0 : (br == 1 ? 768 : (br == 2 ? 1536 : 2048));
      const int Kb = br == 1 ? 512 : 256;
      const long woff = br == 0 ? 0 : (br == 1 ? 1024 * 256 : (br == 2 ? 1024 * 768 : 1024 * 1024));
      f32x16 acc[2][2]; zero_acc(acc);
      gemm_loop_dma(p.z1 + (long)r0 * Z1W + yoff, Z1W, p.WbrT + woff + (long)c0 * Kb, Kb, Kb, acc, smem);
#pragma unroll
      for (int mb = 0; mb < 2; mb++)
#pragma unroll
        for (int nb = 0; nb < 2; nb++)
#pragma unroll
          for (int i = 0; i < 16; i += 2) {
            const unsigned g2 = gp[j][mb][nb][i >> 1], m2 = mrgp[mb][nb][i >> 1];
            const float m0 = __uint_as_float(m2 << 16) + __uint_as_float(g2 << 16) * acc[mb][nb][i];
            const float m1 = __uint_as_float(m2 & 0xffff0000u) + __uint_as_float(g2 & 0xffff0000u) * acc[mb][nb][i + 1];
            mrgp[mb][nb][i >> 1] = pk2(m0, m1);
          }
    }
  }
  {
    f32x16 mrg[2][2];
#pragma unroll
    for (int a = 0; a < 2; a++)
#pragma unroll
      for (int b = 0; b < 2; b++)
#pragma unroll
        for (int i = 0; i < 16; i += 2) { const unsigned m2 = mrgp[a][b][i >> 1]; mrg[a][b][i] = __uint_as_float(m2 << 16); mrg[a][b][i + 1] = __uint_as_float(m2 & 0xffff0000u); }
    acc_to_lds(mrg, ep);
  }
  __syncthreads();
  rowwise(ep, [&](int row, int c8, float (&v)[8]) { *(u32x4*)(p.mg + (long)(r0 + row) * 1024 + c0 + c8) = pack8(v); });
  __syncthreads();
}

DI void out_tile(const P& p, int l, int tm, int tn, char* smem) {
  bf16_t* sm = (bf16_t*)smem; float* ep = (float*)smem;
  const int r0 = tm * 128, c0 = tn * 128;
  f32x4 acc[4][4]; zero_acc4(acc);
  gemm_loop_dma16(p.mg + (long)r0 * 1024, 1024, p.WoutT + (long)l * 1024 * 1024 + (long)c0 * 1024, 1024, 1024, acc, smem);
  acc_to_lds4(acc, ep);
  __syncthreads();
  const float* xin = (l == 0) ? p.x : p.out;
  rowwise2(ep, [&](int row, int c8) {
    LdX L;
    const long off = (long)(r0 + row) * 1024 + c0 + c8;
    L.a = *(const f32x4*)(xin + off); L.b = *(const f32x4*)(xin + off + 4);
    return L;
  }, [&](int row, int c8, float (&v)[8], const LdX& L) {
    const long off = (long)(r0 + row) * 1024 + c0 + c8;
    const f32x4 a = L.a, b = L.b;
    v[0] += a.x; v[1] += a.y; v[2] += a.z; v[3] += a.w; v[4] += b.x; v[5] += b.y; v[6] += b.z; v[7] += b.w;
    f32x4 oa, ob; oa.x = v[0]; oa.y = v[1]; oa.z = v[2]; oa.w = v[3]; ob.x = v[4]; ob.y = v[5]; ob.z = v[6]; ob.w = v[7];
    if (!p.dry) { *(f32x4*)(p.out + off) = oa; *(f32x4*)(p.out + off + 4) = ob; }
    if (l == 0) {
      *(u32x4*)(p.xb + off) = pack8(v);
      float ss = 0.f;
#pragma unroll
      for (int j = 0; j < 8; j++) ss += v[j] * v[j];
      ss = sum16(ss);
      if ((c8 >> 3) == 0) p.ssp[(long)tn * T_ + r0 + row] = ss;
    }
  });
  __syncthreads();
}

DI void run_phase(const P& p, int ph, char* smem, int vb) {
  const int G = gridDim.x, bid = blockIdx.x;
  int* slot = (int*)(smem + SM_MISC);
  if (ph == 0) {
    conv_all(p, 0, smem);
    for (int it = NCONV + bid; it < NAUX; it += G) aux_item(p, 0, it, smem);
    for (int it = bid; it < 2048; it += G) p0_xrow_item(p, it);
    for (int it = bid; it < 1024; it += G) p0_rope_item(p, it);
    return;
  }
  const int l = (ph - 1) / 6, s = (ph - 1) % 6;
  if (s == 0) {
    const int total = 3456 + 64, nr = (total + G - 1) / G;
    for (int r = 0; r < nr; r++) {
      const int L = static_L(r, vb);
      if (L >= total) continue;
      int tm, tn;
      if (L < 3456) { tile_from_linear(L, 27, tm, tn); g1_tile(p, l, tm, tn, smem); }
      else { tile_from_linear(L - 3456, 4, tm, tn); g1m_tile(p, l, tm, tn, smem); }
    }
  } else if (s == 1) {
    const long dm = p.dry;
    {
      const int total = 1024, nr = (total + G - 1) / G;
      if (!dm || (dm & 2)) for (int r = 0; r < nr; r++) { const int L = static_L(r, vb); if (L >= total) continue; int tm, tn; tile_from_linear(L, 8, tm, tn); g2q_tile(p, l, tm, tn, smem); }
      if (!dm || (dm & 8)) for (int r = 0; r < nr; r++) { const int L = static_L(r, vb); if (L >= total) continue; int tm, tn; tile_from_linear(L, 8, tm, tn); g2kv_tile(p, l, tm, tn, smem); }
    }
    if (!dm || (dm & 4)) for (int it = vb; it < 512; it += G) mattn_item(p, it, smem);
    {
      const bool split = (G >= 256);
      if (!dm || (dm & 16)) { const int a1 = split ? 128 : 128; for (int it = vb; it < a1; it += G) a_item(p, l, it, smem); }
      const int cstep = split ? (vb < 128 ? 1024 : G - 128) : G;
      if (!dm || (dm & 32)) {
#pragma unroll 1
        for (int it = vb; it < 1024; it += cstep) c1_item(p, l, it, smem);
      }
    }
  } else if (s == 2) {
    const long dm = p.dry;
    if (G == 512) {
#pragma unroll 1
      for (int j = 0; j < 4; j++) {
        if (j < 2) { if (dm && !(dm & 2)) continue; battn_item(p, j ? 1023 - vb : vb, smem); }
        else { if (dm && !(dm & 4)) continue; c3_item(p, l, vb + (j - 2) * 512, smem); }
      }
    } else {
#pragma unroll 1
      for (int it = vb; it < 2048; it += G) {
        if (it < 1024) { if (dm && !(dm & 2)) continue; battn_item(p, it, smem); } else { if (dm && !(dm & 4)) continue; c3_item(p, l, it - 1024, smem); }
      }
    }
  } else if (s == 3) {
    for (int it = bid; it < 256; it += G) glu_tile(p, l, it >> 1, it & 1, smem);
  } else if (s == 4) {
    const int total = 1024, nr = (total + G - 1) / G;
    for (int r = 0; r < nr; r++) { const int L = static_L(r, vb); if (L >= total) continue; int tm, tn; tile_from_linear(L, 8, tm, tn); pf_tile(p, l, tm, tn, smem); }
  } else {
    const int total = 1024, nr = (total + G - 1) / G;
    for (int r = 0; r < nr; r++) { const int L = static_L(r, vb); if (L >= total) continue; int tm, tn; tile_from_linear(L, 8, tm, tn); out_tile(p, l, tm, tn, smem); }
    if (l == 0) { conv_all(p, 1, smem); for (int it = NCONV + bid; it < NAUX; it += G) aux_item(p, 1, it, smem); }
  }
}

DI unsigned xb_ld(unsigned* q) { return __hip_atomic_load(q, __ATOMIC_RELAXED, __HIP_MEMORY_SCOPE_AGENT); }
DI unsigned xb_add(unsigned* q, unsigned v) { return __hip_atomic_fetch_add(q, v, __ATOMIC_RELAXED, __HIP_MEMORY_SCOPE_AGENT); }
DI void gbar(unsigned* bar, const int* st) {
  asm volatile("s_waitcnt vmcnt(0)" ::: "memory");
  __syncthreads();
  if (threadIdx.x == 0) {
    __builtin_amdgcn_s_waitcnt(0);
    const unsigned x = (unsigned)st[0], nloc = (unsigned)st[1], nx = (unsigned)st[2];
    const unsigned old = xb_add(&bar[1024 + 64 * x], 1u);
    const unsigned gen = old / nloc;
    if (old + 1u == (gen + 1u) * nloc) {
      __builtin_amdgcn_fence(__ATOMIC_RELEASE, "agent");
      asm volatile("s_waitcnt vmcnt(0)" ::: "memory");
      const unsigned og = xb_add(&bar[3072], 1u);
      const unsigned tg = og / nx;
      if (og + 1u == (tg + 1u) * nx) xb_add(&bar[3136], 1u);
      else while (xb_ld(&bar[3136]) == tg) __builtin_amdgcn_s_sleep(1);
      __builtin_amdgcn_fence(__ATOMIC_ACQUIRE, "agent");
      xb_add(&bar[2048 + 64 * x], 1u);
      asm volatile("s_waitcnt vmcnt(0)" ::: "memory");
    } else {
      while (xb_ld(&bar[2048 + 64 * x]) == gen) __builtin_amdgcn_s_sleep(1);
      __builtin_amdgcn_fence(__ATOMIC_ACQUIRE, "agent");
      asm volatile("s_waitcnt vmcnt(0)" ::: "memory");
    }
  }
  __syncthreads();
}

#if MK_MULTI
__global__ void __launch_bounds__(256, 2) hyb_phase(P p, int ph) {
  __shared__ __attribute__((aligned(16))) char smem[SM_TOTAL];
  run_phase(p, ph, smem, blockIdx.x);
}
#else
__global__ void __launch_bounds__(256, 2) hyb_mega(P p) {
  __shared__ __attribute__((aligned(16))) char smem[SM_TOTAL];
  cg::grid_group grid = cg::this_grid();
  if (p.dry == 0x7fffffff) grid.sync();
  int vb;
  {
    int* sl = (int*)(smem + SM_MISC) + 2;
    if (threadIdx.x == 0) {
      const unsigned xcc = (unsigned)__builtin_amdgcn_s_getreg((3 << 11) | 20) & 7u;
      const unsigned loc = xb_add(p.ctr + 40 + xcc, 1u);
      const unsigned Gx = gridDim.x >> 3;
      *sl = (loc < Gx) ? (int)(loc * 8 + xcc) : -1;
      unsigned sum, cnt, mine;
      for (;;) {
        sum = 0u; cnt = 0u; mine = 0u;
        for (unsigned j = 0; j < 8; ++j) { const unsigned c = xb_ld(p.ctr + 40 + j); sum += c; cnt += (c > 0u) ? 1u : 0u; mine = (j == xcc) ? c : mine; }
        if (sum == gridDim.x) break;
        __builtin_amdgcn_s_sleep(1);
      }
      sl[2] = (int)xcc; sl[3] = (int)mine; sl[4] = (int)cnt;
    }
    __syncthreads();
    vb = blockIdx.x;
  }
  const int* bst = (const int*)(smem + SM_MISC) + 4;
#ifdef DRY_PH
  P pd = p; { int one = DRY_MASK; asm volatile("" : "+s"(one)); pd.dry = one; }
#endif
#pragma unroll 1
  for (int ph = 0; ph < 13; ph++) {
#ifdef DRY_PH
    if (ph == DRY_PH) { run_phase(pd, ph, smem, vb); gbar(p.bar, bst); }
#endif
    run_phase(p, ph, smem, vb);
    if (ph < 12) gbar(p.bar, bst);
  }
}
#endif

extern "C" void kernel_launch(void* const* d_in, const int* in_sizes, int n_in, void* d_out, int out_size, void* d_ws, size_t ws_size, hipStream_t stream) {
  P p{};
  p.x = (const float*)d_in[0]; p.mem = (const float*)d_in[1]; p.pos = (const int*)d_in[2];
  p.norm_g = (const float*)d_in[3]; p.w_in = (const float*)d_in[4]; p.b_merge = (const float*)d_in[5];
  p.a_norm_g = (const float*)d_in[6]; p.a_w_s = (const float*)d_in[7]; p.a_b_s = (const float*)d_in[8];
  p.b_q_norm_g = (const float*)d_in[9]; p.b_kv_norm_g = (const float*)d_in[10]; p.b_w_uq = (const float*)d_in[11]; p.b_w_ukv = (const float*)d_in[12];
  p.b_qk_g_q = (const float*)d_in[13]; p.b_qk_g_k = (const float*)d_in[14];
  p.c_a_re = (const float*)d_in[15]; p.c_a_im = (const float*)d_in[16]; p.c_log_dt = (const float*)d_in[17];
  p.c_b_re = (const float*)d_in[18]; p.c_b_im = (const float*)d_in[19]; p.c_c_re = (const float*)d_in[20]; p.c_c_im = (const float*)d_in[21];
  p.c_d = (const float*)d_in[22]; p.c_w_glu = (const float*)d_in[23]; p.c_b_glu = (const float*)d_in[24];
  p.m_norm_g = (const float*)d_in[25]; p.m_w_kv = (const float*)d_in[26]; p.m_qk_g_q = (const float*)d_in[27]; p.m_qk_g_k = (const float*)d_in[28];
  p.w_br_a = (const float*)d_in[29]; p.w_br_b = (const float*)d_in[30]; p.w_br_c = (const float*)d_in[31]; p.w_br_m = (const float*)d_in[32];
  p.w_out = (const float*)d_in[33];
  p.out = (float*)d_out;
  char* ws = (char*)d_ws; size_t off = 0;
  auto take = [&](size_t bytes) { char* r = ws + off; off += (bytes + 255) & ~(size_t)255; return r; };
  p.z1 = (bf16_t*)take((size_t)T_ * Z1W * 2);
  p.z2 = (bf16_t*)take((size_t)T_ * Z2W * 2);
  p.xb = (bf16_t*)take((size_t)T_ * 1024 * 2);
  p.qf = (bf16_t*)take((size_t)T_ * 768 * 2);
  p.kf = (bf16_t*)take((size_t)T_ * 768 * 2);
  p.mg = p.qf;
  p.vt = (bf16_t*)take((size_t)8 * 8 * 64 * S_ * 2);
  p.hm = (bf16_t*)take((size_t)2048 * 1024 * 2);
  p.memk = (bf16_t*)take((size_t)2048 * 256 * 2);
  p.memvt = (bf16_t*)take((size_t)2048 * 256 * 2);
  p.WinT = (bf16_t*)take((size_t)NWIN * 1024 * 2);
  p.WuqT = (bf16_t*)take((size_t)1024 * 768 * 2);
  p.WukvT = (bf16_t*)take((size_t)1024 * 256 * 2);
  p.WgluT = (bf16_t*)take((size_t)256 * 256 * 2);
  p.WbrT = (bf16_t*)take((size_t)1024 * 1280 * 2);
  p.WoutT = (bf16_t*)take((size_t)2 * 1024 * 1024 * 2);
  p.WmkvT = (bf16_t*)take((size_t)512 * 1024 * 2);
  p.ssp = (float*)take((size_t)8 * T_ * 4);
  p.ssq = (float*)take((size_t)9 * T_ * 4);
  p.rope = (float*)take((size_t)T_ * 32 * 4);
  p.carry = (float*)take((size_t)8 * 16 * 32 * 64 * 2 * 4);
  p.ctr = (unsigned*)take(256);
  p.bar = (unsigned*)take(16384);
  if (off > ws_size) { fprintf(stderr, "workspace too small: need %zu have %zu\n", off, ws_size); return; }

  static int grid_blocks = 0;
  if (!grid_blocks) {
    int dev = 0, cus = 0, per_cu = 0;
    hipGetDevice(&dev);
    hipDeviceGetAttribute(&cus, hipDeviceAttributeMultiprocessorCount, dev);
#if MK_MULTI
    hipOccupancyMaxActiveBlocksPerMultiprocessor(&per_cu, hyb_phase, 256, 0);
#else
    hipOccupancyMaxActiveBlocksPerMultiprocessor(&per_cu, hyb_mega, 256, 0);
#endif
    if (per_cu > 2) per_cu = 2;
    if (per_cu < 1) per_cu = 1;
    grid_blocks = cus * per_cu;
    grid_blocks &= ~7;
  }
#if MK_MULTI
  for (int ph = 0; ph < 13; ph++) hipLaunchKernelGGL(hyb_phase, dim3(grid_blocks), dim3(256), 0, stream, p, ph);
#else
  hipMemsetAsync(p.ctr, 0, 256 + 16384, stream);
  void* args[] = {&p};
  hipError_t e = hipLaunchCooperativeKernel((void*)hyb_mega, dim3(grid_blocks), dim3(256), args, 0, stream);
  if (e != hipSuccess) fprintf(stderr, "cooperative launch failed: %s (grid %d)\n", hipGetErrorString(e), grid_blocks);
#endif
}
```

```cpp
#include <hip/hip_runtime.h>
#include <hip/hip_cooperative_groups.h>
#include <stdint.h>
#include <stdio.h>
#include <type_traits>
namespace cg = cooperative_groups;

#ifndef MK_MULTI
#define MK_MULTI 0
#endif

typedef unsigned short bf16_t;
typedef short bf16x8 __attribute__((ext_vector_type(8)));
typedef short s16x4 __attribute__((ext_vector_type(4)));
typedef float f32x16 __attribute__((ext_vector_type(16)));
typedef float f32x4 __attribute__((ext_vector_type(4)));
typedef float f32x2 __attribute__((ext_vector_type(2)));
typedef unsigned u32x4 __attribute__((ext_vector_type(4)));
typedef unsigned u32x2 __attribute__((ext_vector_type(2)));
#define DI __device__ __forceinline__
#define MFMA(a, b, c) __builtin_amdgcn_mfma_f32_32x32x16_bf16((a), (b), (c), 0, 0, 0)

constexpr int T_ = 16384, S_ = 2048;
constexpr int INW = 7456;
constexpr int Z1W = 2304, Z2W = 1152;
constexpr int NWIN = 7552;
constexpr float EPS = 1e-6f;
constexpr float LOG2E = 1.4426950408889634f;
constexpr int LDT = 72;
constexpr int EPW = 132;
constexpr int SM_MAIN = 4 * 128 * LDT * 2;
constexpr int SM_RS = SM_MAIN;
constexpr int SM_SS = SM_MAIN + 512;
constexpr int SM_MISC = SM_MAIN + 1024;
constexpr int SM_TOTAL = SM_MAIN + 1024 + 64;

struct P {
  const float* x; const float* mem; const int* pos;
  const float* norm_g; const float* w_in; const float* b_merge; const float* a_norm_g; const float* a_w_s; const float* a_b_s;
  const float* b_q_norm_g; const float* b_kv_norm_g; const float* b_w_uq; const float* b_w_ukv; const float* b_qk_g_q; const float* b_qk_g_k;
  const float* c_a_re; const float* c_a_im; const float* c_log_dt; const float* c_b_re; const float* c_b_im; const float* c_c_re; const float* c_c_im;
  const float* c_d; const float* c_w_glu; const float* c_b_glu;
  const float* m_norm_g; const float* m_w_kv; const float* m_qk_g_q; const float* m_qk_g_k;
  const float* w_br_a; const float* w_br_b; const float* w_br_c; const float* w_br_m; const float* w_out;
  float* out;
  bf16_t* z1; bf16_t* z2; bf16_t* xb; bf16_t* qf; bf16_t* kf; bf16_t* mg; bf16_t* vt; bf16_t* hm; bf16_t* memk; bf16_t* memvt;
  bf16_t* WinT; bf16_t* WuqT; bf16_t* WukvT; bf16_t* WgluT; bf16_t* WbrT; bf16_t* WoutT; bf16_t* WmkvT;
  float* ssp; float* ssq; float* rope; float* carry; unsigned* ctr; unsigned* bar;
  long dry;
};

DI int tid() { int t = threadIdx.x; asm volatile("" : "+v"(t)); return t; }
DI float bf2f(bf16_t b) { return __uint_as_float(((unsigned)b) << 16); }
DI unsigned pk2(float lo, float hi) { unsigned r; asm("v_cvt_pk_bf16_f32 %0, %1, %2" : "=v"(r) : "v"(lo), "v"(hi)); return r; }
DI unsigned pk2n(float lo, float hi) { unsigned r; asm("s_nop 1\n\tv_cvt_pk_bf16_f32 %0, %1, %2" : "=v"(r) : "v"(lo), "v"(hi)); return r; }
DI bf16_t f2bf(float x) { return (bf16_t)(pk2(x, 0.f) & 0xffffu); }
DI void unpack8(u32x4 v, float (&f)[8]) {
  f[0] = __uint_as_float(v.x << 16); f[1] = __uint_as_float(v.x & 0xffff0000u);
  f[2] = __uint_as_float(v.y << 16); f[3] = __uint_as_float(v.y & 0xffff0000u);
  f[4] = __uint_as_float(v.z << 16); f[5] = __uint_as_float(v.z & 0xffff0000u);
  f[6] = __uint_as_float(v.w << 16); f[7] = __uint_as_float(v.w & 0xffff0000u);
}
DI void unpack4(u32x2 v, float (&f)[4]) {
  f[0] = __uint_as_float(v.x << 16); f[1] = __uint_as_float(v.x & 0xffff0000u);
  f[2] = __uint_as_float(v.y << 16); f[3] = __uint_as_float(v.y & 0xffff0000u);
}
DI u32x4 pack8(const float (&f)[8]) { u32x4 r; r.x = pk2(f[0], f[1]); r.y = pk2(f[2], f[3]); r.z = pk2(f[4], f[5]); r.w = pk2(f[6], f[7]); return r; }
DI float sigm(float x) { return __builtin_amdgcn_rcpf(1.f + __expf(-x)); }
DI float silu(float x) { return x * sigm(x); }
DI float gelu_t(float x) { return x * sigm(1.5957691216057308f * (x + 0.044715f * x * x * x)); }
DI float sum16(float v) { v += __shfl_xor(v, 1); v += __shfl_xor(v, 2); v += __shfl_xor(v, 4); v += __shfl_xor(v, 8); return v; }
DI float sum8(float v) { v += __shfl_xor(v, 1); v += __shfl_xor(v, 2); v += __shfl_xor(v, 4); return v; }
DI float sum64(float v) { v = sum16(v); v += __shfl_xor(v, 16); v += __shfl_xor(v, 32); return v; }
DI int crow(int i, int h) { return (i & 3) + 8 * (i >> 2) + 4 * h; }
DI void zero_acc(f32x16 (&acc)[2][2]) {
#pragma unroll
  for (int a = 0; a < 2; a++)
#pragma unroll
    for (int b = 0; b < 2; b++)
#pragma unroll
      for (int i = 0; i < 16; i++) acc[a][b][i] = 0.f;
}

template <bool SS>
DI void gemm_loop(const bf16_t* __restrict__ A, long lda, const bf16_t* __restrict__ B, long ldb, int K,
                  f32x16 (&acc)[2][2], bf16_t* sm, float* ssS) {
  const int t = tid(), lane = t & 63, w = t >> 6, wm = w >> 1, wn = w & 1, l31 = lane & 31, h = lane >> 5;
  const int lr = t >> 3, lc = (t & 7) * 8;
  const bf16_t* ap = A + (long)lr * lda + lc;
  const bf16_t* bp = B + (long)lr * ldb + lc;
  bf16_t* wp = sm + lr * LDT + lc;
  const bf16_t* rA = sm + (wm * 64 + l31) * LDT + h * 8;
  const bf16_t* rB = sm + 2 * 128 * LDT + (wn * 64 + l31) * LDT + h * 8;
  u32x4 ra[4], rb[4];
  float ss[4] = {0.f, 0.f, 0.f, 0.f};
  const int nk = K >> 6;
  auto gl = [&](int ko) {
#pragma unroll
    for (int i = 0; i < 4; i++) { ra[i] = *(const u32x4*)(ap + (long)(32 * i) * lda + ko); rb[i] = *(const u32x4*)(bp + (long)(32 * i) * ldb + ko); }
  };
  auto st = [&](auto BUF) {
    constexpr int buf = decltype(BUF)::value;
#pragma unroll
    for (int i = 0; i < 4; i++) {
      *(u32x4*)(wp + buf * 128 * LDT + 32 * i * LDT) = ra[i];
      *(u32x4*)(wp + 2 * 128 * LDT + buf * 128 * LDT + 32 * i * LDT) = rb[i];
      if (SS) { float f[8]; unpack8(ra[i], f);
#pragma unroll
        for (int j = 0; j < 8; j++) ss[i] += f[j] * f[j]; }
    }
  };
  auto comp = [&](auto BUF) {
    constexpr int buf = decltype(BUF)::value;
#pragma unroll
    for (int kk = 0; kk < 4; kk++) {
      bf16x8 af[2], bfr[2];
#pragma unroll
      for (int mb = 0; mb < 2; mb++) af[mb] = *(const bf16x8*)(rA + buf * 128 * LDT + mb * 32 * LDT + kk * 16);
#pragma unroll
      for (int nb = 0; nb < 2; nb++) bfr[nb] = *(const bf16x8*)(rB + buf * 128 * LDT + nb * 32 * LDT + kk * 16);
#pragma unroll
      for (int mb = 0; mb < 2; mb++)
#pragma unroll
        for (int nb = 0; nb < 2; nb++) acc[mb][nb] = MFMA(af[mb], bfr[nb], acc[mb][nb]);
    }
  };
  using B0 = std::integral_constant<int, 0>; using B1 = std::integral_constant<int, 1>;
  gl(0);
  st(B0{});
  gl(64);
  __syncthreads();
  for (int ks = 0; ks < nk; ks += 2) {
    st(B1{});
    __builtin_amdgcn_sched_barrier(0);
    if (ks + 2 < nk) gl((ks + 2) * 64);
    __builtin_amdgcn_sched_barrier(0);
    comp(B0{});
    __syncthreads();
    if (ks + 2 < nk) st(B0{});
    __builtin_amdgcn_sched_barrier(0);
    if (ks + 3 < nk) gl((ks + 3) * 64);
    __builtin_amdgcn_sched_barrier(0);
    comp(B1{});
    __syncthreads();
  }
  if (SS) {
    const float inv = 1.0f / (float)K;
#pragma unroll
    for (int i = 0; i < 4; i++) { float s = sum8(ss[i]); if ((t & 7) == 0) ssS[lr + 32 * i] = rsqrtf(s * inv + EPS); }
  }
}

#define LAS3 __attribute__((address_space(3)))
struct GDesc { const bf16_t* A; long lda; const bf16_t* B; long ldb; };
DI void gemm_dma_stage0(const GDesc& d, char* smc) {
  const int t = tid(), lane = t & 63, w = t >> 6;
  const unsigned wdst = (unsigned)(uintptr_t)smc + (unsigned)w * 4096u;
#pragma unroll
  for (int i = 0; i < 4; i++) {
    const int row = 32 * w + 8 * i + (lane >> 3), c = (lane & 7) ^ ((row >> 1) & 7);
    __builtin_amdgcn_global_load_lds((const unsigned*)(d.A + row * d.lda + c * 8), (LAS3 unsigned*)(uintptr_t)(wdst + i * 1024), 16, 0, 0);
    __builtin_amdgcn_global_load_lds((const unsigned*)(d.B + row * d.ldb + c * 8), (LAS3 unsigned*)(uintptr_t)(wdst + 16384 + i * 1024), 16, 0, 0);
  }
}
DI void gemm_loop_dma(const bf16_t* __restrict__ A, long lda, const bf16_t* __restrict__ B, long ldb, int K, f32x16 (&acc)[2][2], char* smc,
                      bool started = false, bool has_next = false, GDesc next = GDesc{nullptr, 0, nullptr, 0}) {
  const int t = tid(), lane = t & 63, w = t >> 6, wm = w >> 1, wn = w & 1, l31 = lane & 31, h = lane >> 5;
  unsigned aoff[4], boff[4];
#pragma unroll
  for (int i = 0; i < 4; i++) {
    const int row = 32 * w + 8 * i + (lane >> 3), c = (lane & 7) ^ ((row >> 1) & 7);
    aoff[i] = (unsigned)((row * lda + c * 8) * 2); boff[i] = (unsigned)((row * ldb + c * 8) * 2);
  }
  const char* Ab = (const char*)A; const char* Bb = (const char*)B;
  const unsigned lbase = (unsigned)(uintptr_t)smc;
  const unsigned wdst = lbase + (unsigned)w * 4096u;
  const int swz = (l31 >> 1) & 7;
  unsigned fo[4];
#pragma unroll
  for (int kk = 0; kk < 4; kk++) fo[kk] = (unsigned)(((2 * kk + h) ^ swz) * 16);
  const char* rA = smc + (wm * 64 + l31) * 128;
  const char* rB = smc + 16384 + (wn * 64 + l31) * 128;
  const int nk = K >> 6;
  auto issue = [&](auto BUF, int ko) {
    constexpr int buf = decltype(BUF)::value;
#pragma unroll
    for (int i = 0; i < 4; i++) {
      __builtin_amdgcn_global_load_lds((const unsigned*)(Ab + (size_t)ko * 2 + aoff[i]), (LAS3 unsigned*)(uintptr_t)(wdst + buf * 32768 + i * 1024), 16, 0, 0);
      __builtin_amdgcn_global_load_lds((const unsigned*)(Bb + (size_t)ko * 2 + boff[i]), (LAS3 unsigned*)(uintptr_t)(wdst + buf * 32768 + 16384 + i * 1024), 16, 0, 0);
    }
  };
  auto comp = [&](auto BUF) {
    constexpr int buf = decltype(BUF)::value;
#pragma unroll
    for (int kk = 0; kk < 4; kk++) {
      bf16x8 af[2], bfr[2];
#pragma unroll
      for (int mb = 0; mb < 2; mb++) af[mb] = *(const bf16x8*)(rA + buf * 32768 + mb * 32 * 128 + fo[kk]);
#pragma unroll
      for (int nb = 0; nb < 2; nb++) bfr[nb] = *(const bf16x8*)(rB + buf * 32768 + nb * 32 * 128 + fo[kk]);
#pragma unroll
      for (int mb = 0; mb < 2; mb++)
#pragma unroll
        for (int nb = 0; nb < 2; nb++) acc[mb][nb] = MFMA(af[mb], bfr[nb], acc[mb][nb]);
    }
  };
  using B0 = std::integral_constant<int, 0>; using B1 = std::integral_constant<int, 1>;
  if (!started) issue(B0{}, 0);
  __syncthreads();
  for (int ks = 0; ks < nk; ks += 2) {
    issue(B1{}, (ks + 1) * 64);
    __builtin_amdgcn_sched_barrier(0);
    comp(B0{});
    __syncthreads();
    if (ks + 2 < nk) issue(B0{}, (ks + 2) * 64);
    else if (has_next) gemm_dma_stage0(next, smc);
    __builtin_amdgcn_sched_barrier(0);
    comp(B1{});
    __syncthreads();
  }
}

DI void gemm_loop_dma2(const bf16_t* __restrict__ A, long lda, const bf16_t* __restrict__ B0, const bf16_t* __restrict__ B1, long ldb, int K,
                       f32x16 (&accP)[2][2], f32x16 (&accQ)[2][2], char* smc) {
  const int t = tid(), lane = t & 63, w = t >> 6, wm = w >> 1, wn = w & 1, l31 = lane & 31, h = lane >> 5;
  unsigned aoff[2], boff[2];
#pragma unroll
  for (int i = 0; i < 2; i++) {
    const int row = 16 * (2 * w + i) + (lane >> 2), c = (lane & 3) ^ ((row >> 2) & 3);
    aoff[i] = (unsigned)((row * lda + c * 8) * 2); boff[i] = (unsigned)((row * ldb + c * 8) * 2);
  }
  const char* Ab = (const char*)A; const char* B0b = (const char*)B0; const char* B1b = (const char*)B1;
  const unsigned wdst = (unsigned)(uintptr_t)smc + (unsigned)w * 2048u;
  const int swz = (l31 >> 2) & 3;
  unsigned fo[2];
#pragma unroll
  for (int kk = 0; kk < 2; kk++) fo[kk] = (unsigned)(((2 * kk + h) ^ swz) * 16);
  const char* rA = smc + (wm * 64 + l31) * 64;
  const char* rB0 = smc + 8192 + (wn * 64 + l31) * 64;
  const char* rB1 = smc + 16384 + (wn * 64 + l31) * 64;
  const int nk = K >> 5;
  auto issue = [&](auto BUF, int ko) {
    constexpr int buf = decltype(BUF)::value;
#pragma unroll
    for (int i = 0; i < 2; i++) {
      __builtin_amdgcn_global_load_lds((const unsigned*)(Ab + (size_t)ko * 2 + aoff[i]), (LAS3 unsigned*)(uintptr_t)(wdst + buf * 24576 + i * 1024), 16, 0, 0);
      __builtin_amdgcn_global_load_lds((const unsigned*)(B0b + (size_t)ko * 2 + boff[i]), (LAS3 unsigned*)(uintptr_t)(wdst + buf * 24576 + 8192 + i * 1024), 16, 0, 0);
      __builtin_amdgcn_global_load_lds((const unsigned*)(B1b + (size_t)ko * 2 + boff[i]), (LAS3 unsigned*)(uintptr_t)(wdst + buf * 24576 + 16384 + i * 1024), 16, 0, 0);
    }
  };
  auto comp = [&](auto BUF) {
    constexpr int buf = decltype(BUF)::value;
#pragma unroll
    for (int kk = 0; kk < 2; kk++) {
      bf16x8 af[2], b0[2], b1[2];
#pragma unroll
      for (int mb = 0; mb < 2; mb++) af[mb] = *(const bf16x8*)(rA + buf * 24576 + mb * 32 * 64 + fo[kk]);
#pragma unroll
      for (int nb = 0; nb < 2; nb++) { b0[nb] = *(const bf16x8*)(rB0 + buf * 24576 + nb * 32 * 64 + fo[kk]); b1[nb] = *(const bf16x8*)(rB1 + buf * 24576 + nb * 32 * 64 + fo[kk]); }
#pragma unroll
      for (int mb = 0; mb < 2; mb++)
#pragma unroll
        for (int nb = 0; nb < 2; nb++) { accP[mb][nb] = MFMA(af[mb], b0[nb], accP[mb][nb]); accQ[mb][nb] = MFMA(af[mb], b1[nb], accQ[mb][nb]); }
    }
  };
  using S0 = std::integral_constant<int, 0>; using S1 = std::integral_constant<int, 1>;
  issue(S0{}, 0);
  __syncthreads();
  for (int ks = 0; ks < nk; ks += 2) {
    issue(S1{}, (ks + 1) * 32);
    __builtin_amdgcn_sched_barrier(0);
    comp(S0{});
    __syncthreads();
    if (ks + 2 < nk) issue(S0{}, (ks + 2) * 32);
    __builtin_amdgcn_sched_barrier(0);
    comp(S1{});
    __syncthreads();
  }
}

DI void acc_to_lds(const f32x16 (&acc)[2][2], float* ep) {
  const int t = tid(), lane = t & 63, w = t >> 6, wm = w >> 1, wn = w & 1, l31 = lane & 31, h = lane >> 5;
#pragma unroll
  for (int mb = 0; mb < 2; mb++)
#pragma unroll
    for (int nb = 0; nb < 2; nb++)
#pragma unroll
      for (int i = 0; i < 16; i++) ep[(wm * 64 + mb * 32 + crow(i, h)) * EPW + wn * 64 + nb * 32 + l31] = acc[mb][nb][i];
}
template <class F>
DI void rowwise(const float* ep, F f) {
  const int t = tid();
#pragma unroll 1
  for (int ps = 0; ps < 8; ps++) {
    const int row = ps * 16 + (t >> 4), c8 = (t & 15) * 8;
    float v[8];
    const f32x4 a = *(const f32x4*)(ep + row * EPW + c8), b = *(const f32x4*)(ep + row * EPW + c8 + 4);
    v[0] = a.x; v[1] = a.y; v[2] = a.z; v[3] = a.w; v[4] = b.x; v[5] = b.y; v[6] = b.z; v[7] = b.w;
    f(row, c8, v);
  }
}
template <class L, class F>
DI void rowwise2(const float* ep, L pre, F f) {
  const int t = tid();
  const int c8 = (t & 15) * 8;
#pragma unroll 1
  for (int g = 0; g < 2; g++) {
    decltype(pre(0, 0)) ld[4];
#pragma unroll
    for (int q = 0; q < 4; q++) ld[q] = pre((g * 4 + q) * 16 + (t >> 4), c8);
#pragma unroll
    for (int q = 0; q < 4; q++) {
      const int row = (g * 4 + q) * 16 + (t >> 4);
      float v[8];
      const f32x4 a = *(const f32x4*)(ep + row * EPW + c8), b = *(const f32x4*)(ep + row * EPW + c8 + 4);
      v[0] = a.x; v[1] = a.y; v[2] = a.z; v[3] = a.w; v[4] = b.x; v[5] = b.y; v[6] = b.z; v[7] = b.w;
      f(row, c8, v, ld[q]);
    }
  }
}
struct LdRope { f32x4 r[4]; };
struct LdKv { unsigned k2; u32x4 x1, x2; f32x4 r[4]; };
struct LdX { f32x4 a, b; };
struct LdGlu { u32x4 yg, gt; };
template <class F>
DI void tstore(const float* ep, int cb, int nc, const float* rowscale, F dst) {
  const int t = tid();
  const int ntask = nc * 16;
  for (int e = t; e < ntask; e += 256) {
    const int col = e % nc, rg = e / nc;
    float v[8];
#pragma unroll
    for (int j = 0; j < 8; j++) { float x = ep[(rg * 8 + j) * EPW + cb + col]; if (rowscale) x *= rowscale[rg * 8 + j]; v[j] = x; }
    *(u32x4*)(dst(col) + rg * 8) = pack8(v);
  }
}

DI void tile_from_linear(int L, int nN, int& tm, int& tn) { const int band = L / (8 * nN), rr = L % (8 * nN); tn = rr >> 3; tm = band * 8 + (rr & 7); }
DI int static_L(int round, int vb) { const int Gx = gridDim.x >> 3; return (round * 8 + (vb & 7)) * Gx + (vb >> 3); }
DI int next_item(unsigned* ctr, int* slot) {
  __syncthreads();
  if (threadIdx.x == 0) *slot = (int)atomicAdd(ctr, 1u);
  __syncthreads();
  return *slot;
}

DI int colmap(int mode, int n) {
  if (mode == 0) return n;
  if (mode == 1) { if (n < 768) return n; if (n < 2304) return n + 1056; if (n < 3360) return n - 1536; if (n < 3456) return -1; return n - 96; }
  { const int hh = n >> 7, j = n & 127; return j < 96 ? hh * 96 + j : -1; }
}
struct CDesc { const float* src; const float* g; bf16_t* dst; int ld, K, mode, it; };
DI void conv_load(const CDesc& d, f32x4 (&v)[8]) {
  const int t = tid();
  const int nkt = d.K >> 6, kt = d.it % nkt, nt = d.it / nkt, k0 = kt * 64, n0 = nt * 128;
  const int n4 = (t & 31) * 4, c = colmap(d.mode, n0 + n4);
#pragma unroll
  for (int i = 0; i < 8; i++) {
    const int kk = (t >> 5) + 8 * i;
    if (c >= 0) v[i] = __builtin_nontemporal_load((const f32x4*)(d.src + (long)(k0 + kk) * d.ld + c)); else { v[i].x = 0.f; v[i].y = 0.f; v[i].z = 0.f; v[i].w = 0.f; }
  }
}
DI void conv_finish(const CDesc& d, f32x4 (&v)[8], float* sm) {
  const int t = tid();
  const int nkt = d.K >> 6, kt = d.it % nkt, nt = d.it / nkt, k0 = kt * 64, n0 = nt * 128;
  const int n4 = (t & 31) * 4;
#pragma unroll
  for (int i = 0; i < 8; i++) {
    const int kk = (t >> 5) + 8 * i;
    if (d.g) { const float gg = d.g[k0 + kk]; v[i].x *= gg; v[i].y *= gg; v[i].z *= gg; v[i].w *= gg; }
    *(f32x4*)(sm + kk * 132 + n4) = v[i];
  }
  __syncthreads();
#pragma unroll
  for (int i = 0; i < 2; i++) {
    const int nn = (t >> 2) + 64 * i, ks = (t & 3) * 16;
    float f[16];
#pragma unroll
    for (int j = 0; j < 16; j++) f[j] = sm[(ks + j) * 132 + nn];
    u32x4 o0, o1;
    o0.x = pk2(f[0], f[1]); o0.y = pk2(f[2], f[3]); o0.z = pk2(f[4], f[5]); o0.w = pk2(f[6], f[7]);
    o1.x = pk2(f[8], f[9]); o1.y = pk2(f[10], f[11]); o1.z = pk2(f[12], f[13]); o1.w = pk2(f[14], f[15]);
    bf16_t* dd = d.dst + (long)(n0 + nn) * d.K + k0 + ks;
    *(u32x4*)dd = o0; *(u32x4*)(dd + 8) = o1;
  }
  __syncthreads();
}
constexpr int NCONV = 944 + 96 + 32 + 8 + 32 + 64 + 32 + 32 + 128 + 64;
constexpr int NAUX = NCONV + 512;
DI CDesc conv_desc(const P& p, int l, int it) {
  CDesc d; d.g = nullptr; d.mode = 0;
  if (it < 944) { d.src = p.w_in + (long)l * 1024 * INW; d.ld = INW; d.K = 1024; d.mode = 1; d.g = p.norm_g + l * 1024; d.dst = p.WinT; d.it = it; return d; }
  it -= 944;
  if (it < 96) { d.src = p.b_w_uq + (long)l * 768 * 768; d.ld = 768; d.K = 768; d.mode = 2; d.g = p.b_q_norm_g + l * 768; d.dst = p.WuqT; d.it = it; return d; }
  it -= 96;
  if (it < 32) { d.src = p.b_w_ukv + (long)l * 256 * 1024; d.ld = 1024; d.K = 256; d.g = p.b_kv_norm_g + l * 256; d.dst = p.WukvT; d.it = it; return d; }
  it -= 32;
  if (it < 8) { d.src = p.c_w_glu + (long)l * 256 * 256; d.ld = 256; d.K = 256; d.dst = p.WgluT; d.it = it; return d; }
  it -= 8;
  if (it < 32) { d.src = p.w_br_a + (long)l * 256 * 1024; d.ld = 1024; d.K = 256; d.dst = p.WbrT; d.it = it; return d; }
  it -= 32;
  if (it < 64) { d.src = p.w_br_b + (long)l * 512 * 1024; d.ld = 1024; d.K = 512; d.dst = p.WbrT + 1024 * 256; d.it = it; return d; }
  it -= 64;
  if (it < 32) { d.src = p.w_br_c + (long)l * 256 * 1024; d.ld = 1024; d.K = 256; d.dst = p.WbrT + 1024 * 768; d.it = it; return d; }
  it -= 32;
  if (it < 32) { d.src = p.w_br_m + (long)l * 256 * 1024; d.ld = 1024; d.K = 256; d.dst = p.WbrT + 1024 * 1024; d.it = it; return d; }
  it -= 32;
  if (it < 128) { d.src = p.w_out + (long)l * 1024 * 1024; d.ld = 1024; d.K = 1024; d.dst = p.WoutT + (long)l * 1024 * 1024; d.it = it; return d; }
  it -= 128;
  d.src = p.m_w_kv + (long)l * 1024 * 512; d.ld = 512; d.K = 1024; d.dst = p.WmkvT; d.it = it; return d;
}
DI void conv_all(const P& p, int l, char* smem) {
  const int G = gridDim.x, bid = blockIdx.x;
  float* sm = (float*)smem;
  if (bid >= NCONV) return;
  f32x4 va[8], vb[8];
  CDesc da = conv_desc(p, l, bid), db = da;
  conv_load(da, va);
#pragma unroll 1
  for (int it = bid; it < NCONV; it += 2 * G) {
    const bool h1 = it + G < NCONV;
    if (h1) { db = conv_desc(p, l, it + G); conv_load(db, vb); }
    conv_finish(da, va, sm);
    const bool h2 = it + 2 * G < NCONV;
    if (h2) { da = conv_desc(p, l, it + 2 * G); conv_load(da, va); }
    if (h1) conv_finish(db, vb, sm);
  }
}
DI void aux_item(const P& p, int l, int it, char* smem) {
  it -= NCONV;
  {
    const int t = tid(), lane = t & 63, row = it * 4 + (t >> 6);
    const float* src = p.mem + (long)row * 1024; const float* g = p.m_norm_g + l * 1024;
    f32x4 v[4]; float ss = 0.f;
#pragma unroll
    for (int i = 0; i < 4; i++) { v[i] = *(const f32x4*)(src + (lane + 64 * i) * 4); ss += v[i].x * v[i].x + v[i].y * v[i].y + v[i].z * v[i].z + v[i].w * v[i].w; }
    ss = sum64(ss);
    const float r = rsqrtf(ss * (1.f / 1024.f) + EPS);
#pragma unroll
    for (int i = 0; i < 4; i++) {
      const f32x4 gg = *(const f32x4*)(g + (lane + 64 * i) * 4);
      u32x2 o; o.x = pk2(v[i].x * r * gg.x, v[i].y * r * gg.y); o.y = pk2(v[i].z * r * gg.z, v[i].w * r * gg.w);
      *(u32x2*)(p.hm + (long)row * 1024 + (lane + 64 * i) * 4) = o;
    }
  }
}

DI void p0_xrow_item(const P& p, int it) {
  const int t = tid(), lane = t & 63;
  f32x4 v[2][4];
#pragma unroll
  for (int r = 0; r < 2; r++) {
    const float* src = p.x + (long)(it * 8 + (t >> 6) * 2 + r) * 1024;
#pragma unroll
    for (int i = 0; i < 4; i++) v[r][i] = __builtin_nontemporal_load((const f32x4*)(src + (lane + 64 * i) * 4));
  }
#pragma unroll
  for (int r = 0; r < 2; r++) {
    const int row = it * 8 + (t >> 6) * 2 + r;
    float ss = 0.f;
#pragma unroll
    for (int i = 0; i < 4; i++) ss += v[r][i].x * v[r][i].x + v[r][i].y * v[r][i].y + v[r][i].z * v[r][i].z + v[r][i].w * v[r][i].w;
    ss = sum64(ss);
#pragma unroll
    for (int i = 0; i < 4; i++) { u32x2 o; o.x = pk2(v[r][i].x, v[r][i].y); o.y = pk2(v[r][i].z, v[r][i].w); *(u32x2*)(p.xb + (long)row * 1024 + (lane + 64 * i) * 4) = o; }
    if (lane < 8) p.ssp[(long)lane * T_ + row] = (lane == 0) ? ss : 0.f;
  }
}
DI void p0_rope_item(const P& p, int it) {
  const int e = it * 256 + threadIdx.x, tok = e >> 4, i = e & 15;
  const float inv_freq = exp2f(-(float)i * (13.287712379549449f / 16.f));
  const float ang = (float)p.pos[tok] * inv_freq;
  const double rev = (double)ang * 0.15915494309189535;
  const float fr = (float)(rev - rint(rev));
  p.rope[(long)e * 2] = __builtin_amdgcn_cosf(fr);
  p.rope[(long)e * 2 + 1] = __builtin_amdgcn_sinf(fr);
}

DI void load_rs(const P& p, int r0, float* rsS) {
  const int t = tid();
  if (t < 128) { float s = 0.f;
#pragma unroll
    for (int j = 0; j < 8; j++) s += p.ssp[(long)j * T_ + r0 + t];
    rsS[t] = rsqrtf(s * (1.f / 1024.f) + EPS); }
}
DI void g1_tile(const P& p, int l, int tm, int tn, char* smem) {
  bf16_t* sm = (bf16_t*)smem; float* ep = (float*)smem; float* rsS = (float*)(smem + SM_RS);
  const int r0 = tm * 128, c0 = tn * 128;
  load_rs(p, r0, rsS);
  f32x16 acc[2][2]; zero_acc(acc);
  gemm_loop_dma(p.xb + (long)r0 * 1024, 1024, p.WinT + (long)c0 * 1024, 1024, 1024, acc, smem);
  acc_to_lds(acc, ep);
  __syncthreads();
  int type; bf16_t* dst; int ld;
  if (c0 < 2304) { dst = p.z1 + c0; ld = Z1W;
    if (c0 < 512) type = 1; else if (c0 < 1280) type = 2; else if (c0 < 1536) type = 0; else if (c0 < 1792) type = 2; else if (c0 < 2048) type = 3; else type = 2;
  } else { dst = p.z2 + (c0 - 2304); ld = Z2W; type = 0; }
  const float* gq = p.m_qk_g_q + l * 64;
  rowwise(ep, [&](int row, int c8, float (&v)[8]) {
    const float r = rsS[row];
#pragma unroll
    for (int j = 0; j < 8; j++) v[j] *= r;
    if (type == 1) {
#pragma unroll
      for (int j = 0; j < 8; j++) v[j] = gelu_t(v[j]);
    } else if (type == 2) {
#pragma unroll
      for (int j = 0; j < 8; j++) v[j] = silu(v[j]);
    } else if (type == 3) {
      float ss = 0.f;
#pragma unroll
      for (int j = 0; j < 8; j++) ss += v[j] * v[j];
      ss = sum8(ss);
      const float rq = rsqrtf(ss * (1.f / 64.f) + EPS) * (0.125f * LOG2E);
#pragma unroll
      for (int j = 0; j < 8; j++) v[j] *= rq * gq[(c8 & 63) + j];
    }
    *(u32x4*)(dst + (long)(r0 + row) * ld + c8) = pack8(v);
    if (c0 >= 2304) {
      float ss = 0.f;
#pragma unroll
      for (int j = 0; j < 8; j++) ss += v[j] * v[j];
      ss = sum16(ss);
      if ((c8 >> 3) == 0) p.ssq[(long)((c0 - 2304) >> 7) * T_ + r0 + row] = ss;
    }
  });
  __syncthreads();
}
DI void g1m_tile(const P& p, int l, int tm, int tn, char* smem) {
  bf16_t* sm = (bf16_t*)smem; float* ep = (float*)smem;
  const int r0 = tm * 128, c0 = tn * 128;
  f32x16 acc[2][2]; zero_acc(acc);
  gemm_loop_dma(p.hm + (long)r0 * 1024, 1024, p.WmkvT + (long)c0 * 1024, 1024, 1024, acc, smem);
  acc_to_lds(acc, ep);
  __syncthreads();
  if (tn < 2) {
    const float* gk = p.m_qk_g_k + l * 64;
    rowwise(ep, [&](int row, int c8, float (&v)[8]) {
      float ss = 0.f;
#pragma unroll
      for (int j = 0; j < 8; j++) ss += v[j] * v[j];
      ss = sum8(ss);
      const float rq = rsqrtf(ss * (1.f / 64.f) + EPS);
#pragma unroll
      for (int j = 0; j < 8; j++) v[j] *= rq * gk[(c8 & 63) + j];
      *(u32x4*)(p.memk + (long)(r0 + row) * 256 + c0 + c8) = pack8(v);
    });
  } else {
    const int b = r0 >> 8, m0 = r0 & 255, cv0 = c0 - 256;
    tstore(ep, 0, 128, nullptr, [&](int col) { const int cv = cv0 + col; return p.memvt + ((long)((b * 4 + (cv >> 6)) * 64 + (cv & 63))) * 256 + m0; });
  }
  __syncthreads();
}

DI void g2q_tile(const P& p, int l, int tm, int hh, char* smem) {
  bf16_t* sm = (bf16_t*)smem; float* ep = (float*)smem; float* ssS = (float*)(smem + SM_SS);
  const int r0 = tm * 128;
  f32x16 acc[2][2]; zero_acc(acc);
  { const int t = tid(); if (t < 128) { float q = 0.f;
#pragma unroll
      for (int j = 0; j < 6; j++) q += p.ssq[(long)j * T_ + r0 + t];
      ssS[t] = rsqrtf(q * (1.f / 768.f) + EPS); } }
  gemm_loop_dma(p.z2 + (long)r0 * Z2W, Z2W, p.WuqT + (long)hh * 128 * 768, 768, 768, acc, smem);
  acc_to_lds(acc, ep);
  __syncthreads();
  const float* gq = p.b_qk_g_q + l * 96;
  const float QSC = 0.10206207261596575f * LOG2E;
  rowwise2(ep, [&](int row, int c8) {
    LdRope L;
    const int tc = c8 >> 3;
    if (tc >= 8 && tc < 12) {
      const float* rp = p.rope + ((long)(r0 + row) * 16 + (tc & 1) * 8) * 2;
#pragma unroll
      for (int j = 0; j < 4; j++) L.r[j] = *(const f32x4*)(rp + 4 * j);
    } else {
#pragma unroll
      for (int j = 0; j < 4; j++) { L.r[j].x = 0.f; L.r[j].y = 0.f; L.r[j].z = 0.f; L.r[j].w = 0.f; }
    }
    return L;
  }, [&](int row, int c8, float (&v)[8], const LdRope& L) {
    const float rs = ssS[row];
    float ss = 0.f;
#pragma unroll
    for (int j = 0; j < 8; j++) { v[j] *= rs; ss += v[j] * v[j]; }
    ss = sum16(ss);
    const float rq = rsqrtf(ss * (1.f / 96.f) + EPS);
    const int tc = c8 >> 3;
    bf16_t* qd = p.qf + (long)(r0 + row) * 768 + hh * 96;
    if (tc < 8) {
#pragma unroll
      for (int j = 0; j < 8; j++) v[j] *= rq * gq[c8 + j] * QSC;
      *(u32x4*)(qd + c8) = pack8(v);
    } else if (tc < 12) {
      const int i0 = (tc & 1) * 8; const bool first = tc < 10;
      const int pc = first ? 80 + i0 : 64 + i0;
      const float csn[16] = {L.r[0].x, L.r[0].y, L.r[0].z, L.r[0].w, L.r[1].x, L.r[1].y, L.r[1].z, L.r[1].w,
                             L.r[2].x, L.r[2].y, L.r[2].z, L.r[2].w, L.r[3].x, L.r[3].y, L.r[3].z, L.r[3].w};
      float o[8];
#pragma unroll
      for (int j = 0; j < 8; j++) {
        const float own = v[j] * rq * gq[c8 + j];
        const float oth = ep[row * EPW + pc + j] * rs * rq * gq[pc + j];
        const float cs = csn[2 * j], sn = csn[2 * j + 1];
        o[j] = (first ? (own * cs - oth * sn) : (own * cs + oth * sn)) * QSC;
      }
      *(u32x4*)(qd + c8) = pack8(o);
    }
  });
  __syncthreads();
}
DI void g2kv_tile(const P& p, int l, int tm, int hh, char* smem) {
  bf16_t* sm = (bf16_t*)smem; float* ep = (float*)smem; float* ssS = (float*)(smem + SM_SS);
  const int r0 = tm * 128;
  f32x16 acc[2][2]; zero_acc(acc);
  { const int t = tid(); if (t < 128) { const float q = p.ssq[(long)6 * T_ + r0 + t] + p.ssq[(long)7 * T_ + r0 + t];
      ssS[t] = rsqrtf(q * (1.f / 256.f) + EPS); } }
  gemm_loop_dma(p.z2 + (long)r0 * Z2W + 768, Z2W, p.WukvT + (long)hh * 128 * 256, 256, 256, acc, smem);
  acc_to_lds(acc, ep);
  __syncthreads();
  const float* gk = p.b_qk_g_k + l * 96;
  rowwise2(ep, [&](int row, int c8) {
    LdKv L;
    const int tc = c8 >> 3;
    const bf16_t* krp = p.z2 + (long)(r0 + row) * Z2W + 1024;
    L.k2 = *(const unsigned*)(krp + 2 * tc);
    if (tc >= 8 && tc < 12) {
      const int i0 = (tc & 1) * 8;
      L.x1 = *(const u32x4*)(krp + i0); L.x2 = *(const u32x4*)(krp + 16 + i0);
      const float* rp = p.rope + ((long)(r0 + row) * 16 + i0) * 2;
#pragma unroll
      for (int j = 0; j < 4; j++) L.r[j] = *(const f32x4*)(rp + 4 * j);
    } else {
      L.x1.x = 0; L.x1.y = 0; L.x1.z = 0; L.x1.w = 0; L.x2 = L.x1;
#pragma unroll
      for (int j = 0; j < 4; j++) { L.r[j].x = 0.f; L.r[j].y = 0.f; L.r[j].z = 0.f; L.r[j].w = 0.f; }
    }
    return L;
  }, [&](int row, int c8, float (&v)[8], const LdKv& L) {
    const float rs = ssS[row];
    const int tc = c8 >> 3;
    const unsigned k2 = L.k2;
    const float ka = __uint_as_float(k2 << 16), kb = __uint_as_float(k2 & 0xffff0000u);
    float ss = ka * ka + kb * kb;
    if (tc < 8) {
#pragma unroll
      for (int j = 0; j < 8; j++) { v[j] *= rs; ss += v[j] * v[j]; }
    }
    ss = sum16(ss);
    const float kn = rsqrtf(ss * (1.f / 96.f) + EPS);
    bf16_t* kd = p.kf + (long)(r0 + row) * 768 + hh * 96;
    if (tc < 8) {
#pragma unroll
      for (int j = 0; j < 8; j++) v[j] *= kn * gk[c8 + j];
      *(u32x4*)(kd + c8) = pack8(v);
    } else if (tc < 12) {
      const int i0 = (tc & 1) * 8; const bool first = tc < 10;
      float x1[8], x2[8], o[8];
      unpack8(L.x1, x1);
      unpack8(L.x2, x2);
      const float csn[16] = {L.r[0].x, L.r[0].y, L.r[0].z, L.r[0].w, L.r[1].x, L.r[1].y, L.r[1].z, L.r[1].w,
                             L.r[2].x, L.r[2].y, L.r[2].z, L.r[2].w, L.r[3].x, L.r[3].y, L.r[3].z, L.r[3].w};
#pragma unroll
      for (int j = 0; j < 8; j++) {
        const float a = x1[j] * kn * gk[64 + i0 + j], b = x2[j] * kn * gk[80 + i0 + j];
        const float cs = csn[2 * j], sn = csn[2 * j + 1];
        o[j] = first ? (a * cs - b * sn) : (b * cs + a * sn);
      }
      *(u32x4*)(kd + (first ? 64 : 80) + i0) = pack8(o);
    }
  });
  {
    const int b = r0 >> 11, s0 = r0 & 2047;
    tstore(ep, 64, 64, ssS, [&](int col) { return p.vt + ((long)((b * 8 + hh) * 64 + col)) * S_ + s0; });
  }
  __syncthreads();
}

template <int DQK, bool CAUSAL>
DI void attn_item(const bf16_t* __restrict__ q, long q_ld, const bf16_t* __restrict__ k, long k_ld, const bf16_t* __restrict__ vt, long vt_ld,
                  bf16_t* og, long o_ld, int q0, int nkt, char* smem, bool dry) {
  constexpr int KS = DQK + 8, NKC = DQK / 8, NKL = (64 * NKC) / 256, NKK = DQK / 16, VS = 68;
  bf16_t* sK = (bf16_t*)smem;
  bf16_t* sV = (bf16_t*)smem + 2 * 64 * KS;
  const int t = tid(), lane = t & 63, w = t >> 6, l31 = lane & 31, h = lane >> 5;
  bf16x8 qfr[NKK];
  {
    const bf16_t* qp = q + (long)(w * 32 + l31) * q_ld + h * 8;
#pragma unroll
    for (int kk = 0; kk < NKK; kk++) qfr[kk] = *(const bf16x8*)(qp + kk * 16);
  }
  u32x4 rk[NKL], rv[2];
  auto gload = [&](int kt) {
#pragma unroll
    for (int i = 0; i < NKL; i++) { const int c = t + 256 * i, key = c / NKC, kc = c % NKC; rk[i] = *(const u32x4*)(k + (long)(kt * 64 + key) * k_ld + kc * 8); }
#pragma unroll
    for (int i = 0; i < 2; i++) { const int c = t + 256 * i, d = c >> 3, kc = c & 7; rv[i] = *(const u32x4*)(vt + (long)d * vt_ld + kt * 64 + kc * 8); }
  };
  auto lstore = [&](int buf) {
    bf16_t* dK = sK + buf * 64 * KS; bf16_t* dV = sV + buf * 64 * VS;
#pragma unroll
    for (int i = 0; i < NKL; i++) { const int c = t + 256 * i, key = c / NKC, kc = c % NKC; *(u32x4*)(dK + key * KS + kc * 8) = rk[i]; }
#pragma unroll
    for (int i = 0; i < 2; i++) { const int c = t + 256 * i, d = c >> 3, kc = c & 7;
      u32x2 lo, hi; lo.x = rv[i].x; lo.y = rv[i].y; hi.x = rv[i].z; hi.y = rv[i].w;
      *(u32x2*)(dV + d * VS + kc * 8) = lo; *(u32x2*)(dV + d * VS + kc * 8 + 4) = hi; }
  };
  f32x16 o[2];
#pragma unroll
  for (int i = 0; i < 16; i++) { o[0][i] = 0.f; o[1][i] = 0.f; }
  float m = -1e30f, lsum = 0.f;
  const int qpos = q0 + w * 32 + l31;
  gload(0); lstore(0);
  if (nkt > 1) gload(1);
  __syncthreads();
  for (int kt = 0; kt < nkt; kt++) {
    if (kt + 1 < nkt) lstore((kt + 1) & 1);
    __builtin_amdgcn_sched_barrier(0);
    if (kt + 2 < nkt) gload(kt + 2);
    __builtin_amdgcn_sched_barrier(0);
    const bool active = !CAUSAL || (kt * 64 <= q0 + w * 32 + 31);
    if (active) {
      const bf16_t* cK = sK + (kt & 1) * 64 * KS; const bf16_t* cV = sV + (kt & 1) * 64 * VS;
      f32x16 s[2];
#pragma unroll
      for (int i = 0; i < 16; i++) { s[0][i] = 0.f; s[1][i] = 0.f; }
#pragma unroll
      for (int kb = 0; kb < 2; kb++)
#pragma unroll
        for (int kk = 0; kk < NKK; kk++) {
          const bf16x8 kf_ = *(const bf16x8*)(cK + (kb * 32 + l31) * KS + kk * 16 + h * 8);
          s[kb] = MFMA(kf_, qfr[kk], s[kb]);
        }
      if (CAUSAL && (kt * 64 + 63 > q0 + w * 32)) {
#pragma unroll
        for (int kb = 0; kb < 2; kb++)
#pragma unroll
          for (int i = 0; i < 16; i++) { const int key = kt * 64 + kb * 32 + crow(i, h); if (key > qpos) s[kb][i] = -1e30f; }
      }
      float mx = s[0][0];
#pragma unroll
      for (int kb = 0; kb < 2; kb++)
#pragma unroll
        for (int i = 0; i < 16; i++) mx = fmaxf(mx, s[kb][i]);
      mx = fmaxf(mx, __shfl_xor(mx, 32));
      const float mnew = fmaxf(m, mx);
      const float alpha = __builtin_amdgcn_exp2f(m - mnew);
      m = mnew;
      float ps = 0.f;
#pragma unroll
      for (int kb = 0; kb < 2; kb++)
#pragma unroll
        for (int i = 0; i < 16; i++) { const float pv = __builtin_amdgcn_exp2f(s[kb][i] - mnew); s[kb][i] = pv; ps += pv; }
      lsum = lsum * alpha + ps;
#pragma unroll
      for (int i = 0; i < 16; i++) { o[0][i] *= alpha; o[1][i] *= alpha; }
#pragma unroll
      for (int kb = 0; kb < 2; kb++)
#pragma unroll
        for (int st = 0; st < 2; st++) {
          u32x4 pp; pp.x = pk2(s[kb][8 * st + 0], s[kb][8 * st + 1]); pp.y = pk2(s[kb][8 * st + 2], s[kb][8 * st + 3]);
          pp.z = pk2(s[kb][8 * st + 4], s[kb][8 * st + 5]); pp.w = pk2(s[kb][8 * st + 6], s[kb][8 * st + 7]);
          const bf16x8 pf = __builtin_bit_cast(bf16x8, pp);
#pragma unroll
          for (int db = 0; db < 2; db++) {
            const bf16_t* vp = cV + (db * 32 + l31) * VS + kb * 32 + st * 16 + 4 * h;
            const u32x2 lo = *(const u32x2*)vp, hi = *(const u32x2*)(vp + 8);
            u32x4 vv; vv.x = lo.x; vv.y = lo.y; vv.z = hi.x; vv.w = hi.y;
            o[db] = MFMA(__builtin_bit_cast(bf16x8, vv), pf, o[db]);
          }
        }
    }
    __syncthreads();
  }
  lsum += __shfl_xor(lsum, 32);
  const float inv = 1.f / lsum;
  bf16_t* op = og + (long)(w * 32 + l31) * o_ld;
#pragma unroll
  for (int db = 0; db < 2; db++)
#pragma unroll
    for (int ig = 0; ig < 4; ig++) {
      const int d = db * 32 + ig * 8 + 4 * h;
      float gt[4]; unpack4(*(const u32x2*)(op + d), gt);
      u32x2 r; r.x = pk2(o[db][4 * ig + 0] * inv * gt[0], o[db][4 * ig + 1] * inv * gt[1]); r.y = pk2(o[db][4 * ig + 2] * inv * gt[2], o[db][4 * ig + 3] * inv * gt[3]);
      if (!dry) *(u32x2*)(op + d) = r;
    }
}
DI void mattn_item(const P& p, int idx, char* smem) {
  const int b = idx >> 6, hh = (idx >> 4) & 3, qt = idx & 15;
  const long tok0 = (long)b * S_ + qt * 128;
  attn_item<64, false>(p.z1 + tok0 * Z1W + 1792 + hh * 64, Z1W, p.memk + (long)b * 256 * 256 + hh * 64, 256,
                       p.memvt + (long)(b * 4 + hh) * 64 * 256, 256, p.z1 + tok0 * Z1W + 2048 + hh * 64, Z1W, 0, 4, smem, p.dry != 0);
}
DI void battn_item(const P& p, int idx, char* smem) {
  const int qt = 15 - (idx >> 6), bh = idx & 63, b = bh >> 3, hh = bh & 7;
  const long tok0 = (long)b * S_ + qt * 128;
  attn_item<96, true>(p.qf + tok0 * 768 + hh * 96, 768, p.kf + (long)b * S_ * 768 + hh * 96, 768,
                      p.vt + (long)(b * 8 + hh) * 64 * S_, S_, p.z1 + tok0 * Z1W + 768 + hh * 64, Z1W, qt * 128, 2 * qt + 2, smem, p.dry != 0);
}

DI void a_item(const P& p, int l, int idx, char* smem) {
  bf16_t* vnT = (bf16_t*)smem;
  float* part = (float*)(smem + 256 * 136 * 2);
  const int t = tid(); const long r0 = (long)idx * 128;
  {
    const int row = t & 127, half = t >> 7;
    const bf16_t* src = p.z1 + (r0 + row) * Z1W + 256 + half * 128;
    float ss = 0.f;
#pragma unroll 4
    for (int i = 0; i < 16; i++) { float f[8]; unpack8(*(const u32x4*)(src + i * 8), f);
#pragma unroll
      for (int j = 0; j < 8; j++) ss += f[j] * f[j]; }
    part[half * 128 + row] = ss;
    __syncthreads();
    const float r = rsqrtf((part[row] + part[128 + row]) * (1.f / 256.f) + EPS);
    const float* gv = p.a_norm_g + l * 256 + half * 128;
#pragma unroll 4
    for (int i = 0; i < 16; i++) { float f[8]; unpack8(*(const u32x4*)(src + i * 8), f);
#pragma unroll
      for (int j = 0; j < 8; j++) vnT[(half * 128 + i * 8 + j) * 136 + row] = f2bf(f[j] * r * gv[i * 8 + j]); }
  }
  __syncthreads();
  const int lane = t & 63, g = t >> 6, l31 = lane & 31, h = lane >> 5;
  const float* W = p.a_w_s + (long)(l * 4 + g) * 128 * 128;
  const float* bs = p.a_b_s + (l * 4 + g) * 128;
#pragma unroll 1
  for (int mh = 0; mh < 2; mh++) {
    f32x16 acc[2][2]; zero_acc(acc);
#pragma unroll 2
    for (int kk = 0; kk < 8; kk++) {
      bf16x8 af[2], bfr[2];
#pragma unroll
      for (int mb = 0; mb < 2; mb++) {
        const int tt = mh * 64 + mb * 32 + l31, s0 = kk * 16 + h * 8;
        const f32x4 w0 = *(const f32x4*)(W + tt * 128 + s0), w1 = *(const f32x4*)(W + tt * 128 + s0 + 4);
        float f[8] = {w0.x, w0.y, w0.z, w0.w, w1.x, w1.y, w1.z, w1.w};
#pragma unroll
        for (int j = 0; j < 8; j++) if (s0 + j > tt) f[j] = 0.f;
        af[mb] = __builtin_bit_cast(bf16x8, pack8(f));
      }
#pragma unroll
      for (int nb = 0; nb < 2; nb++) bfr[nb] = *(const bf16x8*)(vnT + (g * 64 + nb * 32 + l31) * 136 + kk * 16 + h * 8);
#pragma unroll
      for (int mb = 0; mb < 2; mb++)
#pragma unroll
        for (int nb = 0; nb < 2; nb++) acc[mb][nb] = MFMA(af[mb], bfr[nb], acc[mb][nb]);
    }
#pragma unroll
    for (int mb = 0; mb < 2; mb++)
#pragma unroll
      for (int nb = 0; nb < 2; nb++)
#pragma unroll
        for (int i = 0; i < 16; i++) {
          const int tt = mh * 64 + mb * 32 + crow(i, h), col = g * 64 + nb * 32 + l31;
          bf16_t* zp = p.z1 + (r0 + tt) * Z1W;
          const float u = bf2f(zp[col]), gt = bf2f(zp[512 + col]);
          if (!p.dry) zp[col] = f2bf(u * (acc[mb][nb][i] + bs[tt]) * gt);
        }
  }
  __syncthreads();
}

DI void c_setup(const P& p, int l, int g, int lane, float& ar, float& ai, float (&Br)[16], float (&Bi)[16]) {
  const int gi = (l * 16 + g) * 64 + lane;
  const float lre = p.c_a_re[gi], lim = p.c_a_im[gi];
  const float dt = expf(p.c_log_dt[l * 16 + g]);
  const float mag = expf(lre * dt);
  const float angf = lim * dt;
  const double rev = (double)angf * 0.15915494309189535;
  const float rf = (float)((rev - rint(rev)) * 6.283185307179586);
  const float sn = sinf(rf), cs = cosf(rf);
  ar = mag * cs; ai = mag * sn;
  const float xr = ar - 1.f, xi = ai, den = 1.f / (lre * lre + lim * lim);
  const float cr = (xr * lre + xi * lim) * den, ci = (xi * lre - xr * lim) * den;
  const float* bre = p.c_b_re + (long)gi * 16; const float* bim = p.c_b_im + (long)gi * 16;
#pragma unroll
  for (int c4 = 0; c4 < 4; c4++) {
    const f32x4 r4 = *(const f32x4*)(bre + c4 * 4), i4 = *(const f32x4*)(bim + c4 * 4);
    const float rr[4] = {r4.x, r4.y, r4.z, r4.w}, ii[4] = {i4.x, i4.y, i4.z, i4.w};
#pragma unroll
    for (int j = 0; j < 4; j++) { Br[c4 * 4 + j] = cr * rr[j] - ci * ii[j]; Bi[c4 * 4 + j] = cr * ii[j] + ci * rr[j]; }
  }
}
DI void c_load_u(const P& p, long tok0, int g, int lane, float* ub) {
  const bf16_t* up = p.z1 + (tok0 + lane) * Z1W + 1280 + g * 16;
  float f0[8], f1[8];
  unpack8(*(const u32x4*)up, f0); unpack8(*(const u32x4*)(up + 8), f1);
  f32x4 a; a.x = f0[0]; a.y = f0[1]; a.z = f0[2]; a.w = f0[3]; *(f32x4*)(ub + lane * 16) = a;
  a.x = f0[4]; a.y = f0[5]; a.z = f0[6]; a.w = f0[7]; *(f32x4*)(ub + lane * 16 + 4) = a;
  a.x = f1[0]; a.y = f1[1]; a.z = f1[2]; a.w = f1[3]; *(f32x4*)(ub + lane * 16 + 8) = a;
  a.x = f1[4]; a.y = f1[5]; a.z = f1[6]; a.w = f1[7]; *(f32x4*)(ub + lane * 16 + 12) = a;
}
DI void c_step(const float* ub, int s, const float (&Br)[16], const float (&Bi)[16], float ar, float ai, float& sr, float& si) {
  float bur = 0.f, bui = 0.f;
#pragma unroll
  for (int c4 = 0; c4 < 4; c4++) {
    const f32x4 u = *(const f32x4*)(ub + s * 16 + c4 * 4);
    bur += Br[c4 * 4] * u.x + Br[c4 * 4 + 1] * u.y + Br[c4 * 4 + 2] * u.z + Br[c4 * 4 + 3] * u.w;
    bui += Bi[c4 * 4] * u.x + Bi[c4 * 4 + 1] * u.y + Bi[c4 * 4 + 2] * u.z + Bi[c4 * 4 + 3] * u.w;
  }
  const float nr = ar * sr - ai * si + bur, ni = ar * si + ai * sr + bui;
  sr = nr; si = ni;
}
DI void c1_item(const P& p, int l, int idx, char* smem) {
  const int t = tid(), lane = t & 63, w = t >> 6;
  const int b = idx >> 7, g = (idx >> 3) & 15, k = (idx & 7) * 4 + w;
  float* ub = (float*)smem + w * 1024;
  float ar, ai, Br[16], Bi[16];
  c_setup(p, l, g, lane, ar, ai, Br, Bi);
  const long tok0 = (long)b * S_ + k * 64;
  c_load_u(p, tok0, g, lane, ub);
  __syncthreads();
  float sr = 0.f, si = 0.f;
#pragma unroll 2
  for (int s = 0; s < 64; s++) c_step(ub, s, Br, Bi, ar, ai, sr, si);
  f32x2 e; e.x = sr; e.y = si;
  *(f32x2*)(p.carry + ((long)((b * 16 + g) * 32 + k) * 64 + lane) * 2) = e;
  __syncthreads();
}
DI void c3_item(const P& p, int l, int idx, char* smem) {
  const int t = tid(), lane = t & 63, w = t >> 6;
  const int b = idx >> 7, g = (idx >> 3) & 15, k = (idx & 7) * 4 + w;
  float* ub = (float*)(smem + w * 12288);
  bf16_t* stb = (bf16_t*)(smem + w * 12288 + 4096);
  const int c = lane & 15, sq = lane >> 4;
  bf16x8 cfr[4];
  {
    const float* cre = p.c_c_re + (long)(l * 16 + g) * 1024 + c * 64; const float* cim = p.c_c_im + (long)(l * 16 + g) * 1024 + c * 64;
#pragma unroll
    for (int ks = 0; ks < 4; ks++) {
      const f32x4 r4 = *(const f32x4*)(cre + ks * 16 + sq * 4), i4 = *(const f32x4*)(cim + ks * 16 + sq * 4);
      u32x4 pk; pk.x = pk2(r4.x, -i4.x); pk.y = pk2(r4.y, -i4.y); pk.z = pk2(r4.z, -i4.z); pk.w = pk2(r4.w, -i4.w);
      cfr[ks] = __builtin_bit_cast(bf16x8, pk);
    }
  }
  float ar, ai, Br[16], Bi[16];
  c_setup(p, l, g, lane, ar, ai, Br, Bi);
  const long tok0 = (long)b * S_ + k * 64;
  c_load_u(p, tok0, g, lane, ub);
  float lr = ar, li = ai;
#pragma unroll
  for (int i = 0; i < 6; i++) { const float nr = lr * lr - li * li, ni = 2.f * lr * li; lr = nr; li = ni; }
  float sr = 0.f, si = 0.f;
  {
    const float* cp = p.carry + ((long)((b * 16 + g) * 32) * 64 + lane) * 2;
    for (int j0 = 0; j0 < k; j0 += 8) {
      f32x2 e[8];
#pragma unroll
      for (int jj = 0; jj < 8; jj++) { e[jj].x = 0.f; e[jj].y = 0.f; if (j0 + jj < k) e[jj] = *(const f32x2*)(cp + (long)(j0 + jj) * 128); }
#pragma unroll
      for (int jj = 0; jj < 8; jj++) if (j0 + jj < k) { const float nr = lr * sr - li * si + e[jj].x, ni = lr * si + li * sr + e[jj].y; sr = nr; si = ni; }
    }
  }
  __syncthreads();
  const float dsk = p.c_d[l * 256 + g * 16 + c];
#pragma unroll 1
  for (int sb = 0; sb < 4; sb++) {
#pragma unroll 2
    for (int s2 = 0; s2 < 16; s2++) {
      c_step(ub, sb * 16 + s2, Br, Bi, ar, ai, sr, si);
      *(unsigned*)(stb + s2 * 136 + 2 * lane) = pk2(sr, si);
    }
    asm volatile("s_waitcnt lgkmcnt(0)" ::: "memory");
    __builtin_amdgcn_wave_barrier();
    f32x4 y; y.x = 0.f; y.y = 0.f; y.z = 0.f; y.w = 0.f;
#pragma unroll
    for (int ks = 0; ks < 4; ks++) {
      const bf16x8 af = *(const bf16x8*)(stb + c * 136 + ks * 32 + sq * 8);
      y = __builtin_amdgcn_mfma_f32_16x16x32_bf16(af, cfr[ks], y, 0, 0, 0);
    }
    const float yy[4] = {y.x, y.y, y.z, y.w};
#pragma unroll
    for (int qq = 0; qq < 4; qq++) {
      const int sa = sb * 16 + sq * 4 + qq;
      const float yv = gelu_t(yy[qq] + dsk * ub[sa * 16 + c]);
      if (!p.dry) p.z1[(tok0 + sa) * Z1W + 1280 + g * 16 + c] = f2bf(yv);
    }
    asm volatile("s_waitcnt lgkmcnt(0)" ::: "memory");
    __builtin_amdgcn_wave_barrier();
  }
  __syncthreads();
}

DI void glu_tile(const P& p, int l, int tm, int tn, char* smem) {
  bf16_t* sm = (bf16_t*)smem; float* ep = (float*)smem;
  const int r0 = tm * 128, c0 = tn * 128;
  f32x16 acc[2][2]; zero_acc(acc);
  gemm_loop_dma(p.z1 + (long)r0 * Z1W + 1280, Z1W, p.WgluT + (long)c0 * 256, 256, 256, acc, smem);
  acc_to_lds(acc, ep);
  __syncthreads();
  const float* bg = p.c_b_glu + l * 256 + c0;
  rowwise2(ep, [&](int row, int c8) {
    LdGlu L;
    const bf16_t* zp = p.z1 + (long)(r0 + row) * Z1W + c0 + c8;
    L.yg = *(const u32x4*)(zp + 1280); L.gt = *(const u32x4*)(zp + 1536);
    return L;
  }, [&](int row, int c8, float (&v)[8], const LdGlu& L) {
    bf16_t* zp = p.z1 + (long)(r0 + row) * Z1W + c0 + c8;
    float yg[8], gt[8];
    unpack8(L.yg, yg); unpack8(L.gt, gt);
#pragma unroll
    for (int j = 0; j < 8; j++) v[j] = yg[j] * sigm(v[j] + bg[c8 + j]) * gt[j];
    if (!p.dry) *(u32x4*)(zp + 1536) = pack8(v);
  });
  __syncthreads();
}

DI void pf_tile(const P& p, int l, int tm, int tn, char* smem) {
  float* ep = (float*)smem; float* rsS = (float*)(smem + SM_RS);
  const int t = tid(), lane = t & 63, w = t >> 6, wm = w >> 1, wn = w & 1, l31 = lane & 31, h = lane >> 5;
  const int r0 = tm * 128, c0 = tn * 128;
  load_rs(p, r0, rsS);
  unsigned mrgp[2][2][8];
#pragma unroll
  for (int a = 0; a < 2; a++)
#pragma unroll
    for (int b = 0; b < 2; b++)
#pragma unroll
      for (int i = 0; i < 8; i++) mrgp[a][b][i] = 0u;
#pragma unroll 1
  for (int pr = 0; pr < 2; pr++) {
    unsigned gp[2][2][2][8];
    {
      f32x16 accP[2][2], accQ[2][2]; zero_acc(accP); zero_acc(accQ);
      const bf16_t* wg = p.WinT + (long)(3456 + (2 * pr) * 1024 + c0) * 1024;
      gemm_loop_dma2(p.xb + (long)r0 * 1024, 1024, wg, wg + (long)1024 * 1024, 1024, 1024, accP, accQ, smem);
      const float* bm = p.b_merge + l * 4096 + (2 * pr) * 1024 + c0;
#pragma unroll
      for (int mb = 0; mb < 2; mb++)
#pragma unroll
        for (int nb = 0; nb < 2; nb++) {
          const float bias0 = bm[wn * 64 + nb * 32 + l31], bias1 = bm[1024 + wn * 64 + nb * 32 + l31];
#pragma unroll
          for (int i = 0; i < 16; i += 2) {
            const float ra = rsS[wm * 64 + mb * 32 + crow(i, h)], rb = rsS[wm * 64 + mb * 32 + crow(i + 1, h)];
            gp[0][mb][nb][i >> 1] = pk2n(sigm(accP[mb][nb][i] * ra + bias0), sigm(accP[mb][nb][i + 1] * rb + bias0));
            gp[1][mb][nb][i >> 1] = pk2n(sigm(accQ[mb][nb][i] * ra + bias1), sigm(accQ[mb][nb][i + 1] * rb + bias1));
          }
        }
    }
#pragma unroll
    for (int j = 0; j < 2; j++) {
      const int br = 2 * pr + j;
      const int yoff = br == 0 ? 0 : (br == 1 ? 768 : (br == 2 ? 1536 : 2048));
      const int Kb = br == 1 ? 512 : 256;
      const long woff = br == 0 ? 0 : (br == 1 ? 1024 * 256 : (br == 2 ? 1024 * 768 : 1024 * 1024));
      f32x16 acc[2][2]; zero_acc(acc);
      gemm_loop_dma(p.z1 + (long)r0 * Z1W + yoff, Z1W, p.WbrT + woff + (long)c0 * Kb, Kb, Kb, acc, smem);
#pragma unroll
      for (int mb = 0; mb < 2; mb++)
#pragma unroll
        for (int nb = 0; nb < 2; nb++)
#pragma unroll
          for (int i = 0; i < 16; i += 2) {
            const unsigned g2 = gp[j][mb][nb][i >> 1], m2 = mrgp[mb][nb][i >> 1];
            const float m0 = __uint_as_float(m2 << 16) + __uint_as_float(g2 << 16) * acc[mb][nb][i];
            const float m1 = __uint_as_float(m2 & 0xffff0000u) + __uint_as_float(g2 & 0xffff0000u) * acc[mb][nb][i + 1];
            mrgp[mb][nb][i >> 1] = pk2(m0, m1);
          }
    }
  }
  {
    f32x16 mrg[2][2];
#pragma unroll
    for (int a = 0; a < 2; a++)
#pragma unroll
      for (int b = 0; b < 2; b++)
#pragma unroll
        for (int i = 0; i < 16; i += 2) { const unsigned m2 = mrgp[a][b][i >> 1]; mrg[a][b][i] = __uint_as_float(m2 << 16); mrg[a][b][i + 1] = __uint_as_float(m2 & 0xffff0000u); }
    acc_to_lds(mrg, ep);
  }
  __syncthreads();
  rowwise(ep, [&](int row, int c8, float (&v)[8]) { *(u32x4*)(p.mg + (long)(r0 + row) * 1024 + c0 + c8) = pack8(v); });
  __syncthreads();
}

DI void out_tile(const P& p, int l, int tm, int tn, char* smem) {
  bf16_t* sm = (bf16_t*)smem; float* ep = (float*)smem;
  const int r0 = tm * 128, c0 = tn * 128;
  f32x16 acc[2][2]; zero_acc(acc);
  gemm_loop_dma(p.mg + (long)r0 * 1024, 1024, p.WoutT + (long)l * 1024 * 1024 + (long)c0 * 1024, 1024, 1024, acc, smem);
  acc_to_lds(acc, ep);
  __syncthreads();
  const float* xin = (l == 0) ? p.x : p.out;
  rowwise2(ep, [&](int row, int c8) {
    LdX L;
    const long off = (long)(r0 + row) * 1024 + c0 + c8;
    L.a = *(const f32x4*)(xin + off); L.b = *(const f32x4*)(xin + off + 4);
    return L;
  }, [&](int row, int c8, float (&v)[8], const LdX& L) {
    const long off = (long)(r0 + row) * 1024 + c0 + c8;
    const f32x4 a = L.a, b = L.b;
    v[0] += a.x; v[1] += a.y; v[2] += a.z; v[3] += a.w; v[4] += b.x; v[5] += b.y; v[6] += b.z; v[7] += b.w;
    f32x4 oa, ob; oa.x = v[0]; oa.y = v[1]; oa.z = v[2]; oa.w = v[3]; ob.x = v[4]; ob.y = v[5]; ob.z = v[6]; ob.w = v[7];
    if (!p.dry) {
      if (l == 1) { __builtin_nontemporal_store(oa, (f32x4*)(p.out + off)); __builtin_nontemporal_store(ob, (f32x4*)(p.out + off + 4)); }
      else { *(f32x4*)(p.out + off) = oa; *(f32x4*)(p.out + off + 4) = ob; }
    }
    if (l == 0) {
      *(u32x4*)(p.xb + off) = pack8(v);
      float ss = 0.f;
#pragma unroll
      for (int j = 0; j < 8; j++) ss += v[j] * v[j];
      ss = sum16(ss);
      if ((c8 >> 3) == 0) p.ssp[(long)tn * T_ + r0 + row] = ss;
    }
  });
  __syncthreads();
}

DI void run_phase(const P& p, int ph, char* smem, int vb) {
  const int G = gridDim.x, bid = blockIdx.x;
  int* slot = (int*)(smem + SM_MISC);
  if (ph == 0) {
    conv_all(p, 0, smem);
    for (int it = NCONV + bid; it < NAUX; it += G) aux_item(p, 0, it, smem);
    for (int it = bid; it < 2048; it += G) p0_xrow_item(p, it);
    for (int it = bid; it < 1024; it += G) p0_rope_item(p, it);
    return;
  }
  const int l = (ph - 1) / 6, s = (ph - 1) % 6;
  if (s == 0) {
    const int total = 3456 + 64, nr = (total + G - 1) / G;
    for (int r = 0; r < nr; r++) {
      const int L = static_L(r, vb);
      if (L >= total) continue;
      int tm, tn;
      if (L < 3456) { tile_from_linear(L, 27, tm, tn); g1_tile(p, l, tm, tn, smem); }
      else { tile_from_linear(L - 3456, 4, tm, tn); g1m_tile(p, l, tm, tn, smem); }
    }
  } else if (s == 1) {
    const long dm = p.dry;
    {
      const int total = 1024, nr = (total + G - 1) / G;
      if (!dm || (dm & 2)) for (int r = 0; r < nr; r++) { const int L = static_L(r, vb); if (L >= total) continue; int tm, tn; tile_from_linear(L, 8, tm, tn); g2q_tile(p, l, tm, tn, smem); }
      if (!dm || (dm & 8)) for (int r = 0; r < nr; r++) { const int L = static_L(r, vb); if (L >= total) continue; int tm, tn; tile_from_linear(L, 8, tm, tn); g2kv_tile(p, l, tm, tn, smem); }
    }
    if (!dm || (dm & 4)) for (int it = vb; it < 512; it += G) mattn_item(p, it, smem);
    {
      const bool split = (G >= 256);
      if (!dm || (dm & 16)) { const int a1 = split ? 128 : 128; for (int it = vb; it < a1; it += G) a_item(p, l, it, smem); }
      const int cstep = split ? (vb < 128 ? 1024 : G - 128) : G;
      if (!dm || (dm & 32)) {
#pragma unroll 1
        for (int it = vb; it < 1024; it += cstep) c1_item(p, l, it, smem);
      }
    }
  } else if (s == 2) {
    const long dm = p.dry;
    if (G == 512) {
#pragma unroll 1
      for (int j = 0; j < 4; j++) {
        if (j < 2) { if (dm && !(dm & 2)) continue; battn_item(p, j ? 1023 - vb : vb, smem); }
        else { if (dm && !(dm & 4)) continue; c3_item(p, l, vb + (j - 2) * 512, smem); }
      }
    } else {
#pragma unroll 1
      for (int it = vb; it < 2048; it += G) {
        if (it < 1024) { if (dm && !(dm & 2)) continue; battn_item(p, it, smem); } else { if (dm && !(dm & 4)) continue; c3_item(p, l, it - 1024, smem); }
      }
    }
  } else if (s == 3) {
    for (int it = bid; it < 256; it += G) glu_tile(p, l, it >> 1, it & 1, smem);
  } else if (s == 4) {
    const int total = 1024, nr = (total + G - 1) / G;
    for (int r = 0; r < nr; r++) { const int L = static_L(r, vb); if (L >= total) continue; int tm, tn; tile_from_linear(L, 8, tm, tn); pf_tile(p, l, tm, tn, smem); }
  } else {
    const int total = 1024, nr = (total + G - 1) / G;
    for (int r = 0; r < nr; r++) { const int L = static_L(r, vb); if (L >= total) continue; int tm, tn; tile_from_linear(L, 8, tm, tn); out_tile(p, l, tm, tn, smem); }
    if (l == 0) { conv_all(p, 1, smem); for (int it = NCONV + bid; it < NAUX; it += G) aux_item(p, 1, it, smem); }
  }
}

DI unsigned xb_ld(unsigned* q) { return __hip_atomic_load(q, __ATOMIC_RELAXED, __HIP_MEMORY_SCOPE_AGENT); }
DI unsigned xb_add(unsigned* q, unsigned v) { return __hip_atomic_fetch_add(q, v, __ATOMIC_RELAXED, __HIP_MEMORY_SCOPE_AGENT); }
DI void gbar(unsigned* bar, const int* st) {
  asm volatile("s_waitcnt vmcnt(0)" ::: "memory");
  __syncthreads();
  if (threadIdx.x == 0) {
    __builtin_amdgcn_s_waitcnt(0);
    const unsigned x = (unsigned)st[0], nloc = (unsigned)st[1], nx = (unsigned)st[2];
    const unsigned old = xb_add(&bar[1024 + 64 * x], 1u);
    const unsigned gen = old / nloc;
    if (old + 1u == (gen + 1u) * nloc) {
      __builtin_amdgcn_fence(__ATOMIC_RELEASE, "agent");
      asm volatile("s_waitcnt vmcnt(0)" ::: "memory");
      const unsigned og = xb_add(&bar[3072], 1u);
      const unsigned tg = og / nx;
      if (og + 1u == (tg + 1u) * nx) xb_add(&bar[3136], 1u);
      else while (xb_ld(&bar[3136]) == tg) __builtin_amdgcn_s_sleep(1);
      __builtin_amdgcn_fence(__ATOMIC_ACQUIRE, "agent");
      xb_add(&bar[2048 + 64 * x], 1u);
      asm volatile("s_waitcnt vmcnt(0)" ::: "memory");
    } else {
      while (xb_ld(&bar[2048 + 64 * x]) == gen) __builtin_amdgcn_s_sleep(1);
      __builtin_amdgcn_fence(__ATOMIC_ACQUIRE, "agent");
      asm volatile("s_waitcnt vmcnt(0)" ::: "memory");
    }
  }
  __syncthreads();
}

#if MK_MULTI
__global__ void __launch_bounds__(256, 2) hyb_phase(P p, int ph) {
  __shared__ __attribute__((aligned(16))) char smem[SM_TOTAL];
  run_phase(p, ph, smem, blockIdx.x);
}
#else
__global__ void __launch_bounds__(256, 2) hyb_mega(P p) {
  __shared__ __attribute__((aligned(16))) char smem[SM_TOTAL];
  cg::grid_group grid = cg::this_grid();
  if (p.dry == 0x7fffffff) grid.sync();
  int vb;
  {
    int* sl = (int*)(smem + SM_MISC) + 2;
    if (threadIdx.x == 0) {
      const unsigned xcc = (unsigned)__builtin_amdgcn_s_getreg((3 << 11) | 20) & 7u;
      const unsigned loc = xb_add(p.ctr + 40 + xcc, 1u);
      const unsigned Gx = gridDim.x >> 3;
      *sl = (loc < Gx) ? (int)(loc * 8 + xcc) : -1;
      unsigned sum, cnt, mine;
      for (;;) {
        sum = 0u; cnt = 0u; mine = 0u;
        for (unsigned j = 0; j < 8; ++j) { const unsigned c = xb_ld(p.ctr + 40 + j); sum += c; cnt += (c > 0u) ? 1u : 0u; mine = (j == xcc) ? c : mine; }
        if (sum == gridDim.x) break;
        __builtin_amdgcn_s_sleep(1);
      }
      sl[2] = (int)xcc; sl[3] = (int)mine; sl[4] = (int)cnt;
    }
    __syncthreads();
    vb = blockIdx.x;
  }
  const int* bst = (const int*)(smem + SM_MISC) + 4;
#ifdef DRY_PH
  P pd = p; { int one = DRY_MASK; asm volatile("" : "+s"(one)); pd.dry = one; }
#endif
#pragma unroll 1
  for (int ph = 0; ph < 13; ph++) {
#ifdef DRY_PH
    if (ph == DRY_PH) { run_phase(pd, ph, smem, vb); gbar(p.bar, bst); }
#endif
    run_phase(p, ph, smem, vb);
    if (ph < 12) gbar(p.bar, bst);
  }
}
#endif

extern "C" void kernel_launch(void* const* d_in, const int* in_sizes, int n_in, void* d_out, int out_size, void* d_ws, size_t ws_size, hipStream_t stream) {
  P p{};
  p.x = (const float*)d_in[0]; p.mem = (const float*)d_in[1]; p.pos = (const int*)d_in[2];
  p.norm_g = (const float*)d_in[3]; p.w_in = (const float*)d_in[4]; p.b_merge = (const float*)d_in[5];
  p.a_norm_g = (const float*)d_in[6]; p.a_w_s = (const float*)d_in[7]; p.a_b_s = (const float*)d_in[8];
  p.b_q_norm_g = (const float*)d_in[9]; p.b_kv_norm_g = (const float*)d_in[10]; p.b_w_uq = (const float*)d_in[11]; p.b_w_ukv = (const float*)d_in[12];
  p.b_qk_g_q = (const float*)d_in[13]; p.b_qk_g_k = (const float*)d_in[14];
  p.c_a_re = (const float*)d_in[15]; p.c_a_im = (const float*)d_in[16]; p.c_log_dt = (const float*)d_in[17];
  p.c_b_re = (const float*)d_in[18]; p.c_b_im = (const float*)d_in[19]; p.c_c_re = (const float*)d_in[20]; p.c_c_im = (const float*)d_in[21];
  p.c_d = (const float*)d_in[22]; p.c_w_glu = (const float*)d_in[23]; p.c_b_glu = (const float*)d_in[24];
  p.m_norm_g = (const float*)d_in[25]; p.m_w_kv = (const float*)d_in[26]; p.m_qk_g_q = (const float*)d_in[27]; p.m_qk_g_k = (const float*)d_in[28];
  p.w_br_a = (const float*)d_in[29]; p.w_br_b = (const float*)d_in[30]; p.w_br_c = (const float*)d_in[31]; p.w_br_m = (const float*)d_in[32];
  p.w_out = (const float*)d_in[33];
  p.out = (float*)d_out;
  char* ws = (char*)d_ws; size_t off = 0;
  auto take = [&](size_t bytes) { char* r = ws + off; off += (bytes + 255) & ~(size_t)255; return r; };
  p.z1 = (bf16_t*)take((size_t)T_ * Z1W * 2);
  p.z2 = (bf16_t*)take((size_t)T_ * Z2W * 2);
  p.xb = (bf16_t*)take((size_t)T_ * 1024 * 2);
  p.qf = (bf16_t*)take((size_t)T_ * 768 * 2);
  p.kf = (bf16_t*)take((size_t)T_ * 768 * 2);
  p.mg = p.qf;
  p.vt = (bf16_t*)take((size_t)8 * 8 * 64 * S_ * 2);
  p.hm = (bf16_t*)take((size_t)2048 * 1024 * 2);
  p.memk = (bf16_t*)take((size_t)2048 * 256 * 2);
  p.memvt = (bf16_t*)take((size_t)2048 * 256 * 2);
  p.WinT = (bf16_t*)take((size_t)NWIN * 1024 * 2);
  p.WuqT = (bf16_t*)take((size_t)1024 * 768 * 2);
  p.WukvT = (bf16_t*)take((size_t)1024 * 256 * 2);
  p.WgluT = (bf16_t*)take((size_t)256 * 256 * 2);
  p.WbrT = (bf16_t*)take((size_t)1024 * 1280 * 2);
  p.WoutT = (bf16_t*)take((size_t)2 * 1024 * 1024 * 2);
  p.WmkvT = (bf16_t*)take((size_t)512 * 1024 * 2);
  p.ssp = (float*)take((size_t)8 * T_ * 4);
  p.ssq = (float*)take((size_t)9 * T_ * 4);
  p.rope = (float*)take((size_t)T_ * 32 * 4);
  p.carry = (float*)take((size_t)8 * 16 * 32 * 64 * 2 * 4);
  p.ctr = (unsigned*)take(256);
  p.bar = (unsigned*)take(16384);
  if (off > ws_size) { fprintf(stderr, "workspace too small: need %zu have %zu\n", off, ws_size); return; }

  static int grid_blocks = 0;
  if (!grid_blocks) {
    int dev = 0, cus = 0, per_cu = 0;
    hipGetDevice(&dev);
    hipDeviceGetAttribute(&cus, hipDeviceAttributeMultiprocessorCount, dev);
#if MK_MULTI
    hipOccupancyMaxActiveBlocksPerMultiprocessor(&per_cu, hyb_phase, 256, 0);
#else
    hipOccupancyMaxActiveBlocksPerMultiprocessor(&per_cu, hyb_mega, 256, 0);
#endif
    if (per_cu > 2) per_cu = 2;
    if (per_cu < 1) per_cu = 1;
    grid_blocks = cus * per_cu;
    grid_blocks &= ~7;
  }
#if MK_MULTI
  for (int ph = 0; ph < 13; ph++) hipLaunchKernelGGL(hyb_phase, dim3(grid_blocks), dim3(256), 0, stream, p, ph);
#else
  hipMemsetAsync(p.ctr, 0, 256 + 16384, stream);
  void* args[] = {&p};
  hipError_t e = hipLaunchCooperativeKernel((void*)hyb_mega, dim3(grid_blocks), dim3(256), args, 0, stream);
  if (e != hipSuccess) fprintf(stderr, "cooperative launch failed: %s (grid %d)\n", hipGetErrorString(e), grid_blocks);
#endif
}
```

```cpp
#include <hip/hip_runtime.h>
#include <hip/hip_cooperative_groups.h>
#include <stdint.h>
#include <stdio.h>
#include <type_traits>
namespace cg = cooperative_groups;

#ifndef MK_MULTI
#define MK_MULTI 0
#endif

typedef unsigned short bf16_t;
typedef short bf16x8 __attribute__((ext_vector_type(8)));
typedef short s16x4 __attribute__((ext_vector_type(4)));
typedef float f32x16 __attribute__((ext_vector_type(16)));
typedef float f32x4 __attribute__((ext_vector_type(4)));
typedef float f32x2 __attribute__((ext_vector_type(2)));
typedef unsigned u32x4 __attribute__((ext_vector_type(4)));
typedef unsigned u32x2 __attribute__((ext_vector_type(2)));
#define DI __device__ __forceinline__
#define MFMA(a, b, c) __builtin_amdgcn_mfma_f32_32x32x16_bf16((a), (b), (c), 0, 0, 0)

constexpr int T_ = 16384, S_ = 2048;
constexpr int INW = 7456;
constexpr int Z1W = 2304, Z2W = 1152;
constexpr int NWIN = 7552;
constexpr float EPS = 1e-6f;
constexpr float LOG2E = 1.4426950408889634f;
constexpr int LDT = 72;
constexpr int EPW = 132;
constexpr int SM_MAIN = 4 * 128 * LDT * 2;
constexpr int SM_RS = SM_MAIN;
constexpr int SM_SS = SM_MAIN + 512;
constexpr int SM_MISC = SM_MAIN + 1024;
constexpr int SM_TOTAL = SM_MAIN + 1024 + 64;

struct P {
  const float* x; const float* mem; const int* pos;
  const float* norm_g; const float* w_in; const float* b_merge; const float* a_norm_g; const float* a_w_s; const float* a_b_s;
  const float* b_q_norm_g; const float* b_kv_norm_g; const float* b_w_uq; const float* b_w_ukv; const float* b_qk_g_q; const float* b_qk_g_k;
  const float* c_a_re; const float* c_a_im; const float* c_log_dt; const float* c_b_re; const float* c_b_im; const float* c_c_re; const float* c_c_im;
  const float* c_d; const float* c_w_glu; const float* c_b_glu;
  const float* m_norm_g; const float* m_w_kv; const float* m_qk_g_q; const float* m_qk_g_k;
  const float* w_br_a; const float* w_br_b; const float* w_br_c; const float* w_br_m; const float* w_out;
  float* out;
  bf16_t* z1; bf16_t* z2; bf16_t* xb; bf16_t* qf; bf16_t* kf; bf16_t* mg; bf16_t* vt; bf16_t* hm; bf16_t* memk; bf16_t* memvt;
  bf16_t* WinT; bf16_t* WuqT; bf16_t* WukvT; bf16_t* WgluT; bf16_t* WbrT; bf16_t* WoutT; bf16_t* WmkvT;
  float* ssp; float* ssq; float* rope; float* carry; unsigned* ctr; unsigned* bar;
  long dry;
};

DI int tid() { int t = threadIdx.x; asm volatile("" : "+v"(t)); return t; }
DI float bf2f(bf16_t b) { return __uint_as_float(((unsigned)b) << 16); }
DI unsigned pk2(float lo, float hi) { unsigned r; asm("v_cvt_pk_bf16_f32 %0, %1, %2" : "=v"(r) : "v"(lo), "v"(hi)); return r; }
DI unsigned pk2n(float lo, float hi) { unsigned r; asm("s_nop 1\n\tv_cvt_pk_bf16_f32 %0, %1, %2" : "=v"(r) : "v"(lo), "v"(hi)); return r; }
DI bf16_t f2bf(float x) { return (bf16_t)(pk2(x, 0.f) & 0xffffu); }
DI void unpack8(u32x4 v, float (&f)[8]) {
  f[0] = __uint_as_float(v.x << 16); f[1] = __uint_as_float(v.x & 0xffff0000u);
  f[2] = __uint_as_float(v.y << 16); f[3] = __uint_as_float(v.y & 0xffff0000u);
  f[4] = __uint_as_float(v.z << 16); f[5] = __uint_as_float(v.z & 0xffff0000u);
  f[6] = __uint_as_float(v.w << 16); f[7] = __uint_as_float(v.w & 0xffff0000u);
}
DI void unpack4(u32x2 v, float (&f)[4]) {
  f[0] = __uint_as_float(v.x << 16); f[1] = __uint_as_float(v.x & 0xffff0000u);
  f[2] = __uint_as_float(v.y << 16); f[3] = __uint_as_float(v.y & 0xffff0000u);
}
DI u32x4 pack8(const float (&f)[8]) { u32x4 r; r.x = pk2(f[0], f[1]); r.y = pk2(f[2], f[3]); r.z = pk2(f[4], f[5]); r.w = pk2(f[6], f[7]); return r; }
DI float sigm(float x) { return __builtin_amdgcn_rcpf(1.f + __expf(-x)); }
DI float silu(float x) { return x * sigm(x); }
DI float gelu_t(float x) { return x * sigm(1.5957691216057308f * (x + 0.044715f * x * x * x)); }
DI float sum16(float v) { v += __shfl_xor(v, 1); v += __shfl_xor(v, 2); v += __shfl_xor(v, 4); v += __shfl_xor(v, 8); return v; }
DI float sum8(float v) { v += __shfl_xor(v, 1); v += __shfl_xor(v, 2); v += __shfl_xor(v, 4); return v; }
DI float sum64(float v) { v = sum16(v); v += __shfl_xor(v, 16); v += __shfl_xor(v, 32); return v; }
DI int crow(int i, int h) { return (i & 3) + 8 * (i >> 2) + 4 * h; }
DI void zero_acc(f32x16 (&acc)[2][2]) {
#pragma unroll
  for (int a = 0; a < 2; a++)
#pragma unroll
    for (int b = 0; b < 2; b++)
#pragma unroll
      for (int i = 0; i < 16; i++) acc[a][b][i] = 0.f;
}

template <bool SS>
DI void gemm_loop(const bf16_t* __restrict__ A, long lda, const bf16_t* __restrict__ B, long ldb, int K,
                  f32x16 (&acc)[2][2], bf16_t* sm, float* ssS) {
  const int t = tid(), lane = t & 63, w = t >> 6, wm = w >> 1, wn = w & 1, l31 = lane & 31, h = lane >> 5;
  const int lr = t >> 3, lc = (t & 7) * 8;
  const bf16_t* ap = A + (long)lr * lda + lc;
  const bf16_t* bp = B + (long)lr * ldb + lc;
  bf16_t* wp = sm + lr * LDT + lc;
  const bf16_t* rA = sm + (wm * 64 + l31) * LDT + h * 8;
  const bf16_t* rB = sm + 2 * 128 * LDT + (wn * 64 + l31) * LDT + h * 8;
  u32x4 ra[4], rb[4];
  float ss[4] = {0.f, 0.f, 0.f, 0.f};
  const int nk = K >> 6;
  auto gl = [&](int ko) {
#pragma unroll
    for (int i = 0; i < 4; i++) { ra[i] = *(const u32x4*)(ap + (long)(32 * i) * lda + ko); rb[i] = *(const u32x4*)(bp + (long)(32 * i) * ldb + ko); }
  };
  auto st = [&](auto BUF) {
    constexpr int buf = decltype(BUF)::value;
#pragma unroll
    for (int i = 0; i < 4; i++) {
      *(u32x4*)(wp + buf * 128 * LDT + 32 * i * LDT) = ra[i];
      *(u32x4*)(wp + 2 * 128 * LDT + buf * 128 * LDT + 32 * i * LDT) = rb[i];
      if (SS) { float f[8]; unpack8(ra[i], f);
#pragma unroll
        for (int j = 0; j < 8; j++) ss[i] += f[j] * f[j]; }
    }
  };
  auto comp = [&](auto BUF) {
    constexpr int buf = decltype(BUF)::value;
#pragma unroll
    for (int kk = 0; kk < 4; kk++) {
      bf16x8 af[2], bfr[2];
#pragma unroll
      for (int mb = 0; mb < 2; mb++) af[mb] = *(const bf16x8*)(rA + buf * 128 * LDT + mb * 32 * LDT + kk * 16);
#pragma unroll
      for (int nb = 0; nb < 2; nb++) bfr[nb] = *(const bf16x8*)(rB + buf * 128 * LDT + nb * 32 * LDT + kk * 16);
#pragma unroll
      for (int mb = 0; mb < 2; mb++)
#pragma unroll
        for (int nb = 0; nb < 2; nb++) acc[mb][nb] = MFMA(af[mb], bfr[nb], acc[mb][nb]);
    }
  };
  using B0 = std::integral_constant<int, 0>; using B1 = std::integral_constant<int, 1>;
  gl(0);
  st(B0{});
  gl(64);
  __syncthreads();
  for (int ks = 0; ks < nk; ks += 2) {
    st(B1{});
    __builtin_amdgcn_sched_barrier(0);
    if (ks + 2 < nk) gl((ks + 2) * 64);
    __builtin_amdgcn_sched_barrier(0);
    comp(B0{});
    __syncthreads();
    if (ks + 2 < nk) st(B0{});
    __builtin_amdgcn_sched_barrier(0);
    if (ks + 3 < nk) gl((ks + 3) * 64);
    __builtin_amdgcn_sched_barrier(0);
    comp(B1{});
    __syncthreads();
  }
  if (SS) {
    const float inv = 1.0f / (float)K;
#pragma unroll
    for (int i = 0; i < 4; i++) { float s = sum8(ss[i]); if ((t & 7) == 0) ssS[lr + 32 * i] = rsqrtf(s * inv + EPS); }
  }
}

#define LAS3 __attribute__((address_space(3)))
struct GDesc { const bf16_t* A; long lda; const bf16_t* B; long ldb; };
DI void gemm_dma_stage0(const GDesc& d, char* smc) {
  const int t = tid(), lane = t & 63, w = t >> 6;
  const unsigned wdst = (unsigned)(uintptr_t)smc + (unsigned)w * 4096u;
#pragma unroll
  for (int i = 0; i < 4; i++) {
    const int row = 32 * w + 8 * i + (lane >> 3), c = (lane & 7) ^ ((row >> 1) & 7);
    __builtin_amdgcn_global_load_lds((const unsigned*)(d.A + row * d.lda + c * 8), (LAS3 unsigned*)(uintptr_t)(wdst + i * 1024), 16, 0, 0);
    __builtin_amdgcn_global_load_lds((const unsigned*)(d.B + row * d.ldb + c * 8), (LAS3 unsigned*)(uintptr_t)(wdst + 16384 + i * 1024), 16, 0, 0);
  }
}
DI void gemm_loop_dma(const bf16_t* __restrict__ A, long lda, const bf16_t* __restrict__ B, long ldb, int K, f32x16 (&acc)[2][2], char* smc,
                      bool started = false, bool has_next = false, GDesc next = GDesc{nullptr, 0, nullptr, 0}) {
  const int t = tid(), lane = t & 63, w = t >> 6, wm = w >> 1, wn = w & 1, l31 = lane & 31, h = lane >> 5;
  unsigned aoff[4], boff[4];
#pragma unroll
  for (int i = 0; i < 4; i++) {
    const int row = 32 * w + 8 * i + (lane >> 3), c = (lane & 7) ^ ((row >> 1) & 7);
    aoff[i] = (unsigned)((row * lda + c * 8) * 2); boff[i] = (unsigned)((row * ldb + c * 8) * 2);
  }
  const char* Ab = (const char*)A; const char* Bb = (const char*)B;
  const unsigned lbase = (unsigned)(uintptr_t)smc;
  const unsigned wdst = lbase + (unsigned)w * 4096u;
  const int swz = (l31 >> 1) & 7;
  unsigned fo[4];
#pragma unroll
  for (int kk = 0; kk < 4; kk++) fo[kk] = (unsigned)(((2 * kk + h) ^ swz) * 16);
  const char* rA = smc + (wm * 64 + l31) * 128;
  const char* rB = smc + 16384 + (wn * 64 + l31) * 128;
  const int nk = K >> 6;
  auto issue = [&](auto BUF, int ko) {
    constexpr int buf = decltype(BUF)::value;
#pragma unroll
    for (int i = 0; i < 4; i++) {
      __builtin_amdgcn_global_load_lds((const unsigned*)(Ab + (size_t)ko * 2 + aoff[i]), (LAS3 unsigned*)(uintptr_t)(wdst + buf * 32768 + i * 1024), 16, 0, 0);
      __builtin_amdgcn_global_load_lds((const unsigned*)(Bb + (size_t)ko * 2 + boff[i]), (LAS3 unsigned*)(uintptr_t)(wdst + buf * 32768 + 16384 + i * 1024), 16, 0, 0);
    }
  };
  auto comp = [&](auto BUF) {
    constexpr int buf = decltype(BUF)::value;
#pragma unroll
    for (int kk = 0; kk < 4; kk++) {
      bf16x8 af[2], bfr[2];
#pragma unroll
      for (int mb = 0; mb < 2; mb++) af[mb] = *(const bf16x8*)(rA + buf * 32768 + mb * 32 * 128 + fo[kk]);
#pragma unroll
      for (int nb = 0; nb < 2; nb++) bfr[nb] = *(const bf16x8*)(rB + buf * 32768 + nb * 32 * 128 + fo[kk]);
#pragma unroll
      for (int mb = 0; mb < 2; mb++)
#pragma unroll
        for (int nb = 0; nb < 2; nb++) acc[mb][nb] = MFMA(af[mb], bfr[nb], acc[mb][nb]);
    }
  };
  using B0 = std::integral_constant<int, 0>; using B1 = std::integral_constant<int, 1>;
  if (!started) issue(B0{}, 0);
  __syncthreads();
  for (int ks = 0; ks < nk; ks += 2) {
    issue(B1{}, (ks + 1) * 64);
    __builtin_amdgcn_sched_barrier(0);
    comp(B0{});
    __syncthreads();
    if (ks + 2 < nk) issue(B0{}, (ks + 2) * 64);
    else if (has_next) gemm_dma_stage0(next, smc);
    __builtin_amdgcn_sched_barrier(0);
    comp(B1{});
    __syncthreads();
  }
}

DI void gemm_loop_dma2(const bf16_t* __restrict__ A, long lda, const bf16_t* __restrict__ B0, const bf16_t* __restrict__ B1, long ldb, int K,
                       f32x16 (&accP)[2][2], f32x16 (&accQ)[2][2], char* smc) {
  const int t = tid(), lane = t & 63, w = t >> 6, wm = w >> 1, wn = w & 1, l31 = lane & 31, h = lane >> 5;
  unsigned aoff[2], boff[2];
#pragma unroll
  for (int i = 0; i < 2; i++) {
    const int row = 16 * (2 * w + i) + (lane >> 2), c = (lane & 3) ^ ((row >> 2) & 3);
    aoff[i] = (unsigned)((row * lda + c * 8) * 2); boff[i] = (unsigned)((row * ldb + c * 8) * 2);
  }
  const char* Ab = (const char*)A; const char* B0b = (const char*)B0; const char* B1b = (const char*)B1;
  const unsigned wdst = (unsigned)(uintptr_t)smc + (unsigned)w * 2048u;
  const int swz = (l31 >> 2) & 3;
  unsigned fo[2];
#pragma unroll
  for (int kk = 0; kk < 2; kk++) fo[kk] = (unsigned)(((2 * kk + h) ^ swz) * 16);
  const char* rA = smc + (wm * 64 + l31) * 64;
  const char* rB0 = smc + 8192 + (wn * 64 + l31) * 64;
  const char* rB1 = smc + 16384 + (wn * 64 + l31) * 64;
  const int nk = K >> 5;
  auto issue = [&](auto BUF, int ko) {
    constexpr int buf = decltype(BUF)::value;
#pragma unroll
    for (int i = 0; i < 2; i++) {
      __builtin_amdgcn_global_load_lds((const unsigned*)(Ab + (size_t)ko * 2 + aoff[i]), (LAS3 unsigned*)(uintptr_t)(wdst + buf * 24576 + i * 1024), 16, 0, 0);
      __builtin_amdgcn_global_load_lds((const unsigned*)(B0b + (size_t)ko * 2 + boff[i]), (LAS3 unsigned*)(uintptr_t)(wdst + buf * 24576 + 8192 + i * 1024), 16, 0, 0);
      __builtin_amdgcn_global_load_lds((const unsigned*)(B1b + (size_t)ko * 2 + boff[i]), (LAS3 unsigned*)(uintptr_t)(wdst + buf * 24576 + 16384 + i * 1024), 16, 0, 0);
    }
  };
  auto comp = [&](auto BUF) {
    constexpr int buf = decltype(BUF)::value;
#pragma unroll
    for (int kk = 0; kk < 2; kk++) {
      bf16x8 af[2], b0[2], b1[2];
#pragma unroll
      for (int mb = 0; mb < 2; mb++) af[mb] = *(const bf16x8*)(rA + buf * 24576 + mb * 32 * 64 + fo[kk]);
#pragma unroll
      for (int nb = 0; nb < 2; nb++) { b0[nb] = *(const bf16x8*)(rB0 + buf * 24576 + nb * 32 * 64 + fo[kk]); b1[nb] = *(const bf16x8*)(rB1 + buf * 24576 + nb * 32 * 64 + fo[kk]); }
#pragma unroll
      for (int mb = 0; mb < 2; mb++)
#pragma unroll
        for (int nb = 0; nb < 2; nb++) { accP[mb][nb] = MFMA(af[mb], b0[nb], accP[mb][nb]); accQ[mb][nb] = MFMA(af[mb], b1[nb], accQ[mb][nb]); }
    }
  };
  using S0 = std::integral_constant<int, 0>; using S1 = std::integral_constant<int, 1>;
  issue(S0{}, 0);
  __syncthreads();
  for (int ks = 0; ks < nk; ks += 2) {
    issue(S1{}, (ks + 1) * 32);
    __builtin_amdgcn_sched_barrier(0);
    comp(S0{});
    __syncthreads();
    if (ks + 2 < nk) issue(S0{}, (ks + 2) * 32);
    __builtin_amdgcn_sched_barrier(0);
    comp(S1{});
    __syncthreads();
  }
}

DI void acc_to_lds(const f32x16 (&acc)[2][2], float* ep) {
  const int t = tid(), lane = t & 63, w = t >> 6, wm = w >> 1, wn = w & 1, l31 = lane & 31, h = lane >> 5;
#pragma unroll
  for (int mb = 0; mb < 2; mb++)
#pragma unroll
    for (int nb = 0; nb < 2; nb++)
#pragma unroll
      for (int i = 0; i < 16; i++) ep[(wm * 64 + mb * 32 + crow(i, h)) * EPW + wn * 64 + nb * 32 + l31] = acc[mb][nb][i];
}
template <class F>
DI void rowwise(const float* ep, F f) {
  const int t = tid();
#pragma unroll 1
  for (int ps = 0; ps < 8; ps++) {
    const int row = ps * 16 + (t >> 4), c8 = (t & 15) * 8;
    float v[8];
    const f32x4 a = *(const f32x4*)(ep + row * EPW + c8), b = *(const f32x4*)(ep + row * EPW + c8 + 4);
    v[0] = a.x; v[1] = a.y; v[2] = a.z; v[3] = a.w; v[4] = b.x; v[5] = b.y; v[6] = b.z; v[7] = b.w;
    f(row, c8, v);
  }
}
template <class L, class F>
DI void rowwise2(const float* ep, L pre, F f) {
  const int t = tid();
  const int c8 = (t & 15) * 8;
#pragma unroll 1
  for (int g = 0; g < 2; g++) {
    decltype(pre(0, 0)) ld[4];
#pragma unroll
    for (int q = 0; q < 4; q++) ld[q] = pre((g * 4 + q) * 16 + (t >> 4), c8);
#pragma unroll
    for (int q = 0; q < 4; q++) {
      const int row = (g * 4 + q) * 16 + (t >> 4);
      float v[8];
      const f32x4 a = *(const f32x4*)(ep + row * EPW + c8), b = *(const f32x4*)(ep + row * EPW + c8 + 4);
      v[0] = a.x; v[1] = a.y; v[2] = a.z; v[3] = a.w; v[4] = b.x; v[5] = b.y; v[6] = b.z; v[7] = b.w;
      f(row, c8, v, ld[q]);
    }
  }
}
struct LdRope { f32x4 r[4]; };
struct LdKv { unsigned k2; u32x4 x1, x2; f32x4 r[4]; };
struct LdX { f32x4 a, b; };
struct LdGlu { u32x4 yg, gt; };
template <class F>
DI void tstore(const float* ep, int cb, int nc, const float* rowscale, F dst) {
  const int t = tid();
  const int ntask = nc * 16;
  for (int e = t; e < ntask; e += 256) {
    const int col = e % nc, rg = e / nc;
    float v[8];
#pragma unroll
    for (int j = 0; j < 8; j++) { float x = ep[(rg * 8 + j) * EPW + cb + col]; if (rowscale) x *= rowscale[rg * 8 + j]; v[j] = x; }
    *(u32x4*)(dst(col) + rg * 8) = pack8(v);
  }
}

DI void tile_from_linear(int L, int nN, int& tm, int& tn) { const int band = L / (8 * nN), rr = L % (8 * nN); tn = rr >> 3; tm = band * 8 + (rr & 7); }
DI int static_L(int round, int vb) { const int Gx = gridDim.x >> 3; return (round * 8 + (vb & 7)) * Gx + (vb >> 3); }
DI int next_item(unsigned* ctr, int* slot) {
  __syncthreads();
  if (threadIdx.x == 0) *slot = (int)atomicAdd(ctr, 1u);
  __syncthreads();
  return *slot;
}

DI int colmap(int mode, int n) {
  if (mode == 0) return n;
  if (mode == 1) { if (n < 768) return n; if (n < 2304) return n + 1056; if (n < 3360) return n - 1536; if (n < 3456) return -1; return n - 96; }
  { const int hh = n >> 7, j = n & 127; return j < 96 ? hh * 96 + j : -1; }
}
struct CDesc { const float* src; const float* g; bf16_t* dst; int ld, K, mode, it; };
DI void conv_load(const CDesc& d, f32x4 (&v)[8]) {
  const int t = tid();
  const int nkt = d.K >> 6, kt = d.it % nkt, nt = d.it / nkt, k0 = kt * 64, n0 = nt * 128;
  const int n4 = (t & 31) * 4, c = colmap(d.mode, n0 + n4);
#pragma unroll
  for (int i = 0; i < 8; i++) {
    const int kk = (t >> 5) + 8 * i;
    if (c >= 0) v[i] = __builtin_nontemporal_load((const f32x4*)(d.src + (long)(k0 + kk) * d.ld + c)); else { v[i].x = 0.f; v[i].y = 0.f; v[i].z = 0.f; v[i].w = 0.f; }
  }
}
DI void conv_finish(const CDesc& d, f32x4 (&v)[8], float* sm) {
  const int t = tid();
  const int nkt = d.K >> 6, kt = d.it % nkt, nt = d.it / nkt, k0 = kt * 64, n0 = nt * 128;
  const int n4 = (t & 31) * 4;
#pragma unroll
  for (int i = 0; i < 8; i++) {
    const int kk = (t >> 5) + 8 * i;
    if (d.g) { const float gg = d.g[k0 + kk]; v[i].x *= gg; v[i].y *= gg; v[i].z *= gg; v[i].w *= gg; }
    *(f32x4*)(sm + kk * 132 + n4) = v[i];
  }
  __syncthreads();
#pragma unroll
  for (int i = 0; i < 2; i++) {
    const int nn = (t >> 2) + 64 * i, ks = (t & 3) * 16;
    float f[16];
#pragma unroll
    for (int j = 0; j < 16; j++) f[j] = sm[(ks + j) * 132 + nn];
    u32x4 o0, o1;
    o0.x = pk2(f[0], f[1]); o0.y = pk2(f[2], f[3]); o0.z = pk2(f[4], f[5]); o0.w = pk2(f[6], f[7]);
    o1.x = pk2(f[8], f[9]); o1.y = pk2(f[10], f[11]); o1.z = pk2(f[12], f[13]); o1.w = pk2(f[14], f[15]);
    bf16_t* dd = d.dst + (long)(n0 + nn) * d.K + k0 + ks;
    *(u32x4*)dd = o0; *(u32x4*)(dd + 8) = o1;
  }
  __syncthreads();
}
constexpr int NCONV = 944 + 96 + 32 + 8 + 32 + 64 + 32 + 32 + 128 + 64;
constexpr int NAUX = NCONV + 512;
DI CDesc conv_desc(const P& p, int l, int it) {
  CDesc d; d.g = nullptr; d.mode = 0;
  if (it < 944) { d.src = p.w_in + (long)l * 1024 * INW; d.ld = INW; d.K = 1024; d.mode = 1; d.g = p.norm_g + l * 1024; d.dst = p.WinT; d.it = it; return d; }
  it -= 944;
  if (it < 96) { d.src = p.b_w_uq + (long)l * 768 * 768; d.ld = 768; d.K = 768; d.mode = 2; d.g = p.b_q_norm_g + l * 768; d.dst = p.WuqT; d.it = it; return d; }
  it -= 96;
  if (it < 32) { d.src = p.b_w_ukv + (long)l * 256 * 1024; d.ld = 1024; d.K = 256; d.g = p.b_kv_norm_g + l * 256; d.dst = p.WukvT; d.it = it; return d; }
  it -= 32;
  if (it < 8) { d.src = p.c_w_glu + (long)l * 256 * 256; d.ld = 256; d.K = 256; d.dst = p.WgluT; d.it = it; return d; }
  it -= 8;
  if (it < 32) { d.src = p.w_br_a + (long)l * 256 * 1024; d.ld = 1024; d.K = 256; d.dst = p.WbrT; d.it = it; return d; }
  it -= 32;
  if (it < 64) { d.src = p.w_br_b + (long)l * 512 * 1024; d.ld = 1024; d.K = 512; d.dst = p.WbrT + 1024 * 256; d.it = it; return d; }
  it -= 64;
  if (it < 32) { d.src = p.w_br_c + (long)l * 256 * 1024; d.ld = 1024; d.K = 256; d.dst = p.WbrT + 1024 * 768; d.it = it; return d; }
  it -= 32;
  if (it < 32) { d.src = p.w_br_m + (long)l * 256 * 1024; d.ld = 1024; d.K = 256; d.dst = p.WbrT + 1024 * 1024; d.it = it; return d; }
  it -= 32;
  if (it < 128) { d.src = p.w_out + (long)l * 1024 * 1024; d.ld = 1024; d.K = 1024; d.dst = p.WoutT + (long)l * 1024 * 1024; d.it = it; return d; }
  it -= 128;
  d.src = p.m_w_kv + (long)l * 1024 * 512; d.ld = 512; d.K = 1024; d.dst = p.WmkvT; d.it = it; return d;
}
DI void conv_all(const P& p, int l, char* smem) {
  const int G = gridDim.x, bid = blockIdx.x;
  float* sm = (float*)smem;
  if (bid >= NCONV) return;
  f32x4 va[8], vb[8];
  CDesc da = conv_desc(p, l, bid), db = da;
  conv_load(da, va);
#pragma unroll 1
  for (int it = bid; it < NCONV; it += 2 * G) {
    const bool h1 = it + G < NCONV;
    if (h1) { db = conv_desc(p, l, it + G); conv_load(db, vb); }
    conv_finish(da, va, sm);
    const bool h2 = it + 2 * G < NCONV;
    if (h2) { da = conv_desc(p, l, it + 2 * G); conv_load(da, va); }
    if (h1) conv_finish(db, vb, sm);
  }
}
DI void aux_item(const P& p, int l, int it, char* smem) {
  it -= NCONV;
  {
    const int t = tid(), lane = t & 63, row = it * 4 + (t >> 6);
    const float* src = p.mem + (long)row * 1024; const float* g = p.m_norm_g + l * 1024;
    f32x4 v[4]; float ss = 0.f;
#pragma unroll
    for (int i = 0; i < 4; i++) { v[i] = *(const f32x4*)(src + (lane + 64 * i) * 4); ss += v[i].x * v[i].x + v[i].y * v[i].y + v[i].z * v[i].z + v[i].w * v[i].w; }
    ss = sum64(ss);
    const float r = rsqrtf(ss * (1.f / 1024.f) + EPS);
#pragma unroll
    for (int i = 0; i < 4; i++) {
      const f32x4 gg = *(const f32x4*)(g + (lane + 64 * i) * 4);
      u32x2 o; o.x = pk2(v[i].x * r * gg.x, v[i].y * r * gg.y); o.y = pk2(v[i].z * r * gg.z, v[i].w * r * gg.w);
      *(u32x2*)(p.hm + (long)row * 1024 + (lane + 64 * i) * 4) = o;
    }
  }
}

DI void p0_xrow_item(const P& p, int it) {
  const int t = tid(), lane = t & 63;
  f32x4 v[2][4];
#pragma unroll
  for (int r = 0; r < 2; r++) {
    const float* src = p.x + (long)(it * 8 + (t >> 6) * 2 + r) * 1024;
#pragma unroll
    for (int i = 0; i < 4; i++) v[r][i] = __builtin_nontemporal_load((const f32x4*)(src + (lane + 64 * i) * 4));
  }
#pragma unroll
  for (int r = 0; r < 2; r++) {
    const int row = it * 8 + (t >> 6) * 2 + r;
    float ss = 0.f;
#pragma unroll
    for (int i = 0; i < 4; i++) ss += v[r][i].x * v[r][i].x + v[r][i].y * v[r][i].y + v[r][i].z * v[r][i].z + v[r][i].w * v[r][i].w;
    ss = sum64(ss);
#pragma unroll
    for (int i = 0; i < 4; i++) { u32x2 o; o.x = pk2(v[r][i].x, v[r][i].y); o.y = pk2(v[r][i].z, v[r][i].w); *(u32x2*)(p.xb + (long)row * 1024 + (lane + 64 * i) * 4) = o; }
    if (lane < 8) p.ssp[(long)lane * T_ + row] = (lane == 0) ? ss : 0.f;
  }
}
DI void p0_rope_item(const P& p, int it) {
  const int e = it * 256 + threadIdx.x, tok = e >> 4, i = e & 15;
  const float inv_freq = exp2f(-(float)i * (13.287712379549449f / 16.f));
  const float ang = (float)p.pos[tok] * inv_freq;
  const double rev = (double)ang * 0.15915494309189535;
  const float fr = (float)(rev - rint(rev));
  p.rope[(long)e * 2] = __builtin_amdgcn_cosf(fr);
  p.rope[(long)e * 2 + 1] = __builtin_amdgcn_sinf(fr);
}

DI void load_rs(const P& p, int r0, float* rsS) {
  const int t = tid();
  if (t < 128) { float s = 0.f;
#pragma unroll
    for (int j = 0; j < 8; j++) s += p.ssp[(long)j * T_ + r0 + t];
    rsS[t] = rsqrtf(s * (1.f / 1024.f) + EPS); }
}
DI void g1_tile(const P& p, int l, int tm, int tn, char* smem) {
  bf16_t* sm = (bf16_t*)smem; float* ep = (float*)smem; float* rsS = (float*)(smem + SM_RS);
  const int r0 = tm * 128, c0 = tn * 128;
  load_rs(p, r0, rsS);
  f32x16 acc[2][2]; zero_acc(acc);
  gemm_loop_dma(p.xb + (long)r0 * 1024, 1024, p.WinT + (long)c0 * 1024, 1024, 1024, acc, smem);
  acc_to_lds(acc, ep);
  __syncthreads();
  int type; bf16_t* dst; int ld;
  if (c0 < 2304) { dst = p.z1 + c0; ld = Z1W;
    if (c0 < 512) type = 1; else if (c0 < 1280) type = 2; else if (c0 < 1536) type = 0; else if (c0 < 1792) type = 2; else if (c0 < 2048) type = 3; else type = 2;
  } else { dst = p.z2 + (c0 - 2304); ld = Z2W; type = 0; }
  const float* gq = p.m_qk_g_q + l * 64;
  rowwise(ep, [&](int row, int c8, float (&v)[8]) {
    const float r = rsS[row];
#pragma unroll
    for (int j = 0; j < 8; j++) v[j] *= r;
    if (type == 1) {
#pragma unroll
      for (int j = 0; j < 8; j++) v[j] = gelu_t(v[j]);
    } else if (type == 2) {
#pragma unroll
      for (int j = 0; j < 8; j++) v[j] = silu(v[j]);
    } else if (type == 3) {
      float ss = 0.f;
#pragma unroll
      for (int j = 0; j < 8; j++) ss += v[j] * v[j];
      ss = sum8(ss);
      const float rq = rsqrtf(ss * (1.f / 64.f) + EPS) * (0.125f * LOG2E);
#pragma unroll
      for (int j = 0; j < 8; j++) v[j] *= rq * gq[(c8 & 63) + j];
    }
    *(u32x4*)(dst + (long)(r0 + row) * ld + c8) = pack8(v);
    if (c0 >= 2304) {
      float ss = 0.f;
#pragma unroll
      for (int j = 0; j < 8; j++) ss += v[j] * v[j];
      ss = sum16(ss);
      if ((c8 >> 3) == 0) p.ssq[(long)((c0 - 2304) >> 7) * T_ + r0 + row] = ss;
    }
  });
  __syncthreads();
}
DI void g1m_tile(const P& p, int l, int tm, int tn, char* smem) {
  bf16_t* sm = (bf16_t*)smem; float* ep = (float*)smem;
  const int r0 = tm * 128, c0 = tn * 128;
  f32x16 acc[2][2]; zero_acc(acc);
  gemm_loop_dma(p.hm + (long)r0 * 1024, 1024, p.WmkvT + (long)c0 * 1024, 1024, 1024, acc, smem);
  acc_to_lds(acc, ep);
  __syncthreads();
  if (tn < 2) {
    const float* gk = p.m_qk_g_k + l * 64;
    rowwise(ep, [&](int row, int c8, float (&v)[8]) {
      float ss = 0.f;
#pragma unroll
      for (int j = 0; j < 8; j++) ss += v[j] * v[j];
      ss = sum8(ss);
      const float rq = rsqrtf(ss * (1.f / 64.f) + EPS);
#pragma unroll
      for (int j = 0; j < 8; j++) v[j] *= rq * gk[(c8 & 63) + j];
      *(u32x4*)(p.memk + (long)(r0 + row) * 256 + c0 + c8) = pack8(v);
    });
  } else {
    const int b = r0 >> 8, m0 = r0 & 255, cv0 = c0 - 256;
    tstore(ep, 0, 128, nullptr, [&](int col) { const int cv = cv0 + col; return p.memvt + ((long)((b * 4 + (cv >> 6)) * 64 + (cv & 63))) * 256 + m0; });
  }
  __syncthreads();
}

DI void g2q_tile(const P& p, int l, int tm, int hh, char* smem) {
  bf16_t* sm = (bf16_t*)smem; float* ep = (float*)smem; float* ssS = (float*)(smem + SM_SS);
  const int r0 = tm * 128;
  f32x16 acc[2][2]; zero_acc(acc);
  { const int t = tid(); if (t < 128) { float q = 0.f;
#pragma unroll
      for (int j = 0; j < 6; j++) q += p.ssq[(long)j * T_ + r0 + t];
      ssS[t] = rsqrtf(q * (1.f / 768.f) + EPS); } }
  gemm_loop_dma(p.z2 + (long)r0 * Z2W, Z2W, p.WuqT + (long)hh * 128 * 768, 768, 768, acc, smem);
  acc_to_lds(acc, ep);
  __syncthreads();
  const float* gq = p.b_qk_g_q + l * 96;
  const float QSC = 0.10206207261596575f * LOG2E;
  rowwise2(ep, [&](int row, int c8) {
    LdRope L;
    const int tc = c8 >> 3;
    if (tc >= 8 && tc < 12) {
      const float* rp = p.rope + ((long)(r0 + row) * 16 + (tc & 1) * 8) * 2;
#pragma unroll
      for (int j = 0; j < 4; j++) L.r[j] = *(const f32x4*)(rp + 4 * j);
    } else {
#pragma unroll
      for (int j = 0; j < 4; j++) { L.r[j].x = 0.f; L.r[j].y = 0.f; L.r[j].z = 0.f; L.r[j].w = 0.f; }
    }
    return L;
  }, [&](int row, int c8, float (&v)[8], const LdRope& L) {
    const float rs = ssS[row];
    float ss = 0.f;
#pragma unroll
    for (int j = 0; j < 8; j++) { v[j] *= rs; ss += v[j] * v[j]; }
    ss = sum16(ss);
    const float rq = rsqrtf(ss * (1.f / 96.f) + EPS);
    const int tc = c8 >> 3;
    bf16_t* qd = p.qf + (long)(r0 + row) * 768 + hh * 96;
    if (tc < 8) {
#pragma unroll
      for (int j = 0; j < 8; j++) v[j] *= rq * gq[c8 + j] * QSC;
      *(u32x4*)(qd + c8) = pack8(v);
    } else if (tc < 12) {
      const int i0 = (tc & 1) * 8; const bool first = tc < 10;
      const int pc = first ? 80 + i0 : 64 + i0;
      const float csn[16] = {L.r[0].x, L.r[0].y, L.r[0].z, L.r[0].w, L.r[1].x, L.r[1].y, L.r[1].z, L.r[1].w,
                             L.r[2].x, L.r[2].y, L.r[2].z, L.r[2].w, L.r[3].x, L.r[3].y, L.r[3].z, L.r[3].w};
      float o[8];
#pragma unroll
      for (int j = 0; j < 8; j++) {
        const float own = v[j] * rq * gq[c8 + j];
        const float oth = ep[row * EPW + pc + j] * rs * rq * gq[pc + j];
        const float cs = csn[2 * j], sn = csn[2 * j + 1];
        o[j] = (first ? (own * cs - oth * sn) : (own * cs + oth * sn)) * QSC;
      }
      *(u32x4*)(qd + c8) = pack8(o);
    }
  });
  __syncthreads();
}
DI void g2kv_tile(const P& p, int l, int tm, int hh, char* smem) {
  bf16_t* sm = (bf16_t*)smem; float* ep = (float*)smem; float* ssS = (float*)(smem + SM_SS);
  const int r0 = tm * 128;
  f32x16 acc[2][2]; zero_acc(acc);
  { const int t = tid(); if (t < 128) { const float q = p.ssq[(long)6 * T_ + r0 + t] + p.ssq[(long)7 * T_ + r0 + t];
      ssS[t] = rsqrtf(q * (1.f / 256.f) + EPS); } }
  gemm_loop_dma(p.z2 + (long)r0 * Z2W + 768, Z2W, p.WukvT + (long)hh * 128 * 256, 256, 256, acc, smem);
  acc_to_lds(acc, ep);
  __syncthreads();
  const float* gk = p.b_qk_g_k + l * 96;
  rowwise2(ep, [&](int row, int c8) {
    LdKv L;
    const int tc = c8 >> 3;
    const bf16_t* krp = p.z2 + (long)(r0 + row) * Z2W + 1024;
    L.k2 = *(const unsigned*)(krp + 2 * tc);
    if (tc >= 8 && tc < 12) {
      const int i0 = (tc & 1) * 8;
      L.x1 = *(const u32x4*)(krp + i0); L.x2 = *(const u32x4*)(krp + 16 + i0);
      const float* rp = p.rope + ((long)(r0 + row) * 16 + i0) * 2;
#pragma unroll
      for (int j = 0; j < 4; j++) L.r[j] = *(const f32x4*)(rp + 4 * j);
    } else {
      L.x1.x = 0; L.x1.y = 0; L.x1.z = 0; L.x1.w = 0; L.x2 = L.x1;
#pragma unroll
      for (int j = 0; j < 4; j++) { L.r[j].x = 0.f; L.r[j].y = 0.f; L.r[j].z = 0.f; L.r[j].w = 0.f; }
    }
    return L;
  }, [&](int row, int c8, float (&v)[8], const LdKv& L) {
    const float rs = ssS[row];
    const int tc = c8 >> 3;
    const unsigned k2 = L.k2;
    const float ka = __uint_as_float(k2 << 16), kb = __uint_as_float(k2 & 0xffff0000u);
    float ss = ka * ka + kb * kb;
    if (tc < 8) {
#pragma unroll
      for (int j = 0; j < 8; j++) { v[j] *= rs; ss += v[j] * v[j]; }
    }
    ss = sum16(ss);
    const float kn = rsqrtf(ss * (1.f / 96.f) + EPS);
    bf16_t* kd = p.kf + (long)(r0 + row) * 768 + hh * 96;
    if (tc < 8) {
#pragma unroll
      for (int j = 0; j < 8; j++) v[j] *= kn * gk[c8 + j];
      *(u32x4*)(kd + c8) = pack8(v);
    } else if (tc < 12) {
      const int i0 = (tc & 1) * 8; const bool first = tc < 10;
      float x1[8], x2[8], o[8];
      unpack8(L.x1, x1);
      unpack8(L.x2, x2);
      const float csn[16] = {L.r[0].x, L.r[0].y, L.r[0].z, L.r[0].w, L.r[1].x, L.r[1].y, L.r[1].z, L.r[1].w,
                             L.r[2].x, L.r[2].y, L.r[2].z, L.r[2].w, L.r[3].x, L.r[3].y, L.r[3].z, L.r[3].w};
#pragma unroll
      for (int j = 0; j < 8; j++) {
        const float a = x1[j] * kn * gk[64 + i0 + j], b = x2[j] * kn * gk[80 + i0 + j];
        const float cs = csn[2 * j], sn = csn[2 * j + 1];
        o[j] = first ? (a * cs - b * sn) : (b * cs + a * sn);
      }
      *(u32x4*)(kd + (first ? 64 : 80) + i0) = pack8(o);
    }
  });
  {
    const int b = r0 >> 11, s0 = r0 & 2047;
    tstore(ep, 64, 64, ssS, [&](int col) { return p.vt + ((long)((b * 8 + hh) * 64 + col)) * S_ + s0; });
  }
  __syncthreads();
}

template <int DQK, bool CAUSAL>
DI void attn_item(const bf16_t* __restrict__ q, long q_ld, const bf16_t* __restrict__ k, long k_ld, const bf16_t* __restrict__ vt, long vt_ld,
                  bf16_t* og, long o_ld, int q0, int nkt, char* smem, bool dry) {
  constexpr int KS = DQK + 8, NKC = DQK / 8, NKL = (64 * NKC) / 256, NKK = DQK / 16, VS = 68;
  bf16_t* sK = (bf16_t*)smem;
  bf16_t* sV = (bf16_t*)smem + 2 * 64 * KS;
  const int t = tid(), lane = t & 63, w = t >> 6, l31 = lane & 31, h = lane >> 5;
  bf16x8 qfr[NKK];
  {
    const bf16_t* qp = q + (long)(w * 32 + l31) * q_ld + h * 8;
#pragma unroll
    for (int kk = 0; kk < NKK; kk++) qfr[kk] = *(const bf16x8*)(qp + kk * 16);
  }
  u32x4 rk[NKL], rv[2];
  auto gload = [&](int kt) {
#pragma unroll
    for (int i = 0; i < NKL; i++) { const int c = t + 256 * i, key = c / NKC, kc = c % NKC; rk[i] = *(const u32x4*)(k + (long)(kt * 64 + key) * k_ld + kc * 8); }
#pragma unroll
    for (int i = 0; i < 2; i++) { const int c = t + 256 * i, d = c >> 3, kc = c & 7; rv[i] = *(const u32x4*)(vt + (long)d * vt_ld + kt * 64 + kc * 8); }
  };
  auto lstore = [&](int buf) {
    bf16_t* dK = sK + buf * 64 * KS; bf16_t* dV = sV + buf * 64 * VS;
#pragma unroll
    for (int i = 0; i < NKL; i++) { const int c = t + 256 * i, key = c / NKC, kc = c % NKC; *(u32x4*)(dK + key * KS + kc * 8) = rk[i]; }
#pragma unroll
    for (int i = 0; i < 2; i++) { const int c = t + 256 * i, d = c >> 3, kc = c & 7;
      u32x2 lo, hi; lo.x = rv[i].x; lo.y = rv[i].y; hi.x = rv[i].z; hi.y = rv[i].w;
      *(u32x2*)(dV + d * VS + kc * 8) = lo; *(u32x2*)(dV + d * VS + kc * 8 + 4) = hi; }
  };
  f32x16 o[2];
#pragma unroll
  for (int i = 0; i < 16; i++) { o[0][i] = 0.f; o[1][i] = 0.f; }
  float m = -1e30f, lsum = 0.f;
  const int qpos = q0 + w * 32 + l31;
  gload(0); lstore(0);
  if (nkt > 1) gload(1);
  __syncthreads();
  for (int kt = 0; kt < nkt; kt++) {
    if (kt + 1 < nkt) lstore((kt + 1) & 1);
    __builtin_amdgcn_sched_barrier(0);
    if (kt + 2 < nkt) gload(kt + 2);
    __builtin_amdgcn_sched_barrier(0);
    const bool active = !CAUSAL || (kt * 64 <= q0 + w * 32 + 31);
    if (active) {
      const bf16_t* cK = sK + (kt & 1) * 64 * KS; const bf16_t* cV = sV + (kt & 1) * 64 * VS;
      f32x16 s[2];
#pragma unroll
      for (int i = 0; i < 16; i++) { s[0][i] = 0.f; s[1][i] = 0.f; }
      __builtin_amdgcn_s_setprio(1);
#pragma unroll
      for (int kb = 0; kb < 2; kb++)
#pragma unroll
        for (int kk = 0; kk < NKK; kk++) {
          const bf16x8 kf_ = *(const bf16x8*)(cK + (kb * 32 + l31) * KS + kk * 16 + h * 8);
          s[kb] = MFMA(kf_, qfr[kk], s[kb]);
        }
      __builtin_amdgcn_s_setprio(0);
      if (CAUSAL && (kt * 64 + 63 > q0 + w * 32)) {
#pragma unroll
        for (int kb = 0; kb < 2; kb++)
#pragma unroll
          for (int i = 0; i < 16; i++) { const int key = kt * 64 + kb * 32 + crow(i, h); if (key > qpos) s[kb][i] = -1e30f; }
      }
      float mx = s[0][0];
#pragma unroll
      for (int kb = 0; kb < 2; kb++)
#pragma unroll
        for (int i = 0; i < 16; i++) mx = fmaxf(mx, s[kb][i]);
      mx = fmaxf(mx, __shfl_xor(mx, 32));
      const float mnew = fmaxf(m, mx);
      const float alpha = __builtin_amdgcn_exp2f(m - mnew);
      m = mnew;
      float ps = 0.f;
#pragma unroll
      for (int kb = 0; kb < 2; kb++)
#pragma unroll
        for (int i = 0; i < 16; i++) { const float pv = __builtin_amdgcn_exp2f(s[kb][i] - mnew); s[kb][i] = pv; ps += pv; }
      lsum = lsum * alpha + ps;
#pragma unroll
      for (int i = 0; i < 16; i++) { o[0][i] *= alpha; o[1][i] *= alpha; }
      __builtin_amdgcn_s_setprio(1);
#pragma unroll
      for (int kb = 0; kb < 2; kb++)
#pragma unroll
        for (int st = 0; st < 2; st++) {
          u32x4 pp; pp.x = pk2(s[kb][8 * st + 0], s[kb][8 * st + 1]); pp.y = pk2(s[kb][8 * st + 2], s[kb][8 * st + 3]);
          pp.z = pk2(s[kb][8 * st + 4], s[kb][8 * st + 5]); pp.w = pk2(s[kb][8 * st + 6], s[kb][8 * st + 7]);
          const bf16x8 pf = __builtin_bit_cast(bf16x8, pp);
#pragma unroll
          for (int db = 0; db < 2; db++) {
            const bf16_t* vp = cV + (db * 32 + l31) * VS + kb * 32 + st * 16 + 4 * h;
            const u32x2 lo = *(const u32x2*)vp, hi = *(const u32x2*)(vp + 8);
            u32x4 vv; vv.x = lo.x; vv.y = lo.y; vv.z = hi.x; vv.w = hi.y;
            o[db] = MFMA(__builtin_bit_cast(bf16x8, vv), pf, o[db]);
          }
        }
      __builtin_amdgcn_s_setprio(0);
    }
    __syncthreads();
  }
  lsum += __shfl_xor(lsum, 32);
  const float inv = 1.f / lsum;
  bf16_t* op = og + (long)(w * 32 + l31) * o_ld;
#pragma unroll
  for (int db = 0; db < 2; db++)
#pragma unroll
    for (int ig = 0; ig < 4; ig++) {
      const int d = db * 32 + ig * 8 + 4 * h;
      float gt[4]; unpack4(*(const u32x2*)(op + d), gt);
      u32x2 r; r.x = pk2(o[db][4 * ig + 0] * inv * gt[0], o[db][4 * ig + 1] * inv * gt[1]); r.y = pk2(o[db][4 * ig + 2] * inv * gt[2], o[db][4 * ig + 3] * inv * gt[3]);
      if (!dry) *(u32x2*)(op + d) = r;
    }
}
DI void mattn_item(const P& p, int idx, char* smem) {
  const int b = idx >> 6, hh = (idx >> 4) & 3, qt = idx & 15;
  const long tok0 = (long)b * S_ + qt * 128;
  attn_item<64, false>(p.z1 + tok0 * Z1W + 1792 + hh * 64, Z1W, p.memk + (long)b * 256 * 256 + hh * 64, 256,
                       p.memvt + (long)(b * 4 + hh) * 64 * 256, 256, p.z1 + tok0 * Z1W + 2048 + hh * 64, Z1W, 0, 4, smem, p.dry != 0);
}
DI void battn_item(const P& p, int idx, char* smem) {
  const int qt = 15 - (idx >> 6), bh = idx & 63, b = bh >> 3, hh = bh & 7;
  const long tok0 = (long)b * S_ + qt * 128;
  attn_item<96, true>(p.qf + tok0 * 768 + hh * 96, 768, p.kf + (long)b * S_ * 768 + hh * 96, 768,
                      p.vt + (long)(b * 8 + hh) * 64 * S_, S_, p.z1 + tok0 * Z1W + 768 + hh * 64, Z1W, qt * 128, 2 * qt + 2, smem, p.dry != 0);
}

DI void a_item(const P& p, int l, int idx, char* smem) {
  bf16_t* vnT = (bf16_t*)smem;
  float* part = (float*)(smem + 256 * 136 * 2);
  const int t = tid(); const long r0 = (long)idx * 128;
  {
    const int row = t & 127, half = t >> 7;
    const bf16_t* src = p.z1 + (r0 + row) * Z1W + 256 + half * 128;
    float ss = 0.f;
#pragma unroll 4
    for (int i = 0; i < 16; i++) { float f[8]; unpack8(*(const u32x4*)(src + i * 8), f);
#pragma unroll
      for (int j = 0; j < 8; j++) ss += f[j] * f[j]; }
    part[half * 128 + row] = ss;
    __syncthreads();
    const float r = rsqrtf((part[row] + part[128 + row]) * (1.f / 256.f) + EPS);
    const float* gv = p.a_norm_g + l * 256 + half * 128;
#pragma unroll 4
    for (int i = 0; i < 16; i++) { float f[8]; unpack8(*(const u32x4*)(src + i * 8), f);
#pragma unroll
      for (int j = 0; j < 8; j++) vnT[(half * 128 + i * 8 + j) * 136 + row] = f2bf(f[j] * r * gv[i * 8 + j]); }
  }
  __syncthreads();
  const int lane = t & 63, g = t >> 6, l31 = lane & 31, h = lane >> 5;
  const float* W = p.a_w_s + (long)(l * 4 + g) * 128 * 128;
  const float* bs = p.a_b_s + (l * 4 + g) * 128;
#pragma unroll 1
  for (int mh = 0; mh < 2; mh++) {
    f32x16 acc[2][2]; zero_acc(acc);
#pragma unroll 2
    for (int kk = 0; kk < 8; kk++) {
      bf16x8 af[2], bfr[2];
#pragma unroll
      for (int mb = 0; mb < 2; mb++) {
        const int tt = mh * 64 + mb * 32 + l31, s0 = kk * 16 + h * 8;
        const f32x4 w0 = *(const f32x4*)(W + tt * 128 + s0), w1 = *(const f32x4*)(W + tt * 128 + s0 + 4);
        float f[8] = {w0.x, w0.y, w0.z, w0.w, w1.x, w1.y, w1.z, w1.w};
#pragma unroll
        for (int j = 0; j < 8; j++) if (s0 + j > tt) f[j] = 0.f;
        af[mb] = __builtin_bit_cast(bf16x8, pack8(f));
      }
#pragma unroll
      for (int nb = 0; nb < 2; nb++) bfr[nb] = *(const bf16x8*)(vnT + (g * 64 + nb * 32 + l31) * 136 + kk * 16 + h * 8);
#pragma unroll
      for (int mb = 0; mb < 2; mb++)
#pragma unroll
        for (int nb = 0; nb < 2; nb++) acc[mb][nb] = MFMA(af[mb], bfr[nb], acc[mb][nb]);
    }
#pragma unroll
    for (int mb = 0; mb < 2; mb++)
#pragma unroll
      for (int nb = 0; nb < 2; nb++)
#pragma unroll
        for (int i = 0; i < 16; i++) {
          const int tt = mh * 64 + mb * 32 + crow(i, h), col = g * 64 + nb * 32 + l31;
          bf16_t* zp = p.z1 + (r0 + tt) * Z1W;
          const float u = bf2f(zp[col]), gt = bf2f(zp[512 + col]);
          if (!p.dry) zp[col] = f2bf(u * (acc[mb][nb][i] + bs[tt]) * gt);
        }
  }
  __syncthreads();
}

DI void c_setup(const P& p, int l, int g, int lane, float& ar, float& ai, float (&Br)[16], float (&Bi)[16]) {
  const int gi = (l * 16 + g) * 64 + lane;
  const float lre = p.c_a_re[gi], lim = p.c_a_im[gi];
  const float dt = expf(p.c_log_dt[l * 16 + g]);
  const float mag = expf(lre * dt);
  const float angf = lim * dt;
  const double rev = (double)angf * 0.15915494309189535;
  const float rf = (float)((rev - rint(rev)) * 6.283185307179586);
  const float sn = sinf(rf), cs = cosf(rf);
  ar = mag * cs; ai = mag * sn;
  const float xr = ar - 1.f, xi = ai, den = 1.f / (lre * lre + lim * lim);
  const float cr = (xr * lre + xi * lim) * den, ci = (xi * lre - xr * lim) * den;
  const float* bre = p.c_b_re + (long)gi * 16; const float* bim = p.c_b_im + (long)gi * 16;
#pragma unroll
  for (int c4 = 0; c4 < 4; c4++) {
    const f32x4 r4 = *(const f32x4*)(bre + c4 * 4), i4 = *(const f32x4*)(bim + c4 * 4);
    const float rr[4] = {r4.x, r4.y, r4.z, r4.w}, ii[4] = {i4.x, i4.y, i4.z, i4.w};
#pragma unroll
    for (int j = 0; j < 4; j++) { Br[c4 * 4 + j] = cr * rr[j] - ci * ii[j]; Bi[c4 * 4 + j] = cr * ii[j] + ci * rr[j]; }
  }
}
DI void c_load_u(const P& p, long tok0, int g, int lane, float* ub) {
  const bf16_t* up = p.z1 + (tok0 + lane) * Z1W + 1280 + g * 16;
  float f0[8], f1[8];
  unpack8(*(const u32x4*)up, f0); unpack8(*(const u32x4*)(up + 8), f1);
  f32x4 a; a.x = f0[0]; a.y = f0[1]; a.z = f0[2]; a.w = f0[3]; *(f32x4*)(ub + lane * 16) = a;
  a.x = f0[4]; a.y = f0[5]; a.z = f0[6]; a.w = f0[7]; *(f32x4*)(ub + lane * 16 + 4) = a;
  a.x = f1[0]; a.y = f1[1]; a.z = f1[2]; a.w = f1[3]; *(f32x4*)(ub + lane * 16 + 8) = a;
  a.x = f1[4]; a.y = f1[5]; a.z = f1[6]; a.w = f1[7]; *(f32x4*)(ub + lane * 16 + 12) = a;
}
DI void c_step(const float* ub, int s, const float (&Br)[16], const float (&Bi)[16], float ar, float ai, float& sr, float& si) {
  float bur = 0.f, bui = 0.f;
#pragma unroll
  for (int c4 = 0; c4 < 4; c4++) {
    const f32x4 u = *(const f32x4*)(ub + s * 16 + c4 * 4);
    bur += Br[c4 * 4] * u.x + Br[c4 * 4 + 1] * u.y + Br[c4 * 4 + 2] * u.z + Br[c4 * 4 + 3] * u.w;
    bui += Bi[c4 * 4] * u.x + Bi[c4 * 4 + 1] * u.y + Bi[c4 * 4 + 2] * u.z + Bi[c4 * 4 + 3] * u.w;
  }
  const float nr = ar * sr - ai * si + bur, ni = ar * si + ai * sr + bui;
  sr = nr; si = ni;
}
DI void c1_item(const P& p, int l, int idx, char* smem) {
  const int t = tid(), lane = t & 63, w = t >> 6;
  const int b = idx >> 7, g = (idx >> 3) & 15, k = (idx & 7) * 4 + w;
  float* ub = (float*)smem + w * 1024;
  float ar, ai, Br[16], Bi[16];
  c_setup(p, l, g, lane, ar, ai, Br, Bi);
  const long tok0 = (long)b * S_ + k * 64;
  c_load_u(p, tok0, g, lane, ub);
  __syncthreads();
  float sr = 0.f, si = 0.f;
#pragma unroll 2
  for (int s = 0; s < 64; s++) c_step(ub, s, Br, Bi, ar, ai, sr, si);
  f32x2 e; e.x = sr; e.y = si;
  *(f32x2*)(p.carry + ((long)((b * 16 + g) * 32 + k) * 64 + lane) * 2) = e;
  __syncthreads();
}
DI void c3_item(const P& p, int l, int idx, char* smem) {
  const int t = tid(), lane = t & 63, w = t >> 6;
  const int b = idx >> 7, g = (idx >> 3) & 15, k = (idx & 7) * 4 + w;
  float* ub = (float*)(smem + w * 12288);
  bf16_t* stb = (bf16_t*)(smem + w * 12288 + 4096);
  const int c = lane & 15, sq = lane >> 4;
  bf16x8 cfr[4];
  {
    const float* cre = p.c_c_re + (long)(l * 16 + g) * 1024 + c * 64; const float* cim = p.c_c_im + (long)(l * 16 + g) * 1024 + c * 64;
#pragma unroll
    for (int ks = 0; ks < 4; ks++) {
      const f32x4 r4 = *(const f32x4*)(cre + ks * 16 + sq * 4), i4 = *(const f32x4*)(cim + ks * 16 + sq * 4);
      u32x4 pk; pk.x = pk2(r4.x, -i4.x); pk.y = pk2(r4.y, -i4.y); pk.z = pk2(r4.z, -i4.z); pk.w = pk2(r4.w, -i4.w);
      cfr[ks] = __builtin_bit_cast(bf16x8, pk);
    }
  }
  float ar, ai, Br[16], Bi[16];
  c_setup(p, l, g, lane, ar, ai, Br, Bi);
  const long tok0 = (long)b * S_ + k * 64;
  c_load_u(p, tok0, g, lane, ub);
  float lr = ar, li = ai;
#pragma unroll
  for (int i = 0; i < 6; i++) { const float nr = lr * lr - li * li, ni = 2.f * lr * li; lr = nr; li = ni; }
  float sr = 0.f, si = 0.f;
  {
    const float* cp = p.carry + ((long)((b * 16 + g) * 32) * 64 + lane) * 2;
    for (int j0 = 0; j0 < k; j0 += 8) {
      f32x2 e[8];
#pragma unroll
      for (int jj = 0; jj < 8; jj++) { e[jj].x = 0.f; e[jj].y = 0.f; if (j0 + jj < k) e[jj] = *(const f32x2*)(cp + (long)(j0 + jj) * 128); }
#pragma unroll
      for (int jj = 0; jj < 8; jj++) if (j0 + jj < k) { const float nr = lr * sr - li * si + e[jj].x, ni = lr * si + li * sr + e[jj].y; sr = nr; si = ni; }
    }
  }
  __syncthreads();
  const float dsk = p.c_d[l * 256 + g * 16 + c];
#pragma unroll 1
  for (int sb = 0; sb < 4; sb++) {
#pragma unroll 2
    for (int s2 = 0; s2 < 16; s2++) {
      c_step(ub, sb * 16 + s2, Br, Bi, ar, ai, sr, si);
      *(unsigned*)(stb + s2 * 136 + 2 * lane) = pk2(sr, si);
    }
    asm volatile("s_waitcnt lgkmcnt(0)" ::: "memory");
    __builtin_amdgcn_wave_barrier();
    f32x4 y; y.x = 0.f; y.y = 0.f; y.z = 0.f; y.w = 0.f;
#pragma unroll
    for (int ks = 0; ks < 4; ks++) {
      const bf16x8 af = *(const bf16x8*)(stb + c * 136 + ks * 32 + sq * 8);
      y = __builtin_amdgcn_mfma_f32_16x16x32_bf16(af, cfr[ks], y, 0, 0, 0);
    }
    const float yy[4] = {y.x, y.y, y.z, y.w};
#pragma unroll
    for (int qq = 0; qq < 4; qq++) {
      const int sa = sb * 16 + sq * 4 + qq;
      const float yv = gelu_t(yy[qq] + dsk * ub[sa * 16 + c]);
      if (!p.dry) p.z1[(tok0 + sa) * Z1W + 1280 + g * 16 + c] = f2bf(yv);
    }
    asm volatile("s_waitcnt lgkmcnt(0)" ::: "memory");
    __builtin_amdgcn_wave_barrier();
  }
  __syncthreads();
}

DI void glu_tile(const P& p, int l, int tm, int tn, char* smem) {
  bf16_t* sm = (bf16_t*)smem; float* ep = (float*)smem;
  const int r0 = tm * 128, c0 = tn * 128;
  f32x16 acc[2][2]; zero_acc(acc);
  gemm_loop_dma(p.z1 + (long)r0 * Z1W + 1280, Z1W, p.WgluT + (long)c0 * 256, 256, 256, acc, smem);
  acc_to_lds(acc, ep);
  __syncthreads();
  const float* bg = p.c_b_glu + l * 256 + c0;
  rowwise2(ep, [&](int row, int c8) {
    LdGlu L;
    const bf16_t* zp = p.z1 + (long)(r0 + row) * Z1W + c0 + c8;
    L.yg = *(const u32x4*)(zp + 1280); L.gt = *(const u32x4*)(zp + 1536);
    return L;
  }, [&](int row, int c8, float (&v)[8], const LdGlu& L) {
    bf16_t* zp = p.z1 + (long)(r0 + row) * Z1W + c0 + c8;
    float yg[8], gt[8];
    unpack8(L.yg, yg); unpack8(L.gt, gt);
#pragma unroll
    for (int j = 0; j < 8; j++) v[j] = yg[j] * sigm(v[j] + bg[c8 + j]) * gt[j];
    if (!p.dry) *(u32x4*)(zp + 1536) = pack8(v);
  });
  __syncthreads();
}

DI void pf_tile(const P& p, int l, int tm, int tn, char* smem) {
  float* ep = (float*)smem; float* rsS = (float*)(smem + SM_RS);
  const int t = tid(), lane = t & 63, w = t >> 6, wm = w >> 1, wn = w & 1, l31 = lane & 31, h = lane >> 5;
  const int r0 = tm * 128, c0 = tn * 128;
  load_rs(p, r0, rsS);
  unsigned mrgp[2][2][8];
#pragma unroll
  for (int a = 0; a < 2; a++)
#pragma unroll
    for (int b = 0; b < 2; b++)
#pragma unroll
      for (int i = 0; i < 8; i++) mrgp[a][b][i] = 0u;
#pragma unroll 1
  for (int pr = 0; pr < 2; pr++) {
    unsigned gp[2][2][2][8];
    {
      f32x16 accP[2][2], accQ[2][2]; zero_acc(accP); zero_acc(accQ);
      const bf16_t* wg = p.WinT + (long)(3456 + (2 * pr) * 1024 + c0) * 1024;
      gemm_loop_dma2(p.xb + (long)r0 * 1024, 1024, wg, wg + (long)1024 * 1024, 1024, 1024, accP, accQ, smem);
      const float* bm = p.b_merge + l * 4096 + (2 * pr) * 1024 + c0;
#pragma unroll
      for (int mb = 0; mb < 2; mb++)
#pragma unroll
        for (int nb = 0; nb < 2; nb++) {
          const float bias0 = bm[wn * 64 + nb * 32 + l31], bias1 = bm[1024 + wn * 64 + nb * 32 + l31];
#pragma unroll
          for (int i = 0; i < 16; i += 2) {
            const float ra = rsS[wm * 64 + mb * 32 + crow(i, h)], rb = rsS[wm * 64 + mb * 32 + crow(i + 1, h)];
            gp[0][mb][nb][i >> 1] = pk2n(sigm(accP[mb][nb][i] * ra + bias0), sigm(accP[mb][nb][i + 1] * rb + bias0));
            gp[1][mb][nb][i >> 1] = pk2n(sigm(accQ[mb][nb][i] * ra + bias1), sigm(accQ[mb][nb][i + 1] * rb + bias1));
          }
        }
    }
#pragma unroll
    for (int j = 0; j < 2; j++) {
      const int br = 2 * pr + j;
      const int yoff = br == 0 ? 0 : (br == 1 ? 768 : (br == 2 ? 1536 : 2048));
      const int Kb = br == 1 ? 512 : 256;
      const long woff = br == 0 ? 0 : (br == 1 ? 1024 * 256 : (br == 2 ? 1024 * 768 : 1024 * 1024));
      f32x16 acc[2][2]; zero_acc(acc);
      gemm_loop_dma(p.z1 + (long)r0 * Z1W + yoff, Z1W, p.WbrT + woff + (long)c0 * Kb, Kb, Kb, acc, smem);
#pragma unroll
      for (int mb = 0; mb < 2; mb++)
#pragma unroll
        for (int nb = 0; nb < 2; nb++)
#pragma unroll
          for (int i = 0; i < 16; i += 2) {
            const unsigned g2 = gp[j][mb][nb][i >> 1], m2 = mrgp[mb][nb][i >> 1];
            const float m0 = __uint_as_float(m2 << 16) + __uint_as_float(g2 << 16) * acc[mb][nb][i];
            const float m1 = __uint_as_float(m2 & 0xffff0000u) + __uint_as_float(g2 & 0xffff0000u) * acc[mb][nb][i + 1];
            mrgp[mb][nb][i >> 1] = pk2(m0, m1);
          }
    }
  }
  {
    f32x16 mrg[2][2];
#pragma unroll
    for (int a = 0; a < 2; a++)
#pragma unroll
      for (int b = 0; b < 2; b++)
#pragma unroll
        for (int i = 0; i < 16; i += 2) { const unsigned m2 = mrgp[a][b][i >> 1]; mrg[a][b][i] = __uint_as_float(m2 << 16); mrg[a][b][i + 1] = __uint_as_float(m2 & 0xffff0000u); }
    acc_to_lds(mrg, ep);
  }
  __syncthreads();
  rowwise(ep, [&](int row, int c8, float (&v)[8]) { *(u32x4*)(p.mg + (long)(r0 + row) * 1024 + c0 + c8) = pack8(v); });
  __syncthreads();
}

DI void out_tile(const P& p, int l, int tm, int tn, char* smem) {
  bf16_t* sm = (bf16_t*)smem; float* ep = (float*)smem;
  const int r0 = tm * 128, c0 = tn * 128;
  f32x16 acc[2][2]; zero_acc(acc);
  gemm_loop_dma(p.mg + (long)r0 * 1024, 1024, p.WoutT + (long)l * 1024 * 1024 + (long)c0 * 1024, 1024, 1024, acc, smem);
  acc_to_lds(acc, ep);
  __syncthreads();
  const float* xin = (l == 0) ? p.x : p.out;
  rowwise2(ep, [&](int row, int c8) {
    LdX L;
    const long off = (long)(r0 + row) * 1024 + c0 + c8;
    L.a = *(const f32x4*)(xin + off); L.b = *(const f32x4*)(xin + off + 4);
    return L;
  }, [&](int row, int c8, float (&v)[8], const LdX& L) {
    const long off = (long)(r0 + row) * 1024 + c0 + c8;
    const f32x4 a = L.a, b = L.b;
    v[0] += a.x; v[1] += a.y; v[2] += a.z; v[3] += a.w; v[4] += b.x; v[5] += b.y; v[6] += b.z; v[7] += b.w;
    f32x4 oa, ob; oa.x = v[0]; oa.y = v[1]; oa.z = v[2]; oa.w = v[3]; ob.x = v[4]; ob.y = v[5]; ob.z = v[6]; ob.w = v[7];
    if (!p.dry) {
      if (l == 1) { __builtin_nontemporal_store(oa, (f32x4*)(p.out + off)); __builtin_nontemporal_store(ob, (f32x4*)(p.out + off + 4)); }
      else { *(f32x4*)(p.out + off) = oa; *(f32x4*)(p.out + off + 4) = ob; }
    }
    if (l == 0) {
      *(u32x4*)(p.xb + off) = pack8(v);
      float ss = 0.f;
#pragma unroll
      for (int j = 0; j < 8; j++) ss += v[j] * v[j];
      ss = sum16(ss);
      if ((c8 >> 3) == 0) p.ssp[(long)tn * T_ + r0 + row] = ss;
    }
  });
  __syncthreads();
}

DI void run_phase(const P& p, int ph, char* smem, int vb) {
  const int G = gridDim.x, bid = blockIdx.x;
  int* slot = (int*)(smem + SM_MISC);
  if (ph == 0) {
    conv_all(p, 0, smem);
    for (int it = NCONV + bid; it < NAUX; it += G) aux_item(p, 0, it, smem);
    for (int it = bid; it < 2048; it += G) p0_xrow_item(p, it);
    for (int it = bid; it < 1024; it += G) p0_rope_item(p, it);
    return;
  }
  const int l = (ph - 1) / 6, s = (ph - 1) % 6;
  if (s == 0) {
    const int total = 3456 + 64, nr = (total + G - 1) / G;
    for (int r = 0; r < nr; r++) {
      const int L = static_L(r, vb);
      if (L >= total) continue;
      int tm, tn;
      if (L < 3456) { tile_from_linear(L, 27, tm, tn); g1_tile(p, l, tm, tn, smem); }
      else { tile_from_linear(L - 3456, 4, tm, tn); g1m_tile(p, l, tm, tn, smem); }
    }
  } else if (s == 1) {
    const long dm = p.dry;
    {
      const int total = 1024, nr = (total + G - 1) / G;
      if (!dm || (dm & 2)) for (int r = 0; r < nr; r++) { const int L = static_L(r, vb); if (L >= total) continue; int tm, tn; tile_from_linear(L, 8, tm, tn); g2q_tile(p, l, tm, tn, smem); }
      if (!dm || (dm & 8)) for (int r = 0; r < nr; r++) { const int L = static_L(r, vb); if (L >= total) continue; int tm, tn; tile_from_linear(L, 8, tm, tn); g2kv_tile(p, l, tm, tn, smem); }
    }
    if (!dm || (dm & 4)) for (int it = vb; it < 512; it += G) mattn_item(p, it, smem);
    {
      const bool split = (G >= 256);
      if (!dm || (dm & 16)) { const int a1 = split ? 128 : 128; for (int it = vb; it < a1; it += G) a_item(p, l, it, smem); }
      const int cstep = split ? (vb < 128 ? 1024 : G - 128) : G;
      if (!dm || (dm & 32)) {
#pragma unroll 1
        for (int it = vb; it < 1024; it += cstep) c1_item(p, l, it, smem);
      }
    }
  } else if (s == 2) {
    const long dm = p.dry;
    if (G == 512) {
#pragma unroll 1
      for (int j = 0; j < 4; j++) {
        if (j < 2) { if (dm && !(dm & 2)) continue; battn_item(p, j ? 1023 - vb : vb, smem); }
        else { if (dm && !(dm & 4)) continue; c3_item(p, l, vb + (j - 2) * 512, smem); }
      }
    } else {
#pragma unroll 1
      for (int it = vb; it < 2048; it += G) {
        if (it < 1024) { if (dm && !(dm & 2)) continue; battn_item(p, it, smem); } else { if (dm && !(dm & 4)) continue; c3_item(p, l, it - 1024, smem); }
      }
    }
  } else if (s == 3) {
    for (int it = bid; it < 256; it += G) glu_tile(p, l, it >> 1, it & 1, smem);
  } else if (s == 4) {
    const int total = 1024, nr = (total + G - 1) / G;
    for (int r = 0; r < nr; r++) { const int L = static_L(r, vb); if (L >= total) continue; int tm, tn; tile_from_linear(L, 8, tm, tn); pf_tile(p, l, tm, tn, smem); }
  } else {
    const int total = 1024, nr = (total + G - 1) / G;
    for (int r = 0; r < nr; r++) { const int L = static_L(r, vb); if (L >= total) continue; int tm, tn; tile_from_linear(L, 8, tm, tn); out_tile(p, l, tm, tn, smem); }
    if (l == 0) { conv_all(p, 1, smem); for (int it = NCONV + bid; it < NAUX; it += G) aux_item(p, 1, it, smem); }
  }
}

DI unsigned xb_ld(unsigned* q) { return __hip_atomic_load(q, __ATOMIC_RELAXED, __HIP_MEMORY_SCOPE_AGENT); }
DI unsigned xb_add(unsigned* q, unsigned v) { return __hip_atomic_fetch_add(q, v, __ATOMIC_RELAXED, __HIP_MEMORY_SCOPE_AGENT); }
DI void gbar(unsigned* bar, const int* st) {
  asm volatile("s_waitcnt vmcnt(0)" ::: "memory");
  __syncthreads();
  if (threadIdx.x == 0) {
    __builtin_amdgcn_s_waitcnt(0);
    const unsigned x = (unsigned)st[0], nloc = (unsigned)st[1], nx = (unsigned)st[2];
    const unsigned old = xb_add(&bar[1024 + 64 * x], 1u);
    const unsigned gen = old / nloc;
    if (old + 1u == (gen + 1u) * nloc) {
      __builtin_amdgcn_fence(__ATOMIC_RELEASE, "agent");
      asm volatile("s_waitcnt vmcnt(0)" ::: "memory");
      const unsigned og = xb_add(&bar[3072], 1u);
      const unsigned tg = og / nx;
      if (og + 1u == (tg + 1u) * nx) xb_add(&bar[3136], 1u);
      else while (xb_ld(&bar[3136]) == tg) __builtin_amdgcn_s_sleep(1);
      __builtin_amdgcn_fence(__ATOMIC_ACQUIRE, "agent");
      xb_add(&bar[2048 + 64 * x], 1u);
      asm volatile("s_waitcnt vmcnt(0)" ::: "memory");
    } else {
      while (xb_ld(&bar[2048 + 64 * x]) == gen) __builtin_amdgcn_s_sleep(1);
      __builtin_amdgcn_fence(__ATOMIC_ACQUIRE, "agent");
      asm volatile("s_waitcnt vmcnt(0)" ::: "memory");
    }
  }
  __syncthreads();
}

#if MK_MULTI
__global__ void __launch_bounds__(256, 2) hyb_phase(P p, int ph) {
  __shared__ __attribute__((aligned(16))) char smem[SM_TOTAL];
  run_phase(p, ph, smem, blockIdx.x);
}
#else
__global__ void __launch_bounds__(256, 2) hyb_mega(P p) {
  __shared__ __attribute__((aligned(16))) char smem[SM_TOTAL];
  cg::grid_group grid = cg::this_grid();
  if (p.dry == 0x7fffffff) grid.sync();
  int vb;
  {
    int* sl = (int*)(smem + SM_MISC) + 2;
    if (threadIdx.x == 0) {
      const unsigned xcc = (unsigned)__builtin_amdgcn_s_getreg((3 << 11) | 20) & 7u;
      const unsigned loc = xb_add(p.ctr + 40 + xcc, 1u);
      const unsigned Gx = gridDim.x >> 3;
      *sl = (loc < Gx) ? (int)(loc * 8 + xcc) : -1;
      unsigned sum, cnt, mine;
      for (;;) {
        sum = 0u; cnt = 0u; mine = 0u;
        for (unsigned j = 0; j < 8; ++j) { const unsigned c = xb_ld(p.ctr + 40 + j); sum += c; cnt += (c > 0u) ? 1u : 0u; mine = (j == xcc) ? c : mine; }
        if (sum == gridDim.x) break;
        __builtin_amdgcn_s_sleep(1);
      }
      sl[2] = (int)xcc; sl[3] = (int)mine; sl[4] = (int)cnt;
    }
    __syncthreads();
    vb = blockIdx.x;
  }
  const int* bst = (const int*)(smem + SM_MISC) + 4;
#ifdef DRY_PH
  P pd = p; { int one = DRY_MASK; asm volatile("" : "+s"(one)); pd.dry = one; }
#endif
#pragma unroll 1
  for (int ph = 0; ph < 13; ph++) {
#ifdef DRY_PH
    if (ph == DRY_PH) { run_phase(pd, ph, smem, vb); gbar(p.bar, bst); }
#endif
    run_phase(p, ph, smem, vb);
    if (ph < 12) gbar(p.bar, bst);
  }
}
#endif

extern "C" void kernel_launch(void* const* d_in, const int* in_sizes, int n_in, void* d_out, int out_size, void* d_ws, size_t ws_size, hipStream_t stream) {
  P p{};
  p.x = (const float*)d_in[0]; p.mem = (const float*)d_in[1]; p.pos = (const int*)d_in[2];
  p.norm_g = (const float*)d_in[3]; p.w_in = (const float*)d_in[4]; p.b_merge = (const float*)d_in[5];
  p.a_norm_g = (const float*)d_in[6]; p.a_w_s = (const float*)d_in[7]; p.a_b_s = (const float*)d_in[8];
  p.b_q_norm_g = (const float*)d_in[9]; p.b_kv_norm_g = (const float*)d_in[10]; p.b_w_uq = (const float*)d_in[11]; p.b_w_ukv = (const float*)d_in[12];
  p.b_qk_g_q = (const float*)d_in[13]; p.b_qk_g_k = (const float*)d_in[14];
  p.c_a_re = (const float*)d_in[15]; p.c_a_im = (const float*)d_in[16]; p.c_log_dt = (const float*)d_in[17];
  p.c_b_re = (const float*)d_in[18]; p.c_b_im = (const float*)d_in[19]; p.c_c_re = (const float*)d_in[20]; p.c_c_im = (const float*)d_in[21];
  p.c_d = (const float*)d_in[22]; p.c_w_glu = (const float*)d_in[23]; p.c_b_glu = (const float*)d_in[24];
  p.m_norm_g = (const float*)d_in[25]; p.m_w_kv = (const float*)d_in[26]; p.m_qk_g_q = (const float*)d_in[27]; p.m_qk_g_k = (const float*)d_in[28];
  p.w_br_a = (const float*)d_in[29]; p.w_br_b = (const float*)d_in[30]; p.w_br_c = (const float*)d_in[31]; p.w_br_m = (const float*)d_in[32];
  p.w_out = (const float*)d_in[33];
  p.out = (float*)d_out;
  char* ws = (char*)d_ws; size_t off = 0;
  auto take = [&](size_t bytes) { char* r = ws + off; off += (bytes + 255) & ~(size_t)255; return r; };
  p.z1 = (bf16_t*)take((size_t)T_ * Z1W * 2);
  p.z2 = (bf16_t*)take((size_t)T_ * Z2W * 2);
  p.xb = (bf16_t*)take((size_t)T_ * 1024 * 2);
  p.qf = (bf16_t*)take((size_t)T_ * 768 * 2);
  p.kf = (bf16_t*)take((size_t)T_ * 768 * 2);
  p.mg = p.qf;
  p.vt = (bf16_t*)take((size_t)8 * 8 * 64 * S_ * 2);
  p.hm = (bf16_t*)take((size_t)2048 * 1024 * 2);
  p.memk = (bf16_t*)take((size_t)2048 * 256 * 2);
  p.memvt = (bf16_t*)take((size_t)2048 * 256 * 2);
  p.WinT = (bf16_t*)take((size_t)NWIN * 1024 * 2);
  p.WuqT = (bf16_t*)take((size_t)1024 * 768 * 2);
  p.WukvT = (bf16_t*)take((size_t)1024 * 256 * 2);
  p.WgluT = (bf16_t*)take((size_t)256 * 256 * 2);
  p.WbrT = (bf16_t*)take((size_t)1024 * 1280 * 2);
  p.WoutT = (bf16_t*)take((size_t)2 * 1024 * 1024 * 2);
  p.WmkvT = (bf16_t*)take((size_t)512 * 1024 * 2);
  p.ssp = (float*)take((size_t)8 * T_ * 4);
  p.ssq = (float*)take((size_t)9 * T_ * 4);
  p.rope = (float*)take((size_t)T_ * 32 * 4);
  p.carry = (float*)take((size_t)8 * 16 * 32 * 64 * 2 * 4);
  p.ctr = (unsigned*)take(256);
  p.bar = (unsigned*)take(16384);
  if (off > ws_size) { fprintf(stderr, "workspace too small: need %zu have %zu\n", off, ws_size); return; }

  static int grid_blocks = 0;
  if (!grid_blocks) {
    int dev = 0, cus = 0, per_cu = 0;
    hipGetDevice(&dev);
    hipDeviceGetAttribute(&cus, hipDeviceAttributeMultiprocessorCount, dev);
#if MK_MULTI
    hipOccupancyMaxActiveBlocksPerMultiprocessor(&per_cu, hyb_phase, 256, 0);
#else
    hipOccupancyMaxActiveBlocksPerMultiprocessor(&per_cu, hyb_mega, 256, 0);
#endif
    if (per_cu > 2) per_cu = 2;
    if (per_cu < 1) per_cu = 1;
    grid_blocks = cus * per_cu;
    grid_blocks &= ~7;
  }
#if MK_MULTI
  for (int ph = 0; ph < 13; ph++) hipLaunchKernelGGL(hyb_phase, dim3(grid_blocks), dim3(256), 0, stream, p, ph);
#else
  hipMemsetAsync(p.ctr, 0, 256 + 16384, stream);
  void* args[] = {&p};
  hipError_t e = hipLaunchCooperativeKernel((void*)hyb_mega, dim3(grid_blocks), dim3(256), args, 0, stream);
  if (e != hipSuccess) fprintf(stderr, "cooperative launch failed: %s (grid %d)\n", hipGetErrorString(e), grid_blocks);
#endif
}
```

```cpp
#include <hip/hip_runtime.h>
#include <hip/hip_cooperative_groups.h>
#include <stdint.h>
#include <stdio.h>
#include <type_traits>
namespace cg = cooperative_groups;

#ifndef MK_MULTI
#define MK_MULTI 0
#endif

typedef unsigned short bf16_t;
typedef short bf16x8 __attribute__((ext_vector_type(8)));
typedef short s16x4 __attribute__((ext_vector_type(4)));
typedef float f32x16 __attribute__((ext_vector_type(16)));
typedef float f32x4 __attribute__((ext_vector_type(4)));
typedef float f32x2 __attribute__((ext_vector_type(2)));
typedef unsigned u32x4 __attribute__((ext_vector_type(4)));
typedef unsigned u32x2 __attribute__((ext_vector_type(2)));
#define DI __device__ __forceinline__
#define MFMA(a, b, c) __builtin_amdgcn_mfma_f32_32x32x16_bf16((a), (b), (c), 0, 0, 0)

constexpr int T_ = 16384, S_ = 2048;
constexpr int INW = 7456;
constexpr int Z1W = 2304, Z2W = 1152;
constexpr int NWIN = 7552;
constexpr float EPS = 1e-6f;
constexpr float LOG2E = 1.4426950408889634f;
constexpr int LDT = 72;
constexpr int EPW = 132;
constexpr int SM_MAIN = 4 * 128 * LDT * 2;
constexpr int SM_RS = SM_MAIN;
constexpr int SM_SS = SM_MAIN + 512;
constexpr int SM_MISC = SM_MAIN + 1024;
constexpr int SM_TOTAL = SM_MAIN + 1024 + 64;

struct P {
  const float* x; const float* mem; const int* pos;
  const float* norm_g; const float* w_in; const float* b_merge; const float* a_norm_g; const float* a_w_s; const float* a_b_s;
  const float* b_q_norm_g; const float* b_kv_norm_g; const float* b_w_uq; const float* b_w_ukv; const float* b_qk_g_q; const float* b_qk_g_k;
  const float* c_a_re; const float* c_a_im; const float* c_log_dt; const float* c_b_re; const float* c_b_im; const float* c_c_re; const float* c_c_im;
  const float* c_d; const float* c_w_glu; const float* c_b_glu;
  const float* m_norm_g; const float* m_w_kv; const float* m_qk_g_q; const float* m_qk_g_k;
  const float* w_br_a; const float* w_br_b; const float* w_br_c; const float* w_br_m; const float* w_out;
  float* out;
  bf16_t* z1; bf16_t* z2; bf16_t* xb; bf16_t* qf; bf16_t* kf; bf16_t* mg; bf16_t* vt; bf16_t* hm; bf16_t* memk; bf16_t* memvt;
  bf16_t* WinT; bf16_t* WuqT; bf16_t* WukvT; bf16_t* WgluT; bf16_t* WbrT; bf16_t* WoutT; bf16_t* WmkvT;
  float* ssp; float* ssq; float* rope; float* carry; unsigned* ctr; unsigned* bar;
  long dry;
};

DI int tid() { int t = threadIdx.x; asm volatile("" : "+v"(t)); return t; }
DI float bf2f(bf16_t b) { return __uint_as_float(((unsigned)b) << 16); }
DI unsigned pk2(float lo, float hi) { unsigned r; asm("v_cvt_pk_bf16_f32 %0, %1, %2" : "=v"(r) : "v"(lo), "v"(hi)); return r; }
DI unsigned pk2n(float lo, float hi) { unsigned r; asm("s_nop 1\n\tv_cvt_pk_bf16_f32 %0, %1, %2" : "=v"(r) : "v"(lo), "v"(hi)); return r; }
DI bf16_t f2bf(float x) { return (bf16_t)(pk2(x, 0.f) & 0xffffu); }
DI void unpack8(u32x4 v, float (&f)[8]) {
  f[0] = __uint_as_float(v.x << 16); f[1] = __uint_as_float(v.x & 0xffff0000u);
  f[2] = __uint_as_float(v.y << 16); f[3] = __uint_as_float(v.y & 0xffff0000u);
  f[4] = __uint_as_float(v.z << 16); f[5] = __uint_as_float(v.z & 0xffff0000u);
  f[6] = __uint_as_float(v.w << 16); f[7] = __uint_as_float(v.w & 0xffff0000u);
}
DI void unpack4(u32x2 v, float (&f)[4]) {
  f[0] = __uint_as_float(v.x << 16); f[1] = __uint_as_float(v.x & 0xffff0000u);
  f[2] = __uint_as_float(v.y << 16); f[3] = __uint_as_float(v.y & 0xffff0000u);
}
DI u32x4 pack8(const float (&f)[8]) { u32x4 r; r.x = pk2(f[0], f[1]); r.y = pk2(f[2], f[3]); r.z = pk2(f[4], f[5]); r.w = pk2(f[6], f[7]); return r; }
DI float sigm(float x) { return __builtin_amdgcn_rcpf(1.f + __expf(-x)); }
DI float silu(float x) { return x * sigm(x); }
DI float gelu_t(float x) { return x * sigm(1.5957691216057308f * (x + 0.044715f * x * x * x)); }
DI float sum16(float v) { v += __shfl_xor(v, 1); v += __shfl_xor(v, 2); v += __shfl_xor(v, 4); v += __shfl_xor(v, 8); return v; }
DI float sum8(float v) { v += __shfl_xor(v, 1); v += __shfl_xor(v, 2); v += __shfl_xor(v, 4); return v; }
DI float sum64(float v) { v = sum16(v); v += __shfl_xor(v, 16); v += __shfl_xor(v, 32); return v; }
DI int crow(int i, int h) { return (i & 3) + 8 * (i >> 2) + 4 * h; }
#define MFMA16(a, b, c) __builtin_amdgcn_mfma_f32_16x16x32_bf16((a), (b), (c), 0, 0, 0)
template <int NB>
DI void zero_acc4(f32x4 (&acc)[4][NB]) {
#pragma unroll
  for (int a = 0; a < 4; a++)
#pragma unroll
    for (int b = 0; b < NB; b++) { acc[a][b].x = 0.f; acc[a][b].y = 0.f; acc[a][b].z = 0.f; acc[a][b].w = 0.f; }
}
DI void zero_acc(f32x16 (&acc)[2][2]) {
#pragma unroll
  for (int a = 0; a < 2; a++)
#pragma unroll
    for (int b = 0; b < 2; b++)
#pragma unroll
      for (int i = 0; i < 16; i++) acc[a][b][i] = 0.f;
}

template <bool SS>
DI void gemm_loop(const bf16_t* __restrict__ A, long lda, const bf16_t* __restrict__ B, long ldb, int K,
                  f32x16 (&acc)[2][2], bf16_t* sm, float* ssS) {
  const int t = tid(), lane = t & 63, w = t >> 6, wm = w >> 1, wn = w & 1, l31 = lane & 31, h = lane >> 5;
  const int lr = t >> 3, lc = (t & 7) * 8;
  const bf16_t* ap = A + (long)lr * lda + lc;
  const bf16_t* bp = B + (long)lr * ldb + lc;
  bf16_t* wp = sm + lr * LDT + lc;
  const bf16_t* rA = sm + (wm * 64 + l31) * LDT + h * 8;
  const bf16_t* rB = sm + 2 * 128 * LDT + (wn * 64 + l31) * LDT + h * 8;
  u32x4 ra[4], rb[4];
  float ss[4] = {0.f, 0.f, 0.f, 0.f};
  const int nk = K >> 6;
  auto gl = [&](int ko) {
#pragma unroll
    for (int i = 0; i < 4; i++) { ra[i] = *(const u32x4*)(ap + (long)(32 * i) * lda + ko); rb[i] = *(const u32x4*)(bp + (long)(32 * i) * ldb + ko); }
  };
  auto st = [&](auto BUF) {
    constexpr int buf = decltype(BUF)::value;
#pragma unroll
    for (int i = 0; i < 4; i++) {
      *(u32x4*)(wp + buf * 128 * LDT + 32 * i * LDT) = ra[i];
      *(u32x4*)(wp + 2 * 128 * LDT + buf * 128 * LDT + 32 * i * LDT) = rb[i];
      if (SS) { float f[8]; unpack8(ra[i], f);
#pragma unroll
        for (int j = 0; j < 8; j++) ss[i] += f[j] * f[j]; }
    }
  };
  auto comp = [&](auto BUF) {
    constexpr int buf = decltype(BUF)::value;
#pragma unroll
    for (int kk = 0; kk < 4; kk++) {
      bf16x8 af[2], bfr[2];
#pragma unroll
      for (int mb = 0; mb < 2; mb++) af[mb] = *(const bf16x8*)(rA + buf * 128 * LDT + mb * 32 * LDT + kk * 16);
#pragma unroll
      for (int nb = 0; nb < 2; nb++) bfr[nb] = *(const bf16x8*)(rB + buf * 128 * LDT + nb * 32 * LDT + kk * 16);
#pragma unroll
      for (int mb = 0; mb < 2; mb++)
#pragma unroll
        for (int nb = 0; nb < 2; nb++) acc[mb][nb] = MFMA(af[mb], bfr[nb], acc[mb][nb]);
    }
  };
  using B0 = std::integral_constant<int, 0>; using B1 = std::integral_constant<int, 1>;
  gl(0);
  st(B0{});
  gl(64);
  __syncthreads();
  for (int ks = 0; ks < nk; ks += 2) {
    st(B1{});
    __builtin_amdgcn_sched_barrier(0);
    if (ks + 2 < nk) gl((ks + 2) * 64);
    __builtin_amdgcn_sched_barrier(0);
    comp(B0{});
    __syncthreads();
    if (ks + 2 < nk) st(B0{});
    __builtin_amdgcn_sched_barrier(0);
    if (ks + 3 < nk) gl((ks + 3) * 64);
    __builtin_amdgcn_sched_barrier(0);
    comp(B1{});
    __syncthreads();
  }
  if (SS) {
    const float inv = 1.0f / (float)K;
#pragma unroll
    for (int i = 0; i < 4; i++) { float s = sum8(ss[i]); if ((t & 7) == 0) ssS[lr + 32 * i] = rsqrtf(s * inv + EPS); }
  }
}

#define LAS3 __attribute__((address_space(3)))
struct GDesc { const bf16_t* A; long lda; const bf16_t* B; long ldb; };
DI void gemm_dma_stage0(const GDesc& d, char* smc) {
  const int t = tid(), lane = t & 63, w = t >> 6;
  const unsigned wdst = (unsigned)(uintptr_t)smc + (unsigned)w * 4096u;
#pragma unroll
  for (int i = 0; i < 4; i++) {
    const int row = 32 * w + 8 * i + (lane >> 3), c = (lane & 7) ^ ((row >> 1) & 7);
    __builtin_amdgcn_global_load_lds((const unsigned*)(d.A + row * d.lda + c * 8), (LAS3 unsigned*)(uintptr_t)(wdst + i * 1024), 16, 0, 0);
    __builtin_amdgcn_global_load_lds((const unsigned*)(d.B + row * d.ldb + c * 8), (LAS3 unsigned*)(uintptr_t)(wdst + 16384 + i * 1024), 16, 0, 0);
  }
}
DI void gemm_loop_dma(const bf16_t* __restrict__ A, long lda, const bf16_t* __restrict__ B, long ldb, int K, f32x16 (&acc)[2][2], char* smc,
                      bool started = false, bool has_next = false, GDesc next = GDesc{nullptr, 0, nullptr, 0}) {
  const int t = tid(), lane = t & 63, w = t >> 6, wm = w >> 1, wn = w & 1, l31 = lane & 31, h = lane >> 5;
  unsigned aoff[4], boff[4];
#pragma unroll
  for (int i = 0; i < 4; i++) {
    const int row = 32 * w + 8 * i + (lane >> 3), c = (lane & 7) ^ ((row >> 1) & 7);
    aoff[i] = (unsigned)((row * lda + c * 8) * 2); boff[i] = (unsigned)((row * ldb + c * 8) * 2);
  }
  const char* Ab = (const char*)A; const char* Bb = (const char*)B;
  const unsigned lbase = (unsigned)(uintptr_t)smc;
  const unsigned wdst = lbase + (unsigned)w * 4096u;
  const int swz = (l31 >> 1) & 7;
  unsigned fo[4];
#pragma unroll
  for (int kk = 0; kk < 4; kk++) fo[kk] = (unsigned)(((2 * kk + h) ^ swz) * 16);
  const char* rA = smc + (wm * 64 + l31) * 128;
  const char* rB = smc + 16384 + (wn * 64 + l31) * 128;
  const int nk = K >> 6;
  auto issue = [&](auto BUF, int ko) {
    constexpr int buf = decltype(BUF)::value;
#pragma unroll
    for (int i = 0; i < 4; i++) {
      __builtin_amdgcn_global_load_lds((const unsigned*)(Ab + (size_t)ko * 2 + aoff[i]), (LAS3 unsigned*)(uintptr_t)(wdst + buf * 32768 + i * 1024), 16, 0, 0);
      __builtin_amdgcn_global_load_lds((const unsigned*)(Bb + (size_t)ko * 2 + boff[i]), (LAS3 unsigned*)(uintptr_t)(wdst + buf * 32768 + 16384 + i * 1024), 16, 0, 0);
    }
  };
  auto comp = [&](auto BUF) {
    constexpr int buf = decltype(BUF)::value;
#pragma unroll
    for (int kk = 0; kk < 4; kk++) {
      bf16x8 af[2], bfr[2];
#pragma unroll
      for (int mb = 0; mb < 2; mb++) af[mb] = *(const bf16x8*)(rA + buf * 32768 + mb * 32 * 128 + fo[kk]);
#pragma unroll
      for (int nb = 0; nb < 2; nb++) bfr[nb] = *(const bf16x8*)(rB + buf * 32768 + nb * 32 * 128 + fo[kk]);
#pragma unroll
      for (int mb = 0; mb < 2; mb++)
#pragma unroll
        for (int nb = 0; nb < 2; nb++) acc[mb][nb] = MFMA(af[mb], bfr[nb], acc[mb][nb]);
    }
  };
  using B0 = std::integral_constant<int, 0>; using B1 = std::integral_constant<int, 1>;
  if (!started) issue(B0{}, 0);
  __syncthreads();
  for (int ks = 0; ks < nk; ks += 2) {
    issue(B1{}, (ks + 1) * 64);
    __builtin_amdgcn_sched_barrier(0);
    comp(B0{});
    __syncthreads();
    if (ks + 2 < nk) issue(B0{}, (ks + 2) * 64);
    else if (has_next) gemm_dma_stage0(next, smc);
    __builtin_amdgcn_sched_barrier(0);
    comp(B1{});
    __syncthreads();
  }
}

template <int NB>
DI void gemm_loop_dma16(const bf16_t* __restrict__ A, long lda, const bf16_t* __restrict__ B, long ldb, int K, f32x4 (&acc)[4][NB], char* smc,
                      bool started = false, bool has_next = false, GDesc next = GDesc{nullptr, 0, nullptr, 0}) {
  const int t = tid(), lane = t & 63, w = t >> 6, wm = w >> 1, wn = w & 1, r16 = lane & 15, q = lane >> 4;
  unsigned aoff[4], boff[NB];
#pragma unroll
  for (int i = 0; i < 4; i++) {
    const int row = 32 * w + 8 * i + (lane >> 3), c = (lane & 7) ^ ((row >> 1) & 7);
    aoff[i] = (unsigned)((row * lda + c * 8) * 2);
  }
#pragma unroll
  for (int i = 0; i < NB; i++) {
    const int row = 8 * (NB * w + i) + (lane >> 3), c = (lane & 7) ^ ((row >> 1) & 7);
    boff[i] = (unsigned)((row * ldb + c * 8) * 2);
  }
  const char* Ab = (const char*)A; const char* Bb = (const char*)B;
  const unsigned lbase = (unsigned)(uintptr_t)smc;
  const unsigned wdst = lbase + (unsigned)w * 4096u;
  const int swz = (r16 >> 1) & 7;
  unsigned fo[2];
#pragma unroll
  for (int k32 = 0; k32 < 2; k32++) fo[k32] = (unsigned)(((4 * k32 + q) ^ swz) * 16);
  const char* rA = smc + (wm * 64 + r16) * 128;
  const char* rB = smc + 16384 + (wn * 16 * NB + r16) * 128;
  const int nk = K >> 6;
  auto issue = [&](auto BUF, int ko) {
    constexpr int buf = decltype(BUF)::value;
#pragma unroll
    for (int i = 0; i < 4; i++)
      __builtin_amdgcn_global_load_lds((const unsigned*)(Ab + (size_t)ko * 2 + aoff[i]), (LAS3 unsigned*)(uintptr_t)(wdst + buf * 32768 + i * 1024), 16, 0, 0);
#pragma unroll
    for (int i = 0; i < NB; i++)
      __builtin_amdgcn_global_load_lds((const unsigned*)(Bb + (size_t)ko * 2 + boff[i]), (LAS3 unsigned*)(uintptr_t)(lbase + buf * 32768 + 16384 + (NB * w + i) * 1024), 16, 0, 0);
  };
  auto comp = [&](auto BUF) {
    constexpr int buf = decltype(BUF)::value;
#pragma unroll
    for (int k32 = 0; k32 < 2; k32++) {
      bf16x8 af[4], bq[NB];
#pragma unroll
      for (int mb = 0; mb < 4; mb++) af[mb] = *(const bf16x8*)(rA + buf * 32768 + mb * 16 * 128 + fo[k32]);
#pragma unroll
      for (int nb = 0; nb < NB; nb++) bq[nb] = *(const bf16x8*)(rB + buf * 32768 + nb * 16 * 128 + fo[k32]);
#pragma unroll
      for (int mb = 0; mb < 4; mb++)
#pragma unroll
        for (int nb = 0; nb < NB; nb++) acc[mb][nb] = MFMA16(af[mb], bq[nb], acc[mb][nb]);
    }
  };
  using B0 = std::integral_constant<int, 0>; using B1 = std::integral_constant<int, 1>;
  if (!started) issue(B0{}, 0);
  __syncthreads();
  for (int ks = 0; ks < nk; ks += 2) {
    issue(B1{}, (ks + 1) * 64); __builtin_amdgcn_sched_barrier(0);
    comp(B0{});
    __syncthreads();
    if (ks + 2 < nk) issue(B0{}, (ks + 2) * 64);
    else if (has_next) gemm_dma_stage0(next, smc);
    __builtin_amdgcn_sched_barrier(0);
    comp(B1{});
    __syncthreads();
  }
}

DI void gemm_loop_dma2(const bf16_t* __restrict__ A, long lda, const bf16_t* __restrict__ B0, const bf16_t* __restrict__ B1, long ldb, int K,
                       f32x16 (&accP)[2][2], f32x16 (&accQ)[2][2], char* smc) {
  const int t = tid(), lane = t & 63, w = t >> 6, wm = w >> 1, wn = w & 1, l31 = lane & 31, h = lane >> 5;
  unsigned aoff[2], boff[2];
#pragma unroll
  for (int i = 0; i < 2; i++) {
    const int row = 16 * (2 * w + i) + (lane >> 2), c = (lane & 3) ^ ((row >> 2) & 3);
    aoff[i] = (unsigned)((row * lda + c * 8) * 2); boff[i] = (unsigned)((row * ldb + c * 8) * 2);
  }
  const char* Ab = (const char*)A; const char* B0b = (const char*)B0; const char* B1b = (const char*)B1;
  const unsigned wdst = (unsigned)(uintptr_t)smc + (unsigned)w * 2048u;
  const int swz = (l31 >> 2) & 3;
  unsigned fo[2];
#pragma unroll
  for (int kk = 0; kk < 2; kk++) fo[kk] = (unsigned)(((2 * kk + h) ^ swz) * 16);
  const char* rA = smc + (wm * 64 + l31) * 64;
  const char* rB0 = smc + 8192 + (wn * 64 + l31) * 64;
  const char* rB1 = smc + 16384 + (wn * 64 + l31) * 64;
  const int nk = K >> 5;
  auto issue = [&](auto BUF, int ko) {
    constexpr int buf = decltype(BUF)::value;
#pragma unroll
    for (int i = 0; i < 2; i++) {
      __builtin_amdgcn_global_load_lds((const unsigned*)(Ab + (size_t)ko * 2 + aoff[i]), (LAS3 unsigned*)(uintptr_t)(wdst + buf * 24576 + i * 1024), 16, 0, 0);
      __builtin_amdgcn_global_load_lds((const unsigned*)(B0b + (size_t)ko * 2 + boff[i]), (LAS3 unsigned*)(uintptr_t)(wdst + buf * 24576 + 8192 + i * 1024), 16, 0, 0);
      __builtin_amdgcn_global_load_lds((const unsigned*)(B1b + (size_t)ko * 2 + boff[i]), (LAS3 unsigned*)(uintptr_t)(wdst + buf * 24576 + 16384 + i * 1024), 16, 0, 0);
    }
  };
  auto comp = [&](auto BUF) {
    constexpr int buf = decltype(BUF)::value;
#pragma unroll
    for (int kk = 0; kk < 2; kk++) {
      bf16x8 af[2], b0[2], b1[2];
#pragma unroll
      for (int mb = 0; mb < 2; mb++) af[mb] = *(const bf16x8*)(rA + buf * 24576 + mb * 32 * 64 + fo[kk]);
#pragma unroll
      for (int nb = 0; nb < 2; nb++) { b0[nb] = *(const bf16x8*)(rB0 + buf * 24576 + nb * 32 * 64 + fo[kk]); b1[nb] = *(const bf16x8*)(rB1 + buf * 24576 + nb * 32 * 64 + fo[kk]); }
#pragma unroll
      for (int mb = 0; mb < 2; mb++)
#pragma unroll
        for (int nb = 0; nb < 2; nb++) { accP[mb][nb] = MFMA(af[mb], b0[nb], accP[mb][nb]); accQ[mb][nb] = MFMA(af[mb], b1[nb], accQ[mb][nb]); }
    }
  };
  using S0 = std::integral_constant<int, 0>; using S1 = std::integral_constant<int, 1>;
  issue(S0{}, 0);
  __syncthreads();
  for (int ks = 0; ks < nk; ks += 2) {
    issue(S1{}, (ks + 1) * 32);
    __builtin_amdgcn_sched_barrier(0);
    comp(S0{});
    __syncthreads();
    if (ks + 2 < nk) issue(S0{}, (ks + 2) * 32);
    __builtin_amdgcn_sched_barrier(0);
    comp(S1{});
    __syncthreads();
  }
}

DI void acc_to_lds(const f32x16 (&acc)[2][2], float* ep) {
  const int t = tid(), lane = t & 63, w = t >> 6, wm = w >> 1, wn = w & 1, l31 = lane & 31, h = lane >> 5;
#pragma unroll
  for (int mb = 0; mb < 2; mb++)
#pragma unroll
    for (int nb = 0; nb < 2; nb++)
#pragma unroll
      for (int i = 0; i < 16; i++) ep[(wm * 64 + mb * 32 + crow(i, h)) * EPW + wn * 64 + nb * 32 + l31] = acc[mb][nb][i];
}
template <int NB>
DI void acc_to_lds4(const f32x4 (&acc)[4][NB], float* ep) {
  const int t = tid(), lane = t & 63, w = t >> 6, wm = w >> 1, wn = w & 1, r16 = lane & 15, q = lane >> 4;
#pragma unroll
  for (int mb = 0; mb < 4; mb++)
#pragma unroll
    for (int nb = 0; nb < NB; nb++) {
      float* d = ep + (wm * 64 + mb * 16 + q * 4) * EPW + wn * 16 * NB + nb * 16 + r16;
      d[0] = acc[mb][nb].x; d[EPW] = acc[mb][nb].y; d[2 * EPW] = acc[mb][nb].z; d[3 * EPW] = acc[mb][nb].w;
    }
}
template <class F>
DI void rowwise(const float* ep, F f) {
  const int t = tid();
#pragma unroll 1
  for (int ps = 0; ps < 8; ps++) {
    const int row = ps * 16 + (t >> 4), c8 = (t & 15) * 8;
    float v[8];
    const f32x4 a = *(const f32x4*)(ep + row * EPW + c8), b = *(const f32x4*)(ep + row * EPW + c8 + 4);
    v[0] = a.x; v[1] = a.y; v[2] = a.z; v[3] = a.w; v[4] = b.x; v[5] = b.y; v[6] = b.z; v[7] = b.w;
    f(row, c8, v);
  }
}
template <class L, class F>
DI void rowwise2(const float* ep, L pre, F f) {
  const int t = tid();
  const int c8 = (t & 15) * 8;
#pragma unroll 1
  for (int g = 0; g < 2; g++) {
    decltype(pre(0, 0)) ld[4];
#pragma unroll
    for (int q = 0; q < 4; q++) ld[q] = pre((g * 4 + q) * 16 + (t >> 4), c8);
#pragma unroll
    for (int q = 0; q < 4; q++) {
      const int row = (g * 4 + q) * 16 + (t >> 4);
      float v[8];
      const f32x4 a = *(const f32x4*)(ep + row * EPW + c8), b = *(const f32x4*)(ep + row * EPW + c8 + 4);
      v[0] = a.x; v[1] = a.y; v[2] = a.z; v[3] = a.w; v[4] = b.x; v[5] = b.y; v[6] = b.z; v[7] = b.w;
      f(row, c8, v, ld[q]);
    }
  }
}
struct LdRope { f32x4 r[4]; };
struct LdKv { unsigned k2; u32x4 x1, x2; f32x4 r[4]; };
struct LdX { f32x4 a, b; };
struct LdGlu { u32x4 yg, gt; };
template <class F>
DI void tstore(const float* ep, int cb, int nc, const float* rowscale, F dst) {
  const int t = tid();
  const int ntask = nc * 16;
  for (int e = t; e < ntask; e += 256) {
    const int col = e % nc, rg = e / nc;
    float v[8];
#pragma unroll
    for (int j = 0; j < 8; j++) { float x = ep[(rg * 8 + j) * EPW + cb + col]; if (rowscale) x *= rowscale[rg * 8 + j]; v[j] = x; }
    *(u32x4*)(dst(col) + rg * 8) = pack8(v);
  }
}

DI void tile_from_linear(int L, int nN, int& tm, int& tn) { const int band = L / (8 * nN), rr = L % (8 * nN); tn = rr >> 3; tm = band * 8 + (rr & 7); }
DI int static_L(int round, int vb) { const int Gx = gridDim.x >> 3; return (round * 8 + (vb & 7)) * Gx + (vb >> 3); }
DI int next_item(unsigned* ctr, int* slot) {
  __syncthreads();
  if (threadIdx.x == 0) *slot = (int)atomicAdd(ctr, 1u);
  __syncthreads();
  return *slot;
}

DI int colmap(int mode, int n) {
  if (mode == 0) return n;
  if (mode == 1) { if (n < 768) return n; if (n < 2304) return n + 1056; if (n < 3360) return n - 1536; if (n < 3456) return -1; return n - 96; }
  { const int hh = n >> 7, j = n & 127; return j < 96 ? hh * 96 + j : -1; }
}
struct CDesc { const float* src; const float* g; bf16_t* dst; int ld, K, mode, it; };
DI void conv_load(const CDesc& d, f32x4 (&v)[8]) {
  const int t = tid();
  const int nkt = d.K >> 6, kt = d.it % nkt, nt = d.it / nkt, k0 = kt * 64, n0 = nt * 128;
  const int n4 = (t & 31) * 4, c = colmap(d.mode, n0 + n4);
#pragma unroll
  for (int i = 0; i < 8; i++) {
    const int kk = (t >> 5) + 8 * i;
    if (c >= 0) v[i] = __builtin_nontemporal_load((const f32x4*)(d.src + (long)(k0 + kk) * d.ld + c)); else { v[i].x = 0.f; v[i].y = 0.f; v[i].z = 0.f; v[i].w = 0.f; }
  }
}
DI void conv_finish(const CDesc& d, f32x4 (&v)[8], float* sm) {
  const int t = tid();
  const int nkt = d.K >> 6, kt = d.it % nkt, nt = d.it / nkt, k0 = kt * 64, n0 = nt * 128;
  const int n4 = (t & 31) * 4;
#pragma unroll
  for (int i = 0; i < 8; i++) {
    const int kk = (t >> 5) + 8 * i;
    if (d.g) { const float gg = d.g[k0 + kk]; v[i].x *= gg; v[i].y *= gg; v[i].z *= gg; v[i].w *= gg; }
    *(f32x4*)(sm + kk * 132 + n4) = v[i];
  }
  __syncthreads();
#pragma unroll
  for (int i = 0; i < 2; i++) {
    const int nn = (t >> 2) + 64 * i, ks = (t & 3) * 16;
    float f[16];
#pragma unroll
    for (int j = 0; j < 16; j++) f[j] = sm[(ks + j) * 132 + nn];
    u32x4 o0, o1;
    o0.x = pk2(f[0], f[1]); o0.y = pk2(f[2], f[3]); o0.z = pk2(f[4], f[5]); o0.w = pk2(f[6], f[7]);
    o1.x = pk2(f[8], f[9]); o1.y = pk2(f[10], f[11]); o1.z = pk2(f[12], f[13]); o1.w = pk2(f[14], f[15]);
    bf16_t* dd = d.dst + (long)(n0 + nn) * d.K + k0 + ks;
    *(u32x4*)dd = o0; *(u32x4*)(dd + 8) = o1;
  }
  __syncthreads();
}
constexpr int NCONV = 944 + 72 + 32 + 8 + 32 + 64 + 32 + 32 + 128 + 64;
constexpr int NAUX = NCONV + 512;
DI CDesc conv_desc(const P& p, int l, int it) {
  CDesc d; d.g = nullptr; d.mode = 0;
  if (it < 944) { d.src = p.w_in + (long)l * 1024 * INW; d.ld = INW; d.K = 1024; d.mode = 1; d.g = p.norm_g + l * 1024; d.dst = p.WinT; d.it = it; return d; }
  it -= 944;
  if (it < 72) { d.src = p.b_w_uq + (long)l * 768 * 768; d.ld = 768; d.K = 768; d.g = p.b_q_norm_g + l * 768; d.dst = p.WuqT; d.it = it; return d; }
  it -= 72;
  if (it < 32) { d.src = p.b_w_ukv + (long)l * 256 * 1024; d.ld = 1024; d.K = 256; d.g = p.b_kv_norm_g + l * 256; d.dst = p.WukvT; d.it = it; return d; }
  it -= 32;
  if (it < 8) { d.src = p.c_w_glu + (long)l * 256 * 256; d.ld = 256; d.K = 256; d.dst = p.WgluT; d.it = it; return d; }
  it -= 8;
  if (it < 32) { d.src = p.w_br_a + (long)l * 256 * 1024; d.ld = 1024; d.K = 256; d.dst = p.WbrT; d.it = it; return d; }
  it -= 32;
  if (it < 64) { d.src = p.w_br_b + (long)l * 512 * 1024; d.ld = 1024; d.K = 512; d.dst = p.WbrT + 1024 * 256; d.it = it; return d; }
  it -= 64;
  if (it < 32) { d.src = p.w_br_c + (long)l * 256 * 1024; d.ld = 1024; d.K = 256; d.dst = p.WbrT + 1024 * 768; d.it = it; return d; }
  it -= 32;
  if (it < 32) { d.src = p.w_br_m + (long)l * 256 * 1024; d.ld = 1024; d.K = 256; d.dst = p.WbrT + 1024 * 1024; d.it = it; return d; }
  it -= 32;
  if (it < 128) { d.src = p.w_out + (long)l * 1024 * 1024; d.ld = 1024; d.K = 1024; d.dst = p.WoutT + (long)l * 1024 * 1024; d.it = it; return d; }
  it -= 128;
  d.src = p.m_w_kv + (long)l * 1024 * 512; d.ld = 512; d.K = 1024; d.dst = p.WmkvT; d.it = it; return d;
}
DI void conv_all(const P& p, int l, char* smem) {
  const int G = gridDim.x, bid = blockIdx.x;
  float* sm = (float*)smem;
  if (bid >= NCONV) return;
  f32x4 va[8], vb[8];
  CDesc da = conv_desc(p, l, bid), db = da;
  conv_load(da, va);
#pragma unroll 1
  for (int it = bid; it < NCONV; it += 2 * G) {
    const bool h1 = it + G < NCONV;
    if (h1) { db = conv_desc(p, l, it + G); conv_load(db, vb); }
    conv_finish(da, va, sm);
    const bool h2 = it + 2 * G < NCONV;
    if (h2) { da = conv_desc(p, l, it + 2 * G); conv_load(da, va); }
    if (h1) conv_finish(db, vb, sm);
  }
}
DI void aux_item(const P& p, int l, int it, char* smem) {
  it -= NCONV;
  {
    const int t = tid(), lane = t & 63, row = it * 4 + (t >> 6);
    const float* src = p.mem + (long)row * 1024; const float* g = p.m_norm_g + l * 1024;
    f32x4 v[4]; float ss = 0.f;
#pragma unroll
    for (int i = 0; i < 4; i++) { v[i] = *(const f32x4*)(src + (lane + 64 * i) * 4); ss += v[i].x * v[i].x + v[i].y * v[i].y + v[i].z * v[i].z + v[i].w * v[i].w; }
    ss = sum64(ss);
    const float r = rsqrtf(ss * (1.f / 1024.f) + EPS);
#pragma unroll
    for (int i = 0; i < 4; i++) {
      const f32x4 gg = *(const f32x4*)(g + (lane + 64 * i) * 4);
      u32x2 o; o.x = pk2(v[i].x * r * gg.x, v[i].y * r * gg.y); o.y = pk2(v[i].z * r * gg.z, v[i].w * r * gg.w);
      *(u32x2*)(p.hm + (long)row * 1024 + (lane + 64 * i) * 4) = o;
    }
  }
}

DI void p0_xrow_item(const P& p, int it) {
  const int t = tid(), lane = t & 63;
  f32x4 v[2][4];
#pragma unroll
  for (int r = 0; r < 2; r++) {
    const float* src = p.x + (long)(it * 8 + (t >> 6) * 2 + r) * 1024;
#pragma unroll
    for (int i = 0; i < 4; i++) v[r][i] = __builtin_nontemporal_load((const f32x4*)(src + (lane + 64 * i) * 4));
  }
#pragma unroll
  for (int r = 0; r < 2; r++) {
    const int row = it * 8 + (t >> 6) * 2 + r;
    float ss = 0.f;
#pragma unroll
    for (int i = 0; i < 4; i++) ss += v[r][i].x * v[r][i].x + v[r][i].y * v[r][i].y + v[r][i].z * v[r][i].z + v[r][i].w * v[r][i].w;
    ss = sum64(ss);
#pragma unroll
    for (int i = 0; i < 4; i++) { u32x2 o; o.x = pk2(v[r][i].x, v[r][i].y); o.y = pk2(v[r][i].z, v[r][i].w); *(u32x2*)(p.xb + (long)row * 1024 + (lane + 64 * i) * 4) = o; }
    if (lane < 8) p.ssp[(long)lane * T_ + row] = (lane == 0) ? ss : 0.f;
  }
}
DI void p0_rope_item(const P& p, int it) {
  const int e = it * 256 + threadIdx.x, tok = e >> 4, i = e & 15;
  const float inv_freq = exp2f(-(float)i * (13.287712379549449f / 16.f));
  const float ang = (float)p.pos[tok] * inv_freq;
  const double rev = (double)ang * 0.15915494309189535;
  const float fr = (float)(rev - rint(rev));
  p.rope[(long)e * 2] = __builtin_amdgcn_cosf(fr);
  p.rope[(long)e * 2 + 1] = __builtin_amdgcn_sinf(fr);
}

DI void load_rs(const P& p, int r0, float* rsS) {
  const int t = tid();
  if (t < 128) { float s = 0.f;
#pragma unroll
    for (int j = 0; j < 8; j++) s += p.ssp[(long)j * T_ + r0 + t];
    rsS[t] = rsqrtf(s * (1.f / 1024.f) + EPS); }
}
DI void g1_tile(const P& p, int l, int tm, int tn, char* smem) {
  bf16_t* sm = (bf16_t*)smem; float* ep = (float*)smem; float* rsS = (float*)(smem + SM_RS);
  const int r0 = tm * 128, c0 = tn * 128;
  load_rs(p, r0, rsS);
  f32x16 acc[2][2]; zero_acc(acc);
  gemm_loop_dma(p.xb + (long)r0 * 1024, 1024, p.WinT + (long)c0 * 1024, 1024, 1024, acc, smem);
  acc_to_lds(acc, ep);
  __syncthreads();
  int type; bf16_t* dst; int ld;
  if (c0 < 2304) { dst = p.z1 + c0; ld = Z1W;
    if (c0 < 512) type = 1; else if (c0 < 1280) type = 2; else if (c0 < 1536) type = 0; else if (c0 < 1792) type = 2; else if (c0 < 2048) type = 3; else type = 2;
  } else { dst = p.z2 + (c0 - 2304); ld = Z2W; type = 0; }
  const float* gq = p.m_qk_g_q + l * 64;
  rowwise(ep, [&](int row, int c8, float (&v)[8]) {
    const float r = rsS[row];
#pragma unroll
    for (int j = 0; j < 8; j++) v[j] *= r;
    if (type == 1) {
#pragma unroll
      for (int j = 0; j < 8; j++) v[j] = gelu_t(v[j]);
    } else if (type == 2) {
#pragma unroll
      for (int j = 0; j < 8; j++) v[j] = silu(v[j]);
    } else if (type == 3) {
      float ss = 0.f;
#pragma unroll
      for (int j = 0; j < 8; j++) ss += v[j] * v[j];
      ss = sum8(ss);
      const float rq = rsqrtf(ss * (1.f / 64.f) + EPS) * (0.125f * LOG2E);
#pragma unroll
      for (int j = 0; j < 8; j++) v[j] *= rq * gq[(c8 & 63) + j];
    }
    *(u32x4*)(dst + (long)(r0 + row) * ld + c8) = pack8(v);
    if (c0 >= 2304) {
      float ss = 0.f;
#pragma unroll
      for (int j = 0; j < 8; j++) ss += v[j] * v[j];
      ss = sum16(ss);
      if ((c8 >> 3) == 0) p.ssq[(long)((c0 - 2304) >> 7) * T_ + r0 + row] = ss;
    }
  });
  __syncthreads();
}
DI void g1m_tile(const P& p, int l, int tm, int tn, char* smem) {
  bf16_t* sm = (bf16_t*)smem; float* ep = (float*)smem;
  const int r0 = tm * 128, c0 = tn * 128;
  f32x16 acc[2][2]; zero_acc(acc);
  gemm_loop_dma(p.hm + (long)r0 * 1024, 1024, p.WmkvT + (long)c0 * 1024, 1024, 1024, acc, smem);
  acc_to_lds(acc, ep);
  __syncthreads();
  if (tn < 2) {
    const float* gk = p.m_qk_g_k + l * 64;
    rowwise(ep, [&](int row, int c8, float (&v)[8]) {
      float ss = 0.f;
#pragma unroll
      for (int j = 0; j < 8; j++) ss += v[j] * v[j];
      ss = sum8(ss);
      const float rq = rsqrtf(ss * (1.f / 64.f) + EPS);
#pragma unroll
      for (int j = 0; j < 8; j++) v[j] *= rq * gk[(c8 & 63) + j];
      *(u32x4*)(p.memk + (long)(r0 + row) * 256 + c0 + c8) = pack8(v);
    });
  } else {
    const int b = r0 >> 8, m0 = r0 & 255, cv0 = c0 - 256;
    tstore(ep, 0, 128, nullptr, [&](int col) { const int cv = cv0 + col; return p.memvt + ((long)((b * 4 + (cv >> 6)) * 64 + (cv & 63))) * 256 + m0; });
  }
  __syncthreads();
}

DI void g2q_tile(const P& p, int l, int tm, int hh, char* smem) {
  bf16_t* sm = (bf16_t*)smem; float* ep = (float*)smem; float* ssS = (float*)(smem + SM_SS);
  const int r0 = tm * 128;
  f32x4 acc[4][3]; zero_acc4<3>(acc);
  { const int t = tid(); if (t < 128) { float q = 0.f;
#pragma unroll
      for (int j = 0; j < 6; j++) q += p.ssq[(long)j * T_ + r0 + t];
      ssS[t] = rsqrtf(q * (1.f / 768.f) + EPS); } }
  gemm_loop_dma16<3>(p.z2 + (long)r0 * Z2W, Z2W, p.WuqT + (long)hh * 96 * 768, 768, 768, acc, smem);
  acc_to_lds4<3>(acc, ep);
  __syncthreads();
  const float* gq = p.b_qk_g_q + l * 96;
  const float QSC = 0.10206207261596575f * LOG2E;
  rowwise2(ep, [&](int row, int c8) {
    LdRope L;
    const int tc = c8 >> 3;
    if (tc >= 8 && tc < 12) {
      const float* rp = p.rope + ((long)(r0 + row) * 16 + (tc & 1) * 8) * 2;
#pragma unroll
      for (int j = 0; j < 4; j++) L.r[j] = *(const f32x4*)(rp + 4 * j);
    } else {
#pragma unroll
      for (int j = 0; j < 4; j++) { L.r[j].x = 0.f; L.r[j].y = 0.f; L.r[j].z = 0.f; L.r[j].w = 0.f; }
    }
    return L;
  }, [&](int row, int c8, float (&v)[8], const LdRope& L) {
    const float rs = ssS[row];
    float ss = 0.f;
#pragma unroll
    for (int j = 0; j < 8; j++) { v[j] *= rs; ss += v[j] * v[j]; }
    const int tc = c8 >> 3;
    if (tc >= 12) ss = 0.f;
    ss = sum16(ss);
    const float rq = rsqrtf(ss * (1.f / 96.f) + EPS);
    bf16_t* qd = p.qf + (long)(r0 + row) * 768 + hh * 96;
    if (tc < 8) {
#pragma unroll
      for (int j = 0; j < 8; j++) v[j] *= rq * gq[c8 + j] * QSC;
      *(u32x4*)(qd + c8) = pack8(v);
    } else if (tc < 12) {
      const int i0 = (tc & 1) * 8; const bool first = tc < 10;
      const int pc = first ? 80 + i0 : 64 + i0;
      const float csn[16] = {L.r[0].x, L.r[0].y, L.r[0].z, L.r[0].w, L.r[1].x, L.r[1].y, L.r[1].z, L.r[1].w,
                             L.r[2].x, L.r[2].y, L.r[2].z, L.r[2].w, L.r[3].x, L.r[3].y, L.r[3].z, L.r[3].w};
      float o[8];
#pragma unroll
      for (int j = 0; j < 8; j++) {
        const float own = v[j] * rq * gq[c8 + j];
        const float oth = ep[row * EPW + pc + j] * rs * rq * gq[pc + j];
        const float cs = csn[2 * j], sn = csn[2 * j + 1];
        o[j] = (first ? (own * cs - oth * sn) : (own * cs + oth * sn)) * QSC;
      }
      *(u32x4*)(qd + c8) = pack8(o);
    }
  });
  __syncthreads();
}
DI void g2kv_tile(const P& p, int l, int tm, int hh, char* smem) {
  bf16_t* sm = (bf16_t*)smem; float* ep = (float*)smem; float* ssS = (float*)(smem + SM_SS);
  const int r0 = tm * 128;
  f32x16 acc[2][2]; zero_acc(acc);
  { const int t = tid(); if (t < 128) { const float q = p.ssq[(long)6 * T_ + r0 + t] + p.ssq[(long)7 * T_ + r0 + t];
      ssS[t] = rsqrtf(q * (1.f / 256.f) + EPS); } }
  gemm_loop_dma(p.z2 + (long)r0 * Z2W + 768, Z2W, p.WukvT + (long)hh * 128 * 256, 256, 256, acc, smem);
  acc_to_lds(acc, ep);
  __syncthreads();
  const float* gk = p.b_qk_g_k + l * 96;
  rowwise2(ep, [&](int row, int c8) {
    LdKv L;
    const int tc = c8 >> 3;
    const bf16_t* krp = p.z2 + (long)(r0 + row) * Z2W + 1024;
    L.k2 = *(const unsigned*)(krp + 2 * tc);
    if (tc >= 8 && tc < 12) {
      const int i0 = (tc & 1) * 8;
      L.x1 = *(const u32x4*)(krp + i0); L.x2 = *(const u32x4*)(krp + 16 + i0);
      const float* rp = p.rope + ((long)(r0 + row) * 16 + i0) * 2;
#pragma unroll
      for (int j = 0; j < 4; j++) L.r[j] = *(const f32x4*)(rp + 4 * j);
    } else {
      L.x1.x = 0; L.x1.y = 0; L.x1.z = 0; L.x1.w = 0; L.x2 = L.x1;
#pragma unroll
      for (int j = 0; j < 4; j++) { L.r[j].x = 0.f; L.r[j].y = 0.f; L.r[j].z = 0.f; L.r[j].w = 0.f; }
    }
    return L;
  }, [&](int row, int c8, float (&v)[8], const LdKv& L) {
    const float rs = ssS[row];
    const int tc = c8 >> 3;
    const unsigned k2 = L.k2;
    const float ka = __uint_as_float(k2 << 16), kb = __uint_as_float(k2 & 0xffff0000u);
    float ss = ka * ka + kb * kb;
    if (tc < 8) {
#pragma unroll
      for (int j = 0; j < 8; j++) { v[j] *= rs; ss += v[j] * v[j]; }
    }
    ss = sum16(ss);
    const float kn = rsqrtf(ss * (1.f / 96.f) + EPS);
    bf16_t* kd = p.kf + (long)(r0 + row) * 768 + hh * 96;
    if (tc < 8) {
#pragma unroll
      for (int j = 0; j < 8; j++) v[j] *= kn * gk[c8 + j];
      *(u32x4*)(kd + c8) = pack8(v);
    } else if (tc < 12) {
      const int i0 = (tc & 1) * 8; const bool first = tc < 10;
      float x1[8], x2[8], o[8];
      unpack8(L.x1, x1);
      unpack8(L.x2, x2);
      const float csn[16] = {L.r[0].x, L.r[0].y, L.r[0].z, L.r[0].w, L.r[1].x, L.r[1].y, L.r[1].z, L.r[1].w,
                             L.r[2].x, L.r[2].y, L.r[2].z, L.r[2].w, L.r[3].x, L.r[3].y, L.r[3].z, L.r[3].w};
#pragma unroll
      for (int j = 0; j < 8; j++) {
        const float a = x1[j] * kn * gk[64 + i0 + j], b = x2[j] * kn * gk[80 + i0 + j];
        const float cs = csn[2 * j], sn = csn[2 * j + 1];
        o[j] = first ? (a * cs - b * sn) : (b * cs + a * sn);
      }
      *(u32x4*)(kd + (first ? 64 : 80) + i0) = pack8(o);
    }
  });
  {
    const int b = r0 >> 11, s0 = r0 & 2047;
    tstore(ep, 64, 64, ssS, [&](int col) { return p.vt + ((long)((b * 8 + hh) * 64 + col)) * S_ + s0; });
  }
  __syncthreads();
}

template <int DQK, bool CAUSAL>
DI void attn_item(const bf16_t* __restrict__ q, long q_ld, const bf16_t* __restrict__ k, long k_ld, const bf16_t* __restrict__ vt, long vt_ld,
                  bf16_t* og, long o_ld, int q0, int nkt, char* smem, bool dry) {
  constexpr int KS = DQK + 8, NKC = DQK / 8, NKL = (64 * NKC) / 256, NKK = DQK / 16, VS = 68;
  bf16_t* sK = (bf16_t*)smem;
  bf16_t* sV = (bf16_t*)smem + 2 * 64 * KS;
  const int t = tid(), lane = t & 63, w = t >> 6, l31 = lane & 31, h = lane >> 5;
  bf16x8 qfr[NKK];
  {
    const bf16_t* qp = q + (long)(w * 32 + l31) * q_ld + h * 8;
#pragma unroll
    for (int kk = 0; kk < NKK; kk++) qfr[kk] = *(const bf16x8*)(qp + kk * 16);
  }
  u32x4 rk[NKL], rv[2];
  auto gload = [&](int kt) {
#pragma unroll
    for (int i = 0; i < NKL; i++) { const int c = t + 256 * i, key = c / NKC, kc = c % NKC; rk[i] = *(const u32x4*)(k + (long)(kt * 64 + key) * k_ld + kc * 8); }
#pragma unroll
    for (int i = 0; i < 2; i++) { const int c = t + 256 * i, d = c >> 3, kc = c & 7; rv[i] = *(const u32x4*)(vt + (long)d * vt_ld + kt * 64 + kc * 8); }
  };
  auto lstore = [&](int buf) {
    bf16_t* dK = sK + buf * 64 * KS; bf16_t* dV = sV + buf * 64 * VS;
#pragma unroll
    for (int i = 0; i < NKL; i++) { const int c = t + 256 * i, key = c / NKC, kc = c % NKC; *(u32x4*)(dK + key * KS + kc * 8) = rk[i]; }
#pragma unroll
    for (int i = 0; i < 2; i++) { const int c = t + 256 * i, d = c >> 3, kc = c & 7;
      u32x2 lo, hi; lo.x = rv[i].x; lo.y = rv[i].y; hi.x = rv[i].z; hi.y = rv[i].w;
      *(u32x2*)(dV + d * VS + kc * 8) = lo; *(u32x2*)(dV + d * VS + kc * 8 + 4) = hi; }
  };
  f32x16 o[2];
#pragma unroll
  for (int i = 0; i < 16; i++) { o[0][i] = 0.f; o[1][i] = 0.f; }
  float m = -1e30f, lsum = 0.f;
  const int qpos = q0 + w * 32 + l31;
  gload(0); lstore(0);
  if (nkt > 1) gload(1);
  __syncthreads();
  for (int kt = 0; kt < nkt; kt++) {
    if (kt + 1 < nkt) lstore((kt + 1) & 1);
    __builtin_amdgcn_sched_barrier(0);
    if (kt + 2 < nkt) gload(kt + 2);
    __builtin_amdgcn_sched_barrier(0);
    const bool active = !CAUSAL || (kt * 64 <= q0 + w * 32 + 31);
    if (active) {
      const bf16_t* cK = sK + (kt & 1) * 64 * KS; const bf16_t* cV = sV + (kt & 1) * 64 * VS;
      f32x16 s[2];
#pragma unroll
      for (int i = 0; i < 16; i++) { s[0][i] = 0.f; s[1][i] = 0.f; }
      __builtin_amdgcn_s_setprio(1);
#pragma unroll
      for (int kb = 0; kb < 2; kb++)
#pragma unroll
        for (int kk = 0; kk < NKK; kk++) {
          const bf16x8 kf_ = *(const bf16x8*)(cK + (kb * 32 + l31) * KS + kk * 16 + h * 8);
          s[kb] = MFMA(kf_, qfr[kk], s[kb]);
        }
      __builtin_amdgcn_s_setprio(0);
      if (CAUSAL && (kt * 64 + 63 > q0 + w * 32)) {
#pragma unroll
        for (int kb = 0; kb < 2; kb++)
#pragma unroll
          for (int i = 0; i < 16; i++) { const int key = kt * 64 + kb * 32 + crow(i, h); if (key > qpos) s[kb][i] = -1e30f; }
      }
      float mx = s[0][0];
#pragma unroll
      for (int kb = 0; kb < 2; kb++)
#pragma unroll
        for (int i = 0; i < 16; i++) mx = fmaxf(mx, s[kb][i]);
      mx = fmaxf(mx, __shfl_xor(mx, 32));
      const float mnew = fmaxf(m, mx);
      const float alpha = __builtin_amdgcn_exp2f(m - mnew);
      m = mnew;
      float ps = 0.f;
#pragma unroll
      for (int kb = 0; kb < 2; kb++)
#pragma unroll
        for (int i = 0; i < 16; i++) { const float pv = __builtin_amdgcn_exp2f(s[kb][i] - mnew); s[kb][i] = pv; ps += pv; }
      lsum = lsum * alpha + ps;
#pragma unroll
      for (int i = 0; i < 16; i++) { o[0][i] *= alpha; o[1][i] *= alpha; }
      __builtin_amdgcn_s_setprio(1);
#pragma unroll
      for (int kb = 0; kb < 2; kb++)
#pragma unroll
        for (int st = 0; st < 2; st++) {
          u32x4 pp; pp.x = pk2(s[kb][8 * st + 0], s[kb][8 * st + 1]); pp.y = pk2(s[kb][8 * st + 2], s[kb][8 * st + 3]);
          pp.z = pk2(s[kb][8 * st + 4], s[kb][8 * st + 5]); pp.w = pk2(s[kb][8 * st + 6], s[kb][8 * st + 7]);
          const bf16x8 pf = __builtin_bit_cast(bf16x8, pp);
#pragma unroll
          for (int db = 0; db < 2; db++) {
            const bf16_t* vp = cV + (db * 32 + l31) * VS + kb * 32 + st * 16 + 4 * h;
            const u32x2 lo = *(const u32x2*)vp, hi = *(const u32x2*)(vp + 8);
            u32x4 vv; vv.x = lo.x; vv.y = lo.y; vv.z = hi.x; vv.w = hi.y;
            o[db] = MFMA(__builtin_bit_cast(bf16x8, vv), pf, o[db]);
          }
        }
      __builtin_amdgcn_s_setprio(0);
    }
    __syncthreads();
  }
  lsum += __shfl_xor(lsum, 32);
  const float inv = 1.f / lsum;
  bf16_t* op = og + (long)(w * 32 + l31) * o_ld;
#pragma unroll
  for (int db = 0; db < 2; db++)
#pragma unroll
    for (int ig = 0; ig < 4; ig++) {
      const int d = db * 32 + ig * 8 + 4 * h;
      float gt[4]; unpack4(*(const u32x2*)(op + d), gt);
      u32x2 r; r.x = pk2(o[db][4 * ig + 0] * inv * gt[0], o[db][4 * ig + 1] * inv * gt[1]); r.y = pk2(o[db][4 * ig + 2] * inv * gt[2], o[db][4 * ig + 3] * inv * gt[3]);
      if (!dry) *(u32x2*)(op + d) = r;
    }
}
DI void mattn_item(const P& p, int idx, char* smem) {
  const int b = idx >> 6, hh = (idx >> 4) & 3, qt = idx & 15;
  const long tok0 = (long)b * S_ + qt * 128;
  attn_item<64, false>(p.z1 + tok0 * Z1W + 1792 + hh * 64, Z1W, p.memk + (long)b * 256 * 256 + hh * 64, 256,
                       p.memvt + (long)(b * 4 + hh) * 64 * 256, 256, p.z1 + tok0 * Z1W + 2048 + hh * 64, Z1W, 0, 4, smem, p.dry != 0);
}
DI void battn_item(const P& p, int idx, char* smem) {
  const int qt = 15 - (idx >> 6), bh = idx & 63, b = bh >> 3, hh = bh & 7;
  const long tok0 = (long)b * S_ + qt * 128;
  attn_item<96, true>(p.qf + tok0 * 768 + hh * 96, 768, p.kf + (long)b * S_ * 768 + hh * 96, 768,
                      p.vt + (long)(b * 8 + hh) * 64 * S_, S_, p.z1 + tok0 * Z1W + 768 + hh * 64, Z1W, qt * 128, 2 * qt + 2, smem, p.dry != 0);
}

DI void a_item(const P& p, int l, int idx, char* smem) {
  bf16_t* vnT = (bf16_t*)smem;
  float* part = (float*)(smem + 256 * 136 * 2);
  const int t = tid(); const long r0 = (long)idx * 128;
  {
    const int row = t & 127, half = t >> 7;
    const bf16_t* src = p.z1 + (r0 + row) * Z1W + 256 + half * 128;
    float ss = 0.f;
#pragma unroll 4
    for (int i = 0; i < 16; i++) { float f[8]; unpack8(*(const u32x4*)(src + i * 8), f);
#pragma unroll
      for (int j = 0; j < 8; j++) ss += f[j] * f[j]; }
    part[half * 128 + row] = ss;
    __syncthreads();
    const float r = rsqrtf((part[row] + part[128 + row]) * (1.f / 256.f) + EPS);
    const float* gv = p.a_norm_g + l * 256 + half * 128;
#pragma unroll 4
    for (int i = 0; i < 16; i++) { float f[8]; unpack8(*(const u32x4*)(src + i * 8), f);
#pragma unroll
      for (int j = 0; j < 8; j++) vnT[(half * 128 + i * 8 + j) * 136 + row] = f2bf(f[j] * r * gv[i * 8 + j]); }
  }
  __syncthreads();
  const int lane = t & 63, g = t >> 6, l31 = lane & 31, h = lane >> 5;
  const float* W = p.a_w_s + (long)(l * 4 + g) * 128 * 128;
  const float* bs = p.a_b_s + (l * 4 + g) * 128;
#pragma unroll 1
  for (int mh = 0; mh < 2; mh++) {
    f32x16 acc[2][2]; zero_acc(acc);
#pragma unroll 2
    for (int kk = 0; kk < 8; kk++) {
      bf16x8 af[2], bfr[2];
#pragma unroll
      for (int mb = 0; mb < 2; mb++) {
        const int tt = mh * 64 + mb * 32 + l31, s0 = kk * 16 + h * 8;
        const f32x4 w0 = *(const f32x4*)(W + tt * 128 + s0), w1 = *(const f32x4*)(W + tt * 128 + s0 + 4);
        float f[8] = {w0.x, w0.y, w0.z, w0.w, w1.x, w1.y, w1.z, w1.w};
#pragma unroll
        for (int j = 0; j < 8; j++) if (s0 + j > tt) f[j] = 0.f;
        af[mb] = __builtin_bit_cast(bf16x8, pack8(f));
      }
#pragma unroll
      for (int nb = 0; nb < 2; nb++) bfr[nb] = *(const bf16x8*)(vnT + (g * 64 + nb * 32 + l31) * 136 + kk * 16 + h * 8);
#pragma unroll
      for (int mb = 0; mb < 2; mb++)
#pragma unroll
        for (int nb = 0; nb < 2; nb++) acc[mb][nb] = MFMA(af[mb], bfr[nb], acc[mb][nb]);
    }
#pragma unroll
    for (int mb = 0; mb < 2; mb++)
#pragma unroll
      for (int nb = 0; nb < 2; nb++)
#pragma unroll
        for (int i = 0; i < 16; i++) {
          const int tt = mh * 64 + mb * 32 + crow(i, h), col = g * 64 + nb * 32 + l31;
          bf16_t* zp = p.z1 + (r0 + tt) * Z1W;
          const float u = bf2f(zp[col]), gt = bf2f(zp[512 + col]);
          if (!p.dry) zp[col] = f2bf(u * (acc[mb][nb][i] + bs[tt]) * gt);
        }
  }
  __syncthreads();
}

DI void c_setup(const P& p, int l, int g, int lane, float& ar, float& ai, float (&Br)[16], float (&Bi)[16]) {
  const int gi = (l * 16 + g) * 64 + lane;
  const float lre = p.c_a_re[gi], lim = p.c_a_im[gi];
  const float dt = expf(p.c_log_dt[l * 16 + g]);
  const float mag = expf(lre * dt);
  const float angf = lim * dt;
  const double rev = (double)angf * 0.15915494309189535;
  const float rf = (float)((rev - rint(rev)) * 6.283185307179586);
  const float sn = sinf(rf), cs = cosf(rf);
  ar = mag * cs; ai = mag * sn;
  const float xr = ar - 1.f, xi = ai, den = 1.f / (lre * lre + lim * lim);
  const float cr = (xr * lre + xi * lim) * den, ci = (xi * lre - xr * lim) * den;
  const float* bre = p.c_b_re + (long)gi * 16; const float* bim = p.c_b_im + (long)gi * 16;
#pragma unroll
  for (int c4 = 0; c4 < 4; c4++) {
    const f32x4 r4 = *(const f32x4*)(bre + c4 * 4), i4 = *(const f32x4*)(bim + c4 * 4);
    const float rr[4] = {r4.x, r4.y, r4.z, r4.w}, ii[4] = {i4.x, i4.y, i4.z, i4.w};
#pragma unroll
    for (int j = 0; j < 4; j++) { Br[c4 * 4 + j] = cr * rr[j] - ci * ii[j]; Bi[c4 * 4 + j] = cr * ii[j] + ci * rr[j]; }
  }
}
DI void c_load_u(const P& p, long tok0, int g, int lane, float* ub) {
  const bf16_t* up = p.z1 + (tok0 + lane) * Z1W + 1280 + g * 16;
  float f0[8], f1[8];
  unpack8(*(const u32x4*)up, f0); unpack8(*(const u32x4*)(up + 8), f1);
  f32x4 a; a.x = f0[0]; a.y = f0[1]; a.z = f0[2]; a.w = f0[3]; *(f32x4*)(ub + lane * 16) = a;
  a.x = f0[4]; a.y = f0[5]; a.z = f0[6]; a.w = f0[7]; *(f32x4*)(ub + lane * 16 + 4) = a;
  a.x = f1[0]; a.y = f1[1]; a.z = f1[2]; a.w = f1[3]; *(f32x4*)(ub + lane * 16 + 8) = a;
  a.x = f1[4]; a.y = f1[5]; a.z = f1[6]; a.w = f1[7]; *(f32x4*)(ub + lane * 16 + 12) = a;
}
DI void c_step(const float* ub, int s, const float (&Br)[16], const float (&Bi)[16], float ar, float ai, float& sr, float& si) {
  float bur = 0.f, bui = 0.f;
#pragma unroll
  for (int c4 = 0; c4 < 4; c4++) {
    const f32x4 u = *(const f32x4*)(ub + s * 16 + c4 * 4);
    bur += Br[c4 * 4] * u.x + Br[c4 * 4 + 1] * u.y + Br[c4 * 4 + 2] * u.z + Br[c4 * 4 + 3] * u.w;
    bui += Bi[c4 * 4] * u.x + Bi[c4 * 4 + 1] * u.y + Bi[c4 * 4 + 2] * u.z + Bi[c4 * 4 + 3] * u.w;
  }
  const float nr = ar * sr - ai * si + bur, ni = ar * si + ai * sr + bui;
  sr = nr; si = ni;
}
DI void c1_item(const P& p, int l, int idx, char* smem) {
  const int t = tid(), lane = t & 63, w = t >> 6;
  const int b = idx >> 7, g = (idx >> 3) & 15, k = (idx & 7) * 4 + w;
  float* ub = (float*)smem + w * 1024;
  float ar, ai, Br[16], Bi[16];
  c_setup(p, l, g, lane, ar, ai, Br, Bi);
  const long tok0 = (long)b * S_ + k * 64;
  c_load_u(p, tok0, g, lane, ub);
  __syncthreads();
  float sr = 0.f, si = 0.f;
#pragma unroll 2
  for (int s = 0; s < 64; s++) c_step(ub, s, Br, Bi, ar, ai, sr, si);
  f32x2 e; e.x = sr; e.y = si;
  *(f32x2*)(p.carry + ((long)((b * 16 + g) * 32 + k) * 64 + lane) * 2) = e;
  __syncthreads();
}
DI void c3_item(const P& p, int l, int idx, char* smem) {
  const int t = tid(), lane = t & 63, w = t >> 6;
  const int b = idx >> 7, g = (idx >> 3) & 15, k = (idx & 7) * 4 + w;
  float* ub = (float*)(smem + w * 12288);
  bf16_t* stb = (bf16_t*)(smem + w * 12288 + 4096);
  const int c = lane & 15, sq = lane >> 4;
  bf16x8 cfr[4];
  {
    const float* cre = p.c_c_re + (long)(l * 16 + g) * 1024 + c * 64; const float* cim = p.c_c_im + (long)(l * 16 + g) * 1024 + c * 64;
#pragma unroll
    for (int ks = 0; ks < 4; ks++) {
      const f32x4 r4 = *(const f32x4*)(cre + ks * 16 + sq * 4), i4 = *(const f32x4*)(cim + ks * 16 + sq * 4);
      u32x4 pk; pk.x = pk2(r4.x, -i4.x); pk.y = pk2(r4.y, -i4.y); pk.z = pk2(r4.z, -i4.z); pk.w = pk2(r4.w, -i4.w);
      cfr[ks] = __builtin_bit_cast(bf16x8, pk);
    }
  }
  float ar, ai, Br[16], Bi[16];
  c_setup(p, l, g, lane, ar, ai, Br, Bi);
  const long tok0 = (long)b * S_ + k * 64;
  c_load_u(p, tok0, g, lane, ub);
  float lr = ar, li = ai;
#pragma unroll
  for (int i = 0; i < 6; i++) { const float nr = lr * lr - li * li, ni = 2.f * lr * li; lr = nr; li = ni; }
  float sr = 0.f, si = 0.f;
  {
    const float* cp = p.carry + ((long)((b * 16 + g) * 32) * 64 + lane) * 2;
    for (int j0 = 0; j0 < k; j0 += 8) {
      f32x2 e[8];
#pragma unroll
      for (int jj = 0; jj < 8; jj++) { e[jj].x = 0.f; e[jj].y = 0.f; if (j0 + jj < k) e[jj] = *(const f32x2*)(cp + (long)(j0 + jj) * 128); }
#pragma unroll
      for (int jj = 0; jj < 8; jj++) if (j0 + jj < k) { const float nr = lr * sr - li * si + e[jj].x, ni = lr * si + li * sr + e[jj].y; sr = nr; si = ni; }
    }
  }
  __syncthreads();
  const float dsk = p.c_d[l * 256 + g * 16 + c];
#pragma unroll 1
  for (int sb = 0; sb < 4; sb++) {
#pragma unroll 2
    for (int s2 = 0; s2 < 16; s2++) {
      c_step(ub, sb * 16 + s2, Br, Bi, ar, ai, sr, si);
      *(unsigned*)(stb + s2 * 136 + 2 * lane) = pk2(sr, si);
    }
    asm volatile("s_waitcnt lgkmcnt(0)" ::: "memory");
    __builtin_amdgcn_wave_barrier();
    f32x4 y; y.x = 0.f; y.y = 0.f; y.z = 0.f; y.w = 0.f;
#pragma unroll
    for (int ks = 0; ks < 4; ks++) {
      const bf16x8 af = *(const bf16x8*)(stb + c * 136 + ks * 32 + sq * 8);
      y = __builtin_amdgcn_mfma_f32_16x16x32_bf16(af, cfr[ks], y, 0, 0, 0);
    }
    const float yy[4] = {y.x, y.y, y.z, y.w};
#pragma unroll
    for (int qq = 0; qq < 4; qq++) {
      const int sa = sb * 16 + sq * 4 + qq;
      const float yv = gelu_t(yy[qq] + dsk * ub[sa * 16 + c]);
      if (!p.dry) p.z1[(tok0 + sa) * Z1W + 1280 + g * 16 + c] = f2bf(yv);
    }
    asm volatile("s_waitcnt lgkmcnt(0)" ::: "memory");
    __builtin_amdgcn_wave_barrier();
  }
  __syncthreads();
}

DI void glu_tile(const P& p, int l, int tm, int tn, char* smem) {
  bf16_t* sm = (bf16_t*)smem; float* ep = (float*)smem;
  const int r0 = tm * 128, c0 = tn * 128;
  f32x16 acc[2][2]; zero_acc(acc);
  gemm_loop_dma(p.z1 + (long)r0 * Z1W + 1280, Z1W, p.WgluT + (long)c0 * 256, 256, 256, acc, smem);
  acc_to_lds(acc, ep);
  __syncthreads();
  const float* bg = p.c_b_glu + l * 256 + c0;
  rowwise2(ep, [&](int row, int c8) {
    LdGlu L;
    const bf16_t* zp = p.z1 + (long)(r0 + row) * Z1W + c0 + c8;
    L.yg = *(const u32x4*)(zp + 1280); L.gt = *(const u32x4*)(zp + 1536);
    return L;
  }, [&](int row, int c8, float (&v)[8], const LdGlu& L) {
    bf16_t* zp = p.z1 + (long)(r0 + row) * Z1W + c0 + c8;
    float yg[8], gt[8];
    unpack8(L.yg, yg); unpack8(L.gt, gt);
#pragma unroll
    for (int j = 0; j < 8; j++) v[j] = yg[j] * sigm(v[j] + bg[c8 + j]) * gt[j];
    if (!p.dry) *(u32x4*)(zp + 1536) = pack8(v);
  });
  __syncthreads();
}

DI void pf_tile(const P& p, int l, int tm, int tn, char* smem) {
  float* ep = (float*)smem; float* rsS = (float*)(smem + SM_RS);
  const int t = tid(), lane = t & 63, w = t >> 6, wm = w >> 1, wn = w & 1, l31 = lane & 31, h = lane >> 5;
  const int r0 = tm * 128, c0 = tn * 128;
  load_rs(p, r0, rsS);
  unsigned mrgp[2][2][8];
#pragma unroll
  for (int a = 0; a < 2; a++)
#pragma unroll
    for (int b = 0; b < 2; b++)
#pragma unroll
      for (int i = 0; i < 8; i++) mrgp[a][b][i] = 0u;
#pragma unroll 1
  for (int pr = 0; pr < 2; pr++) {
    unsigned gp[2][2][2][8];
    {
      f32x16 accP[2][2], accQ[2][2]; zero_acc(accP); zero_acc(accQ);
      const bf16_t* wg = p.WinT + (long)(3456 + (2 * pr) * 1024 + c0) * 1024;
      gemm_loop_dma2(p.xb + (long)r0 * 1024, 1024, wg, wg + (long)1024 * 1024, 1024, 1024, accP, accQ, smem);
      const float* bm = p.b_merge + l * 4096 + (2 * pr) * 1024 + c0;
#pragma unroll
      for (int mb = 0; mb < 2; mb++)
#pragma unroll
        for (int nb = 0; nb < 2; nb++) {
          const float bias0 = bm[wn * 64 + nb * 32 + l31], bias1 = bm[1024 + wn * 64 + nb * 32 + l31];
#pragma unroll
          for (int i = 0; i < 16; i += 2) {
            const float ra = rsS[wm * 64 + mb * 32 + crow(i, h)], rb = rsS[wm * 64 + mb * 32 + crow(i + 1, h)];
            gp[0][mb][nb][i >> 1] = pk2n(sigm(accP[mb][nb][i] * ra + bias0), sigm(accP[mb][nb][i + 1] * rb + bias0));
            gp[1][mb][nb][i >> 1] = pk2n(sigm(accQ[mb][nb][i] * ra + bias1), sigm(accQ[mb][nb][i + 1] * rb + bias1));
          }
        }
    }
#pragma unroll
    for (int j = 0; j < 2; j++) {
      const int br = 2 * pr + j;
      const int yoff = br == 0 ? 0 : (br == 1 ? 768 : (br == 2 ? 1536 : 2048));
      const int Kb = br == 1 ? 512 : 256;
      const long woff = br == 0 ? 0 : (br == 1 ? 1024 * 256 : (br == 2 ? 1024 * 768 : 1024 * 1024));
      f32x16 acc[2][2]; zero_acc(acc);
      gemm_loop_dma(p.z1 + (long)r0 * Z1W + yoff, Z1W, p.WbrT + woff + (long)c0 * Kb, Kb, Kb, acc, smem);
#pragma unroll
      for (int mb = 0; mb < 2; mb++)
#pragma unroll
        for (int nb = 0; nb < 2; nb++)
#pragma unroll
          for (int i = 0; i < 16; i += 2) {
            const unsigned g2 = gp[j][mb][nb][i >> 1], m2 = mrgp[mb][nb][i >> 1];
            const float m0 = __uint_as_float(m2 << 16) + __uint_as_float(g2 << 16) * acc[mb][nb][i];
            const float m1 = __uint_as_float(m2 & 0xffff0000u) + __uint_as_float(g2 & 0xffff0000u) * acc[mb][nb][i + 1];
            mrgp[mb][nb][i >> 1] = pk2(m0, m1);
          }
    }
  }
  {
    f32x16 mrg[2][2];
#pragma unroll
    for (int a = 0; a < 2; a++)
#pragma unroll
      for (int b = 0; b < 2; b++)
#pragma unroll
        for (int i = 0; i < 16; i += 2) { const unsigned m2 = mrgp[a][b][i >> 1]; mrg[a][b][i] = __uint_as_float(m2 << 16); mrg[a][b][i + 1] = __uint_as_float(m2 & 0xffff0000u); }
    acc_to_lds(mrg, ep);
  }
  __syncthreads();
  rowwise(ep, [&](int row, int c8, float (&v)[8]) { *(u32x4*)(p.mg + (long)(r0 + row) * 1024 + c0 + c8) = pack8(v); });
  __syncthreads();
}

DI void out_tile(const P& p, int l, int tm, int tn, char* smem) {
  bf16_t* sm = (bf16_t*)smem; float* ep = (float*)smem;
  const int r0 = tm * 128, c0 = tn * 128;
  f32x16 acc[2][2]; zero_acc(acc);
  gemm_loop_dma(p.mg + (long)r0 * 1024, 1024, p.WoutT + (long)l * 1024 * 1024 + (long)c0 * 1024, 1024, 1024, acc, smem);
  acc_to_lds(acc, ep);
  __syncthreads();
  const float* xin = (l == 0) ? p.x : p.out;
  rowwise2(ep, [&](int row, int c8) {
    LdX L;
    const long off = (long)(r0 + row) * 1024 + c0 + c8;
    L.a = *(const f32x4*)(xin + off); L.b = *(const f32x4*)(xin + off + 4);
    return L;
  }, [&](int row, int c8, float (&v)[8], const LdX& L) {
    const long off = (long)(r0 + row) * 1024 + c0 + c8;
    const f32x4 a = L.a, b = L.b;
    v[0] += a.x; v[1] += a.y; v[2] += a.z; v[3] += a.w; v[4] += b.x; v[5] += b.y; v[6] += b.z; v[7] += b.w;
    f32x4 oa, ob; oa.x = v[0]; oa.y = v[1]; oa.z = v[2]; oa.w = v[3]; ob.x = v[4]; ob.y = v[5]; ob.z = v[6]; ob.w = v[7];
    if (!p.dry) {
      if (l == 1) { __builtin_nontemporal_store(oa, (f32x4*)(p.out + off)); __builtin_nontemporal_store(ob, (f32x4*)(p.out + off + 4)); }
      else { *(f32x4*)(p.out + off) = oa; *(f32x4*)(p.out + off + 4) = ob; }
    }
    if (l == 0) {
      *(u32x4*)(p.xb + off) = pack8(v);
      float ss = 0.f;
#pragma unroll
      for (int j = 0; j < 8; j++) ss += v[j] * v[j];
      ss = sum16(ss);
      if ((c8 >> 3) == 0) p.ssp[(long)tn * T_ + r0 + row] = ss;
    }
  });
  __syncthreads();
}

DI void run_phase(const P& p, int ph, char* smem, int vb) {
  const int G = gridDim.x, bid = blockIdx.x;
  int* slot = (int*)(smem + SM_MISC);
  if (ph == 0) {
    conv_all(p, 0, smem);
    for (int it = NCONV + bid; it < NAUX; it += G) aux_item(p, 0, it, smem);
    for (int it = bid; it < 2048; it += G) p0_xrow_item(p, it);
    for (int it = bid; it < 1024; it += G) p0_rope_item(p, it);
    return;
  }
  const int l = (ph - 1) / 6, s = (ph - 1) % 6;
  if (s == 0) {
    const int total = 3456 + 64, nr = (total + G - 1) / G;
    for (int r = 0; r < nr; r++) {
      const int L = static_L(r, vb);
      if (L >= total) continue;
      int tm, tn;
      if (L < 3456) { tile_from_linear(L, 27, tm, tn); g1_tile(p, l, tm, tn, smem); }
      else { tile_from_linear(L - 3456, 4, tm, tn); g1m_tile(p, l, tm, tn, smem); }
    }
  } else if (s == 1) {
    const long dm = p.dry;
    {
      const int total = 1024, nr = (total + G - 1) / G;
      if (!dm || (dm & 2)) for (int r = 0; r < nr; r++) { const int L = static_L(r, vb); if (L >= total) continue; int tm, tn; tile_from_linear(L, 8, tm, tn); g2q_tile(p, l, tm, tn, smem); }
      if (!dm || (dm & 8)) for (int r = 0; r < nr; r++) { const int L = static_L(r, vb); if (L >= total) continue; int tm, tn; tile_from_linear(L, 8, tm, tn); g2kv_tile(p, l, tm, tn, smem); }
    }
    if (!dm || (dm & 4)) for (int it = vb; it < 512; it += G) mattn_item(p, it, smem);
    {
      const bool split = (G >= 256);
      if (!dm || (dm & 16)) { const int a1 = split ? 128 : 128; for (int it = vb; it < a1; it += G) a_item(p, l, it, smem); }
      const int cstep = split ? (vb < 128 ? 1024 : G - 128) : G;
      if (!dm || (dm & 32)) {
#pragma unroll 1
        for (int it = vb; it < 1024; it += cstep) c1_item(p, l, it, smem);
      }
    }
  } else if (s == 2) {
    const long dm = p.dry;
    if (G == 512) {
#pragma unroll 1
      for (int j = 0; j < 4; j++) {
        if (j < 2) { if (dm && !(dm & 2)) continue; battn_item(p, j ? 1023 - vb : vb, smem); }
        else { if (dm && !(dm & 4)) continue; c3_item(p, l, vb + (j - 2) * 512, smem); }
      }
    } else {
#pragma unroll 1
      for (int it = vb; it < 2048; it += G) {
        if (it < 1024) { if (dm && !(dm & 2)) continue; battn_item(p, it, smem); } else { if (dm && !(dm & 4)) continue; c3_item(p, l, it - 1024, smem); }
      }
    }
  } else if (s == 3) {
    for (int it = bid; it < 256; it += G) glu_tile(p, l, it >> 1, it & 1, smem);
  } else if (s == 4) {
    const int total = 1024, nr = (total + G - 1) / G;
    for (int r = 0; r < nr; r++) { const int L = static_L(r, vb); if (L >= total) continue; int tm, tn; tile_from_linear(L, 8, tm, tn); pf_tile(p, l, tm, tn, smem); }
  } else {
    const int total = 1024, nr = (total + G - 1) / G;
    for (int r = 0; r < nr; r++) { const int L = static_L(r, vb); if (L >= total) continue; int tm, tn; tile_from_linear(L, 8, tm, tn); out_tile(p, l, tm, tn, smem); }
    if (l == 0) { conv_all(p, 1, smem); for (int it = NCONV + bid; it < NAUX; it += G) aux_item(p, 1, it, smem); }
  }
}

DI unsigned xb_ld(unsigned* q) { return __hip_atomic_load(q, __ATOMIC_RELAXED, __HIP_MEMORY_SCOPE_AGENT); }
DI unsigned xb_add(unsigned* q, unsigned v) { return __hip_atomic_fetch_add(q, v, __ATOMIC_RELAXED, __HIP_MEMORY_SCOPE_AGENT); }
DI void gbar(unsigned* bar, const int* st) {
  asm volatile("s_waitcnt vmcnt(0)" ::: "memory");
  __syncthreads();
  if (threadIdx.x == 0) {
    __builtin_amdgcn_s_waitcnt(0);
    const unsigned x = (unsigned)st[0], nloc = (unsigned)st[1], nx = (unsigned)st[2];
    const unsigned old = xb_add(&bar[1024 + 64 * x], 1u);
    const unsigned gen = old / nloc;
    if (old + 1u == (gen + 1u) * nloc) {
      __builtin_amdgcn_fence(__ATOMIC_RELEASE, "agent");
      asm volatile("s_waitcnt vmcnt(0)" ::: "memory");
      const unsigned og = xb_add(&bar[3072], 1u);
      const unsigned tg = og / nx;
      if (og + 1u == (tg + 1u) * nx) xb_add(&bar[3136], 1u);
      else while (xb_ld(&bar[3136]) == tg) __builtin_amdgcn_s_sleep(1);
      __builtin_amdgcn_fence(__ATOMIC_ACQUIRE, "agent");
      xb_add(&bar[2048 + 64 * x], 1u);
      asm volatile("s_waitcnt vmcnt(0)" ::: "memory");
    } else {
      while (xb_ld(&bar[2048 + 64 * x]) == gen) __builtin_amdgcn_s_sleep(1);
      __builtin_amdgcn_fence(__ATOMIC_ACQUIRE, "agent");
      asm volatile("s_waitcnt vmcnt(0)" ::: "memory");
    }
  }
  __syncthreads();
}

#if MK_MULTI
__global__ void __launch_bounds__(256, 2) hyb_phase(P p, int ph) {
  __shared__ __attribute__((aligned(16))) char smem[SM_TOTAL];
  run_phase(p, ph, smem, blockIdx.x);
}
#else
__global__ void __launch_bounds__(256, 2) hyb_mega(P p) {
  __shared__ __attribute__((aligned(16))) char smem[SM_TOTAL];
  cg::grid_group grid = cg::this_grid();
  if (p.dry == 0x7fffffff) grid.sync();
  int vb;
  {
    int* sl = (int*)(smem + SM_MISC) + 2;
    if (threadIdx.x == 0) {
      const unsigned xcc = (unsigned)__builtin_amdgcn_s_getreg((3 << 11) | 20) & 7u;
      const unsigned loc = xb_add(p.ctr + 40 + xcc, 1u);
      const unsigned Gx = gridDim.x >> 3;
      *sl = (loc < Gx) ? (int)(loc * 8 + xcc) : -1;
      unsigned sum, cnt, mine;
      for (;;) {
        sum = 0u; cnt = 0u; mine = 0u;
        for (unsigned j = 0; j < 8; ++j) { const unsigned c = xb_ld(p.ctr + 40 + j); sum += c; cnt += (c > 0u) ? 1u : 0u; mine = (j == xcc) ? c : mine; }
        if (sum == gridDim.x) break;
        __builtin_amdgcn_s_sleep(1);
      }
      sl[2] = (int)xcc; sl[3] = (int)mine; sl[4] = (int)cnt;
    }
    __syncthreads();
    vb = blockIdx.x;
  }
  const int* bst = (const int*)(smem + SM_MISC) + 4;
#ifdef DRY_PH
  P pd = p; { int one = DRY_MASK; asm volatile("" : "+s"(one)); pd.dry = one; }
#endif
#pragma unroll 1
  for (int ph = 0; ph < 13; ph++) {
#ifdef DRY_PH
    if (ph == DRY_PH) { run_phase(pd, ph, smem, vb); gbar(p.bar, bst); }
#endif
    run_phase(p, ph, smem, vb);
    if (ph < 12) gbar(p.bar, bst);
  }
}
#endif

extern "C" void kernel_launch(void* const* d_in, const int* in_sizes, int n_in, void* d_out, int out_size, void* d_ws, size_t ws_size, hipStream_t stream) {
  P p{};
  p.x = (const float*)d_in[0]; p.mem = (const float*)d_in[1]; p.pos = (const int*)d_in[2];
  p.norm_g = (const float*)d_in[3]; p.w_in = (const float*)d_in[4]; p.b_merge = (const float*)d_in[5];
  p.a_norm_g = (const float*)d_in[6]; p.a_w_s = (const float*)d_in[7]; p.a_b_s = (const float*)d_in[8];
  p.b_q_norm_g = (const float*)d_in[9]; p.b_kv_norm_g = (const float*)d_in[10]; p.b_w_uq = (const float*)d_in[11]; p.b_w_ukv = (const float*)d_in[12];
  p.b_qk_g_q = (const float*)d_in[13]; p.b_qk_g_k = (const float*)d_in[14];
  p.c_a_re = (const float*)d_in[15]; p.c_a_im = (const float*)d_in[16]; p.c_log_dt = (const float*)d_in[17];
  p.c_b_re = (const float*)d_in[18]; p.c_b_im = (const float*)d_in[19]; p.c_c_re = (const float*)d_in[20]; p.c_c_im = (const float*)d_in[21];
  p.c_d = (const float*)d_in[22]; p.c_w_glu = (const float*)d_in[23]; p.c_b_glu = (const float*)d_in[24];
  p.m_norm_g = (const float*)d_in[25]; p.m_w_kv = (const float*)d_in[26]; p.m_qk_g_q = (const float*)d_in[27]; p.m_qk_g_k = (const float*)d_in[28];
  p.w_br_a = (const float*)d_in[29]; p.w_br_b = (const float*)d_in[30]; p.w_br_c = (const float*)d_in[31]; p.w_br_m = (const float*)d_in[32];
  p.w_out = (const float*)d_in[33];
  p.out = (float*)d_out;
  char* ws = (char*)d_ws; size_t off = 0;
  auto take = [&](size_t bytes) { char* r = ws + off; off += (bytes + 255) & ~(size_t)255; return r; };
  p.z1 = (bf16_t*)take((size_t)T_ * Z1W * 2);
  p.z2 = (bf16_t*)take((size_t)T_ * Z2W * 2);
  p.xb = (bf16_t*)take((size_t)T_ * 1024 * 2);
  p.qf = (bf16_t*)take((size_t)T_ * 768 * 2);
  p.kf = (bf16_t*)take((size_t)T_ * 768 * 2);
  p.mg = p.qf;
  p.vt = (bf16_t*)take((size_t)8 * 8 * 64 * S_ * 2);
  p.hm = (bf16_t*)take((size_t)2048 * 1024 * 2);
  p.memk = (bf16_t*)take((size_t)2048 * 256 * 2);
  p.memvt = (bf16_t*)take((size_t)2048 * 256 * 2);
  p.WinT = (bf16_t*)take((size_t)NWIN * 1024 * 2);
  p.WuqT = (bf16_t*)take((size_t)1024 * 768 * 2);
  p.WukvT = (bf16_t*)take((size_t)1024 * 256 * 2);
  p.WgluT = (bf16_t*)take((size_t)256 * 256 * 2);
  p.WbrT = (bf16_t*)take((size_t)1024 * 1280 * 2);
  p.WoutT = (bf16_t*)take((size_t)2 * 1024 * 1024 * 2);
  p.WmkvT = (bf16_t*)take((size_t)512 * 1024 * 2);
  p.ssp = (float*)take((size_t)8 * T_ * 4);
  p.ssq = (float*)take((size_t)9 * T_ * 4);
  p.rope = (float*)take((size_t)T_ * 32 * 4);
  p.carry = (float*)take((size_t)8 * 16 * 32 * 64 * 2 * 4);
  p.ctr = (unsigned*)take(256);
  p.bar = (unsigned*)take(16384);
  if (off > ws_size) { fprintf(stderr, "workspace too small: need %zu have %zu\n", off, ws_size); return; }

  static int grid_blocks = 0;
  if (!grid_blocks) {
    int dev = 0, cus = 0, per_cu = 0;
    hipGetDevice(&dev);
    hipDeviceGetAttribute(&cus, hipDeviceAttributeMultiprocessorCount, dev);
#if MK_MULTI
    hipOccupancyMaxActiveBlocksPerMultiprocessor(&per_cu, hyb_phase, 256, 0);
#else
    hipOccupancyMaxActiveBlocksPerMultiprocessor(&per_cu, hyb_mega, 256, 0);
#endif
    if (per_cu > 2) per_cu = 2;
    if (per_cu < 1) per_cu = 1;
    grid_blocks = cus * per_cu;
    grid_blocks &= ~7;
  }
#if MK_MULTI
  for (int ph = 0; ph < 13; ph++) hipLaunchKernelGGL(hyb_phase, dim3(grid_blocks), dim3(256), 0, stream, p, ph);
#else
  hipMemsetAsync(p.ctr, 0, 256 + 16384, stream);
  void* args[] = {&p};
  hipError_t e = hipLaunchCooperativeKernel((void*)hyb_mega, dim3(grid_blocks), dim3(256), args, 0, stream);
  if (e != hipSuccess) fprintf(stderr, "cooperative launch failed: %s (grid %d)\n", hipGetErrorString(e), grid_blocks);
#endif
}
```

```cpp
#include <hip/hip_runtime.h>
#include <hip/hip_cooperative_groups.h>
#include <stdint.h>
#include <stdio.h>
#include <type_traits>
namespace cg = cooperative_groups;

#ifndef MK_MULTI
#define MK_MULTI 0
#endif

typedef unsigned short bf16_t;
typedef short bf16x8 __attribute__((ext_vector_type(8)));
typedef short s16x4 __attribute__((ext_vector_type(4)));
typedef float f32x16 __attribute__((ext_vector_type(16)));
typedef float f32x4 __attribute__((ext_vector_type(4)));
typedef float f32x2 __attribute__((ext_vector_type(2)));
typedef unsigned u32x4 __attribute__((ext_vector_type(4)));
typedef unsigned u32x2 __attribute__((ext_vector_type(2)));
#define DI __device__ __forceinline__
#define MFMA(a, b, c) __builtin_amdgcn_mfma_f32_32x32x16_bf16((a), (b), (c), 0, 0, 0)

constexpr int T_ = 16384, S_ = 2048;
constexpr int INW = 7456;
constexpr int Z1W = 2304, Z2W = 1152;
constexpr int NWIN = 7552;
constexpr float EPS = 1e-6f;
constexpr float LOG2E = 1.4426950408889634f;
constexpr int LDT = 72;
constexpr int EPW = 132;
constexpr int SM_MAIN = 4 * 128 * LDT * 2;
constexpr int SM_RS = SM_MAIN;
constexpr int SM_SS = SM_MAIN + 512;
constexpr int SM_MISC = SM_MAIN + 1024;
constexpr int SM_TOTAL = SM_MAIN + 1024 + 64;

struct P {
  const float* x; const float* mem; const int* pos;
  const float* norm_g; const float* w_in; const float* b_merge; const float* a_norm_g; const float* a_w_s; const float* a_b_s;
  const float* b_q_norm_g; const float* b_kv_norm_g; const float* b_w_uq; const float* b_w_ukv; const float* b_qk_g_q; const float* b_qk_g_k;
  const float* c_a_re; const float* c_a_im; const float* c_log_dt; const float* c_b_re; const float* c_b_im; const float* c_c_re; const float* c_c_im;
  const float* c_d; const float* c_w_glu; const float* c_b_glu;
  const float* m_norm_g; const float* m_w_kv; const float* m_qk_g_q; const float* m_qk_g_k;
  const float* w_br_a; const float* w_br_b; const float* w_br_c; const float* w_br_m; const float* w_out;
  float* out;
  bf16_t* z1; bf16_t* z2; bf16_t* xb; bf16_t* qf; bf16_t* kf; bf16_t* mg; bf16_t* vt; bf16_t* hm; bf16_t* memk; bf16_t* memvt;
  bf16_t* WinT; bf16_t* WuqT; bf16_t* WukvT; bf16_t* WgluT; bf16_t* WbrT; bf16_t* WoutT; bf16_t* WmkvT;
  float* ssp; float* ssq; float* rope; float* carry; unsigned* ctr; unsigned* bar;
  long dry;
};

DI int tid() { int t = threadIdx.x; asm volatile("" : "+v"(t)); return t; }
DI float bf2f(bf16_t b) { return __uint_as_float(((unsigned)b) << 16); }
DI unsigned pk2(float lo, float hi) { unsigned r; asm("v_cvt_pk_bf16_f32 %0, %1, %2" : "=v"(r) : "v"(lo), "v"(hi)); return r; }
DI unsigned pk2n(float lo, float hi) { unsigned r; asm("s_nop 1\n\tv_cvt_pk_bf16_f32 %0, %1, %2" : "=v"(r) : "v"(lo), "v"(hi)); return r; }
DI bf16_t f2bf(float x) { return (bf16_t)(pk2(x, 0.f) & 0xffffu); }
DI void unpack8(u32x4 v, float (&f)[8]) {
  f[0] = __uint_as_float(v.x << 16); f[1] = __uint_as_float(v.x & 0xffff0000u);
  f[2] = __uint_as_float(v.y << 16); f[3] = __uint_as_float(v.y & 0xffff0000u);
  f[4] = __uint_as_float(v.z << 16); f[5] = __uint_as_float(v.z & 0xffff0000u);
  f[6] = __uint_as_float(v.w << 16); f[7] = __uint_as_float(v.w & 0xffff0000u);
}
DI void unpack4(u32x2 v, float (&f)[4]) {
  f[0] = __uint_as_float(v.x << 16); f[1] = __uint_as_float(v.x & 0xffff0000u);
  f[2] = __uint_as_float(v.y << 16); f[3] = __uint_as_float(v.y & 0xffff0000u);
}
DI u32x4 pack8(const float (&f)[8]) { u32x4 r; r.x = pk2(f[0], f[1]); r.y = pk2(f[2], f[3]); r.z = pk2(f[4], f[5]); r.w = pk2(f[6], f[7]); return r; }
DI float sigm(float x) { return __builtin_amdgcn_rcpf(1.f + __expf(-x)); }
DI float silu(float x) { return x * sigm(x); }
DI float gelu_t(float x) { return x * sigm(1.5957691216057308f * (x + 0.044715f * x * x * x)); }
DI float sum16(float v) { v += __shfl_xor(v, 1); v += __shfl_xor(v, 2); v += __shfl_xor(v, 4); v += __shfl_xor(v, 8); return v; }
DI float sum8(float v) { v += __shfl_xor(v, 1); v += __shfl_xor(v, 2); v += __shfl_xor(v, 4); return v; }
DI float sum64(float v) { v = sum16(v); v += __shfl_xor(v, 16); v += __shfl_xor(v, 32); return v; }
DI int crow(int i, int h) { return (i & 3) + 8 * (i >> 2) + 4 * h; }
#define MFMA16(a, b, c) __builtin_amdgcn_mfma_f32_16x16x32_bf16((a), (b), (c), 0, 0, 0)
template <int NB>
DI void zero_acc4(f32x4 (&acc)[4][NB]) {
#pragma unroll
  for (int a = 0; a < 4; a++)
#pragma unroll
    for (int b = 0; b < NB; b++) { acc[a][b].x = 0.f; acc[a][b].y = 0.f; acc[a][b].z = 0.f; acc[a][b].w = 0.f; }
}
DI void zero_acc(f32x16 (&acc)[2][2]) {
#pragma unroll
  for (int a = 0; a < 2; a++)
#pragma unroll
    for (int b = 0; b < 2; b++)
#pragma unroll
      for (int i = 0; i < 16; i++) acc[a][b][i] = 0.f;
}

template <bool SS>
DI void gemm_loop(const bf16_t* __restrict__ A, long lda, const bf16_t* __restrict__ B, long ldb, int K,
                  f32x16 (&acc)[2][2], bf16_t* sm, float* ssS) {
  const int t = tid(), lane = t & 63, w = t >> 6, wm = w >> 1, wn = w & 1, l31 = lane & 31, h = lane >> 5;
  const int lr = t >> 3, lc = (t & 7) * 8;
  const bf16_t* ap = A + (long)lr * lda + lc;
  const bf16_t* bp = B + (long)lr * ldb + lc;
  bf16_t* wp = sm + lr * LDT + lc;
  const bf16_t* rA = sm + (wm * 64 + l31) * LDT + h * 8;
  const bf16_t* rB = sm + 2 * 128 * LDT + (wn * 64 + l31) * LDT + h * 8;
  u32x4 ra[4], rb[4];
  float ss[4] = {0.f, 0.f, 0.f, 0.f};
  const int nk = K >> 6;
  auto gl = [&](int ko) {
#pragma unroll
    for (int i = 0; i < 4; i++) { ra[i] = *(const u32x4*)(ap + (long)(32 * i) * lda + ko); rb[i] = *(const u32x4*)(bp + (long)(32 * i) * ldb + ko); }
  };
  auto st = [&](auto BUF) {
    constexpr int buf = decltype(BUF)::value;
#pragma unroll
    for (int i = 0; i < 4; i++) {
      *(u32x4*)(wp + buf * 128 * LDT + 32 * i * LDT) = ra[i];
      *(u32x4*)(wp + 2 * 128 * LDT + buf * 128 * LDT + 32 * i * LDT) = rb[i];
      if (SS) { float f[8]; unpack8(ra[i], f);
#pragma unroll
        for (int j = 0; j < 8; j++) ss[i] += f[j] * f[j]; }
    }
  };
  auto comp = [&](auto BUF) {
    constexpr int buf = decltype(BUF)::value;
#pragma unroll
    for (int kk = 0; kk < 4; kk++) {
      bf16x8 af[2], bfr[2];
#pragma unroll
      for (int mb = 0; mb < 2; mb++) af[mb] = *(const bf16x8*)(rA + buf * 128 * LDT + mb * 32 * LDT + kk * 16);
#pragma unroll
      for (int nb = 0; nb < 2; nb++) bfr[nb] = *(const bf16x8*)(rB + buf * 128 * LDT + nb * 32 * LDT + kk * 16);
#pragma unroll
      for (int mb = 0; mb < 2; mb++)
#pragma unroll
        for (int nb = 0; nb < 2; nb++) acc[mb][nb] = MFMA(af[mb], bfr[nb], acc[mb][nb]);
    }
  };
  using B0 = std::integral_constant<int, 0>; using B1 = std::integral_constant<int, 1>;
  gl(0);
  st(B0{});
  gl(64);
  __syncthreads();
  for (int ks = 0; ks < nk; ks += 2) {
    st(B1{});
    __builtin_amdgcn_sched_barrier(0);
    if (ks + 2 < nk) gl((ks + 2) * 64);
    __builtin_amdgcn_sched_barrier(0);
    comp(B0{});
    __syncthreads();
    if (ks + 2 < nk) st(B0{});
    __builtin_amdgcn_sched_barrier(0);
    if (ks + 3 < nk) gl((ks + 3) * 64);
    __builtin_amdgcn_sched_barrier(0);
    comp(B1{});
    __syncthreads();
  }
  if (SS) {
    const float inv = 1.0f / (float)K;
#pragma unroll
    for (int i = 0; i < 4; i++) { float s = sum8(ss[i]); if ((t & 7) == 0) ssS[lr + 32 * i] = rsqrtf(s * inv + EPS); }
  }
}

#define LAS3 __attribute__((address_space(3)))
struct GDesc { const bf16_t* A; long lda; const bf16_t* B; long ldb; };
DI void gemm_dma_stage0(const GDesc& d, char* smc) {
  const int t = tid(), lane = t & 63, w = t >> 6;
  const unsigned wdst = (unsigned)(uintptr_t)smc + (unsigned)w * 4096u;
#pragma unroll
  for (int i = 0; i < 4; i++) {
    const int row = 32 * w + 8 * i + (lane >> 3), c = (lane & 7) ^ ((row >> 1) & 7);
    __builtin_amdgcn_global_load_lds((const unsigned*)(d.A + row * d.lda + c * 8), (LAS3 unsigned*)(uintptr_t)(wdst + i * 1024), 16, 0, 0);
    __builtin_amdgcn_global_load_lds((const unsigned*)(d.B + row * d.ldb + c * 8), (LAS3 unsigned*)(uintptr_t)(wdst + 16384 + i * 1024), 16, 0, 0);
  }
}
DI void gemm_loop_dma(const bf16_t* __restrict__ A, long lda, const bf16_t* __restrict__ B, long ldb, int K, f32x16 (&acc)[2][2], char* smc,
                      bool started = false, bool has_next = false, GDesc next = GDesc{nullptr, 0, nullptr, 0}) {
  const int t = tid(), lane = t & 63, w = t >> 6, wm = w >> 1, wn = w & 1, l31 = lane & 31, h = lane >> 5;
  unsigned aoff[4], boff[4];
#pragma unroll
  for (int i = 0; i < 4; i++) {
    const int row = 32 * w + 8 * i + (lane >> 3), c = (lane & 7) ^ ((row >> 1) & 7);
    aoff[i] = (unsigned)((row * lda + c * 8) * 2); boff[i] = (unsigned)((row * ldb + c * 8) * 2);
  }
  const char* Ab = (const char*)A; const char* Bb = (const char*)B;
  const unsigned lbase = (unsigned)(uintptr_t)smc;
  const unsigned wdst = lbase + (unsigned)w * 4096u;
  const int swz = (l31 >> 1) & 7;
  unsigned fo[4];
#pragma unroll
  for (int kk = 0; kk < 4; kk++) fo[kk] = (unsigned)(((2 * kk + h) ^ swz) * 16);
  const char* rA = smc + (wm * 64 + l31) * 128;
  const char* rB = smc + 16384 + (wn * 64 + l31) * 128;
  const int nk = K >> 6;
  auto issue = [&](auto BUF, int ko) {
    constexpr int buf = decltype(BUF)::value;
#pragma unroll
    for (int i = 0; i < 4; i++) {
      __builtin_amdgcn_global_load_lds((const unsigned*)(Ab + (size_t)ko * 2 + aoff[i]), (LAS3 unsigned*)(uintptr_t)(wdst + buf * 32768 + i * 1024), 16, 0, 0);
      __builtin_amdgcn_global_load_lds((const unsigned*)(Bb + (size_t)ko * 2 + boff[i]), (LAS3 unsigned*)(uintptr_t)(wdst + buf * 32768 + 16384 + i * 1024), 16, 0, 0);
    }
  };
  auto comp = [&](auto BUF) {
    constexpr int buf = decltype(BUF)::value;
#pragma unroll
    for (int kk = 0; kk < 4; kk++) {
      bf16x8 af[2], bfr[2];
#pragma unroll
      for (int mb = 0; mb < 2; mb++) af[mb] = *(const bf16x8*)(rA + buf * 32768 + mb * 32 * 128 + fo[kk]);
#pragma unroll
      for (int nb = 0; nb < 2; nb++) bfr[nb] = *(const bf16x8*)(rB + buf * 32768 + nb * 32 * 128 + fo[kk]);
#pragma unroll
      for (int mb = 0; mb < 2; mb++)
#pragma unroll
        for (int nb = 0; nb < 2; nb++) acc[mb][nb] = MFMA(af[mb], bfr[nb], acc[mb][nb]);
    }
  };
  using B0 = std::integral_constant<int, 0>; using B1 = std::integral_constant<int, 1>;
  if (!started) issue(B0{}, 0);
  __syncthreads();
  for (int ks = 0; ks < nk; ks += 2) {
    issue(B1{}, (ks + 1) * 64);
    __builtin_amdgcn_sched_barrier(0);
    comp(B0{});
    __syncthreads();
    if (ks + 2 < nk) issue(B0{}, (ks + 2) * 64);
    else if (has_next) gemm_dma_stage0(next, smc);
    __builtin_amdgcn_sched_barrier(0);
    comp(B1{});
    __syncthreads();
  }
}

template <int NB>
DI void gemm_loop_dma16(const bf16_t* __restrict__ A, long lda, const bf16_t* __restrict__ B, long ldb, int K, f32x4 (&acc)[4][NB], char* smc,
                      bool started = false, bool has_next = false, GDesc next = GDesc{nullptr, 0, nullptr, 0}) {
  const int t = tid(), lane = t & 63, w = t >> 6, wm = w >> 1, wn = w & 1, r16 = lane & 15, q = lane >> 4;
  unsigned aoff[4], boff[NB];
#pragma unroll
  for (int i = 0; i < 4; i++) {
    const int row = 32 * w + 8 * i + (lane >> 3), c = (lane & 7) ^ ((row >> 1) & 7);
    aoff[i] = (unsigned)((row * lda + c * 8) * 2);
  }
#pragma unroll
  for (int i = 0; i < NB; i++) {
    const int row = 8 * (NB * w + i) + (lane >> 3), c = (lane & 7) ^ ((row >> 1) & 7);
    boff[i] = (unsigned)((row * ldb + c * 8) * 2);
  }
  const char* Ab = (const char*)A; const char* Bb = (const char*)B;
  const unsigned lbase = (unsigned)(uintptr_t)smc;
  const unsigned wdst = lbase + (unsigned)w * 4096u;
  const int swz = (r16 >> 1) & 7;
  unsigned fo[2];
#pragma unroll
  for (int k32 = 0; k32 < 2; k32++) fo[k32] = (unsigned)(((4 * k32 + q) ^ swz) * 16);
  const char* rA = smc + (wm * 64 + r16) * 128;
  const char* rB = smc + 16384 + (wn * 16 * NB + r16) * 128;
  const int nk = K >> 6;
  auto issue = [&](auto BUF, int ko) {
    constexpr int buf = decltype(BUF)::value;
#pragma unroll
    for (int i = 0; i < 4; i++)
      __builtin_amdgcn_global_load_lds((const unsigned*)(Ab + (size_t)ko * 2 + aoff[i]), (LAS3 unsigned*)(uintptr_t)(wdst + buf * 32768 + i * 1024), 16, 0, 0);
#pragma unroll
    for (int i = 0; i < NB; i++)
      __builtin_amdgcn_global_load_lds((const unsigned*)(Bb + (size_t)ko * 2 + boff[i]), (LAS3 unsigned*)(uintptr_t)(lbase + buf * 32768 + 16384 + (NB * w + i) * 1024), 16, 0, 0);
  };
  auto comp = [&](auto BUF) {
    constexpr int buf = decltype(BUF)::value;
#pragma unroll
    for (int k32 = 0; k32 < 2; k32++) {
      bf16x8 af[4], bq[NB];
#pragma unroll
      for (int mb = 0; mb < 4; mb++) af[mb] = *(const bf16x8*)(rA + buf * 32768 + mb * 16 * 128 + fo[k32]);
#pragma unroll
      for (int nb = 0; nb < NB; nb++) bq[nb] = *(const bf16x8*)(rB + buf * 32768 + nb * 16 * 128 + fo[k32]);
#pragma unroll
      for (int mb = 0; mb < 4; mb++)
#pragma unroll
        for (int nb = 0; nb < NB; nb++) acc[mb][nb] = MFMA16(af[mb], bq[nb], acc[mb][nb]);
    }
  };
  using B0 = std::integral_constant<int, 0>; using B1 = std::integral_constant<int, 1>;
  if (!started) issue(B0{}, 0);
  __syncthreads();
  for (int ks = 0; ks < nk; ks += 2) {
    issue(B1{}, (ks + 1) * 64); __builtin_amdgcn_sched_barrier(0);
    comp(B0{});
    __syncthreads();
    if (ks + 2 < nk) issue(B0{}, (ks + 2) * 64);
    else if (has_next) gemm_dma_stage0(next, smc);
    __builtin_amdgcn_sched_barrier(0);
    comp(B1{});
    __syncthreads();
  }
}

DI void gemm_loop_dma2(const bf16_t* __restrict__ A, long lda, const bf16_t* __restrict__ B0, const bf16_t* __restrict__ B1, long ldb, int K,
                       f32x16 (&accP)[2][2], f32x16 (&accQ)[2][2], char* smc) {
  const int t = tid(), lane = t & 63, w = t >> 6, wm = w >> 1, wn = w & 1, l31 = lane & 31, h = lane >> 5;
  unsigned aoff[2], boff[2];
#pragma unroll
  for (int i = 0; i < 2; i++) {
    const int row = 16 * (2 * w + i) + (lane >> 2), c = (lane & 3) ^ ((row >> 2) & 3);
    aoff[i] = (unsigned)((row * lda + c * 8) * 2); boff[i] = (unsigned)((row * ldb + c * 8) * 2);
  }
  const char* Ab = (const char*)A; const char* B0b = (const char*)B0; const char* B1b = (const char*)B1;
  const unsigned wdst = (unsigned)(uintptr_t)smc + (unsigned)w * 2048u;
  const int swz = (l31 >> 2) & 3;
  unsigned fo[2];
#pragma unroll
  for (int kk = 0; kk < 2; kk++) fo[kk] = (unsigned)(((2 * kk + h) ^ swz) * 16);
  const char* rA = smc + (wm * 64 + l31) * 64;
  const char* rB0 = smc + 8192 + (wn * 64 + l31) * 64;
  const char* rB1 = smc + 16384 + (wn * 64 + l31) * 64;
  const int nk = K >> 5;
  auto issue = [&](auto BUF, int ko) {
    constexpr int buf = decltype(BUF)::value;
#pragma unroll
    for (int i = 0; i < 2; i++) {
      __builtin_amdgcn_global_load_lds((const unsigned*)(Ab + (size_t)ko * 2 + aoff[i]), (LAS3 unsigned*)(uintptr_t)(wdst + buf * 24576 + i * 1024), 16, 0, 0);
      __builtin_amdgcn_global_load_lds((const unsigned*)(B0b + (size_t)ko * 2 + boff[i]), (LAS3 unsigned*)(uintptr_t)(wdst + buf * 24576 + 8192 + i * 1024), 16, 0, 0);
      __builtin_amdgcn_global_load_lds((const unsigned*)(B1b + (size_t)ko * 2 + boff[i]), (LAS3 unsigned*)(uintptr_t)(wdst + buf * 24576 + 16384 + i * 1024), 16, 0, 0);
    }
  };
  auto comp = [&](auto BUF) {
    constexpr int buf = decltype(BUF)::value;
#pragma unroll
    for (int kk = 0; kk < 2; kk++) {
      bf16x8 af[2], b0[2], b1[2];
#pragma unroll
      for (int mb = 0; mb < 2; mb++) af[mb] = *(const bf16x8*)(rA + buf * 24576 + mb * 32 * 64 + fo[kk]);
#pragma unroll
      for (int nb = 0; nb < 2; nb++) { b0[nb] = *(const bf16x8*)(rB0 + buf * 24576 + nb * 32 * 64 + fo[kk]); b1[nb] = *(const bf16x8*)(rB1 + buf * 24576 + nb * 32 * 64 + fo[kk]); }
#pragma unroll
      for (int mb = 0; mb < 2; mb++)
#pragma unroll
        for (int nb = 0; nb < 2; nb++) { accP[mb][nb] = MFMA(af[mb], b0[nb], accP[mb][nb]); accQ[mb][nb] = MFMA(af[mb], b1[nb], accQ[mb][nb]); }
    }
  };
  using S0 = std::integral_constant<int, 0>; using S1 = std::integral_constant<int, 1>;
  issue(S0{}, 0);
  __syncthreads();
  for (int ks = 0; ks < nk; ks += 2) {
    issue(S1{}, (ks + 1) * 32);
    __builtin_amdgcn_sched_barrier(0);
    comp(S0{});
    __syncthreads();
    if (ks + 2 < nk) issue(S0{}, (ks + 2) * 32);
    __builtin_amdgcn_sched_barrier(0);
    comp(S1{});
    __syncthreads();
  }
}

DI void acc_to_lds(const f32x16 (&acc)[2][2], float* ep) {
  const int t = tid(), lane = t & 63, w = t >> 6, wm = w >> 1, wn = w & 1, l31 = lane & 31, h = lane >> 5;
#pragma unroll
  for (int mb = 0; mb < 2; mb++)
#pragma unroll
    for (int nb = 0; nb < 2; nb++)
#pragma unroll
      for (int i = 0; i < 16; i++) ep[(wm * 64 + mb * 32 + crow(i, h)) * EPW + wn * 64 + nb * 32 + l31] = acc[mb][nb][i];
}
template <int NB>
DI void acc_to_lds4(const f32x4 (&acc)[4][NB], float* ep) {
  const int t = tid(), lane = t & 63, w = t >> 6, wm = w >> 1, wn = w & 1, r16 = lane & 15, q = lane >> 4;
#pragma unroll
  for (int mb = 0; mb < 4; mb++)
#pragma unroll
    for (int nb = 0; nb < NB; nb++) {
      float* d = ep + (wm * 64 + mb * 16 + q * 4) * EPW + wn * 16 * NB + nb * 16 + r16;
      d[0] = acc[mb][nb].x; d[EPW] = acc[mb][nb].y; d[2 * EPW] = acc[mb][nb].z; d[3 * EPW] = acc[mb][nb].w;
    }
}
template <class F>
DI void rowwise(const float* ep, F f) {
  const int t = tid();
#pragma unroll 1
  for (int ps = 0; ps < 8; ps++) {
    const int row = ps * 16 + (t >> 4), c8 = (t & 15) * 8;
    float v[8];
    const f32x4 a = *(const f32x4*)(ep + row * EPW + c8), b = *(const f32x4*)(ep + row * EPW + c8 + 4);
    v[0] = a.x; v[1] = a.y; v[2] = a.z; v[3] = a.w; v[4] = b.x; v[5] = b.y; v[6] = b.z; v[7] = b.w;
    f(row, c8, v);
  }
}
template <class L, class F>
DI void rowwise2(const float* ep, L pre, F f) {
  const int t = tid();
  const int c8 = (t & 15) * 8;
#pragma unroll 1
  for (int g = 0; g < 2; g++) {
    decltype(pre(0, 0)) ld[4];
#pragma unroll
    for (int q = 0; q < 4; q++) ld[q] = pre((g * 4 + q) * 16 + (t >> 4), c8);
#pragma unroll
    for (int q = 0; q < 4; q++) {
      const int row = (g * 4 + q) * 16 + (t >> 4);
      float v[8];
      const f32x4 a = *(const f32x4*)(ep + row * EPW + c8), b = *(const f32x4*)(ep + row * EPW + c8 + 4);
      v[0] = a.x; v[1] = a.y; v[2] = a.z; v[3] = a.w; v[4] = b.x; v[5] = b.y; v[6] = b.z; v[7] = b.w;
      f(row, c8, v, ld[q]);
    }
  }
}
struct LdRope { f32x4 r[4]; };
struct LdKv { unsigned k2; u32x4 x1, x2; f32x4 r[4]; };
struct LdX { f32x4 a, b; };
struct LdGlu { u32x4 yg, gt; };
template <class F>
DI void tstore(const float* ep, int cb, int nc, const float* rowscale, F dst) {
  const int t = tid();
  const int ntask = nc * 16;
  for (int e = t; e < ntask; e += 256) {
    const int col = e % nc, rg = e / nc;
    float v[8];
#pragma unroll
    for (int j = 0; j < 8; j++) { float x = ep[(rg * 8 + j) * EPW + cb + col]; if (rowscale) x *= rowscale[rg * 8 + j]; v[j] = x; }
    *(u32x4*)(dst(col) + rg * 8) = pack8(v);
  }
}

DI void tile_from_linear(int L, int nN, int& tm, int& tn) { const int band = L / (8 * nN), rr = L % (8 * nN); tn = rr >> 3; tm = band * 8 + (rr & 7); }
DI int static_L(int round, int vb) { const int Gx = gridDim.x >> 3; return (round * 8 + (vb & 7)) * Gx + (vb >> 3); }
DI int next_item(unsigned* ctr, int* slot) {
  __syncthreads();
  if (threadIdx.x == 0) *slot = (int)atomicAdd(ctr, 1u);
  __syncthreads();
  return *slot;
}

DI int colmap(int mode, int n) {
  if (mode == 0) return n;
  if (mode == 1) { if (n < 768) return n; if (n < 2304) return n + 1056; if (n < 3360) return n - 1536; if (n < 3456) return -1; return n - 96; }
  { const int hh = n >> 7, j = n & 127; return j < 96 ? hh * 96 + j : -1; }
}
struct CDesc { const float* src; const float* g; bf16_t* dst; int ld, K, mode, it; };
DI void conv_load(const CDesc& d, f32x4 (&v)[8]) {
  const int t = tid();
  const int nkt = d.K >> 6, kt = d.it % nkt, nt = d.it / nkt, k0 = kt * 64, n0 = nt * 128;
  const int n4 = (t & 31) * 4, c = colmap(d.mode, n0 + n4);
#pragma unroll
  for (int i = 0; i < 8; i++) {
    const int kk = (t >> 5) + 8 * i;
    if (c >= 0) v[i] = __builtin_nontemporal_load((const f32x4*)(d.src + (long)(k0 + kk) * d.ld + c)); else { v[i].x = 0.f; v[i].y = 0.f; v[i].z = 0.f; v[i].w = 0.f; }
  }
}
DI void conv_finish(const CDesc& d, f32x4 (&v)[8], float* sm) {
  const int t = tid();
  const int nkt = d.K >> 6, kt = d.it % nkt, nt = d.it / nkt, k0 = kt * 64, n0 = nt * 128;
  const int n4 = (t & 31) * 4;
#pragma unroll
  for (int i = 0; i < 8; i++) {
    const int kk = (t >> 5) + 8 * i;
    if (d.g) { const float gg = d.g[k0 + kk]; v[i].x *= gg; v[i].y *= gg; v[i].z *= gg; v[i].w *= gg; }
    *(f32x4*)(sm + kk * 132 + n4) = v[i];
  }
  __syncthreads();
#pragma unroll
  for (int i = 0; i < 2; i++) {
    const int nn = (t >> 2) + 64 * i, ks = (t & 3) * 16;
    float f[16];
#pragma unroll
    for (int j = 0; j < 16; j++) f[j] = sm[(ks + j) * 132 + nn];
    u32x4 o0, o1;
    o0.x = pk2(f[0], f[1]); o0.y = pk2(f[2], f[3]); o0.z = pk2(f[4], f[5]); o0.w = pk2(f[6], f[7]);
    o1.x = pk2(f[8], f[9]); o1.y = pk2(f[10], f[11]); o1.z = pk2(f[12], f[13]); o1.w = pk2(f[14], f[15]);
    bf16_t* dd = d.dst + (long)(n0 + nn) * d.K + k0 + ks;
    *(u32x4*)dd = o0; *(u32x4*)(dd + 8) = o1;
  }
  __syncthreads();
}
constexpr int NCONV = 944 + 72 + 32 + 8 + 32 + 64 + 32 + 32 + 128 + 64;
constexpr int NAUX = NCONV + 512;
DI CDesc conv_desc(const P& p, int l, int it) {
  CDesc d; d.g = nullptr; d.mode = 0;
  if (it < 944) { d.src = p.w_in + (long)l * 1024 * INW; d.ld = INW; d.K = 1024; d.mode = 1; d.g = p.norm_g + l * 1024; d.dst = p.WinT; d.it = it; return d; }
  it -= 944;
  if (it < 72) { d.src = p.b_w_uq + (long)l * 768 * 768; d.ld = 768; d.K = 768; d.g = p.b_q_norm_g + l * 768; d.dst = p.WuqT; d.it = it; return d; }
  it -= 72;
  if (it < 32) { d.src = p.b_w_ukv + (long)l * 256 * 1024; d.ld = 1024; d.K = 256; d.g = p.b_kv_norm_g + l * 256; d.dst = p.WukvT; d.it = it; return d; }
  it -= 32;
  if (it < 8) { d.src = p.c_w_glu + (long)l * 256 * 256; d.ld = 256; d.K = 256; d.dst = p.WgluT; d.it = it; return d; }
  it -= 8;
  if (it < 32) { d.src = p.w_br_a + (long)l * 256 * 1024; d.ld = 1024; d.K = 256; d.dst = p.WbrT; d.it = it; return d; }
  it -= 32;
  if (it < 64) { d.src = p.w_br_b + (long)l * 512 * 1024; d.ld = 1024; d.K = 512; d.dst = p.WbrT + 1024 * 256; d.it = it; return d; }
  it -= 64;
  if (it < 32) { d.src = p.w_br_c + (long)l * 256 * 1024; d.ld = 1024; d.K = 256; d.dst = p.WbrT + 1024 * 768; d.it = it; return d; }
  it -= 32;
  if (it < 32) { d.src = p.w_br_m + (long)l * 256 * 1024; d.ld = 1024; d.K = 256; d.dst = p.WbrT + 1024 * 1024; d.it = it; return d; }
  it -= 32;
  if (it < 128) { d.src = p.w_out + (long)l * 1024 * 1024; d.ld = 1024; d.K = 1024; d.dst = p.WoutT + (long)l * 1024 * 1024; d.it = it; return d; }
  it -= 128;
  d.src = p.m_w_kv + (long)l * 1024 * 512; d.ld = 512; d.K = 1024; d.dst = p.WmkvT; d.it = it; return d;
}
DI void conv_all(const P& p, int l, char* smem) {
  const int G = gridDim.x, bid = blockIdx.x;
  float* sm = (float*)smem;
  if (bid >= NCONV) return;
  f32x4 va[8], vb[8];
  CDesc da = conv_desc(p, l, bid), db = da;
  conv_load(da, va);
#pragma unroll 1
  for (int it = bid; it < NCONV; it += 2 * G) {
    const bool h1 = it + G < NCONV;
    if (h1) { db = conv_desc(p, l, it + G); conv_load(db, vb); }
    conv_finish(da, va, sm);
    const bool h2 = it + 2 * G < NCONV;
    if (h2) { da = conv_desc(p, l, it + 2 * G); conv_load(da, va); }
    if (h1) conv_finish(db, vb, sm);
  }
}
DI void aux_item(const P& p, int l, int it, char* smem) {
  it -= NCONV;
  {
    const int t = tid(), lane = t & 63, row = it * 4 + (t >> 6);
    const float* src = p.mem + (long)row * 1024; const float* g = p.m_norm_g + l * 1024;
    f32x4 v[4]; float ss = 0.f;
#pragma unroll
    for (int i = 0; i < 4; i++) { v[i] = *(const f32x4*)(src + (lane + 64 * i) * 4); ss += v[i].x * v[i].x + v[i].y * v[i].y + v[i].z * v[i].z + v[i].w * v[i].w; }
    ss = sum64(ss);
    const float r = rsqrtf(ss * (1.f / 1024.f) + EPS);
#pragma unroll
    for (int i = 0; i < 4; i++) {
      const f32x4 gg = *(const f32x4*)(g + (lane + 64 * i) * 4);
      u32x2 o; o.x = pk2(v[i].x * r * gg.x, v[i].y * r * gg.y); o.y = pk2(v[i].z * r * gg.z, v[i].w * r * gg.w);
      *(u32x2*)(p.hm + (long)row * 1024 + (lane + 64 * i) * 4) = o;
    }
  }
}

DI void p0_xrow_item(const P& p, int it) {
  const int t = tid(), lane = t & 63;
  f32x4 v[2][4];
#pragma unroll
  for (int r = 0; r < 2; r++) {
    const float* src = p.x + (long)(it * 8 + (t >> 6) * 2 + r) * 1024;
#pragma unroll
    for (int i = 0; i < 4; i++) v[r][i] = __builtin_nontemporal_load((const f32x4*)(src + (lane + 64 * i) * 4));
  }
#pragma unroll
  for (int r = 0; r < 2; r++) {
    const int row = it * 8 + (t >> 6) * 2 + r;
    float ss = 0.f;
#pragma unroll
    for (int i = 0; i < 4; i++) ss += v[r][i].x * v[r][i].x + v[r][i].y * v[r][i].y + v[r][i].z * v[r][i].z + v[r][i].w * v[r][i].w;
    ss = sum64(ss);
#pragma unroll
    for (int i = 0; i < 4; i++) { u32x2 o; o.x = pk2(v[r][i].x, v[r][i].y); o.y = pk2(v[r][i].z, v[r][i].w); *(u32x2*)(p.xb + (long)row * 1024 + (lane + 64 * i) * 4) = o; }
    if (lane < 8) p.ssp[(long)lane * T_ + row] = (lane == 0) ? ss : 0.f;
  }
}
DI void p0_rope_item(const P& p, int it) {
  const int e = it * 256 + threadIdx.x, tok = e >> 4, i = e & 15;
  const float inv_freq = exp2f(-(float)i * (13.287712379549449f / 16.f));
  const float ang = (float)p.pos[tok] * inv_freq;
  const double rev = (double)ang * 0.15915494309189535;
  const float fr = (float)(rev - rint(rev));
  p.rope[(long)e * 2] = __builtin_amdgcn_cosf(fr);
  p.rope[(long)e * 2 + 1] = __builtin_amdgcn_sinf(fr);
}

DI void load_rs(const P& p, int r0, float* rsS) {
  const int t = tid();
  if (t < 128) { float s = 0.f;
#pragma unroll
    for (int j = 0; j < 8; j++) s += p.ssp[(long)j * T_ + r0 + t];
    rsS[t] = rsqrtf(s * (1.f / 1024.f) + EPS); }
}
DI void g1_tile(const P& p, int l, int tm, int tn, char* smem) {
  bf16_t* sm = (bf16_t*)smem; float* ep = (float*)smem; float* rsS = (float*)(smem + SM_RS);
  const int r0 = tm * 128, c0 = tn * 128;
  load_rs(p, r0, rsS);
  f32x16 acc[2][2]; zero_acc(acc);
  gemm_loop_dma(p.xb + (long)r0 * 1024, 1024, p.WinT + (long)c0 * 1024, 1024, 1024, acc, smem);
  acc_to_lds(acc, ep);
  __syncthreads();
  int type; bf16_t* dst; int ld;
  if (c0 < 2304) { dst = p.z1 + c0; ld = Z1W;
    if (c0 < 512) type = 1; else if (c0 < 1280) type = 2; else if (c0 < 1536) type = 0; else if (c0 < 1792) type = 2; else if (c0 < 2048) type = 3; else type = 2;
  } else { dst = p.z2 + (c0 - 2304); ld = Z2W; type = 0; }
  const float* gq = p.m_qk_g_q + l * 64;
  rowwise(ep, [&](int row, int c8, float (&v)[8]) {
    const float r = rsS[row];
#pragma unroll
    for (int j = 0; j < 8; j++) v[j] *= r;
    if (type == 1) {
#pragma unroll
      for (int j = 0; j < 8; j++) v[j] = gelu_t(v[j]);
    } else if (type == 2) {
#pragma unroll
      for (int j = 0; j < 8; j++) v[j] = silu(v[j]);
    } else if (type == 3) {
      float ss = 0.f;
#pragma unroll
      for (int j = 0; j < 8; j++) ss += v[j] * v[j];
      ss = sum8(ss);
      const float rq = rsqrtf(ss * (1.f / 64.f) + EPS) * (0.125f * LOG2E);
#pragma unroll
      for (int j = 0; j < 8; j++) v[j] *= rq * gq[(c8 & 63) + j];
    }
    *(u32x4*)(dst + (long)(r0 + row) * ld + c8) = pack8(v);
    if (c0 >= 2304) {
      float ss = 0.f;
#pragma unroll
      for (int j = 0; j < 8; j++) ss += v[j] * v[j];
      ss = sum16(ss);
      if ((c8 >> 3) == 0) p.ssq[(long)((c0 - 2304) >> 7) * T_ + r0 + row] = ss;
    }
  });
  __syncthreads();
}
DI void g1m_tile(const P& p, int l, int tm, int tn, char* smem) {
  bf16_t* sm = (bf16_t*)smem; float* ep = (float*)smem;
  const int r0 = tm * 128, c0 = tn * 128;
  f32x16 acc[2][2]; zero_acc(acc);
  gemm_loop_dma(p.hm + (long)r0 * 1024, 1024, p.WmkvT + (long)c0 * 1024, 1024, 1024, acc, smem);
  acc_to_lds(acc, ep);
  __syncthreads();
  if (tn < 2) {
    const float* gk = p.m_qk_g_k + l * 64;
    rowwise(ep, [&](int row, int c8, float (&v)[8]) {
      float ss = 0.f;
#pragma unroll
      for (int j = 0; j < 8; j++) ss += v[j] * v[j];
      ss = sum8(ss);
      const float rq = rsqrtf(ss * (1.f / 64.f) + EPS);
#pragma unroll
      for (int j = 0; j < 8; j++) v[j] *= rq * gk[(c8 & 63) + j];
      *(u32x4*)(p.memk + (long)(r0 + row) * 256 + c0 + c8) = pack8(v);
    });
  } else {
    const int b = r0 >> 8, m0 = r0 & 255, cv0 = c0 - 256;
    tstore(ep, 0, 128, nullptr, [&](int col) { const int cv = cv0 + col; return p.memvt + ((long)((b * 4 + (cv >> 6)) * 64 + (cv & 63))) * 256 + m0; });
  }
  __syncthreads();
}

DI void g2q_tile(const P& p, int l, int tm, int hh, char* smem) {
  bf16_t* sm = (bf16_t*)smem; float* ep = (float*)smem; float* ssS = (float*)(smem + SM_SS);
  const int r0 = tm * 128;
  f32x4 acc[4][3]; zero_acc4<3>(acc);
  { const int t = tid(); if (t < 128) { float q = 0.f;
#pragma unroll
      for (int j = 0; j < 6; j++) q += p.ssq[(long)j * T_ + r0 + t];
      ssS[t] = rsqrtf(q * (1.f / 768.f) + EPS); } }
  gemm_loop_dma16<3>(p.z2 + (long)r0 * Z2W, Z2W, p.WuqT + (long)hh * 96 * 768, 768, 768, acc, smem);
  acc_to_lds4<3>(acc, ep);
  __syncthreads();
  const float* gq = p.b_qk_g_q + l * 96;
  const float QSC = 0.10206207261596575f * LOG2E;
  rowwise2(ep, [&](int row, int c8) {
    LdRope L;
    const int tc = c8 >> 3;
    if (tc >= 8 && tc < 12) {
      const float* rp = p.rope + ((long)(r0 + row) * 16 + (tc & 1) * 8) * 2;
#pragma unroll
      for (int j = 0; j < 4; j++) L.r[j] = *(const f32x4*)(rp + 4 * j);
    } else {
#pragma unroll
      for (int j = 0; j < 4; j++) { L.r[j].x = 0.f; L.r[j].y = 0.f; L.r[j].z = 0.f; L.r[j].w = 0.f; }
    }
    return L;
  }, [&](int row, int c8, float (&v)[8], const LdRope& L) {
    const float rs = ssS[row];
    float ss = 0.f;
#pragma unroll
    for (int j = 0; j < 8; j++) { v[j] *= rs; ss += v[j] * v[j]; }
    const int tc = c8 >> 3;
    if (tc >= 12) ss = 0.f;
    ss = sum16(ss);
    const float rq = rsqrtf(ss * (1.f / 96.f) + EPS);
    bf16_t* qd = p.qf + (long)(r0 + row) * 768 + hh * 96;
    if (tc < 8) {
#pragma unroll
      for (int j = 0; j < 8; j++) v[j] *= rq * gq[c8 + j] * QSC;
      *(u32x4*)(qd + c8) = pack8(v);
    } else if (tc < 12) {
      const int i0 = (tc & 1) * 8; const bool first = tc < 10;
      const int pc = first ? 80 + i0 : 64 + i0;
      const float csn[16] = {L.r[0].x, L.r[0].y, L.r[0].z, L.r[0].w, L.r[1].x, L.r[1].y, L.r[1].z, L.r[1].w,
                             L.r[2].x, L.r[2].y, L.r[2].z, L.r[2].w, L.r[3].x, L.r[3].y, L.r[3].z, L.r[3].w};
      float o[8];
#pragma unroll
      for (int j = 0; j < 8; j++) {
        const float own = v[j] * rq * gq[c8 + j];
        const float oth = ep[row * EPW + pc + j] * rs * rq * gq[pc + j];
        const float cs = csn[2 * j], sn = csn[2 * j + 1];
        o[j] = (first ? (own * cs - oth * sn) : (own * cs + oth * sn)) * QSC;
      }
      *(u32x4*)(qd + c8) = pack8(o);
    }
  });
  __syncthreads();
}
DI void g2kv_tile(const P& p, int l, int tm, int hh, char* smem) {
  bf16_t* sm = (bf16_t*)smem; float* ep = (float*)smem; float* ssS = (float*)(smem + SM_SS);
  const int r0 = tm * 128;
  f32x16 acc[2][2]; zero_acc(acc);
  { const int t = tid(); if (t < 128) { const float q = p.ssq[(long)6 * T_ + r0 + t] + p.ssq[(long)7 * T_ + r0 + t];
      ssS[t] = rsqrtf(q * (1.f / 256.f) + EPS); } }
  gemm_loop_dma(p.z2 + (long)r0 * Z2W + 768, Z2W, p.WukvT + (long)hh * 128 * 256, 256, 256, acc, smem);
  acc_to_lds(acc, ep);
  __syncthreads();
  const float* gk = p.b_qk_g_k + l * 96;
  rowwise2(ep, [&](int row, int c8) {
    LdKv L;
    const int tc = c8 >> 3;
    const bf16_t* krp = p.z2 + (long)(r0 + row) * Z2W + 1024;
    L.k2 = *(const unsigned*)(krp + 2 * tc);
    if (tc >= 8 && tc < 12) {
      const int i0 = (tc & 1) * 8;
      L.x1 = *(const u32x4*)(krp + i0); L.x2 = *(const u32x4*)(krp + 16 + i0);
      const float* rp = p.rope + ((long)(r0 + row) * 16 + i0) * 2;
#pragma unroll
      for (int j = 0; j < 4; j++) L.r[j] = *(const f32x4*)(rp + 4 * j);
    } else {
      L.x1.x = 0; L.x1.y = 0; L.x1.z = 0; L.x1.w = 0; L.x2 = L.x1;
#pragma unroll
      for (int j = 0; j < 4; j++) { L.r[j].x = 0.f; L.r[j].y = 0.f; L.r[j].z = 0.f; L.r[j].w = 0.f; }
    }
    return L;
  }, [&](int row, int c8, float (&v)[8], const LdKv& L) {
    const float rs = ssS[row];
    const int tc = c8 >> 3;
    const unsigned k2 = L.k2;
    const float ka = __uint_as_float(k2 << 16), kb = __uint_as_float(k2 & 0xffff0000u);
    float ss = ka * ka + kb * kb;
    if (tc < 8) {
#pragma unroll
      for (int j = 0; j < 8; j++) { v[j] *= rs; ss += v[j] * v[j]; }
    }
    ss = sum16(ss);
    const float kn = rsqrtf(ss * (1.f / 96.f) + EPS);
    bf16_t* kd = p.kf + (long)(r0 + row) * 768 + hh * 96;
    if (tc < 8) {
#pragma unroll
      for (int j = 0; j < 8; j++) v[j] *= kn * gk[c8 + j];
      *(u32x4*)(kd + c8) = pack8(v);
    } else if (tc < 12) {
      const int i0 = (tc & 1) * 8; const bool first = tc < 10;
      float x1[8], x2[8], o[8];
      unpack8(L.x1, x1);
      unpack8(L.x2, x2);
      const float csn[16] = {L.r[0].x, L.r[0].y, L.r[0].z, L.r[0].w, L.r[1].x, L.r[1].y, L.r[1].z, L.r[1].w,
                             L.r[2].x, L.r[2].y, L.r[2].z, L.r[2].w, L.r[3].x, L.r[3].y, L.r[3].z, L.r[3].w};
#pragma unroll
      for (int j = 0; j < 8; j++) {
        const float a = x1[j] * kn * gk[64 + i0 + j], b = x2[j] * kn * gk[80 + i0 + j];
        const float cs = csn[2 * j], sn = csn[2 * j + 1];
        o[j] = first ? (a * cs - b * sn) : (b * cs + a * sn);
      }
      *(u32x4*)(kd + (first ? 64 : 80) + i0) = pack8(o);
    }
  });
  {
    const int b = r0 >> 11, s0 = r0 & 2047;
    tstore(ep, 64, 64, ssS, [&](int col) { return p.vt + ((long)((b * 8 + hh) * 64 + col)) * S_ + s0; });
  }
  __syncthreads();
}

template <int DQK, bool CAUSAL>
DI void attn_item(const bf16_t* __restrict__ q, long q_ld, const bf16_t* __restrict__ k, long k_ld, const bf16_t* __restrict__ vt, long vt_ld,
                  bf16_t* og, long o_ld, int q0, int nkt, char* smem, bool dry) {
  constexpr int KS = DQK + 8, NKC = DQK / 8, NKL = (64 * NKC) / 256, NKK = DQK / 16, VS = 68;
  bf16_t* sK = (bf16_t*)smem;
  bf16_t* sV = (bf16_t*)smem + 2 * 64 * KS;
  const int t = tid(), lane = t & 63, w = t >> 6, l31 = lane & 31, h = lane >> 5;
  bf16x8 qfr[NKK];
  {
    const bf16_t* qp = q + (long)(w * 32 + l31) * q_ld + h * 8;
#pragma unroll
    for (int kk = 0; kk < NKK; kk++) qfr[kk] = *(const bf16x8*)(qp + kk * 16);
  }
  u32x4 rk[NKL], rv[2];
  auto gload = [&](int kt) {
#pragma unroll
    for (int i = 0; i < NKL; i++) { const int c = t + 256 * i, key = c / NKC, kc = c % NKC; rk[i] = *(const u32x4*)(k + (long)(kt * 64 + key) * k_ld + kc * 8); }
#pragma unroll
    for (int i = 0; i < 2; i++) { const int c = t + 256 * i, d = c >> 3, kc = c & 7; rv[i] = *(const u32x4*)(vt + (long)d * vt_ld + kt * 64 + kc * 8); }
  };
  auto lstore = [&](int buf) {
    bf16_t* dK = sK + buf * 64 * KS; bf16_t* dV = sV + buf * 64 * VS;
#pragma unroll
    for (int i = 0; i < NKL; i++) { const int c = t + 256 * i, key = c / NKC, kc = c % NKC; *(u32x4*)(dK + key * KS + kc * 8) = rk[i]; }
#pragma unroll
    for (int i = 0; i < 2; i++) { const int c = t + 256 * i, d = c >> 3, kc = c & 7;
      u32x2 lo, hi; lo.x = rv[i].x; lo.y = rv[i].y; hi.x = rv[i].z; hi.y = rv[i].w;
      *(u32x2*)(dV + d * VS + kc * 8) = lo; *(u32x2*)(dV + d * VS + kc * 8 + 4) = hi; }
  };
  f32x16 o[2];
#pragma unroll
  for (int i = 0; i < 16; i++) { o[0][i] = 0.f; o[1][i] = 0.f; }
  float m = -1e30f, lsum = 0.f;
  const int qpos = q0 + w * 32 + l31;
  gload(0); lstore(0);
  if (nkt > 1) gload(1);
  __syncthreads();
  for (int kt = 0; kt < nkt; kt++) {
    if (kt + 1 < nkt) lstore((kt + 1) & 1);
    __builtin_amdgcn_sched_barrier(0);
    if (kt + 2 < nkt) gload(kt + 2);
    __builtin_amdgcn_sched_barrier(0);
    const bool active = !CAUSAL || (kt * 64 <= q0 + w * 32 + 31);
    if (active) {
      const bf16_t* cK = sK + (kt & 1) * 64 * KS; const bf16_t* cV = sV + (kt & 1) * 64 * VS;
      f32x16 s[2];
#pragma unroll
      for (int i = 0; i < 16; i++) { s[0][i] = 0.f; s[1][i] = 0.f; }
      __builtin_amdgcn_s_setprio(1);
#pragma unroll
      for (int kb = 0; kb < 2; kb++)
#pragma unroll
        for (int kk = 0; kk < NKK; kk++) {
          const bf16x8 kf_ = *(const bf16x8*)(cK + (kb * 32 + l31) * KS + kk * 16 + h * 8);
          s[kb] = MFMA(kf_, qfr[kk], s[kb]);
        }
      __builtin_amdgcn_s_setprio(0);
      if (CAUSAL && (kt * 64 + 63 > q0 + w * 32)) {
#pragma unroll
        for (int kb = 0; kb < 2; kb++)
#pragma unroll
          for (int i = 0; i < 16; i++) { const int key = kt * 64 + kb * 32 + crow(i, h); if (key > qpos) s[kb][i] = -1e30f; }
      }
      float mx = s[0][0];
#pragma unroll
      for (int kb = 0; kb < 2; kb++)
#pragma unroll
        for (int i = 0; i < 16; i++) mx = fmaxf(mx, s[kb][i]);
      mx = fmaxf(mx, __shfl_xor(mx, 32));
      const float mnew = fmaxf(m, mx);
      const float alpha = __builtin_amdgcn_exp2f(m - mnew);
      m = mnew;
      float ps = 0.f;
#pragma unroll
      for (int kb = 0; kb < 2; kb++)
#pragma unroll
        for (int i = 0; i < 16; i++) { const float pv = __builtin_amdgcn_exp2f(s[kb][i] - mnew); s[kb][i] = pv; ps += pv; }
      lsum = lsum * alpha + ps;
#pragma unroll
      for (int i = 0; i < 16; i++) { o[0][i] *= alpha; o[1][i] *= alpha; }
      __builtin_amdgcn_s_setprio(1);
#pragma unroll
      for (int kb = 0; kb < 2; kb++)
#pragma unroll
        for (int st = 0; st < 2; st++) {
          u32x4 pp; pp.x = pk2(s[kb][8 * st + 0], s[kb][8 * st + 1]); pp.y = pk2(s[kb][8 * st + 2], s[kb][8 * st + 3]);
          pp.z = pk2(s[kb][8 * st + 4], s[kb][8 * st + 5]); pp.w = pk2(s[kb][8 * st + 6], s[kb][8 * st + 7]);
          const bf16x8 pf = __builtin_bit_cast(bf16x8, pp);
#pragma unroll
          for (int db = 0; db < 2; db++) {
            const bf16_t* vp = cV + (db * 32 + l31) * VS + kb * 32 + st * 16 + 4 * h;
            const u32x2 lo = *(const u32x2*)vp, hi = *(const u32x2*)(vp + 8);
            u32x4 vv; vv.x = lo.x; vv.y = lo.y; vv.z = hi.x; vv.w = hi.y;
            o[db] = MFMA(__builtin_bit_cast(bf16x8, vv), pf, o[db]);
          }
        }
      __builtin_amdgcn_s_setprio(0);
    }
    __syncthreads();
  }
  lsum += __shfl_xor(lsum, 32);
  const float inv = 1.f / lsum;
  bf16_t* op = og + (long)(w * 32 + l31) * o_ld;
#pragma unroll
  for (int db = 0; db < 2; db++)
#pragma unroll
    for (int ig = 0; ig < 4; ig++) {
      const int d = db * 32 + ig * 8 + 4 * h;
      float gt[4]; unpack4(*(const u32x2*)(op + d), gt);
      u32x2 r; r.x = pk2(o[db][4 * ig + 0] * inv * gt[0], o[db][4 * ig + 1] * inv * gt[1]); r.y = pk2(o[db][4 * ig + 2] * inv * gt[2], o[db][4 * ig + 3] * inv * gt[3]);
      if (!dry) *(u32x2*)(op + d) = r;
    }
}
DI void mattn_item(const P& p, int idx, char* smem) {
  const int b = idx >> 6, hh = (idx >> 4) & 3, qt = idx & 15;
  const long tok0 = (long)b * S_ + qt * 128;
  attn_item<64, false>(p.z1 + tok0 * Z1W + 1792 + hh * 64, Z1W, p.memk + (long)b * 256 * 256 + hh * 64, 256,
                       p.memvt + (long)(b * 4 + hh) * 64 * 256, 256, p.z1 + tok0 * Z1W + 2048 + hh * 64, Z1W, 0, 4, smem, p.dry != 0);
}
DI void battn_item(const P& p, int idx, char* smem) {
  const int qt = 15 - (idx >> 6), bh = idx & 63, b = bh >> 3, hh = bh & 7;
  const long tok0 = (long)b * S_ + qt * 128;
  attn_item<96, true>(p.qf + tok0 * 768 + hh * 96, 768, p.kf + (long)b * S_ * 768 + hh * 96, 768,
                      p.vt + (long)(b * 8 + hh) * 64 * S_, S_, p.z1 + tok0 * Z1W + 768 + hh * 64, Z1W, qt * 128, 2 * qt + 2, smem, p.dry != 0);
}

DI void a_item(const P& p, int l, int idx, char* smem) {
  bf16_t* vnT = (bf16_t*)smem;
  float* part = (float*)(smem + 256 * 136 * 2);
  const int t = tid(); const long r0 = (long)idx * 128;
  {
    const int row = t & 127, half = t >> 7;
    const bf16_t* src = p.z1 + (r0 + row) * Z1W + 256 + half * 128;
    float ss = 0.f;
#pragma unroll 4
    for (int i = 0; i < 16; i++) { float f[8]; unpack8(*(const u32x4*)(src + i * 8), f);
#pragma unroll
      for (int j = 0; j < 8; j++) ss += f[j] * f[j]; }
    part[half * 128 + row] = ss;
    __syncthreads();
    const float r = rsqrtf((part[row] + part[128 + row]) * (1.f / 256.f) + EPS);
    const float* gv = p.a_norm_g + l * 256 + half * 128;
#pragma unroll 4
    for (int i = 0; i < 16; i++) { float f[8]; unpack8(*(const u32x4*)(src + i * 8), f);
#pragma unroll
      for (int j = 0; j < 8; j++) vnT[(half * 128 + i * 8 + j) * 136 + row] = f2bf(f[j] * r * gv[i * 8 + j]); }
  }
  __syncthreads();
  const int lane = t & 63, g = t >> 6, l31 = lane & 31, h = lane >> 5;
  const float* W = p.a_w_s + (long)(l * 4 + g) * 128 * 128;
  const float* bs = p.a_b_s + (l * 4 + g) * 128;
#pragma unroll 1
  for (int mh = 0; mh < 2; mh++) {
    f32x16 acc[2][2]; zero_acc(acc);
#pragma unroll 2
    for (int kk = 0; kk < 8; kk++) {
      bf16x8 af[2], bfr[2];
#pragma unroll
      for (int mb = 0; mb < 2; mb++) {
        const int tt = mh * 64 + mb * 32 + l31, s0 = kk * 16 + h * 8;
        const f32x4 w0 = *(const f32x4*)(W + tt * 128 + s0), w1 = *(const f32x4*)(W + tt * 128 + s0 + 4);
        float f[8] = {w0.x, w0.y, w0.z, w0.w, w1.x, w1.y, w1.z, w1.w};
#pragma unroll
        for (int j = 0; j < 8; j++) if (s0 + j > tt) f[j] = 0.f;
        af[mb] = __builtin_bit_cast(bf16x8, pack8(f));
      }
#pragma unroll
      for (int nb = 0; nb < 2; nb++) bfr[nb] = *(const bf16x8*)(vnT + (g * 64 + nb * 32 + l31) * 136 + kk * 16 + h * 8);
#pragma unroll
      for (int mb = 0; mb < 2; mb++)
#pragma unroll
        for (int nb = 0; nb < 2; nb++) acc[mb][nb] = MFMA(af[mb], bfr[nb], acc[mb][nb]);
    }
#pragma unroll
    for (int mb = 0; mb < 2; mb++)
#pragma unroll
      for (int nb = 0; nb < 2; nb++)
#pragma unroll
        for (int i = 0; i < 16; i++) {
          const int tt = mh * 64 + mb * 32 + crow(i, h), col = g * 64 + nb * 32 + l31;
          bf16_t* zp = p.z1 + (r0 + tt) * Z1W;
          const float u = bf2f(zp[col]), gt = bf2f(zp[512 + col]);
          if (!p.dry) zp[col] = f2bf(u * (acc[mb][nb][i] + bs[tt]) * gt);
        }
  }
  __syncthreads();
}

DI void c_setup(const P& p, int l, int g, int lane, float& ar, float& ai, float (&Br)[16], float (&Bi)[16]) {
  const int gi = (l * 16 + g) * 64 + lane;
  const float lre = p.c_a_re[gi], lim = p.c_a_im[gi];
  const float dt = expf(p.c_log_dt[l * 16 + g]);
  const float mag = expf(lre * dt);
  const float angf = lim * dt;
  const double rev = (double)angf * 0.15915494309189535;
  const float rf = (float)((rev - rint(rev)) * 6.283185307179586);
  const float sn = sinf(rf), cs = cosf(rf);
  ar = mag * cs; ai = mag * sn;
  const float xr = ar - 1.f, xi = ai, den = 1.f / (lre * lre + lim * lim);
  const float cr = (xr * lre + xi * lim) * den, ci = (xi * lre - xr * lim) * den;
  const float* bre = p.c_b_re + (long)gi * 16; const float* bim = p.c_b_im + (long)gi * 16;
#pragma unroll
  for (int c4 = 0; c4 < 4; c4++) {
    const f32x4 r4 = *(const f32x4*)(bre + c4 * 4), i4 = *(const f32x4*)(bim + c4 * 4);
    const float rr[4] = {r4.x, r4.y, r4.z, r4.w}, ii[4] = {i4.x, i4.y, i4.z, i4.w};
#pragma unroll
    for (int j = 0; j < 4; j++) { Br[c4 * 4 + j] = cr * rr[j] - ci * ii[j]; Bi[c4 * 4 + j] = cr * ii[j] + ci * rr[j]; }
  }
}
DI void c_load_u(const P& p, long tok0, int g, int lane, float* ub) {
  const bf16_t* up = p.z1 + (tok0 + lane) * Z1W + 1280 + g * 16;
  float f0[8], f1[8];
  unpack8(*(const u32x4*)up, f0); unpack8(*(const u32x4*)(up + 8), f1);
  f32x4 a; a.x = f0[0]; a.y = f0[1]; a.z = f0[2]; a.w = f0[3]; *(f32x4*)(ub + lane * 16) = a;
  a.x = f0[4]; a.y = f0[5]; a.z = f0[6]; a.w = f0[7]; *(f32x4*)(ub + lane * 16 + 4) = a;
  a.x = f1[0]; a.y = f1[1]; a.z = f1[2]; a.w = f1[3]; *(f32x4*)(ub + lane * 16 + 8) = a;
  a.x = f1[4]; a.y = f1[5]; a.z = f1[6]; a.w = f1[7]; *(f32x4*)(ub + lane * 16 + 12) = a;
}
DI void c_step(const float* ub, int s, const float (&Br)[16], const float (&Bi)[16], float ar, float ai, float& sr, float& si) {
  float bur = 0.f, bui = 0.f;
#pragma unroll
  for (int c4 = 0; c4 < 4; c4++) {
    const f32x4 u = *(const f32x4*)(ub + s * 16 + c4 * 4);
    bur += Br[c4 * 4] * u.x + Br[c4 * 4 + 1] * u.y + Br[c4 * 4 + 2] * u.z + Br[c4 * 4 + 3] * u.w;
    bui += Bi[c4 * 4] * u.x + Bi[c4 * 4 + 1] * u.y + Bi[c4 * 4 + 2] * u.z + Bi[c4 * 4 + 3] * u.w;
  }
  const float nr = ar * sr - ai * si + bur, ni = ar * si + ai * sr + bui;
  sr = nr; si = ni;
}
DI void c1_item(const P& p, int l, int idx, char* smem) {
  const int t = tid(), lane = t & 63, w = t >> 6;
  const int b = idx >> 7, g = (idx >> 3) & 15, k = (idx & 7) * 4 + w;
  float* ub = (float*)smem + w * 1024;
  float ar, ai, Br[16], Bi[16];
  c_setup(p, l, g, lane, ar, ai, Br, Bi);
  const long tok0 = (long)b * S_ + k * 64;
  c_load_u(p, tok0, g, lane, ub);
  __syncthreads();
  float sr = 0.f, si = 0.f;
#pragma unroll 2
  for (int s = 0; s < 64; s++) c_step(ub, s, Br, Bi, ar, ai, sr, si);
  f32x2 e; e.x = sr; e.y = si;
  *(f32x2*)(p.carry + ((long)((b * 16 + g) * 32 + k) * 64 + lane) * 2) = e;
  __syncthreads();
}
DI void c3_item(const P& p, int l, int idx, char* smem) {
  const int t = tid(), lane = t & 63, w = t >> 6;
  const int b = idx >> 7, g = (idx >> 3) & 15, k = (idx & 7) * 4 + w;
  float* ub = (float*)(smem + w * 12288);
  bf16_t* stb = (bf16_t*)(smem + w * 12288 + 4096);
  const int c = lane & 15, sq = lane >> 4;
  bf16x8 cfr[4];
  {
    const float* cre = p.c_c_re + (long)(l * 16 + g) * 1024 + c * 64; const float* cim = p.c_c_im + (long)(l * 16 + g) * 1024 + c * 64;
#pragma unroll
    for (int ks = 0; ks < 4; ks++) {
      const f32x4 r4 = *(const f32x4*)(cre + ks * 16 + sq * 4), i4 = *(const f32x4*)(cim + ks * 16 + sq * 4);
      u32x4 pk; pk.x = pk2(r4.x, -i4.x); pk.y = pk2(r4.y, -i4.y); pk.z = pk2(r4.z, -i4.z); pk.w = pk2(r4.w, -i4.w);
      cfr[ks] = __builtin_bit_cast(bf16x8, pk);
    }
  }
  float ar, ai, Br[16], Bi[16];
  c_setup(p, l, g, lane, ar, ai, Br, Bi);
  const long tok0 = (long)b * S_ + k * 64;
  c_load_u(p, tok0, g, lane, ub);
  float lr = ar, li = ai;
#pragma unroll
  for (int i = 0; i < 6; i++) { const float nr = lr * lr - li * li, ni = 2.f * lr * li; lr = nr; li = ni; }
  float sr = 0.f, si = 0.f;
  {
    const float* cp = p.carry + ((long)((b * 16 + g) * 32) * 64 + lane) * 2;
    for (int j0 = 0; j0 < k; j0 += 8) {
      f32x2 e[8];
#pragma unroll
      for (int jj = 0; jj < 8; jj++) { e[jj].x = 0.f; e[jj].y = 0.f; if (j0 + jj < k) e[jj] = *(const f32x2*)(cp + (long)(j0 + jj) * 128); }
#pragma unroll
      for (int jj = 0; jj < 8; jj++) if (j0 + jj < k) { const float nr = lr * sr - li * si + e[jj].x, ni = lr * si + li * sr + e[jj].y; sr = nr; si = ni; }
    }
  }
  __syncthreads();
  const float dsk = p.c_d[l * 256 + g * 16 + c];
#pragma unroll 1
  for (int sb = 0; sb < 4; sb++) {
#pragma unroll 2
    for (int s2 = 0; s2 < 16; s2++) {
      c_step(ub, sb * 16 + s2, Br, Bi, ar, ai, sr, si);
      *(unsigned*)(stb + s2 * 136 + 2 * lane) = pk2(sr, si);
    }
    asm volatile("s_waitcnt lgkmcnt(0)" ::: "memory");
    __builtin_amdgcn_wave_barrier();
    f32x4 y; y.x = 0.f; y.y = 0.f; y.z = 0.f; y.w = 0.f;
#pragma unroll
    for (int ks = 0; ks < 4; ks++) {
      const bf16x8 af = *(const bf16x8*)(stb + c * 136 + ks * 32 + sq * 8);
      y = __builtin_amdgcn_mfma_f32_16x16x32_bf16(af, cfr[ks], y, 0, 0, 0);
    }
    const float yy[4] = {y.x, y.y, y.z, y.w};
#pragma unroll
    for (int qq = 0; qq < 4; qq++) {
      const int sa = sb * 16 + sq * 4 + qq;
      const float yv = gelu_t(yy[qq] + dsk * ub[sa * 16 + c]);
      if (!p.dry) p.z1[(tok0 + sa) * Z1W + 1280 + g * 16 + c] = f2bf(yv);
    }
    asm volatile("s_waitcnt lgkmcnt(0)" ::: "memory");
    __builtin_amdgcn_wave_barrier();
  }
  __syncthreads();
}

DI void glu_tile(const P& p, int l, int tm, int tn, char* smem) {
  bf16_t* sm = (bf16_t*)smem; float* ep = (float*)smem;
  const int r0 = tm * 128, c0 = tn * 128;
  f32x16 acc[2][2]; zero_acc(acc);
  gemm_loop_dma(p.z1 + (long)r0 * Z1W + 1280, Z1W, p.WgluT + (long)c0 * 256, 256, 256, acc, smem);
  acc_to_lds(acc, ep);
  __syncthreads();
  const float* bg = p.c_b_glu + l * 256 + c0;
  rowwise2(ep, [&](int row, int c8) {
    LdGlu L;
    const bf16_t* zp = p.z1 + (long)(r0 + row) * Z1W + c0 + c8;
    L.yg = *(const u32x4*)(zp + 1280); L.gt = *(const u32x4*)(zp + 1536);
    return L;
  }, [&](int row, int c8, float (&v)[8], const LdGlu& L) {
    bf16_t* zp = p.z1 + (long)(r0 + row) * Z1W + c0 + c8;
    float yg[8], gt[8];
    unpack8(L.yg, yg); unpack8(L.gt, gt);
#pragma unroll
    for (int j = 0; j < 8; j++) v[j] = yg[j] * sigm(v[j] + bg[c8 + j]) * gt[j];
    if (!p.dry) *(u32x4*)(zp + 1536) = pack8(v);
  });
  __syncthreads();
}

DI void pf_tile(const P& p, int l, int tm, int tn, char* smem) {
  float* ep = (float*)smem; float* rsS = (float*)(smem + SM_RS);
  const int t = tid(), lane = t & 63, w = t >> 6, wm = w >> 1, wn = w & 1, l31 = lane & 31, h = lane >> 5;
  const int r0 = tm * 128, c0 = tn * 128;
  load_rs(p, r0, rsS);
  unsigned mrgp[2][2][8];
#pragma unroll
  for (int a = 0; a < 2; a++)
#pragma unroll
    for (int b = 0; b < 2; b++)
#pragma unroll
      for (int i = 0; i < 8; i++) mrgp[a][b][i] = 0u;
#pragma unroll 1
  for (int pr = 0; pr < 2; pr++) {
    unsigned gp[2][2][2][8];
    {
      f32x16 accP[2][2], accQ[2][2]; zero_acc(accP); zero_acc(accQ);
      const bf16_t* wg = p.WinT + (long)(3456 + (2 * pr) * 1024 + c0) * 1024;
      gemm_loop_dma2(p.xb + (long)r0 * 1024, 1024, wg, wg + (long)1024 * 1024, 1024, 1024, accP, accQ, smem);
      const float* bm = p.b_merge + l * 4096 + (2 * pr) * 1024 + c0;
#pragma unroll
      for (int mb = 0; mb < 2; mb++)
#pragma unroll
        for (int nb = 0; nb < 2; nb++) {
          const float bias0 = bm[wn * 64 + nb * 32 + l31], bias1 = bm[1024 + wn * 64 + nb * 32 + l31];
#pragma unroll
          for (int i = 0; i < 16; i += 2) {
            const float ra = rsS[wm * 64 + mb * 32 + crow(i, h)], rb = rsS[wm * 64 + mb * 32 + crow(i + 1, h)];
            gp[0][mb][nb][i >> 1] = pk2n(sigm(accP[mb][nb][i] * ra + bias0), sigm(accP[mb][nb][i + 1] * rb + bias0));
            gp[1][mb][nb][i >> 1] = pk2n(sigm(accQ[mb][nb][i] * ra + bias1), sigm(accQ[mb][nb][i + 1] * rb + bias1));
          }
        }
    }
#pragma unroll
    for (int j = 0; j < 2; j++) {
      const int br = 2 * pr + j;
      const int yoff = br == 0 ? 0 : (br == 1 ? 768 : (br == 2 ? 1536 : 2048));
      const int Kb = br == 1 ? 512 : 256;
      const long woff = br == 0 ? 0 : (br == 1 ? 1024 * 256 : (br == 2 ? 1024 * 768 : 1024 * 1024));
      f32x16 acc[2][2]; zero_acc(acc);
      gemm_loop_dma(p.z1 + (long)r0 * Z1W + yoff, Z1W, p.WbrT + woff + (long)c0 * Kb, Kb, Kb, acc, smem);
#pragma unroll
      for (int mb = 0; mb < 2; mb++)
#pragma unroll
        for (int nb = 0; nb < 2; nb++)
#pragma unroll
          for (int i = 0; i < 16; i += 2) {
            const unsigned g2 = gp[j][mb][nb][i >> 1], m2 = mrgp[mb][nb][i >> 1];
            const float m0 = __uint_as_float(m2 << 16) + __uint_as_float(g2 << 16) * acc[mb][nb][i];
            const float m1 = __uint_as_float(m2 & 0xffff0000u) + __uint_as_float(g2 & 0xffff0000u) * acc[mb][nb][i + 1];
            mrgp[mb][nb][i >> 1] = pk2(m0, m1);
          }
    }
  }
  {
    f32x16 mrg[2][2];
#pragma unroll
    for (int a = 0; a < 2; a++)
#pragma unroll
      for (int b = 0; b < 2; b++)
#pragma unroll
        for (int i = 0; i < 16; i += 2) { const unsigned m2 = mrgp[a][b][i >> 1]; mrg[a][b][i] = __uint_as_float(m2 << 16); mrg[a][b][i + 1] = __uint_as_float(m2 & 0xffff0000u); }
    acc_to_lds(mrg, ep);
  }
  __syncthreads();
  rowwise(ep, [&](int row, int c8, float (&v)[8]) { *(u32x4*)(p.mg + (long)(r0 + row) * 1024 + c0 + c8) = pack8(v); });
  __syncthreads();
}

DI void out_tile(const P& p, int l, int tm, int tn, char* smem) {
  bf16_t* sm = (bf16_t*)smem; float* ep = (float*)smem;
  const int r0 = tm * 128, c0 = tn * 128;
  f32x16 acc[2][2]; zero_acc(acc);
  gemm_loop_dma(p.mg + (long)r0 * 1024, 1024, p.WoutT + (long)l * 1024 * 1024 + (long)c0 * 1024, 1024, 1024, acc, smem);
  acc_to_lds(acc, ep);
  __syncthreads();
  const float* xin = (l == 0) ? p.x : p.out;
  rowwise2(ep, [&](int row, int c8) {
    LdX L;
    const long off = (long)(r0 + row) * 1024 + c0 + c8;
    L.a = *(const f32x4*)(xin + off); L.b = *(const f32x4*)(xin + off + 4);
    return L;
  }, [&](int row, int c8, float (&v)[8], const LdX& L) {
    const long off = (long)(r0 + row) * 1024 + c0 + c8;
    const f32x4 a = L.a, b = L.b;
    v[0] += a.x; v[1] += a.y; v[2] += a.z; v[3] += a.w; v[4] += b.x; v[5] += b.y; v[6] += b.z; v[7] += b.w;
    f32x4 oa, ob; oa.x = v[0]; oa.y = v[1]; oa.z = v[2]; oa.w = v[3]; ob.x = v[4]; ob.y = v[5]; ob.z = v[6]; ob.w = v[7];
    if (!p.dry) {
      if (l == 1) { __builtin_nontemporal_store(oa, (f32x4*)(p.out + off)); __builtin_nontemporal_store(ob, (f32x4*)(p.out + off + 4)); }
      else { *(f32x4*)(p.out + off) = oa; *(f32x4*)(p.out + off + 4) = ob; }
    }
    if (l == 0) {
      *(u32x4*)(p.xb + off) = pack8(v);
      float ss = 0.f;
#pragma unroll
      for (int j = 0; j < 8; j++) ss += v[j] * v[j];
      ss = sum16(ss);
      if ((c8 >> 3) == 0) p.ssp[(long)tn * T_ + r0 + row] = ss;
    }
  });
  __syncthreads();
}

DI void out_tile2(const P& p, int l, int tm, int tn2, char* smem) {
  float* ep = (float*)smem;
  const int r0 = tm * 128;
  f32x16 accP[2][2], accQ[2][2]; zero_acc(accP); zero_acc(accQ);
  const bf16_t* w0 = p.WoutT + (long)l * 1024 * 1024 + (long)(tn2 * 256) * 1024;
  gemm_loop_dma2(p.mg + (long)r0 * 1024, 1024, w0, w0 + (long)128 * 1024, 1024, 1024, accP, accQ, smem);
  const float* xin = (l == 0) ? p.x : p.out;
  auto epi = [&](const f32x16 (&acc)[2][2], int tn) {
    const int c0 = tn * 128;
    acc_to_lds(acc, ep);
    __syncthreads();
    rowwise2(ep, [&](int row, int c8) {
      LdX L;
      const long off = (long)(r0 + row) * 1024 + c0 + c8;
      L.a = *(const f32x4*)(xin + off); L.b = *(const f32x4*)(xin + off + 4);
      return L;
    }, [&](int row, int c8, float (&v)[8], const LdX& L) {
      const long off = (long)(r0 + row) * 1024 + c0 + c8;
      const f32x4 a = L.a, b = L.b;
      v[0] += a.x; v[1] += a.y; v[2] += a.z; v[3] += a.w; v[4] += b.x; v[5] += b.y; v[6] += b.z; v[7] += b.w;
      f32x4 oa, ob; oa.x = v[0]; oa.y = v[1]; oa.z = v[2]; oa.w = v[3]; ob.x = v[4]; ob.y = v[5]; ob.z = v[6]; ob.w = v[7];
      if (!p.dry) {
        if (l == 1) { __builtin_nontemporal_store(oa, (f32x4*)(p.out + off)); __builtin_nontemporal_store(ob, (f32x4*)(p.out + off + 4)); }
        else { *(f32x4*)(p.out + off) = oa; *(f32x4*)(p.out + off + 4) = ob; }
      }
      if (l == 0) {
        *(u32x4*)(p.xb + off) = pack8(v);
        float ss = 0.f;
#pragma unroll
        for (int j = 0; j < 8; j++) ss += v[j] * v[j];
        ss = sum16(ss);
        if ((c8 >> 3) == 0) p.ssp[(long)tn * T_ + r0 + row] = ss;
      }
    });
    __syncthreads();
  };
  epi(accP, 2 * tn2);
  epi(accQ, 2 * tn2 + 1);
}

DI void run_phase(const P& p, int ph, char* smem, int vb) {
  const int G = gridDim.x, bid = blockIdx.x;
  int* slot = (int*)(smem + SM_MISC);
  if (ph == 0) {
    conv_all(p, 0, smem);
    for (int it = NCONV + bid; it < NAUX; it += G) aux_item(p, 0, it, smem);
    for (int it = bid; it < 2048; it += G) p0_xrow_item(p, it);
    for (int it = bid; it < 1024; it += G) p0_rope_item(p, it);
    return;
  }
  const int l = (ph - 1) / 6, s = (ph - 1) % 6;
  if (s == 0) {
    const int total = 3456 + 64, nr = (total + G - 1) / G;
    for (int r = 0; r < nr; r++) {
      const int L = static_L(r, vb);
      if (L >= total) continue;
      int tm, tn;
      if (L < 3456) { tile_from_linear(L, 27, tm, tn); g1_tile(p, l, tm, tn, smem); }
      else { tile_from_linear(L - 3456, 4, tm, tn); g1m_tile(p, l, tm, tn, smem); }
    }
  } else if (s == 1) {
    const long dm = p.dry;
    {
      const int total = 1024, nr = (total + G - 1) / G;
      if (!dm || (dm & 2)) for (int r = 0; r < nr; r++) { const int L = static_L(r, vb); if (L >= total) continue; int tm, tn; tile_from_linear(L, 8, tm, tn); g2q_tile(p, l, tm, tn, smem); }
      if (!dm || (dm & 8)) for (int r = 0; r < nr; r++) { const int L = static_L(r, vb); if (L >= total) continue; int tm, tn; tile_from_linear(L, 8, tm, tn); g2kv_tile(p, l, tm, tn, smem); }
    }
    if (!dm || (dm & 4)) for (int it = vb; it < 512; it += G) mattn_item(p, it, smem);
    {
      const bool split = (G >= 256);
      if (!dm || (dm & 16)) { const int a1 = split ? 128 : 128; for (int it = vb; it < a1; it += G) a_item(p, l, it, smem); }
      const int cstep = split ? (vb < 128 ? 1024 : G - 128) : G;
      if (!dm || (dm & 32)) {
#pragma unroll 1
        for (int it = vb; it < 1024; it += cstep) c1_item(p, l, it, smem);
      }
    }
  } else if (s == 2) {
    const long dm = p.dry;
    if (G == 512) {
#pragma unroll 1
      for (int j = 0; j < 4; j++) {
        if (j < 2) { if (dm && !(dm & 2)) continue; battn_item(p, j ? 1023 - vb : vb, smem); }
        else { if (dm && !(dm & 4)) continue; c3_item(p, l, vb + (j - 2) * 512, smem); }
      }
    } else {
#pragma unroll 1
      for (int it = vb; it < 2048; it += G) {
        if (it < 1024) { if (dm && !(dm & 2)) continue; battn_item(p, it, smem); } else { if (dm && !(dm & 4)) continue; c3_item(p, l, it - 1024, smem); }
      }
    }
  } else if (s == 3) {
    for (int it = bid; it < 256; it += G) glu_tile(p, l, it >> 1, it & 1, smem);
  } else if (s == 4) {
    const int total = 1024, nr = (total + G - 1) / G;
    for (int r = 0; r < nr; r++) { const int L = static_L(r, vb); if (L >= total) continue; int tm, tn; tile_from_linear(L, 8, tm, tn); pf_tile(p, l, tm, tn, smem); }
  } else {
    const int nr2 = (512 + G - 1) / G;
    for (int r = 0; r < nr2; r++) { const int L = static_L(r, vb); if (L >= 512) continue; int tm, tn; tile_from_linear(L, 4, tm, tn); out_tile2(p, l, tm, tn, smem); }
    if (l == 0) { conv_all(p, 1, smem); for (int it = NCONV + bid; it < NAUX; it += G) aux_item(p, 1, it, smem); }
  }
}

DI unsigned xb_ld(unsigned* q) { return __hip_atomic_load(q, __ATOMIC_RELAXED, __HIP_MEMORY_SCOPE_AGENT); }
DI unsigned xb_add(unsigned* q, unsigned v) { return __hip_atomic_fetch_add(q, v, __ATOMIC_RELAXED, __HIP_MEMORY_SCOPE_AGENT); }
DI void gbar(unsigned* bar, const int* st) {
  asm volatile("s_waitcnt vmcnt(0)" ::: "memory");
  __syncthreads();
  if (threadIdx.x == 0) {
    __builtin_amdgcn_s_waitcnt(0);
    const unsigned x = (unsigned)st[0], nloc = (unsigned)st[1], nx = (unsigned)st[2];
    const unsigned old = xb_add(&bar[1024 + 64 * x], 1u);
    const unsigned gen = old / nloc;
    if (old + 1u == (gen + 1u) * nloc) {
      __builtin_amdgcn_fence(__ATOMIC_RELEASE, "agent");
      asm volatile("s_waitcnt vmcnt(0)" ::: "memory");
      const unsigned og = xb_add(&bar[3072], 1u);
      const unsigned tg = og / nx;
      if (og + 1u == (tg + 1u) * nx) xb_add(&bar[3136], 1u);
      else while (xb_ld(&bar[3136]) == tg) __builtin_amdgcn_s_sleep(1);
      __builtin_amdgcn_fence(__ATOMIC_ACQUIRE, "agent");
      xb_add(&bar[2048 + 64 * x], 1u);
      asm volatile("s_waitcnt vmcnt(0)" ::: "memory");
    } else {
      while (xb_ld(&bar[2048 + 64 * x]) == gen) __builtin_amdgcn_s_sleep(1);
      __builtin_amdgcn_fence(__ATOMIC_ACQUIRE, "agent");
      asm volatile("s_waitcnt vmcnt(0)" ::: "memory");
    }
  }
  __syncthreads();
}

#if MK_MULTI
__global__ void __launch_bounds__(256, 2) hyb_phase(P p, int ph) {
  __shared__ __attribute__((aligned(16))) char smem[SM_TOTAL];
  run_phase(p, ph, smem, blockIdx.x);
}
#else
__global__ void __launch_bounds__(256, 2) hyb_mega(P p) {
  __shared__ __attribute__((aligned(16))) char smem[SM_TOTAL];
  cg::grid_group grid = cg::this_grid();
  if (p.dry == 0x7fffffff) grid.sync();
  int vb;
  {
    int* sl = (int*)(smem + SM_MISC) + 2;
    if (threadIdx.x == 0) {
      const unsigned xcc = (unsigned)__builtin_amdgcn_s_getreg((3 << 11) | 20) & 7u;
      const unsigned loc = xb_add(p.ctr + 40 + xcc, 1u);
      const unsigned Gx = gridDim.x >> 3;
      *sl = (loc < Gx) ? (int)(loc * 8 + xcc) : -1;
      unsigned sum, cnt, mine;
      for (;;) {
        sum = 0u; cnt = 0u; mine = 0u;
        for (unsigned j = 0; j < 8; ++j) { const unsigned c = xb_ld(p.ctr + 40 + j); sum += c; cnt += (c > 0u) ? 1u : 0u; mine = (j == xcc) ? c : mine; }
        if (sum == gridDim.x) break;
        __builtin_amdgcn_s_sleep(1);
      }
      sl[2] = (int)xcc; sl[3] = (int)mine; sl[4] = (int)cnt;
    }
    __syncthreads();
    vb = blockIdx.x;
  }
  const int* bst = (const int*)(smem + SM_MISC) + 4;
#ifdef DRY_PH
  P pd = p; { int one = DRY_MASK; asm volatile("" : "+s"(one)); pd.dry = one; }
#endif
#pragma unroll 1
  for (int ph = 0; ph < 13; ph++) {
#ifdef DRY_PH
    if (ph == DRY_PH) { run_phase(pd, ph, smem, vb); gbar(p.bar, bst); }
#endif
    run_phase(p, ph, smem, vb);
    if (ph < 12) gbar(p.bar, bst);
  }
}
#endif

extern "C" void kernel_launch(void* const* d_in, const int* in_sizes, int n_in, void* d_out, int out_size, void* d_ws, size_t ws_size, hipStream_t stream) {
  P p{};
  p.x = (const float*)d_in[0]; p.mem = (const float*)d_in[1]; p.pos = (const int*)d_in[2];
  p.norm_g = (const float*)d_in[3]; p.w_in = (const float*)d_in[4]; p.b_merge = (const float*)d_in[5];
  p.a_norm_g = (const float*)d_in[6]; p.a_w_s = (const float*)d_in[7]; p.a_b_s = (const float*)d_in[8];
  p.b_q_norm_g = (const float*)d_in[9]; p.b_kv_norm_g = (const float*)d_in[10]; p.b_w_uq = (const float*)d_in[11]; p.b_w_ukv = (const float*)d_in[12];
  p.b_qk_g_q = (const float*)d_in[13]; p.b_qk_g_k = (const float*)d_in[14];
  p.c_a_re = (const float*)d_in[15]; p.c_a_im = (const float*)d_in[16]; p.c_log_dt = (const float*)d_in[17];
  p.c_b_re = (const float*)d_in[18]; p.c_b_im = (const float*)d_in[19]; p.c_c_re = (const float*)d_in[20]; p.c_c_im = (const float*)d_in[21];
  p.c_d = (const float*)d_in[22]; p.c_w_glu = (const float*)d_in[23]; p.c_b_glu = (const float*)d_in[24];
  p.m_norm_g = (const float*)d_in[25]; p.m_w_kv = (const float*)d_in[26]; p.m_qk_g_q = (const float*)d_in[27]; p.m_qk_g_k = (const float*)d_in[28];
  p.w_br_a = (const float*)d_in[29]; p.w_br_b = (const float*)d_in[30]; p.w_br_c = (const float*)d_in[31]; p.w_br_m = (const float*)d_in[32];
  p.w_out = (const float*)d_in[33];
  p.out = (float*)d_out;
  char* ws = (char*)d_ws; size_t off = 0;
  auto take = [&](size_t bytes) { char* r = ws + off; off += (bytes + 255) & ~(size_t)255; return r; };
  p.z1 = (bf16_t*)take((size_t)T_ * Z1W * 2);
  p.z2 = (bf16_t*)take((size_t)T_ * Z2W * 2);
  p.xb = (bf16_t*)take((size_t)T_ * 1024 * 2);
  p.qf = (bf16_t*)take((size_t)T_ * 768 * 2);
  p.kf = (bf16_t*)take((size_t)T_ * 768 * 2);
  p.mg = p.qf;
  p.vt = (bf16_t*)take((size_t)8 * 8 * 64 * S_ * 2);
  p.hm = (bf16_t*)take((size_t)2048 * 1024 * 2);
  p.memk = (bf16_t*)take((size_t)2048 * 256 * 2);
  p.memvt = (bf16_t*)take((size_t)2048 * 256 * 2);
  p.WinT = (bf16_t*)take((size_t)NWIN * 1024 * 2);
  p.WuqT = (bf16_t*)take((size_t)1024 * 768 * 2);
  p.WukvT = (bf16_t*)take((size_t)1024 * 256 * 2);
  p.WgluT = (bf16_t*)take((size_t)256 * 256 * 2);
  p.WbrT = (bf16_t*)take((size_t)1024 * 1280 * 2);
  p.WoutT = (bf16_t*)take((size_t)2 * 1024 * 1024 * 2);
  p.WmkvT = (bf16_t*)take((size_t)512 * 1024 * 2);
  p.ssp = (float*)take((size_t)8 * T_ * 4);
  p.ssq = (float*)take((size_t)9 * T_ * 4);
  p.rope = (float*)take((size_t)T_ * 32 * 4);
  p.carry = (float*)take((size_t)8 * 16 * 32 * 64 * 2 * 4);
  p.ctr = (unsigned*)take(256);
  p.bar = (unsigned*)take(16384);
  if (off > ws_size) { fprintf(stderr, "workspace too small: need %zu have %zu\n", off, ws_size); return; }

  static int grid_blocks = 0;
  if (!grid_blocks) {
    int dev = 0, cus = 0, per_cu = 0;
    hipGetDevice(&dev);
    hipDeviceGetAttribute(&cus, hipDeviceAttributeMultiprocessorCount, dev);
#if MK_MULTI
    hipOccupancyMaxActiveBlocksPerMultiprocessor(&per_cu, hyb_phase, 256, 0);
#else
    hipOccupancyMaxActiveBlocksPerMultiprocessor(&per_cu, hyb_mega, 256, 0);
#endif
    if (per_cu > 2) per_cu = 2;
    if (per_cu < 1) per_cu = 1;
    grid_blocks = cus * per_cu;
    grid_blocks &= ~7;
  }
#if MK_MULTI
  for (int ph = 0; ph < 13; ph++) hipLaunchKernelGGL(hyb_phase, dim3(grid_blocks), dim3(256), 0, stream, p, ph);
#else
  hipMemsetAsync(p.ctr, 0, 256 + 16384, stream);
  void* args[] = {&p};
  hipError_t e = hipLaunchCooperativeKernel((void*)hyb_mega, dim3(grid_blocks), dim3(256), args, 0, stream);
  if (e != hipSuccess) fprintf(stderr, "cooperative launch failed: %s (grid %d)\n", hipGetErrorString(e), grid_blocks);
#endif
}
```

```cpp
#include <hip/hip_runtime.h>
#include <hip/hip_cooperative_groups.h>
#include <stdint.h>
#include <stdio.h>
#include <type_traits>
namespace cg = cooperative_groups;

#ifndef MK_MULTI
#define MK_MULTI 0
#endif

typedef unsigned short bf16_t;
typedef short bf16x8 __attribute__((ext_vector_type(8)));
typedef short s16x4 __attribute__((ext_vector_type(4)));
typedef float f32x16 __attribute__((ext_vector_type(16)));
typedef float f32x4 __attribute__((ext_vector_type(4)));
typedef float f32x2 __attribute__((ext_vector_type(2)));
typedef unsigned u32x4 __attribute__((ext_vector_type(4)));
typedef unsigned u32x2 __attribute__((ext_vector_type(2)));
#define DI __device__ __forceinline__
#define MFMA(a, b, c) __builtin_amdgcn_mfma_f32_32x32x16_bf16((a), (b), (c), 0, 0, 0)

constexpr int T_ = 16384, S_ = 2048;
constexpr int INW = 7456;
constexpr int Z1W = 2304, Z2W = 1152;
constexpr int NWIN = 7552;
constexpr float EPS = 1e-6f;
constexpr float LOG2E = 1.4426950408889634f;
constexpr int LDT = 72;
constexpr int EPW = 132;
constexpr int SM_MAIN = 4 * 128 * LDT * 2;
constexpr int SM_RS = SM_MAIN;
constexpr int SM_SS = SM_MAIN + 512;
constexpr int SM_MISC = SM_MAIN + 1024;
constexpr int SM_TOTAL = SM_MAIN + 1024 + 64;

struct P {
  const float* x; const float* mem; const int* pos;
  const float* norm_g; const float* w_in; const float* b_merge; const float* a_norm_g; const float* a_w_s; const float* a_b_s;
  const float* b_q_norm_g; const float* b_kv_norm_g; const float* b_w_uq; const float* b_w_ukv; const float* b_qk_g_q; const float* b_qk_g_k;
  const float* c_a_re; const float* c_a_im; const float* c_log_dt; const float* c_b_re; const float* c_b_im; const float* c_c_re; const float* c_c_im;
  const float* c_d; const float* c_w_glu; const float* c_b_glu;
  const float* m_norm_g; const float* m_w_kv; const float* m_qk_g_q; const float* m_qk_g_k;
  const float* w_br_a; const float* w_br_b; const float* w_br_c; const float* w_br_m; const float* w_out;
  float* out;
  bf16_t* z1; bf16_t* z2; bf16_t* xb; bf16_t* qf; bf16_t* kf; bf16_t* mg; bf16_t* vt; bf16_t* hm; bf16_t* memk; bf16_t* memvt;
  bf16_t* WinT; bf16_t* WuqT; bf16_t* WukvT; bf16_t* WgluT; bf16_t* WbrT; bf16_t* WoutT; bf16_t* WmkvT;
  float* ssp; float* ssq; float* rope; float* carry; unsigned* ctr; unsigned* bar;
  long dry;
};

DI int tid() { int t = threadIdx.x; asm volatile("" : "+v"(t)); return t; }
DI float bf2f(bf16_t b) { return __uint_as_float(((unsigned)b) << 16); }
DI unsigned pk2(float lo, float hi) { unsigned r; asm("v_cvt_pk_bf16_f32 %0, %1, %2" : "=v"(r) : "v"(lo), "v"(hi)); return r; }
DI unsigned pk2n(float lo, float hi) { unsigned r; asm("s_nop 1\n\tv_cvt_pk_bf16_f32 %0, %1, %2" : "=v"(r) : "v"(lo), "v"(hi)); return r; }
DI bf16_t f2bf(float x) { return (bf16_t)(pk2(x, 0.f) & 0xffffu); }
DI void unpack8(u32x4 v, float (&f)[8]) {
  f[0] = __uint_as_float(v.x << 16); f[1] = __uint_as_float(v.x & 0xffff0000u);
  f[2] = __uint_as_float(v.y << 16); f[3] = __uint_as_float(v.y & 0xffff0000u);
  f[4] = __uint_as_float(v.z << 16); f[5] = __uint_as_float(v.z & 0xffff0000u);
  f[6] = __uint_as_float(v.w << 16); f[7] = __uint_as_float(v.w & 0xffff0000u);
}
DI void unpack4(u32x2 v, float (&f)[4]) {
  f[0] = __uint_as_float(v.x << 16); f[1] = __uint_as_float(v.x & 0xffff0000u);
  f[2] = __uint_as_float(v.y << 16); f[3] = __uint_as_float(v.y & 0xffff0000u);
}
DI u32x4 pack8(const float (&f)[8]) { u32x4 r; r.x = pk2(f[0], f[1]); r.y = pk2(f[2], f[3]); r.z = pk2(f[4], f[5]); r.w = pk2(f[6], f[7]); return r; }
DI float sigm(float x) { return __builtin_amdgcn_rcpf(1.f + __expf(-x)); }
DI float silu(float x) { return x * sigm(x); }
DI float gelu_t(float x) { return x * sigm(1.5957691216057308f * (x + 0.044715f * x * x * x)); }
DI float sum16(float v) { v += __shfl_xor(v, 1); v += __shfl_xor(v, 2); v += __shfl_xor(v, 4); v += __shfl_xor(v, 8); return v; }
DI float sum8(float v) { v += __shfl_xor(v, 1); v += __shfl_xor(v, 2); v += __shfl_xor(v, 4); return v; }
DI float sum64(float v) { v = sum16(v); v += __shfl_xor(v, 16); v += __shfl_xor(v, 32); return v; }
DI int crow(int i, int h) { return (i & 3) + 8 * (i >> 2) + 4 * h; }
#define MFMA16(a, b, c) __builtin_amdgcn_mfma_f32_16x16x32_bf16((a), (b), (c), 0, 0, 0)
template <int NB>
DI void zero_acc4(f32x4 (&acc)[4][NB]) {
#pragma unroll
  for (int a = 0; a < 4; a++)
#pragma unroll
    for (int b = 0; b < NB; b++) { acc[a][b].x = 0.f; acc[a][b].y = 0.f; acc[a][b].z = 0.f; acc[a][b].w = 0.f; }
}
DI void zero_acc(f32x16 (&acc)[2][2]) {
#pragma unroll
  for (int a = 0; a < 2; a++)
#pragma unroll
    for (int b = 0; b < 2; b++)
#pragma unroll
      for (int i = 0; i < 16; i++) acc[a][b][i] = 0.f;
}

template <bool SS>
DI void gemm_loop(const bf16_t* __restrict__ A, long lda, const bf16_t* __restrict__ B, long ldb, int K,
                  f32x16 (&acc)[2][2], bf16_t* sm, float* ssS) {
  const int t = tid(), lane = t & 63, w = t >> 6, wm = w >> 1, wn = w & 1, l31 = lane & 31, h = lane >> 5;
  const int lr = t >> 3, lc = (t & 7) * 8;
  const bf16_t* ap = A + (long)lr * lda + lc;
  const bf16_t* bp = B + (long)lr * ldb + lc;
  bf16_t* wp = sm + lr * LDT + lc;
  const bf16_t* rA = sm + (wm * 64 + l31) * LDT + h * 8;
  const bf16_t* rB = sm + 2 * 128 * LDT + (wn * 64 + l31) * LDT + h * 8;
  u32x4 ra[4], rb[4];
  float ss[4] = {0.f, 0.f, 0.f, 0.f};
  const int nk = K >> 6;
  auto gl = [&](int ko) {
#pragma unroll
    for (int i = 0; i < 4; i++) { ra[i] = *(const u32x4*)(ap + (long)(32 * i) * lda + ko); rb[i] = *(const u32x4*)(bp + (long)(32 * i) * ldb + ko); }
  };
  auto st = [&](auto BUF) {
    constexpr int buf = decltype(BUF)::value;
#pragma unroll
    for (int i = 0; i < 4; i++) {
      *(u32x4*)(wp + buf * 128 * LDT + 32 * i * LDT) = ra[i];
      *(u32x4*)(wp + 2 * 128 * LDT + buf * 128 * LDT + 32 * i * LDT) = rb[i];
      if (SS) { float f[8]; unpack8(ra[i], f);
#pragma unroll
        for (int j = 0; j < 8; j++) ss[i] += f[j] * f[j]; }
    }
  };
  auto comp = [&](auto BUF) {
    constexpr int buf = decltype(BUF)::value;
#pragma unroll
    for (int kk = 0; kk < 4; kk++) {
      bf16x8 af[2], bfr[2];
#pragma unroll
      for (int mb = 0; mb < 2; mb++) af[mb] = *(const bf16x8*)(rA + buf * 128 * LDT + mb * 32 * LDT + kk * 16);
#pragma unroll
      for (int nb = 0; nb < 2; nb++) bfr[nb] = *(const bf16x8*)(rB + buf * 128 * LDT + nb * 32 * LDT + kk * 16);
#pragma unroll
      for (int mb = 0; mb < 2; mb++)
#pragma unroll
        for (int nb = 0; nb < 2; nb++) acc[mb][nb] = MFMA(af[mb], bfr[nb], acc[mb][nb]);
    }
  };
  using B0 = std::integral_constant<int, 0>; using B1 = std::integral_constant<int, 1>;
  gl(0);
  st(B0{});
  gl(64);
  __syncthreads();
  for (int ks = 0; ks < nk; ks += 2) {
    st(B1{});
    __builtin_amdgcn_sched_barrier(0);
    if (ks + 2 < nk) gl((ks + 2) * 64);
    __builtin_amdgcn_sched_barrier(0);
    comp(B0{});
    __syncthreads();
    if (ks + 2 < nk) st(B0{});
    __builtin_amdgcn_sched_barrier(0);
    if (ks + 3 < nk) gl((ks + 3) * 64);
    __builtin_amdgcn_sched_barrier(0);
    comp(B1{});
    __syncthreads();
  }
  if (SS) {
    const float inv = 1.0f / (float)K;
#pragma unroll
    for (int i = 0; i < 4; i++) { float s = sum8(ss[i]); if ((t & 7) == 0) ssS[lr + 32 * i] = rsqrtf(s * inv + EPS); }
  }
}

#define LAS3 __attribute__((address_space(3)))
struct GDesc { const bf16_t* A; long lda; const bf16_t* B; long ldb; };
DI void gemm_dma_stage0(const GDesc& d, char* smc) {
  const int t = tid(), lane = t & 63, w = t >> 6;
  const unsigned wdst = (unsigned)(uintptr_t)smc + (unsigned)w * 4096u;
#pragma unroll
  for (int i = 0; i < 4; i++) {
    const int row = 32 * w + 8 * i + (lane >> 3), c = (lane & 7) ^ ((row >> 1) & 7);
    __builtin_amdgcn_global_load_lds((const unsigned*)(d.A + row * d.lda + c * 8), (LAS3 unsigned*)(uintptr_t)(wdst + i * 1024), 16, 0, 0);
    __builtin_amdgcn_global_load_lds((const unsigned*)(d.B + row * d.ldb + c * 8), (LAS3 unsigned*)(uintptr_t)(wdst + 16384 + i * 1024), 16, 0, 0);
  }
}
DI void gemm_loop_dma(const bf16_t* __restrict__ A, long lda, const bf16_t* __restrict__ B, long ldb, int K, f32x16 (&acc)[2][2], char* smc,
                      bool started = false, bool has_next = false, GDesc next = GDesc{nullptr, 0, nullptr, 0}) {
  const int t = tid(), lane = t & 63, w = t >> 6, wm = w >> 1, wn = w & 1, l31 = lane & 31, h = lane >> 5;
  unsigned aoff[4], boff[4];
#pragma unroll
  for (int i = 0; i < 4; i++) {
    const int row = 32 * w + 8 * i + (lane >> 3), c = (lane & 7) ^ ((row >> 1) & 7);
    aoff[i] = (unsigned)((row * lda + c * 8) * 2); boff[i] = (unsigned)((row * ldb + c * 8) * 2);
  }
  const char* Ab = (const char*)A; const char* Bb = (const char*)B;
  const unsigned lbase = (unsigned)(uintptr_t)smc;
  const unsigned wdst = lbase + (unsigned)w * 4096u;
  const int swz = (l31 >> 1) & 7;
  unsigned fo[4];
#pragma unroll
  for (int kk = 0; kk < 4; kk++) fo[kk] = (unsigned)(((2 * kk + h) ^ swz) * 16);
  const char* rA = smc + (wm * 64 + l31) * 128;
  const char* rB = smc + 16384 + (wn * 64 + l31) * 128;
  const int nk = K >> 6;
  auto issue = [&](auto BUF, int ko) {
    constexpr int buf = decltype(BUF)::value;
#pragma unroll
    for (int i = 0; i < 4; i++) {
      __builtin_amdgcn_global_load_lds((const unsigned*)(Ab + (size_t)ko * 2 + aoff[i]), (LAS3 unsigned*)(uintptr_t)(wdst + buf * 32768 + i * 1024), 16, 0, 0);
      __builtin_amdgcn_global_load_lds((const unsigned*)(Bb + (size_t)ko * 2 + boff[i]), (LAS3 unsigned*)(uintptr_t)(wdst + buf * 32768 + 16384 + i * 1024), 16, 0, 0);
    }
  };
  auto comp = [&](auto BUF) {
    constexpr int buf = decltype(BUF)::value;
#pragma unroll
    for (int kk = 0; kk < 4; kk++) {
      bf16x8 af[2], bfr[2];
#pragma unroll
      for (int mb = 0; mb < 2; mb++) af[mb] = *(const bf16x8*)(rA + buf * 32768 + mb * 32 * 128 + fo[kk]);
#pragma unroll
      for (int nb = 0; nb < 2; nb++) bfr[nb] = *(const bf16x8*)(rB + buf * 32768 + nb * 32 * 128 + fo[kk]);
#pragma unroll
      for (int mb = 0; mb < 2; mb++)
#pragma unroll
        for (int nb = 0; nb < 2; nb++) acc[mb][nb] = MFMA(af[mb], bfr[nb], acc[mb][nb]);
    }
  };
  using B0 = std::integral_constant<int, 0>; using B1 = std::integral_constant<int, 1>;
  if (!started) issue(B0{}, 0);
  __syncthreads();
  for (int ks = 0; ks < nk; ks += 2) {
    issue(B1{}, (ks + 1) * 64);
    __builtin_amdgcn_sched_barrier(0);
    comp(B0{});
    __syncthreads();
    if (ks + 2 < nk) issue(B0{}, (ks + 2) * 64);
    else if (has_next) gemm_dma_stage0(next, smc);
    __builtin_amdgcn_sched_barrier(0);
    comp(B1{});
    __syncthreads();
  }
}

template <int NB>
DI void gemm_loop_dma16(const bf16_t* __restrict__ A, long lda, const bf16_t* __restrict__ B, long ldb, int K, f32x4 (&acc)[4][NB], char* smc,
                      bool started = false, bool has_next = false, GDesc next = GDesc{nullptr, 0, nullptr, 0}) {
  const int t = tid(), lane = t & 63, w = t >> 6, wm = w >> 1, wn = w & 1, r16 = lane & 15, q = lane >> 4;
  unsigned aoff[4], boff[NB];
#pragma unroll
  for (int i = 0; i < 4; i++) {
    const int row = 32 * w + 8 * i + (lane >> 3), c = (lane & 7) ^ ((row >> 1) & 7);
    aoff[i] = (unsigned)((row * lda + c * 8) * 2);
  }
#pragma unroll
  for (int i = 0; i < NB; i++) {
    const int row = 8 * (NB * w + i) + (lane >> 3), c = (lane & 7) ^ ((row >> 1) & 7);
    boff[i] = (unsigned)((row * ldb + c * 8) * 2);
  }
  const char* Ab = (const char*)A; const char* Bb = (const char*)B;
  const unsigned lbase = (unsigned)(uintptr_t)smc;
  const unsigned wdst = lbase + (unsigned)w * 4096u;
  const int swz = (r16 >> 1) & 7;
  unsigned fo[2];
#pragma unroll
  for (int k32 = 0; k32 < 2; k32++) fo[k32] = (unsigned)(((4 * k32 + q) ^ swz) * 16);
  const char* rA = smc + (wm * 64 + r16) * 128;
  const char* rB = smc + 16384 + (wn * 16 * NB + r16) * 128;
  const int nk = K >> 6;
  auto issue = [&](auto BUF, int ko) {
    constexpr int buf = decltype(BUF)::value;
#pragma unroll
    for (int i = 0; i < 4; i++)
      __builtin_amdgcn_global_load_lds((const unsigned*)(Ab + (size_t)ko * 2 + aoff[i]), (LAS3 unsigned*)(uintptr_t)(wdst + buf * 32768 + i * 1024), 16, 0, 0);
#pragma unroll
    for (int i = 0; i < NB; i++)
      __builtin_amdgcn_global_load_lds((const unsigned*)(Bb + (size_t)ko * 2 + boff[i]), (LAS3 unsigned*)(uintptr_t)(lbase + buf * 32768 + 16384 + (NB * w + i) * 1024), 16, 0, 0);
  };
  auto comp = [&](auto BUF) {
    constexpr int buf = decltype(BUF)::value;
#pragma unroll
    for (int k32 = 0; k32 < 2; k32++) {
      bf16x8 af[4], bq[NB];
#pragma unroll
      for (int mb = 0; mb < 4; mb++) af[mb] = *(const bf16x8*)(rA + buf * 32768 + mb * 16 * 128 + fo[k32]);
#pragma unroll
      for (int nb = 0; nb < NB; nb++) bq[nb] = *(const bf16x8*)(rB + buf * 32768 + nb * 16 * 128 + fo[k32]);
#pragma unroll
      for (int mb = 0; mb < 4; mb++)
#pragma unroll
        for (int nb = 0; nb < NB; nb++) acc[mb][nb] = MFMA16(af[mb], bq[nb], acc[mb][nb]);
    }
  };
  using B0 = std::integral_constant<int, 0>; using B1 = std::integral_constant<int, 1>;
  if (!started) issue(B0{}, 0);
  __syncthreads();
  for (int ks = 0; ks < nk; ks += 2) {
    issue(B1{}, (ks + 1) * 64); __builtin_amdgcn_sched_barrier(0);
    comp(B0{});
    __syncthreads();
    if (ks + 2 < nk) issue(B0{}, (ks + 2) * 64);
    else if (has_next) gemm_dma_stage0(next, smc);
    __builtin_amdgcn_sched_barrier(0);
    comp(B1{});
    __syncthreads();
  }
}

DI void gemm_loop_dma2(const bf16_t* __restrict__ A, long lda, const bf16_t* __restrict__ B0, const bf16_t* __restrict__ B1, long ldb, int K,
                       f32x16 (&accP)[2][2], f32x16 (&accQ)[2][2], char* smc) {
  const int t = tid(), lane = t & 63, w = t >> 6, wm = w >> 1, wn = w & 1, l31 = lane & 31, h = lane >> 5;
  unsigned aoff[2], boff[2];
#pragma unroll
  for (int i = 0; i < 2; i++) {
    const int row = 16 * (2 * w + i) + (lane >> 2), c = (lane & 3) ^ ((row >> 2) & 3);
    aoff[i] = (unsigned)((row * lda + c * 8) * 2); boff[i] = (unsigned)((row * ldb + c * 8) * 2);
  }
  const char* Ab = (const char*)A; const char* B0b = (const char*)B0; const char* B1b = (const char*)B1;
  const unsigned wdst = (unsigned)(uintptr_t)smc + (unsigned)w * 2048u;
  const int swz = (l31 >> 2) & 3;
  unsigned fo[2];
#pragma unroll
  for (int kk = 0; kk < 2; kk++) fo[kk] = (unsigned)(((2 * kk + h) ^ swz) * 16);
  const char* rA = smc + (wm * 64 + l31) * 64;
  const char* rB0 = smc + 8192 + (wn * 64 + l31) * 64;
  const char* rB1 = smc + 16384 + (wn * 64 + l31) * 64;
  const int nk = K >> 5;
  auto issue = [&](auto BUF, int ko) {
    constexpr int buf = decltype(BUF)::value;
#pragma unroll
    for (int i = 0; i < 2; i++) {
      __builtin_amdgcn_global_load_lds((const unsigned*)(Ab + (size_t)ko * 2 + aoff[i]), (LAS3 unsigned*)(uintptr_t)(wdst + buf * 24576 + i * 1024), 16, 0, 0);
      __builtin_amdgcn_global_load_lds((const unsigned*)(B0b + (size_t)ko * 2 + boff[i]), (LAS3 unsigned*)(uintptr_t)(wdst + buf * 24576 + 8192 + i * 1024), 16, 0, 0);
      __builtin_amdgcn_global_load_lds((const unsigned*)(B1b + (size_t)ko * 2 + boff[i]), (LAS3 unsigned*)(uintptr_t)(wdst + buf * 24576 + 16384 + i * 1024), 16, 0, 0);
    }
  };
  auto comp = [&](auto BUF) {
    constexpr int buf = decltype(BUF)::value;
#pragma unroll
    for (int kk = 0; kk < 2; kk++) {
      bf16x8 af[2], b0[2], b1[2];
#pragma unroll
      for (int mb = 0; mb < 2; mb++) af[mb] = *(const bf16x8*)(rA + buf * 24576 + mb * 32 * 64 + fo[kk]);
#pragma unroll
      for (int nb = 0; nb < 2; nb++) { b0[nb] = *(const bf16x8*)(rB0 + buf * 24576 + nb * 32 * 64 + fo[kk]); b1[nb] = *(const bf16x8*)(rB1 + buf * 24576 + nb * 32 * 64 + fo[kk]); }
#pragma unroll
      for (int mb = 0; mb < 2; mb++)
#pragma unroll
        for (int nb = 0; nb < 2; nb++) { accP[mb][nb] = MFMA(af[mb], b0[nb], accP[mb][nb]); accQ[mb][nb] = MFMA(af[mb], b1[nb], accQ[mb][nb]); }
    }
  };
  using S0 = std::integral_constant<int, 0>; using S1 = std::integral_constant<int, 1>;
  issue(S0{}, 0);
  __syncthreads();
  for (int ks = 0; ks < nk; ks += 2) {
    issue(S1{}, (ks + 1) * 32);
    __builtin_amdgcn_sched_barrier(0);
    comp(S0{});
    __syncthreads();
    if (ks + 2 < nk) issue(S0{}, (ks + 2) * 32);
    __builtin_amdgcn_sched_barrier(0);
    comp(S1{});
    __syncthreads();
  }
}

DI void acc_to_lds(const f32x16 (&acc)[2][2], float* ep) {
  const int t = tid(), lane = t & 63, w = t >> 6, wm = w >> 1, wn = w & 1, l31 = lane & 31, h = lane >> 5;
#pragma unroll
  for (int mb = 0; mb < 2; mb++)
#pragma unroll
    for (int nb = 0; nb < 2; nb++)
#pragma unroll
      for (int i = 0; i < 16; i++) ep[(wm * 64 + mb * 32 + crow(i, h)) * EPW + wn * 64 + nb * 32 + l31] = acc[mb][nb][i];
}
template <int NB>
DI void acc_to_lds4(const f32x4 (&acc)[4][NB], float* ep) {
  const int t = tid(), lane = t & 63, w = t >> 6, wm = w >> 1, wn = w & 1, r16 = lane & 15, q = lane >> 4;
#pragma unroll
  for (int mb = 0; mb < 4; mb++)
#pragma unroll
    for (int nb = 0; nb < NB; nb++) {
      float* d = ep + (wm * 64 + mb * 16 + q * 4) * EPW + wn * 16 * NB + nb * 16 + r16;
      d[0] = acc[mb][nb].x; d[EPW] = acc[mb][nb].y; d[2 * EPW] = acc[mb][nb].z; d[3 * EPW] = acc[mb][nb].w;
    }
}
template <class F>
DI void rowwise(const float* ep, F f) {
  const int t = tid();
#pragma unroll 1
  for (int ps = 0; ps < 8; ps++) {
    const int row = ps * 16 + (t >> 4), c8 = (t & 15) * 8;
    float v[8];
    const f32x4 a = *(const f32x4*)(ep + row * EPW + c8), b = *(const f32x4*)(ep + row * EPW + c8 + 4);
    v[0] = a.x; v[1] = a.y; v[2] = a.z; v[3] = a.w; v[4] = b.x; v[5] = b.y; v[6] = b.z; v[7] = b.w;
    f(row, c8, v);
  }
}
template <class L, class F>
DI void rowwise2(const float* ep, L pre, F f) {
  const int t = tid();
  const int c8 = (t & 15) * 8;
#pragma unroll 1
  for (int g = 0; g < 2; g++) {
    decltype(pre(0, 0)) ld[4];
#pragma unroll
    for (int q = 0; q < 4; q++) ld[q] = pre((g * 4 + q) * 16 + (t >> 4), c8);
#pragma unroll
    for (int q = 0; q < 4; q++) {
      const int row = (g * 4 + q) * 16 + (t >> 4);
      float v[8];
      const f32x4 a = *(const f32x4*)(ep + row * EPW + c8), b = *(const f32x4*)(ep + row * EPW + c8 + 4);
      v[0] = a.x; v[1] = a.y; v[2] = a.z; v[3] = a.w; v[4] = b.x; v[5] = b.y; v[6] = b.z; v[7] = b.w;
      f(row, c8, v, ld[q]);
    }
  }
}
struct LdRope { f32x4 r[4]; };
struct LdKv { unsigned k2; u32x4 x1, x2; f32x4 r[4]; };
struct LdX { f32x4 a, b; };
struct LdGlu { u32x4 yg, gt; };
template <class F>
DI void tstore(const float* ep, int cb, int nc, const float* rowscale, F dst) {
  const int t = tid();
  const int ntask = nc * 16;
  for (int e = t; e < ntask; e += 256) {
    const int col = e % nc, rg = e / nc;
    float v[8];
#pragma unroll
    for (int j = 0; j < 8; j++) { float x = ep[(rg * 8 + j) * EPW + cb + col]; if (rowscale) x *= rowscale[rg * 8 + j]; v[j] = x; }
    *(u32x4*)(dst(col) + rg * 8) = pack8(v);
  }
}

DI void tile_from_linear(int L, int nN, int& tm, int& tn) { const int band = L / (8 * nN), rr = L % (8 * nN); tn = rr >> 3; tm = band * 8 + (rr & 7); }
DI int static_L(int round, int vb) { const int Gx = gridDim.x >> 3; return (round * 8 + (vb & 7)) * Gx + (vb >> 3); }
DI int next_item(unsigned* ctr, int* slot) {
  __syncthreads();
  if (threadIdx.x == 0) *slot = (int)atomicAdd(ctr, 1u);
  __syncthreads();
  return *slot;
}

DI int colmap(int mode, int n) {
  if (mode == 0) return n;
  if (mode == 1) { if (n < 768) return n; if (n < 2304) return n + 1056; if (n < 3360) return n - 1536; if (n < 3456) return -1; return n - 96; }
  { const int hh = n >> 7, j = n & 127; return j < 96 ? hh * 96 + j : -1; }
}
struct CDesc { const float* src; const float* g; bf16_t* dst; int ld, K, mode, it; };
DI void conv_load(const CDesc& d, f32x4 (&v)[8]) {
  const int t = tid();
  const int nkt = d.K >> 6, kt = d.it % nkt, nt = d.it / nkt, k0 = kt * 64, n0 = nt * 128;
  const int n4 = (t & 31) * 4, c = colmap(d.mode, n0 + n4);
#pragma unroll
  for (int i = 0; i < 8; i++) {
    const int kk = (t >> 5) + 8 * i;
    if (c >= 0) v[i] = __builtin_nontemporal_load((const f32x4*)(d.src + (long)(k0 + kk) * d.ld + c)); else { v[i].x = 0.f; v[i].y = 0.f; v[i].z = 0.f; v[i].w = 0.f; }
  }
}
DI void conv_finish(const CDesc& d, f32x4 (&v)[8], float* sm) {
  const int t = tid();
  const int nkt = d.K >> 6, kt = d.it % nkt, nt = d.it / nkt, k0 = kt * 64, n0 = nt * 128;
  const int n4 = (t & 31) * 4;
#pragma unroll
  for (int i = 0; i < 8; i++) {
    const int kk = (t >> 5) + 8 * i;
    if (d.g) { const float gg = d.g[k0 + kk]; v[i].x *= gg; v[i].y *= gg; v[i].z *= gg; v[i].w *= gg; }
    *(f32x4*)(sm + kk * 132 + n4) = v[i];
  }
  __syncthreads();
#pragma unroll
  for (int i = 0; i < 2; i++) {
    const int nn = (t >> 2) + 64 * i, ks = (t & 3) * 16;
    float f[16];
#pragma unroll
    for (int j = 0; j < 16; j++) f[j] = sm[(ks + j) * 132 + nn];
    u32x4 o0, o1;
    o0.x = pk2(f[0], f[1]); o0.y = pk2(f[2], f[3]); o0.z = pk2(f[4], f[5]); o0.w = pk2(f[6], f[7]);
    o1.x = pk2(f[8], f[9]); o1.y = pk2(f[10], f[11]); o1.z = pk2(f[12], f[13]); o1.w = pk2(f[14], f[15]);
    bf16_t* dd = d.dst + (long)(n0 + nn) * d.K + k0 + ks;
    *(u32x4*)dd = o0; *(u32x4*)(dd + 8) = o1;
  }
  __syncthreads();
}
constexpr int NCONV = 944 + 72 + 32 + 8 + 32 + 64 + 32 + 32 + 128 + 64;
constexpr int NAUX = NCONV + 512;
DI CDesc conv_desc(const P& p, int l, int it) {
  CDesc d; d.g = nullptr; d.mode = 0;
  if (it < 944) { d.src = p.w_in + (long)l * 1024 * INW; d.ld = INW; d.K = 1024; d.mode = 1; d.g = p.norm_g + l * 1024; d.dst = p.WinT; d.it = it; return d; }
  it -= 944;
  if (it < 72) { d.src = p.b_w_uq + (long)l * 768 * 768; d.ld = 768; d.K = 768; d.g = p.b_q_norm_g + l * 768; d.dst = p.WuqT; d.it = it; return d; }
  it -= 72;
  if (it < 32) { d.src = p.b_w_ukv + (long)l * 256 * 1024; d.ld = 1024; d.K = 256; d.g = p.b_kv_norm_g + l * 256; d.dst = p.WukvT; d.it = it; return d; }
  it -= 32;
  if (it < 8) { d.src = p.c_w_glu + (long)l * 256 * 256; d.ld = 256; d.K = 256; d.dst = p.WgluT; d.it = it; return d; }
  it -= 8;
  if (it < 32) { d.src = p.w_br_a + (long)l * 256 * 1024; d.ld = 1024; d.K = 256; d.dst = p.WbrT; d.it = it; return d; }
  it -= 32;
  if (it < 64) { d.src = p.w_br_b + (long)l * 512 * 1024; d.ld = 1024; d.K = 512; d.dst = p.WbrT + 1024 * 256; d.it = it; return d; }
  it -= 64;
  if (it < 32) { d.src = p.w_br_c + (long)l * 256 * 1024; d.ld = 1024; d.K = 256; d.dst = p.WbrT + 1024 * 768; d.it = it; return d; }
  it -= 32;
  if (it < 32) { d.src = p.w_br_m + (long)l * 256 * 1024; d.ld = 1024; d.K = 256; d.dst = p.WbrT + 1024 * 1024; d.it = it; return d; }
  it -= 32;
  if (it < 128) { d.src = p.w_out + (long)l * 1024 * 1024; d.ld = 1024; d.K = 1024; d.dst = p.WoutT + (long)l * 1024 * 1024; d.it = it; return d; }
  it -= 128;
  d.src = p.m_w_kv + (long)l * 1024 * 512; d.ld = 512; d.K = 1024; d.dst = p.WmkvT; d.it = it; return d;
}
DI void conv_all(const P& p, int l, char* smem) {
  const int G = gridDim.x, bid = blockIdx.x;
  float* sm = (float*)smem;
  if (bid >= NCONV) return;
  f32x4 va[8], vb[8];
  CDesc da = conv_desc(p, l, bid), db = da;
  conv_load(da, va);
#pragma unroll 1
  for (int it = bid; it < NCONV; it += 2 * G) {
    const bool h1 = it + G < NCONV;
    if (h1) { db = conv_desc(p, l, it + G); conv_load(db, vb); }
    conv_finish(da, va, sm);
    const bool h2 = it + 2 * G < NCONV;
    if (h2) { da = conv_desc(p, l, it + 2 * G); conv_load(da, va); }
    if (h1) conv_finish(db, vb, sm);
  }
}
DI void aux_item(const P& p, int l, int it, char* smem) {
  it -= NCONV;
  {
    const int t = tid(), lane = t & 63, row = it * 4 + (t >> 6);
    const float* src = p.mem + (long)row * 1024; const float* g = p.m_norm_g + l * 1024;
    f32x4 v[4]; float ss = 0.f;
#pragma unroll
    for (int i = 0; i < 4; i++) { v[i] = *(const f32x4*)(src + (lane + 64 * i) * 4); ss += v[i].x * v[i].x + v[i].y * v[i].y + v[i].z * v[i].z + v[i].w * v[i].w; }
    ss = sum64(ss);
    const float r = rsqrtf(ss * (1.f / 1024.f) + EPS);
#pragma unroll
    for (int i = 0; i < 4; i++) {
      const f32x4 gg = *(const f32x4*)(g + (lane + 64 * i) * 4);
      u32x2 o; o.x = pk2(v[i].x * r * gg.x, v[i].y * r * gg.y); o.y = pk2(v[i].z * r * gg.z, v[i].w * r * gg.w);
      *(u32x2*)(p.hm + (long)row * 1024 + (lane + 64 * i) * 4) = o;
    }
  }
}

DI void p0_xrow_item(const P& p, int it) {
  const int t = tid(), lane = t & 63;
  f32x4 v[2][4];
#pragma unroll
  for (int r = 0; r < 2; r++) {
    const float* src = p.x + (long)(it * 8 + (t >> 6) * 2 + r) * 1024;
#pragma unroll
    for (int i = 0; i < 4; i++) v[r][i] = __builtin_nontemporal_load((const f32x4*)(src + (lane + 64 * i) * 4));
  }
#pragma unroll
  for (int r = 0; r < 2; r++) {
    const int row = it * 8 + (t >> 6) * 2 + r;
    float ss = 0.f;
#pragma unroll
    for (int i = 0; i < 4; i++) ss += v[r][i].x * v[r][i].x + v[r][i].y * v[r][i].y + v[r][i].z * v[r][i].z + v[r][i].w * v[r][i].w;
    ss = sum64(ss);
#pragma unroll
    for (int i = 0; i < 4; i++) { u32x2 o; o.x = pk2(v[r][i].x, v[r][i].y); o.y = pk2(v[r][i].z, v[r][i].w); *(u32x2*)(p.xb + (long)row * 1024 + (lane + 64 * i) * 4) = o; }
    if (lane < 8) p.ssp[(long)lane * T_ + row] = (lane == 0) ? ss : 0.f;
  }
}
DI void p0_rope_item(const P& p, int it) {
  const int e = it * 256 + threadIdx.x, tok = e >> 4, i = e & 15;
  const float inv_freq = exp2f(-(float)i * (13.287712379549449f / 16.f));
  const float ang = (float)p.pos[tok] * inv_freq;
  const double rev = (double)ang * 0.15915494309189535;
  const float fr = (float)(rev - rint(rev));
  p.rope[(long)e * 2] = __builtin_amdgcn_cosf(fr);
  p.rope[(long)e * 2 + 1] = __builtin_amdgcn_sinf(fr);
}

DI void load_rs(const P& p, int r0, float* rsS) {
  const int t = tid();
  if (t < 128) { float s = 0.f;
#pragma unroll
    for (int j = 0; j < 8; j++) s += p.ssp[(long)j * T_ + r0 + t];
    rsS[t] = rsqrtf(s * (1.f / 1024.f) + EPS); }
}
DI void g1_tile(const P& p, int l, int tm, int tn, char* smem) {
  bf16_t* sm = (bf16_t*)smem; float* ep = (float*)smem; float* rsS = (float*)(smem + SM_RS);
  const int r0 = tm * 128, c0 = tn * 128;
  load_rs(p, r0, rsS);
  f32x16 acc[2][2]; zero_acc(acc);
  gemm_loop_dma(p.xb + (long)r0 * 1024, 1024, p.WinT + (long)c0 * 1024, 1024, 1024, acc, smem);
  acc_to_lds(acc, ep);
  __syncthreads();
  int type; bf16_t* dst; int ld;
  if (c0 < 2304) { dst = p.z1 + c0; ld = Z1W;
    if (c0 < 512) type = 1; else if (c0 < 1280) type = 2; else if (c0 < 1536) type = 0; else if (c0 < 1792) type = 2; else if (c0 < 2048) type = 3; else type = 2;
  } else { dst = p.z2 + (c0 - 2304); ld = Z2W; type = 0; }
  const float* gq = p.m_qk_g_q + l * 64;
  rowwise(ep, [&](int row, int c8, float (&v)[8]) {
    const float r = rsS[row];
#pragma unroll
    for (int j = 0; j < 8; j++) v[j] *= r;
    if (type == 1) {
#pragma unroll
      for (int j = 0; j < 8; j++) v[j] = gelu_t(v[j]);
    } else if (type == 2) {
#pragma unroll
      for (int j = 0; j < 8; j++) v[j] = silu(v[j]);
    } else if (type == 3) {
      float ss = 0.f;
#pragma unroll
      for (int j = 0; j < 8; j++) ss += v[j] * v[j];
      ss = sum8(ss);
      const float rq = rsqrtf(ss * (1.f / 64.f) + EPS) * (0.125f * LOG2E);
#pragma unroll
      for (int j = 0; j < 8; j++) v[j] *= rq * gq[(c8 & 63) + j];
    }
    *(u32x4*)(dst + (long)(r0 + row) * ld + c8) = pack8(v);
    if (c0 >= 2304) {
      float ss = 0.f;
#pragma unroll
      for (int j = 0; j < 8; j++) ss += v[j] * v[j];
      ss = sum16(ss);
      if ((c8 >> 3) == 0) p.ssq[(long)((c0 - 2304) >> 7) * T_ + r0 + row] = ss;
    }
  });
  __syncthreads();
}
DI void g1_tile2(const P& p, int l, int tm, int tn, char* smem) {
  float* ep = (float*)smem; float* rsS = (float*)(smem + SM_RS);
  const int r0 = tm * 128;
  load_rs(p, r0, rsS);
  f32x16 accP[2][2], accQ[2][2]; zero_acc(accP); zero_acc(accQ);
  const bf16_t* w0 = p.WinT + (long)(tn * 128) * 1024;
  gemm_loop_dma2(p.xb + (long)r0 * 1024, 1024, w0, w0 + (long)128 * 1024, 1024, 1024, accP, accQ, smem);
  auto epi = [&](const f32x16 (&acc)[2][2], int tnn) {
    const int c0 = tnn * 128;
    acc_to_lds(acc, ep);
    __syncthreads();
    int type; bf16_t* dst; int ld;
    if (c0 < 2304) { dst = p.z1 + c0; ld = Z1W;
      if (c0 < 512) type = 1; else if (c0 < 1280) type = 2; else if (c0 < 1536) type = 0; else if (c0 < 1792) type = 2; else if (c0 < 2048) type = 3; else type = 2;
    } else { dst = p.z2 + (c0 - 2304); ld = Z2W; type = 0; }
    const float* gq = p.m_qk_g_q + l * 64;
    rowwise(ep, [&](int row, int c8, float (&v)[8]) {
      const float r = rsS[row];
#pragma unroll
      for (int j = 0; j < 8; j++) v[j] *= r;
      if (type == 1) {
#pragma unroll
        for (int j = 0; j < 8; j++) v[j] = gelu_t(v[j]);
      } else if (type == 2) {
#pragma unroll
        for (int j = 0; j < 8; j++) v[j] = silu(v[j]);
      } else if (type == 3) {
        float ss = 0.f;
#pragma unroll
        for (int j = 0; j < 8; j++) ss += v[j] * v[j];
        ss = sum8(ss);
        const float rq = rsqrtf(ss * (1.f / 64.f) + EPS) * (0.125f * LOG2E);
#pragma unroll
        for (int j = 0; j < 8; j++) v[j] *= rq * gq[(c8 & 63) + j];
      }
      *(u32x4*)(dst + (long)(r0 + row) * ld + c8) = pack8(v);
      if (c0 >= 2304) {
        float ss = 0.f;
#pragma unroll
        for (int j = 0; j < 8; j++) ss += v[j] * v[j];
        ss = sum16(ss);
        if ((c8 >> 3) == 0) p.ssq[(long)((c0 - 2304) >> 7) * T_ + r0 + row] = ss;
      }
    });
    __syncthreads();
  };
  epi(accP, tn);
  epi(accQ, tn + 1);
}
DI void g1m_tile(const P& p, int l, int tm, int tn, char* smem) {
  bf16_t* sm = (bf16_t*)smem; float* ep = (float*)smem;
  const int r0 = tm * 128, c0 = tn * 128;
  f32x16 acc[2][2]; zero_acc(acc);
  gemm_loop_dma(p.hm + (long)r0 * 1024, 1024, p.WmkvT + (long)c0 * 1024, 1024, 1024, acc, smem);
  acc_to_lds(acc, ep);
  __syncthreads();
  if (tn < 2) {
    const float* gk = p.m_qk_g_k + l * 64;
    rowwise(ep, [&](int row, int c8, float (&v)[8]) {
      float ss = 0.f;
#pragma unroll
      for (int j = 0; j < 8; j++) ss += v[j] * v[j];
      ss = sum8(ss);
      const float rq = rsqrtf(ss * (1.f / 64.f) + EPS);
#pragma unroll
      for (int j = 0; j < 8; j++) v[j] *= rq * gk[(c8 & 63) + j];
      *(u32x4*)(p.memk + (long)(r0 + row) * 256 + c0 + c8) = pack8(v);
    });
  } else {
    const int b = r0 >> 8, m0 = r0 & 255, cv0 = c0 - 256;
    tstore(ep, 0, 128, nullptr, [&](int col) { const int cv = cv0 + col; return p.memvt + ((long)((b * 4 + (cv >> 6)) * 64 + (cv & 63))) * 256 + m0; });
  }
  __syncthreads();
}

DI void g2q_tile(const P& p, int l, int tm, int hh, char* smem) {
  bf16_t* sm = (bf16_t*)smem; float* ep = (float*)smem; float* ssS = (float*)(smem + SM_SS);
  const int r0 = tm * 128;
  f32x4 acc[4][3]; zero_acc4<3>(acc);
  { const int t = tid(); if (t < 128) { float q = 0.f;
#pragma unroll
      for (int j = 0; j < 6; j++) q += p.ssq[(long)j * T_ + r0 + t];
      ssS[t] = rsqrtf(q * (1.f / 768.f) + EPS); } }
  gemm_loop_dma16<3>(p.z2 + (long)r0 * Z2W, Z2W, p.WuqT + (long)hh * 96 * 768, 768, 768, acc, smem);
  acc_to_lds4<3>(acc, ep);
  __syncthreads();
  const float* gq = p.b_qk_g_q + l * 96;
  const float QSC = 0.10206207261596575f * LOG2E;
  rowwise2(ep, [&](int row, int c8) {
    LdRope L;
    const int tc = c8 >> 3;
    if (tc >= 8 && tc < 12) {
      const float* rp = p.rope + ((long)(r0 + row) * 16 + (tc & 1) * 8) * 2;
#pragma unroll
      for (int j = 0; j < 4; j++) L.r[j] = *(const f32x4*)(rp + 4 * j);
    } else {
#pragma unroll
      for (int j = 0; j < 4; j++) { L.r[j].x = 0.f; L.r[j].y = 0.f; L.r[j].z = 0.f; L.r[j].w = 0.f; }
    }
    return L;
  }, [&](int row, int c8, float (&v)[8], const LdRope& L) {
    const float rs = ssS[row];
    float ss = 0.f;
#pragma unroll
    for (int j = 0; j < 8; j++) { v[j] *= rs; ss += v[j] * v[j]; }
    const int tc = c8 >> 3;
    if (tc >= 12) ss = 0.f;
    ss = sum16(ss);
    const float rq = rsqrtf(ss * (1.f / 96.f) + EPS);
    bf16_t* qd = p.qf + (long)(r0 + row) * 768 + hh * 96;
    if (tc < 8) {
#pragma unroll
      for (int j = 0; j < 8; j++) v[j] *= rq * gq[c8 + j] * QSC;
      *(u32x4*)(qd + c8) = pack8(v);
    } else if (tc < 12) {
      const int i0 = (tc & 1) * 8; const bool first = tc < 10;
      const int pc = first ? 80 + i0 : 64 + i0;
      const float csn[16] = {L.r[0].x, L.r[0].y, L.r[0].z, L.r[0].w, L.r[1].x, L.r[1].y, L.r[1].z, L.r[1].w,
                             L.r[2].x, L.r[2].y, L.r[2].z, L.r[2].w, L.r[3].x, L.r[3].y, L.r[3].z, L.r[3].w};
      float o[8];
#pragma unroll
      for (int j = 0; j < 8; j++) {
        const float own = v[j] * rq * gq[c8 + j];
        const float oth = ep[row * EPW + pc + j] * rs * rq * gq[pc + j];
        const float cs = csn[2 * j], sn = csn[2 * j + 1];
        o[j] = (first ? (own * cs - oth * sn) : (own * cs + oth * sn)) * QSC;
      }
      *(u32x4*)(qd + c8) = pack8(o);
    }
  });
  __syncthreads();
}
DI void g2kv_tile(const P& p, int l, int tm, int hh, char* smem) {
  bf16_t* sm = (bf16_t*)smem; float* ep = (float*)smem; float* ssS = (float*)(smem + SM_SS);
  const int r0 = tm * 128;
  f32x16 acc[2][2]; zero_acc(acc);
  { const int t = tid(); if (t < 128) { const float q = p.ssq[(long)6 * T_ + r0 + t] + p.ssq[(long)7 * T_ + r0 + t];
      ssS[t] = rsqrtf(q * (1.f / 256.f) + EPS); } }
  gemm_loop_dma(p.z2 + (long)r0 * Z2W + 768, Z2W, p.WukvT + (long)hh * 128 * 256, 256, 256, acc, smem);
  acc_to_lds(acc, ep);
  __syncthreads();
  const float* gk = p.b_qk_g_k + l * 96;
  rowwise2(ep, [&](int row, int c8) {
    LdKv L;
    const int tc = c8 >> 3;
    const bf16_t* krp = p.z2 + (long)(r0 + row) * Z2W + 1024;
    L.k2 = *(const unsigned*)(krp + 2 * tc);
    if (tc >= 8 && tc < 12) {
      const int i0 = (tc & 1) * 8;
      L.x1 = *(const u32x4*)(krp + i0); L.x2 = *(const u32x4*)(krp + 16 + i0);
      const float* rp = p.rope + ((long)(r0 + row) * 16 + i0) * 2;
#pragma unroll
      for (int j = 0; j < 4; j++) L.r[j] = *(const f32x4*)(rp + 4 * j);
    } else {
      L.x1.x = 0; L.x1.y = 0; L.x1.z = 0; L.x1.w = 0; L.x2 = L.x1;
#pragma unroll
      for (int j = 0; j < 4; j++) { L.r[j].x = 0.f; L.r[j].y = 0.f; L.r[j].z = 0.f; L.r[j].w = 0.f; }
    }
    return L;
  }, [&](int row, int c8, float (&v)[8], const LdKv& L) {
    const float rs = ssS[row];
    const int tc = c8 >> 3;
    const unsigned k2 = L.k2;
    const float ka = __uint_as_float(k2 << 16), kb = __uint_as_float(k2 & 0xffff0000u);
    float ss = ka * ka + kb * kb;
    if (tc < 8) {
#pragma unroll
      for (int j = 0; j < 8; j++) { v[j] *= rs; ss += v[j] * v[j]; }
    }
    ss = sum16(ss);
    const float kn = rsqrtf(ss * (1.f / 96.f) + EPS);
    bf16_t* kd = p.kf + (long)(r0 + row) * 768 + hh * 96;
    if (tc < 8) {
#pragma unroll
      for (int j = 0; j < 8; j++) v[j] *= kn * gk[c8 + j];
      *(u32x4*)(kd + c8) = pack8(v);
    } else if (tc < 12) {
      const int i0 = (tc & 1) * 8; const bool first = tc < 10;
      float x1[8], x2[8], o[8];
      unpack8(L.x1, x1);
      unpack8(L.x2, x2);
      const float csn[16] = {L.r[0].x, L.r[0].y, L.r[0].z, L.r[0].w, L.r[1].x, L.r[1].y, L.r[1].z, L.r[1].w,
                             L.r[2].x, L.r[2].y, L.r[2].z, L.r[2].w, L.r[3].x, L.r[3].y, L.r[3].z, L.r[3].w};
#pragma unroll
      for (int j = 0; j < 8; j++) {
        const float a = x1[j] * kn * gk[64 + i0 + j], b = x2[j] * kn * gk[80 + i0 + j];
        const float cs = csn[2 * j], sn = csn[2 * j + 1];
        o[j] = first ? (a * cs - b * sn) : (b * cs + a * sn);
      }
      *(u32x4*)(kd + (first ? 64 : 80) + i0) = pack8(o);
    }
  });
  {
    const int b = r0 >> 11, s0 = r0 & 2047;
    tstore(ep, 64, 64, ssS, [&](int col) { return p.vt + ((long)((b * 8 + hh) * 64 + col)) * S_ + s0; });
  }
  __syncthreads();
}

template <int DQK, bool CAUSAL>
DI void attn_item(const bf16_t* __restrict__ q, long q_ld, const bf16_t* __restrict__ k, long k_ld, const bf16_t* __restrict__ vt, long vt_ld,
                  bf16_t* og, long o_ld, int q0, int nkt, char* smem, bool dry) {
  constexpr int KS = DQK + 8, NKC = DQK / 8, NKL = (64 * NKC) / 256, NKK = DQK / 16, VS = 68;
  bf16_t* sK = (bf16_t*)smem;
  bf16_t* sV = (bf16_t*)smem + 2 * 64 * KS;
  const int t = tid(), lane = t & 63, w = t >> 6, l31 = lane & 31, h = lane >> 5;
  bf16x8 qfr[NKK];
  {
    const bf16_t* qp = q + (long)(w * 32 + l31) * q_ld + h * 8;
#pragma unroll
    for (int kk = 0; kk < NKK; kk++) qfr[kk] = *(const bf16x8*)(qp + kk * 16);
  }
  u32x4 rk[NKL], rv[2];
  auto gload = [&](int kt) {
#pragma unroll
    for (int i = 0; i < NKL; i++) { const int c = t + 256 * i, key = c / NKC, kc = c % NKC; rk[i] = *(const u32x4*)(k + (long)(kt * 64 + key) * k_ld + kc * 8); }
#pragma unroll
    for (int i = 0; i < 2; i++) { const int c = t + 256 * i, d = c >> 3, kc = c & 7; rv[i] = *(const u32x4*)(vt + (long)d * vt_ld + kt * 64 + kc * 8); }
  };
  auto lstore = [&](int buf) {
    bf16_t* dK = sK + buf * 64 * KS; bf16_t* dV = sV + buf * 64 * VS;
#pragma unroll
    for (int i = 0; i < NKL; i++) { const int c = t + 256 * i, key = c / NKC, kc = c % NKC; *(u32x4*)(dK + key * KS + kc * 8) = rk[i]; }
#pragma unroll
    for (int i = 0; i < 2; i++) { const int c = t + 256 * i, d = c >> 3, kc = c & 7;
      u32x2 lo, hi; lo.x = rv[i].x; lo.y = rv[i].y; hi.x = rv[i].z; hi.y = rv[i].w;
      *(u32x2*)(dV + d * VS + kc * 8) = lo; *(u32x2*)(dV + d * VS + kc * 8 + 4) = hi; }
  };
  f32x16 o[2];
#pragma unroll
  for (int i = 0; i < 16; i++) { o[0][i] = 0.f; o[1][i] = 0.f; }
  float m = -1e30f, lsum = 0.f;
  const int qpos = q0 + w * 32 + l31;
  gload(0); lstore(0);
  if (nkt > 1) gload(1);
  __syncthreads();
  for (int kt = 0; kt < nkt; kt++) {
    if (kt + 1 < nkt) lstore((kt + 1) & 1);
    __builtin_amdgcn_sched_barrier(0);
    if (kt + 2 < nkt) gload(kt + 2);
    __builtin_amdgcn_sched_barrier(0);
    const bool active = !CAUSAL || (kt * 64 <= q0 + w * 32 + 31);
    if (active) {
      const bf16_t* cK = sK + (kt & 1) * 64 * KS; const bf16_t* cV = sV + (kt & 1) * 64 * VS;
      f32x16 s[2];
#pragma unroll
      for (int i = 0; i < 16; i++) { s[0][i] = 0.f; s[1][i] = 0.f; }
      __builtin_amdgcn_s_setprio(1);
#pragma unroll
      for (int kb = 0; kb < 2; kb++)
#pragma unroll
        for (int kk = 0; kk < NKK; kk++) {
          const bf16x8 kf_ = *(const bf16x8*)(cK + (kb * 32 + l31) * KS + kk * 16 + h * 8);
          s[kb] = MFMA(kf_, qfr[kk], s[kb]);
        }
      __builtin_amdgcn_s_setprio(0);
      if (CAUSAL && (kt * 64 + 63 > q0 + w * 32)) {
#pragma unroll
        for (int kb = 0; kb < 2; kb++)
#pragma unroll
          for (int i = 0; i < 16; i++) { const int key = kt * 64 + kb * 32 + crow(i, h); if (key > qpos) s[kb][i] = -1e30f; }
      }
      float mx = s[0][0];
#pragma unroll
      for (int kb = 0; kb < 2; kb++)
#pragma unroll
        for (int i = 0; i < 16; i++) mx = fmaxf(mx, s[kb][i]);
      mx = fmaxf(mx, __shfl_xor(mx, 32));
      const float mnew = fmaxf(m, mx);
      const float alpha = __builtin_amdgcn_exp2f(m - mnew);
      m = mnew;
      float ps = 0.f;
#pragma unroll
      for (int kb = 0; kb < 2; kb++)
#pragma unroll
        for (int i = 0; i < 16; i++) { const float pv = __builtin_amdgcn_exp2f(s[kb][i] - mnew); s[kb][i] = pv; ps += pv; }
      lsum = lsum * alpha + ps;
#pragma unroll
      for (int i = 0; i < 16; i++) { o[0][i] *= alpha; o[1][i] *= alpha; }
      __builtin_amdgcn_s_setprio(1);
#pragma unroll
      for (int kb = 0; kb < 2; kb++)
#pragma unroll
        for (int st = 0; st < 2; st++) {
          u32x4 pp; pp.x = pk2(s[kb][8 * st + 0], s[kb][8 * st + 1]); pp.y = pk2(s[kb][8 * st + 2], s[kb][8 * st + 3]);
          pp.z = pk2(s[kb][8 * st + 4], s[kb][8 * st + 5]); pp.w = pk2(s[kb][8 * st + 6], s[kb][8 * st + 7]);
          const bf16x8 pf = __builtin_bit_cast(bf16x8, pp);
#pragma unroll
          for (int db = 0; db < 2; db++) {
            const bf16_t* vp = cV + (db * 32 + l31) * VS + kb * 32 + st * 16 + 4 * h;
            const u32x2 lo = *(const u32x2*)vp, hi = *(const u32x2*)(vp + 8);
            u32x4 vv; vv.x = lo.x; vv.y = lo.y; vv.z = hi.x; vv.w = hi.y;
            o[db] = MFMA(__builtin_bit_cast(bf16x8, vv), pf, o[db]);
          }
        }
      __builtin_amdgcn_s_setprio(0);
    }
    __syncthreads();
  }
  lsum += __shfl_xor(lsum, 32);
  const float inv = 1.f / lsum;
  bf16_t* op = og + (long)(w * 32 + l31) * o_ld;
#pragma unroll
  for (int db = 0; db < 2; db++)
#pragma unroll
    for (int ig = 0; ig < 4; ig++) {
      const int d = db * 32 + ig * 8 + 4 * h;
      float gt[4]; unpack4(*(const u32x2*)(op + d), gt);
      u32x2 r; r.x = pk2(o[db][4 * ig + 0] * inv * gt[0], o[db][4 * ig + 1] * inv * gt[1]); r.y = pk2(o[db][4 * ig + 2] * inv * gt[2], o[db][4 * ig + 3] * inv * gt[3]);
      if (!dry) *(u32x2*)(op + d) = r;
    }
}
DI void mattn_item(const P& p, int idx, char* smem) {
  const int b = idx >> 6, hh = (idx >> 4) & 3, qt = idx & 15;
  const long tok0 = (long)b * S_ + qt * 128;
  attn_item<64, false>(p.z1 + tok0 * Z1W + 1792 + hh * 64, Z1W, p.memk + (long)b * 256 * 256 + hh * 64, 256,
                       p.memvt + (long)(b * 4 + hh) * 64 * 256, 256, p.z1 + tok0 * Z1W + 2048 + hh * 64, Z1W, 0, 4, smem, p.dry != 0);
}
DI void battn_item(const P& p, int idx, char* smem) {
  const int qt = 15 - (idx >> 6), bh = idx & 63, b = bh >> 3, hh = bh & 7;
  const long tok0 = (long)b * S_ + qt * 128;
  attn_item<96, true>(p.qf + tok0 * 768 + hh * 96, 768, p.kf + (long)b * S_ * 768 + hh * 96, 768,
                      p.vt + (long)(b * 8 + hh) * 64 * S_, S_, p.z1 + tok0 * Z1W + 768 + hh * 64, Z1W, qt * 128, 2 * qt + 2, smem, p.dry != 0);
}

DI void a_item(const P& p, int l, int idx, char* smem) {
  bf16_t* vnT = (bf16_t*)smem;
  float* part = (float*)(smem + 256 * 136 * 2);
  const int t = tid(); const long r0 = (long)idx * 128;
  {
    const int row = t & 127, half = t >> 7;
    const bf16_t* src = p.z1 + (r0 + row) * Z1W + 256 + half * 128;
    float ss = 0.f;
#pragma unroll 4
    for (int i = 0; i < 16; i++) { float f[8]; unpack8(*(const u32x4*)(src + i * 8), f);
#pragma unroll
      for (int j = 0; j < 8; j++) ss += f[j] * f[j]; }
    part[half * 128 + row] = ss;
    __syncthreads();
    const float r = rsqrtf((part[row] + part[128 + row]) * (1.f / 256.f) + EPS);
    const float* gv = p.a_norm_g + l * 256 + half * 128;
#pragma unroll 4
    for (int i = 0; i < 16; i++) { float f[8]; unpack8(*(const u32x4*)(src + i * 8), f);
#pragma unroll
      for (int j = 0; j < 8; j++) vnT[(half * 128 + i * 8 + j) * 136 + row] = f2bf(f[j] * r * gv[i * 8 + j]); }
  }
  __syncthreads();
  const int lane = t & 63, g = t >> 6, l31 = lane & 31, h = lane >> 5;
  const float* W = p.a_w_s + (long)(l * 4 + g) * 128 * 128;
  const float* bs = p.a_b_s + (l * 4 + g) * 128;
#pragma unroll 1
  for (int mh = 0; mh < 2; mh++) {
    f32x16 acc[2][2]; zero_acc(acc);
#pragma unroll 2
    for (int kk = 0; kk < 8; kk++) {
      bf16x8 af[2], bfr[2];
#pragma unroll
      for (int mb = 0; mb < 2; mb++) {
        const int tt = mh * 64 + mb * 32 + l31, s0 = kk * 16 + h * 8;
        const f32x4 w0 = *(const f32x4*)(W + tt * 128 + s0), w1 = *(const f32x4*)(W + tt * 128 + s0 + 4);
        float f[8] = {w0.x, w0.y, w0.z, w0.w, w1.x, w1.y, w1.z, w1.w};
#pragma unroll
        for (int j = 0; j < 8; j++) if (s0 + j > tt) f[j] = 0.f;
        af[mb] = __builtin_bit_cast(bf16x8, pack8(f));
      }
#pragma unroll
      for (int nb = 0; nb < 2; nb++) bfr[nb] = *(const bf16x8*)(vnT + (g * 64 + nb * 32 + l31) * 136 + kk * 16 + h * 8);
#pragma unroll
      for (int mb = 0; mb < 2; mb++)
#pragma unroll
        for (int nb = 0; nb < 2; nb++) acc[mb][nb] = MFMA(af[mb], bfr[nb], acc[mb][nb]);
    }
#pragma unroll
    for (int mb = 0; mb < 2; mb++)
#pragma unroll
      for (int nb = 0; nb < 2; nb++)
#pragma unroll
        for (int i = 0; i < 16; i++) {
          const int tt = mh * 64 + mb * 32 + crow(i, h), col = g * 64 + nb * 32 + l31;
          bf16_t* zp = p.z1 + (r0 + tt) * Z1W;
          const float u = bf2f(zp[col]), gt = bf2f(zp[512 + col]);
          if (!p.dry) zp[col] = f2bf(u * (acc[mb][nb][i] + bs[tt]) * gt);
        }
  }
  __syncthreads();
}

DI void c_setup(const P& p, int l, int g, int lane, float& ar, float& ai, float (&Br)[16], float (&Bi)[16]) {
  const int gi = (l * 16 + g) * 64 + lane;
  const float lre = p.c_a_re[gi], lim = p.c_a_im[gi];
  const float dt = expf(p.c_log_dt[l * 16 + g]);
  const float mag = expf(lre * dt);
  const float angf = lim * dt;
  const double rev = (double)angf * 0.15915494309189535;
  const float rf = (float)((rev - rint(rev)) * 6.283185307179586);
  const float sn = sinf(rf), cs = cosf(rf);
  ar = mag * cs; ai = mag * sn;
  const float xr = ar - 1.f, xi = ai, den = 1.f / (lre * lre + lim * lim);
  const float cr = (xr * lre + xi * lim) * den, ci = (xi * lre - xr * lim) * den;
  const float* bre = p.c_b_re + (long)gi * 16; const float* bim = p.c_b_im + (long)gi * 16;
#pragma unroll
  for (int c4 = 0; c4 < 4; c4++) {
    const f32x4 r4 = *(const f32x4*)(bre + c4 * 4), i4 = *(const f32x4*)(bim + c4 * 4);
    const float rr[4] = {r4.x, r4.y, r4.z, r4.w}, ii[4] = {i4.x, i4.y, i4.z, i4.w};
#pragma unroll
    for (int j = 0; j < 4; j++) { Br[c4 * 4 + j] = cr * rr[j] - ci * ii[j]; Bi[c4 * 4 + j] = cr * ii[j] + ci * rr[j]; }
  }
}
DI void c_load_u(const P& p, long tok0, int g, int lane, float* ub) {
  const bf16_t* up = p.z1 + (tok0 + lane) * Z1W + 1280 + g * 16;
  float f0[8], f1[8];
  unpack8(*(const u32x4*)up, f0); unpack8(*(const u32x4*)(up + 8), f1);
  f32x4 a; a.x = f0[0]; a.y = f0[1]; a.z = f0[2]; a.w = f0[3]; *(f32x4*)(ub + lane * 16) = a;
  a.x = f0[4]; a.y = f0[5]; a.z = f0[6]; a.w = f0[7]; *(f32x4*)(ub + lane * 16 + 4) = a;
  a.x = f1[0]; a.y = f1[1]; a.z = f1[2]; a.w = f1[3]; *(f32x4*)(ub + lane * 16 + 8) = a;
  a.x = f1[4]; a.y = f1[5]; a.z = f1[6]; a.w = f1[7]; *(f32x4*)(ub + lane * 16 + 12) = a;
}
DI void c_step(const float* ub, int s, const float (&Br)[16], const float (&Bi)[16], float ar, float ai, float& sr, float& si) {
  float bur = 0.f, bui = 0.f;
#pragma unroll
  for (int c4 = 0; c4 < 4; c4++) {
    const f32x4 u = *(const f32x4*)(ub + s * 16 + c4 * 4);
    bur += Br[c4 * 4] * u.x + Br[c4 * 4 + 1] * u.y + Br[c4 * 4 + 2] * u.z + Br[c4 * 4 + 3] * u.w;
    bui += Bi[c4 * 4] * u.x + Bi[c4 * 4 + 1] * u.y + Bi[c4 * 4 + 2] * u.z + Bi[c4 * 4 + 3] * u.w;
  }
  const float nr = ar * sr - ai * si + bur, ni = ar * si + ai * sr + bui;
  sr = nr; si = ni;
}
DI void c1_item(const P& p, int l, int idx, char* smem) {
  const int t = tid(), lane = t & 63, w = t >> 6;
  const int b = idx >> 7, g = (idx >> 3) & 15, k = (idx & 7) * 4 + w;
  float* ub = (float*)smem + w * 1024;
  float ar, ai, Br[16], Bi[16];
  c_setup(p, l, g, lane, ar, ai, Br, Bi);
  const long tok0 = (long)b * S_ + k * 64;
  c_load_u(p, tok0, g, lane, ub);
  __syncthreads();
  float sr = 0.f, si = 0.f;
#pragma unroll 2
  for (int s = 0; s < 64; s++) c_step(ub, s, Br, Bi, ar, ai, sr, si);
  f32x2 e; e.x = sr; e.y = si;
  *(f32x2*)(p.carry + ((long)((b * 16 + g) * 32 + k) * 64 + lane) * 2) = e;
  __syncthreads();
}
DI void c3_item(const P& p, int l, int idx, char* smem) {
  const int t = tid(), lane = t & 63, w = t >> 6;
  const int b = idx >> 7, g = (idx >> 3) & 15, k = (idx & 7) * 4 + w;
  float* ub = (float*)(smem + w * 12288);
  bf16_t* stb = (bf16_t*)(smem + w * 12288 + 4096);
  const int c = lane & 15, sq = lane >> 4;
  bf16x8 cfr[4];
  {
    const float* cre = p.c_c_re + (long)(l * 16 + g) * 1024 + c * 64; const float* cim = p.c_c_im + (long)(l * 16 + g) * 1024 + c * 64;
#pragma unroll
    for (int ks = 0; ks < 4; ks++) {
      const f32x4 r4 = *(const f32x4*)(cre + ks * 16 + sq * 4), i4 = *(const f32x4*)(cim + ks * 16 + sq * 4);
      u32x4 pk; pk.x = pk2(r4.x, -i4.x); pk.y = pk2(r4.y, -i4.y); pk.z = pk2(r4.z, -i4.z); pk.w = pk2(r4.w, -i4.w);
      cfr[ks] = __builtin_bit_cast(bf16x8, pk);
    }
  }
  float ar, ai, Br[16], Bi[16];
  c_setup(p, l, g, lane, ar, ai, Br, Bi);
  const long tok0 = (long)b * S_ + k * 64;
  c_load_u(p, tok0, g, lane, ub);
  float lr = ar, li = ai;
#pragma unroll
  for (int i = 0; i < 6; i++) { const float nr = lr * lr - li * li, ni = 2.f * lr * li; lr = nr; li = ni; }
  float sr = 0.f, si = 0.f;
  {
    const float* cp = p.carry + ((long)((b * 16 + g) * 32) * 64 + lane) * 2;
    for (int j0 = 0; j0 < k; j0 += 8) {
      f32x2 e[8];
#pragma unroll
      for (int jj = 0; jj < 8; jj++) { e[jj].x = 0.f; e[jj].y = 0.f; if (j0 + jj < k) e[jj] = *(const f32x2*)(cp + (long)(j0 + jj) * 128); }
#pragma unroll
      for (int jj = 0; jj < 8; jj++) if (j0 + jj < k) { const float nr = lr * sr - li * si + e[jj].x, ni = lr * si + li * sr + e[jj].y; sr = nr; si = ni; }
    }
  }
  __syncthreads();
  const float dsk = p.c_d[l * 256 + g * 16 + c];
#pragma unroll 1
  for (int sb = 0; sb < 4; sb++) {
#pragma unroll 2
    for (int s2 = 0; s2 < 16; s2++) {
      c_step(ub, sb * 16 + s2, Br, Bi, ar, ai, sr, si);
      *(unsigned*)(stb + s2 * 136 + 2 * lane) = pk2(sr, si);
    }
    asm volatile("s_waitcnt lgkmcnt(0)" ::: "memory");
    __builtin_amdgcn_wave_barrier();
    f32x4 y; y.x = 0.f; y.y = 0.f; y.z = 0.f; y.w = 0.f;
#pragma unroll
    for (int ks = 0; ks < 4; ks++) {
      const bf16x8 af = *(const bf16x8*)(stb + c * 136 + ks * 32 + sq * 8);
      y = __builtin_amdgcn_mfma_f32_16x16x32_bf16(af, cfr[ks], y, 0, 0, 0);
    }
    const float yy[4] = {y.x, y.y, y.z, y.w};
#pragma unroll
    for (int qq = 0; qq < 4; qq++) {
      const int sa = sb * 16 + sq * 4 + qq;
      const float yv = gelu_t(yy[qq] + dsk * ub[sa * 16 + c]);
      if (!p.dry) p.z1[(tok0 + sa) * Z1W + 1280 + g * 16 + c] = f2bf(yv);
    }
    asm volatile("s_waitcnt lgkmcnt(0)" ::: "memory");
    __builtin_amdgcn_wave_barrier();
  }
  __syncthreads();
}

DI void glu_tile(const P& p, int l, int tm, int tn, char* smem) {
  bf16_t* sm = (bf16_t*)smem; float* ep = (float*)smem;
  const int r0 = tm * 128, c0 = tn * 128;
  f32x16 acc[2][2]; zero_acc(acc);
  gemm_loop_dma(p.z1 + (long)r0 * Z1W + 1280, Z1W, p.WgluT + (long)c0 * 256, 256, 256, acc, smem);
  acc_to_lds(acc, ep);
  __syncthreads();
  const float* bg = p.c_b_glu + l * 256 + c0;
  rowwise2(ep, [&](int row, int c8) {
    LdGlu L;
    const bf16_t* zp = p.z1 + (long)(r0 + row) * Z1W + c0 + c8;
    L.yg = *(const u32x4*)(zp + 1280); L.gt = *(const u32x4*)(zp + 1536);
    return L;
  }, [&](int row, int c8, float (&v)[8], const LdGlu& L) {
    bf16_t* zp = p.z1 + (long)(r0 + row) * Z1W + c0 + c8;
    float yg[8], gt[8];
    unpack8(L.yg, yg); unpack8(L.gt, gt);
#pragma unroll
    for (int j = 0; j < 8; j++) v[j] = yg[j] * sigm(v[j] + bg[c8 + j]) * gt[j];
    if (!p.dry) *(u32x4*)(zp + 1536) = pack8(v);
  });
  __syncthreads();
}

DI void pf_tile(const P& p, int l, int tm, int tn, char* smem) {
  float* ep = (float*)smem; float* rsS = (float*)(smem + SM_RS);
  const int t = tid(), lane = t & 63, w = t >> 6, wm = w >> 1, wn = w & 1, l31 = lane & 31, h = lane >> 5;
  const int r0 = tm * 128, c0 = tn * 128;
  load_rs(p, r0, rsS);
  unsigned mrgp[2][2][8];
#pragma unroll
  for (int a = 0; a < 2; a++)
#pragma unroll
    for (int b = 0; b < 2; b++)
#pragma unroll
      for (int i = 0; i < 8; i++) mrgp[a][b][i] = 0u;
#pragma unroll 1
  for (int pr = 0; pr < 2; pr++) {
    unsigned gp[2][2][2][8];
    {
      f32x16 accP[2][2], accQ[2][2]; zero_acc(accP); zero_acc(accQ);
      const bf16_t* wg = p.WinT + (long)(3456 + (2 * pr) * 1024 + c0) * 1024;
      gemm_loop_dma2(p.xb + (long)r0 * 1024, 1024, wg, wg + (long)1024 * 1024, 1024, 1024, accP, accQ, smem);
      const float* bm = p.b_merge + l * 4096 + (2 * pr) * 1024 + c0;
#pragma unroll
      for (int mb = 0; mb < 2; mb++)
#pragma unroll
        for (int nb = 0; nb < 2; nb++) {
          const float bias0 = bm[wn * 64 + nb * 32 + l31], bias1 = bm[1024 + wn * 64 + nb * 32 + l31];
#pragma unroll
          for (int i = 0; i < 16; i += 2) {
            const float ra = rsS[wm * 64 + mb * 32 + crow(i, h)], rb = rsS[wm * 64 + mb * 32 + crow(i + 1, h)];
            gp[0][mb][nb][i >> 1] = pk2n(sigm(accP[mb][nb][i] * ra + bias0), sigm(accP[mb][nb][i + 1] * rb + bias0));
            gp[1][mb][nb][i >> 1] = pk2n(sigm(accQ[mb][nb][i] * ra + bias1), sigm(accQ[mb][nb][i + 1] * rb + bias1));
          }
        }
    }
#pragma unroll
    for (int j = 0; j < 2; j++) {
      const int br = 2 * pr + j;
      const int yoff = br == 0 ? 0 : (br == 1 ? 768 : (br == 2 ? 1536 : 2048));
      const int Kb = br == 1 ? 512 : 256;
      const long woff = br == 0 ? 0 : (br == 1 ? 1024 * 256 : (br == 2 ? 1024 * 768 : 1024 * 1024));
      f32x16 acc[2][2]; zero_acc(acc);
      gemm_loop_dma(p.z1 + (long)r0 * Z1W + yoff, Z1W, p.WbrT + woff + (long)c0 * Kb, Kb, Kb, acc, smem);
#pragma unroll
      for (int mb = 0; mb < 2; mb++)
#pragma unroll
        for (int nb = 0; nb < 2; nb++)
#pragma unroll
          for (int i = 0; i < 16; i += 2) {
            const unsigned g2 = gp[j][mb][nb][i >> 1], m2 = mrgp[mb][nb][i >> 1];
            const float m0 = __uint_as_float(m2 << 16) + __uint_as_float(g2 << 16) * acc[mb][nb][i];
            const float m1 = __uint_as_float(m2 & 0xffff0000u) + __uint_as_float(g2 & 0xffff0000u) * acc[mb][nb][i + 1];
            mrgp[mb][nb][i >> 1] = pk2(m0, m1);
          }
    }
  }
  {
    f32x16 mrg[2][2];
#pragma unroll
    for (int a = 0; a < 2; a++)
#pragma unroll
      for (int b = 0; b < 2; b++)
#pragma unroll
        for (int i = 0; i < 16; i += 2) { const unsigned m2 = mrgp[a][b][i >> 1]; mrg[a][b][i] = __uint_as_float(m2 << 16); mrg[a][b][i + 1] = __uint_as_float(m2 & 0xffff0000u); }
    acc_to_lds(mrg, ep);
  }
  __syncthreads();
  rowwise(ep, [&](int row, int c8, float (&v)[8]) { *(u32x4*)(p.mg + (long)(r0 + row) * 1024 + c0 + c8) = pack8(v); });
  __syncthreads();
}

DI void out_tile(const P& p, int l, int tm, int tn, char* smem) {
  bf16_t* sm = (bf16_t*)smem; float* ep = (float*)smem;
  const int r0 = tm * 128, c0 = tn * 128;
  f32x16 acc[2][2]; zero_acc(acc);
  gemm_loop_dma(p.mg + (long)r0 * 1024, 1024, p.WoutT + (long)l * 1024 * 1024 + (long)c0 * 1024, 1024, 1024, acc, smem);
  acc_to_lds(acc, ep);
  __syncthreads();
  const float* xin = (l == 0) ? p.x : p.out;
  rowwise2(ep, [&](int row, int c8) {
    LdX L;
    const long off = (long)(r0 + row) * 1024 + c0 + c8;
    L.a = *(const f32x4*)(xin + off); L.b = *(const f32x4*)(xin + off + 4);
    return L;
  }, [&](int row, int c8, float (&v)[8], const LdX& L) {
    const long off = (long)(r0 + row) * 1024 + c0 + c8;
    const f32x4 a = L.a, b = L.b;
    v[0] += a.x; v[1] += a.y; v[2] += a.z; v[3] += a.w; v[4] += b.x; v[5] += b.y; v[6] += b.z; v[7] += b.w;
    f32x4 oa, ob; oa.x = v[0]; oa.y = v[1]; oa.z = v[2]; oa.w = v[3]; ob.x = v[4]; ob.y = v[5]; ob.z = v[6]; ob.w = v[7];
    if (!p.dry) {
      if (l == 1) { __builtin_nontemporal_store(oa, (f32x4*)(p.out + off)); __builtin_nontemporal_store(ob, (f32x4*)(p.out + off + 4)); }
      else { *(f32x4*)(p.out + off) = oa; *(f32x4*)(p.out + off + 4) = ob; }
    }
    if (l == 0) {
      *(u32x4*)(p.xb + off) = pack8(v);
      float ss = 0.f;
#pragma unroll
      for (int j = 0; j < 8; j++) ss += v[j] * v[j];
      ss = sum16(ss);
      if ((c8 >> 3) == 0) p.ssp[(long)tn * T_ + r0 + row] = ss;
    }
  });
  __syncthreads();
}

DI void out_tile2(const P& p, int l, int tm, int tn2, char* smem) {
  float* ep = (float*)smem;
  const int r0 = tm * 128;
  f32x16 accP[2][2], accQ[2][2]; zero_acc(accP); zero_acc(accQ);
  const bf16_t* w0 = p.WoutT + (long)l * 1024 * 1024 + (long)(tn2 * 256) * 1024;
  gemm_loop_dma2(p.mg + (long)r0 * 1024, 1024, w0, w0 + (long)128 * 1024, 1024, 1024, accP, accQ, smem);
  const float* xin = (l == 0) ? p.x : p.out;
  auto epi = [&](const f32x16 (&acc)[2][2], int tn) {
    const int c0 = tn * 128;
    acc_to_lds(acc, ep);
    __syncthreads();
    rowwise2(ep, [&](int row, int c8) {
      LdX L;
      const long off = (long)(r0 + row) * 1024 + c0 + c8;
      L.a = *(const f32x4*)(xin + off); L.b = *(const f32x4*)(xin + off + 4);
      return L;
    }, [&](int row, int c8, float (&v)[8], const LdX& L) {
      const long off = (long)(r0 + row) * 1024 + c0 + c8;
      const f32x4 a = L.a, b = L.b;
      v[0] += a.x; v[1] += a.y; v[2] += a.z; v[3] += a.w; v[4] += b.x; v[5] += b.y; v[6] += b.z; v[7] += b.w;
      f32x4 oa, ob; oa.x = v[0]; oa.y = v[1]; oa.z = v[2]; oa.w = v[3]; ob.x = v[4]; ob.y = v[5]; ob.z = v[6]; ob.w = v[7];
      if (!p.dry) {
        if (l == 1) { __builtin_nontemporal_store(oa, (f32x4*)(p.out + off)); __builtin_nontemporal_store(ob, (f32x4*)(p.out + off + 4)); }
        else { *(f32x4*)(p.out + off) = oa; *(f32x4*)(p.out + off + 4) = ob; }
      }
      if (l == 0) {
        *(u32x4*)(p.xb + off) = pack8(v);
        float ss = 0.f;
#pragma unroll
        for (int j = 0; j < 8; j++) ss += v[j] * v[j];
        ss = sum16(ss);
        if ((c8 >> 3) == 0) p.ssp[(long)tn * T_ + r0 + row] = ss;
      }
    });
    __syncthreads();
  };
  epi(accP, 2 * tn2);
  epi(accQ, 2 * tn2 + 1);
}

DI void run_phase(const P& p, int ph, char* smem, int vb) {
  const int G = gridDim.x, bid = blockIdx.x;
  int* slot = (int*)(smem + SM_MISC);
  if (ph == 0) {
    conv_all(p, 0, smem);
    for (int it = NCONV + bid; it < NAUX; it += G) aux_item(p, 0, it, smem);
    for (int it = bid; it < 2048; it += G) p0_xrow_item(p, it);
    for (int it = bid; it < 1024; it += G) p0_rope_item(p, it);
    return;
  }
  const int l = (ph - 1) / 6, s = (ph - 1) % 6;
  if (s == 0) {
    const int nd = 128 * 12, nrd = (nd + G - 1) / G;
    for (int r = 0; r < nrd; r++) { const int L = static_L(r, vb); if (L >= nd) continue; int tm, tp; tile_from_linear(L, 12, tm, tp); g1_tile2(p, l, tm, 2 * tp, smem); }
    for (int L = vb; L < 384 + 64; L += G) {
      int tm, tn;
      if (L < 384) { tile_from_linear(L, 3, tm, tn); g1_tile(p, l, tm, 24 + tn, smem); }
      else { tile_from_linear(L - 384, 4, tm, tn); g1m_tile(p, l, tm, tn, smem); }
    }
  } else if (s == 1) {
    const long dm = p.dry;
    {
      const int total = 1024, nr = (total + G - 1) / G;
      if (!dm || (dm & 2)) for (int r = 0; r < nr; r++) { const int L = static_L(r, vb); if (L >= total) continue; int tm, tn; tile_from_linear(L, 8, tm, tn); g2q_tile(p, l, tm, tn, smem); }
      if (!dm || (dm & 8)) for (int r = 0; r < nr; r++) { const int L = static_L(r, vb); if (L >= total) continue; int tm, tn; tile_from_linear(L, 8, tm, tn); g2kv_tile(p, l, tm, tn, smem); }
    }
    if (!dm || (dm & 4)) for (int it = vb; it < 512; it += G) mattn_item(p, it, smem);
    {
      const bool split = (G >= 256);
      if (!dm || (dm & 16)) { const int a1 = split ? 128 : 128; for (int it = vb; it < a1; it += G) a_item(p, l, it, smem); }
      const int cstep = split ? (vb < 128 ? 1024 : G - 128) : G;
      if (!dm || (dm & 32)) {
#pragma unroll 1
        for (int it = vb; it < 1024; it += cstep) c1_item(p, l, it, smem);
      }
    }
  } else if (s == 2) {
    const long dm = p.dry;
    if (G == 512) {
#pragma unroll 1
      for (int j = 0; j < 4; j++) {
        if (j < 2) { if (dm && !(dm & 2)) continue; battn_item(p, j ? 1023 - vb : vb, smem); }
        else { if (dm && !(dm & 4)) continue; c3_item(p, l, vb + (j - 2) * 512, smem); }
      }
    } else {
#pragma unroll 1
      for (int it = vb; it < 2048; it += G) {
        if (it < 1024) { if (dm && !(dm & 2)) continue; battn_item(p, it, smem); } else { if (dm && !(dm & 4)) continue; c3_item(p, l, it - 1024, smem); }
      }
    }
  } else if (s == 3) {
    for (int it = bid; it < 256; it += G) glu_tile(p, l, it >> 1, it & 1, smem);
  } else if (s == 4) {
    const int total = 1024, nr = (total + G - 1) / G;
    for (int r = 0; r < nr; r++) { const int L = static_L(r, vb); if (L >= total) continue; int tm, tn; tile_from_linear(L, 8, tm, tn); pf_tile(p, l, tm, tn, smem); }
  } else {
    const int nr2 = (512 + G - 1) / G;
    for (int r = 0; r < nr2; r++) { const int L = static_L(r, vb); if (L >= 512) continue; int tm, tn; tile_from_linear(L, 4, tm, tn); out_tile2(p, l, tm, tn, smem); }
    if (l == 0) { conv_all(p, 1, smem); for (int it = NCONV + bid; it < NAUX; it += G) aux_item(p, 1, it, smem); }
  }
}

DI unsigned xb_ld(unsigned* q) { return __hip_atomic_load(q, __ATOMIC_RELAXED, __HIP_MEMORY_SCOPE_AGENT); }
DI unsigned xb_add(unsigned* q, unsigned v) { return __hip_atomic_fetch_add(q, v, __ATOMIC_RELAXED, __HIP_MEMORY_SCOPE_AGENT); }
DI void gbar(unsigned* bar, const int* st) {
  asm volatile("s_waitcnt vmcnt(0)" ::: "memory");
  __syncthreads();
  if (threadIdx.x == 0) {
    __builtin_amdgcn_s_waitcnt(0);
    const unsigned x = (unsigned)st[0], nloc = (unsigned)st[1], nx = (unsigned)st[2];
    const unsigned old = xb_add(&bar[1024 + 64 * x], 1u);
    const unsigned gen = old / nloc;
    if (old + 1u == (gen + 1u) * nloc) {
      __builtin_amdgcn_fence(__ATOMIC_RELEASE, "agent");
      asm volatile("s_waitcnt vmcnt(0)" ::: "memory");
      const unsigned og = xb_add(&bar[3072], 1u);
      const unsigned tg = og / nx;
      if (og + 1u == (tg + 1u) * nx) xb_add(&bar[3136], 1u);
      else while (xb_ld(&bar[3136]) == tg) __builtin_amdgcn_s_sleep(1);
      __builtin_amdgcn_fence(__ATOMIC_ACQUIRE, "agent");
      xb_add(&bar[2048 + 64 * x], 1u);
      asm volatile("s_waitcnt vmcnt(0)" ::: "memory");
    } else {
      while (xb_ld(&bar[2048 + 64 * x]) == gen) __builtin_amdgcn_s_sleep(1);
      __builtin_amdgcn_fence(__ATOMIC_ACQUIRE, "agent");
      asm volatile("s_waitcnt vmcnt(0)" ::: "memory");
    }
  }
  __syncthreads();
}

#if MK_MULTI
__global__ void __launch_bounds__(256, 2) hyb_phase(P p, int ph) {
  __shared__ __attribute__((aligned(16))) char smem[SM_TOTAL];
  run_phase(p, ph, smem, blockIdx.x);
}
#else
__global__ void __launch_bounds__(256, 2) hyb_mega(P p) {
  __shared__ __attribute__((aligned(16))) char smem[SM_TOTAL];
  cg::grid_group grid = cg::this_grid();
  if (p.dry == 0x7fffffff) grid.sync();
  int vb;
  {
    int* sl = (int*)(smem + SM_MISC) + 2;
    if (threadIdx.x == 0) {
      const unsigned xcc = (unsigned)__builtin_amdgcn_s_getreg((3 << 11) | 20) & 7u;
      const unsigned loc = xb_add(p.ctr + 40 + xcc, 1u);
      const unsigned Gx = gridDim.x >> 3;
      *sl = (loc < Gx) ? (int)(loc * 8 + xcc) : -1;
      unsigned sum, cnt, mine;
      for (;;) {
        sum = 0u; cnt = 0u; mine = 0u;
        for (unsigned j = 0; j < 8; ++j) { const unsigned c = xb_ld(p.ctr + 40 + j); sum += c; cnt += (c > 0u) ? 1u : 0u; mine = (j == xcc) ? c : mine; }
        if (sum == gridDim.x) break;
        __builtin_amdgcn_s_sleep(1);
      }
      sl[2] = (int)xcc; sl[3] = (int)mine; sl[4] = (int)cnt;
    }
    __syncthreads();
    vb = blockIdx.x;
  }
  const int* bst = (const int*)(smem + SM_MISC) + 4;
#ifdef DRY_PH
  P pd = p; { int one = DRY_MASK; asm volatile("" : "+s"(one)); pd.dry = one; }
#endif
#pragma unroll 1
  for (int ph = 0; ph < 13; ph++) {
#ifdef DRY_PH
    if (ph == DRY_PH) { run_phase(pd, ph, smem, vb); gbar(p.bar, bst); }
#endif
    run_phase(p, ph, smem, vb);
    if (ph < 12) gbar(p.bar, bst);
  }
}
#endif

extern "C" void kernel_launch(void* const* d_in, const int* in_sizes, int n_in, void* d_out, int out_size, void* d_ws, size_t ws_size, hipStream_t stream) {
  P p{};
  p.x = (const float*)d_in[0]; p.mem = (const float*)d_in[1]; p.pos = (const int*)d_in[2];
  p.norm_g = (const float*)d_in[3]; p.w_in = (const float*)d_in[4]; p.b_merge = (const float*)d_in[5];
  p.a_norm_g = (const float*)d_in[6]; p.a_w_s = (const float*)d_in[7]; p.a_b_s = (const float*)d_in[8];
  p.b_q_norm_g = (const float*)d_in[9]; p.b_kv_norm_g = (const float*)d_in[10]; p.b_w_uq = (const float*)d_in[11]; p.b_w_ukv = (const float*)d_in[12];
  p.b_qk_g_q = (const float*)d_in[13]; p.b_qk_g_k = (const float*)d_in[14];
  p.c_a_re = (const float*)d_in[15]; p.c_a_im = (const float*)d_in[16]; p.c_log_dt = (const float*)d_in[17];
  p.c_b_re = (const float*)d_in[18]; p.c_b_im = (const float*)d_in[19]; p.c_c_re = (const float*)d_in[20]; p.c_c_im = (const float*)d_in[21];
  p.c_d = (const float*)d_in[22]; p.c_w_glu = (const float*)d_in[23]; p.c_b_glu = (const float*)d_in[24];
  p.m_norm_g = (const float*)d_in[25]; p.m_w_kv = (const float*)d_in[26]; p.m_qk_g_q = (const float*)d_in[27]; p.m_qk_g_k = (const float*)d_in[28];
  p.w_br_a = (const float*)d_in[29]; p.w_br_b = (const float*)d_in[30]; p.w_br_c = (const float*)d_in[31]; p.w_br_m = (const float*)d_in[32];
  p.w_out = (const float*)d_in[33];
  p.out = (float*)d_out;
  char* ws = (char*)d_ws; size_t off = 0;
  auto take = [&](size_t bytes) { char* r = ws + off; off += (bytes + 255) & ~(size_t)255; return r; };
  p.z1 = (bf16_t*)take((size_t)T_ * Z1W * 2);
  p.z2 = (bf16_t*)take((size_t)T_ * Z2W * 2);
  p.xb = (bf16_t*)take((size_t)T_ * 1024 * 2);
  p.qf = (bf16_t*)take((size_t)T_ * 768 * 2);
  p.kf = (bf16_t*)take((size_t)T_ * 768 * 2);
  p.mg = p.qf;
  p.vt = (bf16_t*)take((size_t)8 * 8 * 64 * S_ * 2);
  p.hm = (bf16_t*)take((size_t)2048 * 1024 * 2);
  p.memk = (bf16_t*)take((size_t)2048 * 256 * 2);
  p.memvt = (bf16_t*)take((size_t)2048 * 256 * 2);
  p.WinT = (bf16_t*)take((size_t)NWIN * 1024 * 2);
  p.WuqT = (bf16_t*)take((size_t)1024 * 768 * 2);
  p.WukvT = (bf16_t*)take((size_t)1024 * 256 * 2);
  p.WgluT = (bf16_t*)take((size_t)256 * 256 * 2);
  p.WbrT = (bf16_t*)take((size_t)1024 * 1280 * 2);
  p.WoutT = (bf16_t*)take((size_t)2 * 1024 * 1024 * 2);
  p.WmkvT = (bf16_t*)take((size_t)512 * 1024 * 2);
  p.ssp = (float*)take((size_t)8 * T_ * 4);
  p.ssq = (float*)take((size_t)9 * T_ * 4);
  p.rope = (float*)take((size_t)T_ * 32 * 4);
  p.carry = (float*)take((size_t)8 * 16 * 32 * 64 * 2 * 4);
  p.ctr = (unsigned*)take(256);
  p.bar = (unsigned*)take(16384);
  if (off > ws_size) { fprintf(stderr, "workspace too small: need %zu have %zu\n", off, ws_size); return; }

  static int grid_blocks = 0;
  if (!grid_blocks) {
    int dev = 0, cus = 0, per_cu = 0;
    hipGetDevice(&dev);
    hipDeviceGetAttribute(&cus, hipDeviceAttributeMultiprocessorCount, dev);
#if MK_MULTI
    hipOccupancyMaxActiveBlocksPerMultiprocessor(&per_cu, hyb_phase, 256, 0);
#else
    hipOccupancyMaxActiveBlocksPerMultiprocessor(&per_cu, hyb_mega, 256, 0);
#endif
    if (per_cu > 2) per_cu = 2;
    if (per_cu < 1) per_cu = 1;
    grid_blocks = cus * per_cu;
    grid_blocks &= ~7;
  }
#if MK_MULTI
  for (int ph = 0; ph < 13; ph++) hipLaunchKernelGGL(hyb_phase, dim3(grid_blocks), dim3(256), 0, stream, p, ph);
#else
  hipMemsetAsync(p.ctr, 0, 256 + 16384, stream);
  void* args[] = {&p};
  hipError_t e = hipLaunchCooperativeKernel((void*)hyb_mega, dim3(grid_blocks), dim3(256), args, 0, stream);
  if (e != hipSuccess) fprintf(stderr, "cooperative launch failed: %s (grid %d)\n", hipGetErrorString(e), grid_blocks);
#endif
}
```

```cpp
#include <hip/hip_runtime.h>
#include <hip/hip_cooperative_groups.h>
#include <stdint.h>
#include <stdio.h>
#include <type_traits>
namespace cg = cooperative_groups;

#ifndef MK_MULTI
#define MK_MULTI 0
#endif

typedef unsigned short bf16_t;
typedef short bf16x8 __attribute__((ext_vector_type(8)));
typedef short s16x4 __attribute__((ext_vector_type(4)));
typedef float f32x16 __attribute__((ext_vector_type(16)));
typedef float f32x4 __attribute__((ext_vector_type(4)));
typedef float f32x2 __attribute__((ext_vector_type(2)));
typedef unsigned u32x4 __attribute__((ext_vector_type(4)));
typedef unsigned u32x2 __attribute__((ext_vector_type(2)));
#define DI __device__ __forceinline__
#define MFMA(a, b, c) __builtin_amdgcn_mfma_f32_32x32x16_bf16((a), (b), (c), 0, 0, 0)

constexpr int T_ = 16384, S_ = 2048;
constexpr int INW = 7456;
constexpr int Z1W = 2304, Z2W = 1152;
constexpr int NWIN = 7552;
constexpr float EPS = 1e-6f;
constexpr float LOG2E = 1.4426950408889634f;
constexpr int LDT = 72;
constexpr int EPW = 132;
constexpr int SM_MAIN = 4 * 128 * LDT * 2;
constexpr int SM_RS = SM_MAIN;
constexpr int SM_SS = SM_MAIN + 512;
constexpr int SM_MISC = SM_MAIN + 1024;
constexpr int SM_TOTAL = SM_MAIN + 1024 + 64;

struct P {
  const float* x; const float* mem; const int* pos;
  const float* norm_g; const float* w_in; const float* b_merge; const float* a_norm_g; const float* a_w_s; const float* a_b_s;
  const float* b_q_norm_g; const float* b_kv_norm_g; const float* b_w_uq; const float* b_w_ukv; const float* b_qk_g_q; const float* b_qk_g_k;
  const float* c_a_re; const float* c_a_im; const float* c_log_dt; const float* c_b_re; const float* c_b_im; const float* c_c_re; const float* c_c_im;
  const float* c_d; const float* c_w_glu; const float* c_b_glu;
  const float* m_norm_g; const float* m_w_kv; const float* m_qk_g_q; const float* m_qk_g_k;
  const float* w_br_a; const float* w_br_b; const float* w_br_c; const float* w_br_m; const float* w_out;
  float* out;
  bf16_t* z1; bf16_t* z2; bf16_t* xb; bf16_t* qf; bf16_t* kf; bf16_t* mg; bf16_t* vt; bf16_t* hm; bf16_t* memk; bf16_t* memvt;
  bf16_t* WinT; bf16_t* WuqT; bf16_t* WukvT; bf16_t* WgluT; bf16_t* WbrT; bf16_t* WoutT; bf16_t* WmkvT;
  float* ssp; float* ssq; float* rope; float* carry; float* s5c; unsigned* ctr; unsigned* bar;
  long dry;
};

DI int tid() { int t = threadIdx.x; asm volatile("" : "+v"(t)); return t; }
DI float bf2f(bf16_t b) { return __uint_as_float(((unsigned)b) << 16); }
DI unsigned pk2(float lo, float hi) { unsigned r; asm("v_cvt_pk_bf16_f32 %0, %1, %2" : "=v"(r) : "v"(lo), "v"(hi)); return r; }
DI unsigned pk2n(float lo, float hi) { unsigned r; asm("s_nop 1\n\tv_cvt_pk_bf16_f32 %0, %1, %2" : "=v"(r) : "v"(lo), "v"(hi)); return r; }
DI bf16_t f2bf(float x) { return (bf16_t)(pk2(x, 0.f) & 0xffffu); }
DI void unpack8(u32x4 v, float (&f)[8]) {
  f[0] = __uint_as_float(v.x << 16); f[1] = __uint_as_float(v.x & 0xffff0000u);
  f[2] = __uint_as_float(v.y << 16); f[3] = __uint_as_float(v.y & 0xffff0000u);
  f[4] = __uint_as_float(v.z << 16); f[5] = __uint_as_float(v.z & 0xffff0000u);
  f[6] = __uint_as_float(v.w << 16); f[7] = __uint_as_float(v.w & 0xffff0000u);
}
DI void unpack4(u32x2 v, float (&f)[4]) {
  f[0] = __uint_as_float(v.x << 16); f[1] = __uint_as_float(v.x & 0xffff0000u);
  f[2] = __uint_as_float(v.y << 16); f[3] = __uint_as_float(v.y & 0xffff0000u);
}
DI u32x4 pack8(const float (&f)[8]) { u32x4 r; r.x = pk2(f[0], f[1]); r.y = pk2(f[2], f[3]); r.z = pk2(f[4], f[5]); r.w = pk2(f[6], f[7]); return r; }
DI float sigm(float x) { return __builtin_amdgcn_rcpf(1.f + __expf(-x)); }
DI float silu(float x) { return x * sigm(x); }
DI float gelu_t(float x) { return x * sigm(1.5957691216057308f * (x + 0.044715f * x * x * x)); }
DI float sum16(float v) { v += __shfl_xor(v, 1); v += __shfl_xor(v, 2); v += __shfl_xor(v, 4); v += __shfl_xor(v, 8); return v; }
DI float sum8(float v) { v += __shfl_xor(v, 1); v += __shfl_xor(v, 2); v += __shfl_xor(v, 4); return v; }
DI float sum64(float v) { v = sum16(v); v += __shfl_xor(v, 16); v += __shfl_xor(v, 32); return v; }
DI int crow(int i, int h) { return (i & 3) + 8 * (i >> 2) + 4 * h; }
#define MFMA16(a, b, c) __builtin_amdgcn_mfma_f32_16x16x32_bf16((a), (b), (c), 0, 0, 0)
template <int NB>
DI void zero_acc4(f32x4 (&acc)[4][NB]) {
#pragma unroll
  for (int a = 0; a < 4; a++)
#pragma unroll
    for (int b = 0; b < NB; b++) { acc[a][b].x = 0.f; acc[a][b].y = 0.f; acc[a][b].z = 0.f; acc[a][b].w = 0.f; }
}
DI void zero_acc(f32x16 (&acc)[2][2]) {
#pragma unroll
  for (int a = 0; a < 2; a++)
#pragma unroll
    for (int b = 0; b < 2; b++)
#pragma unroll
      for (int i = 0; i < 16; i++) acc[a][b][i] = 0.f;
}

template <bool SS>
DI void gemm_loop(const bf16_t* __restrict__ A, long lda, const bf16_t* __restrict__ B, long ldb, int K,
                  f32x16 (&acc)[2][2], bf16_t* sm, float* ssS) {
  const int t = tid(), lane = t & 63, w = t >> 6, wm = w >> 1, wn = w & 1, l31 = lane & 31, h = lane >> 5;
  const int lr = t >> 3, lc = (t & 7) * 8;
  const bf16_t* ap = A + (long)lr * lda + lc;
  const bf16_t* bp = B + (long)lr * ldb + lc;
  bf16_t* wp = sm + lr * LDT + lc;
  const bf16_t* rA = sm + (wm * 64 + l31) * LDT + h * 8;
  const bf16_t* rB = sm + 2 * 128 * LDT + (wn * 64 + l31) * LDT + h * 8;
  u32x4 ra[4], rb[4];
  float ss[4] = {0.f, 0.f, 0.f, 0.f};
  const int nk = K >> 6;
  auto gl = [&](int ko) {
#pragma unroll
    for (int i = 0; i < 4; i++) { ra[i] = *(const u32x4*)(ap + (long)(32 * i) * lda + ko); rb[i] = *(const u32x4*)(bp + (long)(32 * i) * ldb + ko); }
  };
  auto st = [&](auto BUF) {
    constexpr int buf = decltype(BUF)::value;
#pragma unroll
    for (int i = 0; i < 4; i++) {
      *(u32x4*)(wp + buf * 128 * LDT + 32 * i * LDT) = ra[i];
      *(u32x4*)(wp + 2 * 128 * LDT + buf * 128 * LDT + 32 * i * LDT) = rb[i];
      if (SS) { float f[8]; unpack8(ra[i], f);
#pragma unroll
        for (int j = 0; j < 8; j++) ss[i] += f[j] * f[j]; }
    }
  };
  auto comp = [&](auto BUF) {
    constexpr int buf = decltype(BUF)::value;
#pragma unroll
    for (int kk = 0; kk < 4; kk++) {
      bf16x8 af[2], bfr[2];
#pragma unroll
      for (int mb = 0; mb < 2; mb++) af[mb] = *(const bf16x8*)(rA + buf * 128 * LDT + mb * 32 * LDT + kk * 16);
#pragma unroll
      for (int nb = 0; nb < 2; nb++) bfr[nb] = *(const bf16x8*)(rB + buf * 128 * LDT + nb * 32 * LDT + kk * 16);
#pragma unroll
      for (int mb = 0; mb < 2; mb++)
#pragma unroll
        for (int nb = 0; nb < 2; nb++) acc[mb][nb] = MFMA(af[mb], bfr[nb], acc[mb][nb]);
    }
  };
  using B0 = std::integral_constant<int, 0>; using B1 = std::integral_constant<int, 1>;
  gl(0);
  st(B0{});
  gl(64);
  __syncthreads();
  for (int ks = 0; ks < nk; ks += 2) {
    st(B1{});
    __builtin_amdgcn_sched_barrier(0);
    if (ks + 2 < nk) gl((ks + 2) * 64);
    __builtin_amdgcn_sched_barrier(0);
    comp(B0{});
    __syncthreads();
    if (ks + 2 < nk) st(B0{});
    __builtin_amdgcn_sched_barrier(0);
    if (ks + 3 < nk) gl((ks + 3) * 64);
    __builtin_amdgcn_sched_barrier(0);
    comp(B1{});
    __syncthreads();
  }
  if (SS) {
    const float inv = 1.0f / (float)K;
#pragma unroll
    for (int i = 0; i < 4; i++) { float s = sum8(ss[i]); if ((t & 7) == 0) ssS[lr + 32 * i] = rsqrtf(s * inv + EPS); }
  }
}

#define LAS3 __attribute__((address_space(3)))
struct GDesc { const bf16_t* A; long lda; const bf16_t* B; long ldb; };
DI void gemm_dma_stage0(const GDesc& d, char* smc) {
  const int t = tid(), lane = t & 63, w = t >> 6;
  const unsigned wdst = (unsigned)(uintptr_t)smc + (unsigned)w * 4096u;
#pragma unroll
  for (int i = 0; i < 4; i++) {
    const int row = 32 * w + 8 * i + (lane >> 3), c = (lane & 7) ^ ((row >> 1) & 7);
    __builtin_amdgcn_global_load_lds((const unsigned*)(d.A + row * d.lda + c * 8), (LAS3 unsigned*)(uintptr_t)(wdst + i * 1024), 16, 0, 0);
    __builtin_amdgcn_global_load_lds((const unsigned*)(d.B + row * d.ldb + c * 8), (LAS3 unsigned*)(uintptr_t)(wdst + 16384 + i * 1024), 16, 0, 0);
  }
}
DI void gemm_loop_dma(const bf16_t* __restrict__ A, long lda, const bf16_t* __restrict__ B, long ldb, int K, f32x16 (&acc)[2][2], char* smc,
                      bool started = false, bool has_next = false, GDesc next = GDesc{nullptr, 0, nullptr, 0}) {
  const int t = tid(), lane = t & 63, w = t >> 6, wm = w >> 1, wn = w & 1, l31 = lane & 31, h = lane >> 5;
  unsigned aoff[4], boff[4];
#pragma unroll
  for (int i = 0; i < 4; i++) {
    const int row = 32 * w + 8 * i + (lane >> 3), c = (lane & 7) ^ ((row >> 1) & 7);
    aoff[i] = (unsigned)((row * lda + c * 8) * 2); boff[i] = (unsigned)((row * ldb + c * 8) * 2);
  }
  const char* Ab = (const char*)A; const char* Bb = (const char*)B;
  const unsigned lbase = (unsigned)(uintptr_t)smc;
  const unsigned wdst = lbase + (unsigned)w * 4096u;
  const int swz = (l31 >> 1) & 7;
  unsigned fo[4];
#pragma unroll
  for (int kk = 0; kk < 4; kk++) fo[kk] = (unsigned)(((2 * kk + h) ^ swz) * 16);
  const char* rA = smc + (wm * 64 + l31) * 128;
  const char* rB = smc + 16384 + (wn * 64 + l31) * 128;
  const int nk = K >> 6;
  auto issue = [&](auto BUF, int ko) {
    constexpr int buf = decltype(BUF)::value;
#pragma unroll
    for (int i = 0; i < 4; i++) {
      __builtin_amdgcn_global_load_lds((const unsigned*)(Ab + (size_t)ko * 2 + aoff[i]), (LAS3 unsigned*)(uintptr_t)(wdst + buf * 32768 + i * 1024), 16, 0, 0);
      __builtin_amdgcn_global_load_lds((const unsigned*)(Bb + (size_t)ko * 2 + boff[i]), (LAS3 unsigned*)(uintptr_t)(wdst + buf * 32768 + 16384 + i * 1024), 16, 0, 0);
    }
  };
  auto comp = [&](auto BUF) {
    constexpr int buf = decltype(BUF)::value;
#pragma unroll
    for (int kk = 0; kk < 4; kk++) {
      bf16x8 af[2], bfr[2];
#pragma unroll
      for (int mb = 0; mb < 2; mb++) af[mb] = *(const bf16x8*)(rA + buf * 32768 + mb * 32 * 128 + fo[kk]);
#pragma unroll
      for (int nb = 0; nb < 2; nb++) bfr[nb] = *(const bf16x8*)(rB + buf * 32768 + nb * 32 * 128 + fo[kk]);
#pragma unroll
      for (int mb = 0; mb < 2; mb++)
#pragma unroll
        for (int nb = 0; nb < 2; nb++) acc[mb][nb] = MFMA(af[mb], bfr[nb], acc[mb][nb]);
    }
  };
  using B0 = std::integral_constant<int, 0>; using B1 = std::integral_constant<int, 1>;
  if (!started) issue(B0{}, 0);
  __syncthreads();
  for (int ks = 0; ks < nk; ks += 2) {
    issue(B1{}, (ks + 1) * 64);
    __builtin_amdgcn_sched_barrier(0);
    comp(B0{});
    __syncthreads();
    if (ks + 2 < nk) issue(B0{}, (ks + 2) * 64);
    else if (has_next) gemm_dma_stage0(next, smc);
    __builtin_amdgcn_sched_barrier(0);
    comp(B1{});
    __syncthreads();
  }
}

template <int NB>
DI void gemm_loop_dma16(const bf16_t* __restrict__ A, long lda, const bf16_t* __restrict__ B, long ldb, int K, f32x4 (&acc)[4][NB], char* smc,
                      bool started = false, bool has_next = false, GDesc next = GDesc{nullptr, 0, nullptr, 0}) {
  const int t = tid(), lane = t & 63, w = t >> 6, wm = w >> 1, wn = w & 1, r16 = lane & 15, q = lane >> 4;
  unsigned aoff[4], boff[NB];
#pragma unroll
  for (int i = 0; i < 4; i++) {
    const int row = 32 * w + 8 * i + (lane >> 3), c = (lane & 7) ^ ((row >> 1) & 7);
    aoff[i] = (unsigned)((row * lda + c * 8) * 2);
  }
#pragma unroll
  for (int i = 0; i < NB; i++) {
    const int row = 8 * (NB * w + i) + (lane >> 3), c = (lane & 7) ^ ((row >> 1) & 7);
    boff[i] = (unsigned)((row * ldb + c * 8) * 2);
  }
  const char* Ab = (const char*)A; const char* Bb = (const char*)B;
  const unsigned lbase = (unsigned)(uintptr_t)smc;
  const unsigned wdst = lbase + (unsigned)w * 4096u;
  const int swz = (r16 >> 1) & 7;
  unsigned fo[2];
#pragma unroll
  for (int k32 = 0; k32 < 2; k32++) fo[k32] = (unsigned)(((4 * k32 + q) ^ swz) * 16);
  const char* rA = smc + (wm * 64 + r16) * 128;
  const char* rB = smc + 16384 + (wn * 16 * NB + r16) * 128;
  const int nk = K >> 6;
  auto issue = [&](auto BUF, int ko) {
    constexpr int buf = decltype(BUF)::value;
#pragma unroll
    for (int i = 0; i < 4; i++)
      __builtin_amdgcn_global_load_lds((const unsigned*)(Ab + (size_t)ko * 2 + aoff[i]), (LAS3 unsigned*)(uintptr_t)(wdst + buf * 32768 + i * 1024), 16, 0, 0);
#pragma unroll
    for (int i = 0; i < NB; i++)
      __builtin_amdgcn_global_load_lds((const unsigned*)(Bb + (size_t)ko * 2 + boff[i]), (LAS3 unsigned*)(uintptr_t)(lbase + buf * 32768 + 16384 + (NB * w + i) * 1024), 16, 0, 0);
  };
  auto comp = [&](auto BUF) {
    constexpr int buf = decltype(BUF)::value;
#pragma unroll
    for (int k32 = 0; k32 < 2; k32++) {
      bf16x8 af[4], bq[NB];
#pragma unroll
      for (int mb = 0; mb < 4; mb++) af[mb] = *(const bf16x8*)(rA + buf * 32768 + mb * 16 * 128 + fo[k32]);
#pragma unroll
      for (int nb = 0; nb < NB; nb++) bq[nb] = *(const bf16x8*)(rB + buf * 32768 + nb * 16 * 128 + fo[k32]);
#pragma unroll
      for (int mb = 0; mb < 4; mb++)
#pragma unroll
        for (int nb = 0; nb < NB; nb++) acc[mb][nb] = MFMA16(af[mb], bq[nb], acc[mb][nb]);
    }
  };
  using B0 = std::integral_constant<int, 0>; using B1 = std::integral_constant<int, 1>;
  if (!started) issue(B0{}, 0);
  __syncthreads();
  for (int ks = 0; ks < nk; ks += 2) {
    issue(B1{}, (ks + 1) * 64); __builtin_amdgcn_sched_barrier(0);
    comp(B0{});
    __syncthreads();
    if (ks + 2 < nk) issue(B0{}, (ks + 2) * 64);
    else if (has_next) gemm_dma_stage0(next, smc);
    __builtin_amdgcn_sched_barrier(0);
    comp(B1{});
    __syncthreads();
  }
}

DI void gemm_loop_dma2(const bf16_t* __restrict__ A, long lda, const bf16_t* __restrict__ B0, const bf16_t* __restrict__ B1, long ldb, int K,
                       f32x16 (&accP)[2][2], f32x16 (&accQ)[2][2], char* smc) {
  const int t = tid(), lane = t & 63, w = t >> 6, wm = w >> 1, wn = w & 1, l31 = lane & 31, h = lane >> 5;
  unsigned aoff[2], boff[2];
#pragma unroll
  for (int i = 0; i < 2; i++) {
    const int row = 16 * (2 * w + i) + (lane >> 2), c = (lane & 3) ^ ((row >> 2) & 3);
    aoff[i] = (unsigned)((row * lda + c * 8) * 2); boff[i] = (unsigned)((row * ldb + c * 8) * 2);
  }
  const char* Ab = (const char*)A; const char* B0b = (const char*)B0; const char* B1b = (const char*)B1;
  const unsigned wdst = (unsigned)(uintptr_t)smc + (unsigned)w * 2048u;
  const int swz = (l31 >> 2) & 3;
  unsigned fo[2];
#pragma unroll
  for (int kk = 0; kk < 2; kk++) fo[kk] = (unsigned)(((2 * kk + h) ^ swz) * 16);
  const char* rA = smc + (wm * 64 + l31) * 64;
  const char* rB0 = smc + 8192 + (wn * 64 + l31) * 64;
  const char* rB1 = smc + 16384 + (wn * 64 + l31) * 64;
  const int nk = K >> 5;
  auto issue = [&](auto BUF, int ko) {
    constexpr int buf = decltype(BUF)::value;
#pragma unroll
    for (int i = 0; i < 2; i++) {
      __builtin_amdgcn_global_load_lds((const unsigned*)(Ab + (size_t)ko * 2 + aoff[i]), (LAS3 unsigned*)(uintptr_t)(wdst + buf * 24576 + i * 1024), 16, 0, 0);
      __builtin_amdgcn_global_load_lds((const unsigned*)(B0b + (size_t)ko * 2 + boff[i]), (LAS3 unsigned*)(uintptr_t)(wdst + buf * 24576 + 8192 + i * 1024), 16, 0, 0);
      __builtin_amdgcn_global_load_lds((const unsigned*)(B1b + (size_t)ko * 2 + boff[i]), (LAS3 unsigned*)(uintptr_t)(wdst + buf * 24576 + 16384 + i * 1024), 16, 0, 0);
    }
  };
  auto comp = [&](auto BUF) {
    constexpr int buf = decltype(BUF)::value;
#pragma unroll
    for (int kk = 0; kk < 2; kk++) {
      bf16x8 af[2], b0[2], b1[2];
#pragma unroll
      for (int mb = 0; mb < 2; mb++) af[mb] = *(const bf16x8*)(rA + buf * 24576 + mb * 32 * 64 + fo[kk]);
#pragma unroll
      for (int nb = 0; nb < 2; nb++) { b0[nb] = *(const bf16x8*)(rB0 + buf * 24576 + nb * 32 * 64 + fo[kk]); b1[nb] = *(const bf16x8*)(rB1 + buf * 24576 + nb * 32 * 64 + fo[kk]); }
#pragma unroll
      for (int mb = 0; mb < 2; mb++)
#pragma unroll
        for (int nb = 0; nb < 2; nb++) { accP[mb][nb] = MFMA(af[mb], b0[nb], accP[mb][nb]); accQ[mb][nb] = MFMA(af[mb], b1[nb], accQ[mb][nb]); }
    }
  };
  using S0 = std::integral_constant<int, 0>; using S1 = std::integral_constant<int, 1>;
  issue(S0{}, 0);
  __syncthreads();
  for (int ks = 0; ks < nk; ks += 2) {
    issue(S1{}, (ks + 1) * 32);
    __builtin_amdgcn_sched_barrier(0);
    comp(S0{});
    __syncthreads();
    if (ks + 2 < nk) issue(S0{}, (ks + 2) * 32);
    __builtin_amdgcn_sched_barrier(0);
    comp(S1{});
    __syncthreads();
  }
}

DI void acc_to_lds(const f32x16 (&acc)[2][2], float* ep) {
  const int t = tid(), lane = t & 63, w = t >> 6, wm = w >> 1, wn = w & 1, l31 = lane & 31, h = lane >> 5;
#pragma unroll
  for (int mb = 0; mb < 2; mb++)
#pragma unroll
    for (int nb = 0; nb < 2; nb++)
#pragma unroll
      for (int i = 0; i < 16; i++) ep[(wm * 64 + mb * 32 + crow(i, h)) * EPW + wn * 64 + nb * 32 + l31] = acc[mb][nb][i];
}
template <int NB>
DI void acc_to_lds4(const f32x4 (&acc)[4][NB], float* ep) {
  const int t = tid(), lane = t & 63, w = t >> 6, wm = w >> 1, wn = w & 1, r16 = lane & 15, q = lane >> 4;
#pragma unroll
  for (int mb = 0; mb < 4; mb++)
#pragma unroll
    for (int nb = 0; nb < NB; nb++) {
      float* d = ep + (wm * 64 + mb * 16 + q * 4) * EPW + wn * 16 * NB + nb * 16 + r16;
      d[0] = acc[mb][nb].x; d[EPW] = acc[mb][nb].y; d[2 * EPW] = acc[mb][nb].z; d[3 * EPW] = acc[mb][nb].w;
    }
}
template <class F>
DI void rowwise(const float* ep, F f) {
  const int t = tid();
#pragma unroll 1
  for (int ps = 0; ps < 8; ps++) {
    const int row = ps * 16 + (t >> 4), c8 = (t & 15) * 8;
    float v[8];
    const f32x4 a = *(const f32x4*)(ep + row * EPW + c8), b = *(const f32x4*)(ep + row * EPW + c8 + 4);
    v[0] = a.x; v[1] = a.y; v[2] = a.z; v[3] = a.w; v[4] = b.x; v[5] = b.y; v[6] = b.z; v[7] = b.w;
    f(row, c8, v);
  }
}
template <class L, class F>
DI void rowwise2(const float* ep, L pre, F f) {
  const int t = tid();
  const int c8 = (t & 15) * 8;
#pragma unroll 1
  for (int g = 0; g < 2; g++) {
    decltype(pre(0, 0)) ld[4];
#pragma unroll
    for (int q = 0; q < 4; q++) ld[q] = pre((g * 4 + q) * 16 + (t >> 4), c8);
#pragma unroll
    for (int q = 0; q < 4; q++) {
      const int row = (g * 4 + q) * 16 + (t >> 4);
      float v[8];
      const f32x4 a = *(const f32x4*)(ep + row * EPW + c8), b = *(const f32x4*)(ep + row * EPW + c8 + 4);
      v[0] = a.x; v[1] = a.y; v[2] = a.z; v[3] = a.w; v[4] = b.x; v[5] = b.y; v[6] = b.z; v[7] = b.w;
      f(row, c8, v, ld[q]);
    }
  }
}
struct LdRope { f32x4 r[4]; };
struct LdKv { unsigned k2; u32x4 x1, x2; f32x4 r[4]; };
struct LdX { f32x4 a, b; };
struct LdGlu { u32x4 yg, gt; };
template <class F>
DI void tstore(const float* ep, int cb, int nc, const float* rowscale, F dst) {
  const int t = tid();
  const int ntask = nc * 16;
  for (int e = t; e < ntask; e += 256) {
    const int col = e % nc, rg = e / nc;
    float v[8];
#pragma unroll
    for (int j = 0; j < 8; j++) { float x = ep[(rg * 8 + j) * EPW + cb + col]; if (rowscale) x *= rowscale[rg * 8 + j]; v[j] = x; }
    *(u32x4*)(dst(col) + rg * 8) = pack8(v);
  }
}

DI void tile_from_linear(int L, int nN, int& tm, int& tn) { const int band = L / (8 * nN), rr = L % (8 * nN); tn = rr >> 3; tm = band * 8 + (rr & 7); }
DI int static_L(int round, int vb) { const int Gx = gridDim.x >> 3; return (round * 8 + (vb & 7)) * Gx + (vb >> 3); }
DI int next_item(unsigned* ctr, int* slot) {
  __syncthreads();
  if (threadIdx.x == 0) *slot = (int)atomicAdd(ctr, 1u);
  __syncthreads();
  return *slot;
}

DI int colmap(int mode, int n) {
  if (mode == 0) return n;
  if (mode == 1) { if (n < 768) return n; if (n < 2304) return n + 1056; if (n < 3360) return n - 1536; if (n < 3456) return -1; return n - 96; }
  { const int hh = n >> 7, j = n & 127; return j < 96 ? hh * 96 + j : -1; }
}
struct CDesc { const float* src; const float* g; bf16_t* dst; int ld, K, mode, it; };
DI void conv_load(const CDesc& d, f32x4 (&v)[8]) {
  const int t = tid();
  const int nkt = d.K >> 6, kt = d.it % nkt, nt = d.it / nkt, k0 = kt * 64, n0 = nt * 128;
  const int n4 = (t & 31) * 4, c = colmap(d.mode, n0 + n4);
#pragma unroll
  for (int i = 0; i < 8; i++) {
    const int kk = (t >> 5) + 8 * i;
    if (c >= 0) v[i] = __builtin_nontemporal_load((const f32x4*)(d.src + (long)(k0 + kk) * d.ld + c)); else { v[i].x = 0.f; v[i].y = 0.f; v[i].z = 0.f; v[i].w = 0.f; }
  }
}
DI void conv_finish(const CDesc& d, f32x4 (&v)[8], float* sm) {
  const int t = tid();
  const int nkt = d.K >> 6, kt = d.it % nkt, nt = d.it / nkt, k0 = kt * 64, n0 = nt * 128;
  const int n4 = (t & 31) * 4;
#pragma unroll
  for (int i = 0; i < 8; i++) {
    const int kk = (t >> 5) + 8 * i;
    if (d.g) { const float gg = d.g[k0 + kk]; v[i].x *= gg; v[i].y *= gg; v[i].z *= gg; v[i].w *= gg; }
    *(f32x4*)(sm + kk * 132 + n4) = v[i];
  }
  __syncthreads();
#pragma unroll
  for (int i = 0; i < 2; i++) {
    const int nn = (t >> 2) + 64 * i, ks = (t & 3) * 16;
    float f[16];
#pragma unroll
    for (int j = 0; j < 16; j++) f[j] = sm[(ks + j) * 132 + nn];
    u32x4 o0, o1;
    o0.x = pk2(f[0], f[1]); o0.y = pk2(f[2], f[3]); o0.z = pk2(f[4], f[5]); o0.w = pk2(f[6], f[7]);
    o1.x = pk2(f[8], f[9]); o1.y = pk2(f[10], f[11]); o1.z = pk2(f[12], f[13]); o1.w = pk2(f[14], f[15]);
    bf16_t* dd = d.dst + (long)(n0 + nn) * d.K + k0 + ks;
    *(u32x4*)dd = o0; *(u32x4*)(dd + 8) = o1;
  }
  __syncthreads();
}
constexpr int NCONV = 944 + 72 + 32 + 8 + 32 + 64 + 32 + 32 + 128 + 64;
constexpr int NAUX = NCONV + 512;
DI CDesc conv_desc(const P& p, int l, int it) {
  CDesc d; d.g = nullptr; d.mode = 0;
  if (it < 944) { d.src = p.w_in + (long)l * 1024 * INW; d.ld = INW; d.K = 1024; d.mode = 1; d.g = p.norm_g + l * 1024; d.dst = p.WinT; d.it = it; return d; }
  it -= 944;
  if (it < 72) { d.src = p.b_w_uq + (long)l * 768 * 768; d.ld = 768; d.K = 768; d.g = p.b_q_norm_g + l * 768; d.dst = p.WuqT; d.it = it; return d; }
  it -= 72;
  if (it < 32) { d.src = p.b_w_ukv + (long)l * 256 * 1024; d.ld = 1024; d.K = 256; d.g = p.b_kv_norm_g + l * 256; d.dst = p.WukvT; d.it = it; return d; }
  it -= 32;
  if (it < 8) { d.src = p.c_w_glu + (long)l * 256 * 256; d.ld = 256; d.K = 256; d.dst = p.WgluT; d.it = it; return d; }
  it -= 8;
  if (it < 32) { d.src = p.w_br_a + (long)l * 256 * 1024; d.ld = 1024; d.K = 256; d.dst = p.WbrT; d.it = it; return d; }
  it -= 32;
  if (it < 64) { d.src = p.w_br_b + (long)l * 512 * 1024; d.ld = 1024; d.K = 512; d.dst = p.WbrT + 1024 * 256; d.it = it; return d; }
  it -= 64;
  if (it < 32) { d.src = p.w_br_c + (long)l * 256 * 1024; d.ld = 1024; d.K = 256; d.dst = p.WbrT + 1024 * 768; d.it = it; return d; }
  it -= 32;
  if (it < 32) { d.src = p.w_br_m + (long)l * 256 * 1024; d.ld = 1024; d.K = 256; d.dst = p.WbrT + 1024 * 1024; d.it = it; return d; }
  it -= 32;
  if (it < 128) { d.src = p.w_out + (long)l * 1024 * 1024; d.ld = 1024; d.K = 1024; d.dst = p.WoutT + (long)l * 1024 * 1024; d.it = it; return d; }
  it -= 128;
  d.src = p.m_w_kv + (long)l * 1024 * 512; d.ld = 512; d.K = 1024; d.dst = p.WmkvT; d.it = it; return d;
}
DI void conv_all(const P& p, int l, char* smem) {
  const int G = gridDim.x, bid = blockIdx.x;
  float* sm = (float*)smem;
  if (bid >= NCONV) return;
  f32x4 va[8], vb[8];
  CDesc da = conv_desc(p, l, bid), db = da;
  conv_load(da, va);
#pragma unroll 1
  for (int it = bid; it < NCONV; it += 2 * G) {
    const bool h1 = it + G < NCONV;
    if (h1) { db = conv_desc(p, l, it + G); conv_load(db, vb); }
    conv_finish(da, va, sm);
    const bool h2 = it + 2 * G < NCONV;
    if (h2) { da = conv_desc(p, l, it + 2 * G); conv_load(da, va); }
    if (h1) conv_finish(db, vb, sm);
  }
}
DI void aux_item(const P& p, int l, int it, char* smem) {
  it -= NCONV;
  {
    const int t = tid(), lane = t & 63, row = it * 4 + (t >> 6);
    const float* src = p.mem + (long)row * 1024; const float* g = p.m_norm_g + l * 1024;
    f32x4 v[4]; float ss = 0.f;
#pragma unroll
    for (int i = 0; i < 4; i++) { v[i] = *(const f32x4*)(src + (lane + 64 * i) * 4); ss += v[i].x * v[i].x + v[i].y * v[i].y + v[i].z * v[i].z + v[i].w * v[i].w; }
    ss = sum64(ss);
    const float r = rsqrtf(ss * (1.f / 1024.f) + EPS);
#pragma unroll
    for (int i = 0; i < 4; i++) {
      const f32x4 gg = *(const f32x4*)(g + (lane + 64 * i) * 4);
      u32x2 o; o.x = pk2(v[i].x * r * gg.x, v[i].y * r * gg.y); o.y = pk2(v[i].z * r * gg.z, v[i].w * r * gg.w);
      *(u32x2*)(p.hm + (long)row * 1024 + (lane + 64 * i) * 4) = o;
    }
  }
}

DI void p0_xrow_item(const P& p, int it) {
  const int t = tid(), lane = t & 63;
  f32x4 v[2][4];
#pragma unroll
  for (int r = 0; r < 2; r++) {
    const float* src = p.x + (long)(it * 8 + (t >> 6) * 2 + r) * 1024;
#pragma unroll
    for (int i = 0; i < 4; i++) v[r][i] = __builtin_nontemporal_load((const f32x4*)(src + (lane + 64 * i) * 4));
  }
#pragma unroll
  for (int r = 0; r < 2; r++) {
    const int row = it * 8 + (t >> 6) * 2 + r;
    float ss = 0.f;
#pragma unroll
    for (int i = 0; i < 4; i++) ss += v[r][i].x * v[r][i].x + v[r][i].y * v[r][i].y + v[r][i].z * v[r][i].z + v[r][i].w * v[r][i].w;
    ss = sum64(ss);
#pragma unroll
    for (int i = 0; i < 4; i++) { u32x2 o; o.x = pk2(v[r][i].x, v[r][i].y); o.y = pk2(v[r][i].z, v[r][i].w); *(u32x2*)(p.xb + (long)row * 1024 + (lane + 64 * i) * 4) = o; }
    if (lane < 8) p.ssp[(long)lane * T_ + row] = (lane == 0) ? ss : 0.f;
  }
}
DI void p0_rope_item(const P& p, int it) {
  const int e = it * 256 + threadIdx.x, tok = e >> 4, i = e & 15;
  const float inv_freq = exp2f(-(float)i * (13.287712379549449f / 16.f));
  const float ang = (float)p.pos[tok] * inv_freq;
  const double rev = (double)ang * 0.15915494309189535;
  const float fr = (float)(rev - rint(rev));
  p.rope[(long)e * 2] = __builtin_amdgcn_cosf(fr);
  p.rope[(long)e * 2 + 1] = __builtin_amdgcn_sinf(fr);
}

DI void load_rs(const P& p, int r0, float* rsS) {
  const int t = tid();
  if (t < 128) { float s = 0.f;
#pragma unroll
    for (int j = 0; j < 8; j++) s += p.ssp[(long)j * T_ + r0 + t];
    rsS[t] = rsqrtf(s * (1.f / 1024.f) + EPS); }
}
DI void g1_tile(const P& p, int l, int tm, int tn, char* smem) {
  bf16_t* sm = (bf16_t*)smem; float* ep = (float*)smem; float* rsS = (float*)(smem + SM_RS);
  const int r0 = tm * 128, c0 = tn * 128;
  load_rs(p, r0, rsS);
  f32x16 acc[2][2]; zero_acc(acc);
  gemm_loop_dma(p.xb + (long)r0 * 1024, 1024, p.WinT + (long)c0 * 1024, 1024, 1024, acc, smem);
  acc_to_lds(acc, ep);
  __syncthreads();
  int type; bf16_t* dst; int ld;
  if (c0 < 2304) { dst = p.z1 + c0; ld = Z1W;
    if (c0 < 512) type = 1; else if (c0 < 1280) type = 2; else if (c0 < 1536) type = 0; else if (c0 < 1792) type = 2; else if (c0 < 2048) type = 3; else type = 2;
  } else { dst = p.z2 + (c0 - 2304); ld = Z2W; type = 0; }
  const float* gq = p.m_qk_g_q + l * 64;
  rowwise(ep, [&](int row, int c8, float (&v)[8]) {
    const float r = rsS[row];
#pragma unroll
    for (int j = 0; j < 8; j++) v[j] *= r;
    if (type == 1) {
#pragma unroll
      for (int j = 0; j < 8; j++) v[j] = gelu_t(v[j]);
    } else if (type == 2) {
#pragma unroll
      for (int j = 0; j < 8; j++) v[j] = silu(v[j]);
    } else if (type == 3) {
      float ss = 0.f;
#pragma unroll
      for (int j = 0; j < 8; j++) ss += v[j] * v[j];
      ss = sum8(ss);
      const float rq = rsqrtf(ss * (1.f / 64.f) + EPS) * (0.125f * LOG2E);
#pragma unroll
      for (int j = 0; j < 8; j++) v[j] *= rq * gq[(c8 & 63) + j];
    }
    *(u32x4*)(dst + (long)(r0 + row) * ld + c8) = pack8(v);
    if (c0 >= 2304) {
      float ss = 0.f;
#pragma unroll
      for (int j = 0; j < 8; j++) ss += v[j] * v[j];
      ss = sum16(ss);
      if ((c8 >> 3) == 0) p.ssq[(long)((c0 - 2304) >> 7) * T_ + r0 + row] = ss;
    }
  });
  __syncthreads();
}
DI void g1_tile2(const P& p, int l, int tm, int tn, char* smem) {
  float* ep = (float*)smem; float* rsS = (float*)(smem + SM_RS);
  const int r0 = tm * 128;
  load_rs(p, r0, rsS);
  f32x16 accP[2][2], accQ[2][2]; zero_acc(accP); zero_acc(accQ);
  const bf16_t* w0 = p.WinT + (long)(tn * 128) * 1024;
  gemm_loop_dma2(p.xb + (long)r0 * 1024, 1024, w0, w0 + (long)128 * 1024, 1024, 1024, accP, accQ, smem);
  auto epi = [&](const f32x16 (&acc)[2][2], int tnn) {
    const int c0 = tnn * 128;
    acc_to_lds(acc, ep);
    __syncthreads();
    int type; bf16_t* dst; int ld;
    if (c0 < 2304) { dst = p.z1 + c0; ld = Z1W;
      if (c0 < 512) type = 1; else if (c0 < 1280) type = 2; else if (c0 < 1536) type = 0; else if (c0 < 1792) type = 2; else if (c0 < 2048) type = 3; else type = 2;
    } else { dst = p.z2 + (c0 - 2304); ld = Z2W; type = 0; }
    const float* gq = p.m_qk_g_q + l * 64;
    rowwise(ep, [&](int row, int c8, float (&v)[8]) {
      const float r = rsS[row];
#pragma unroll
      for (int j = 0; j < 8; j++) v[j] *= r;
      if (type == 1) {
#pragma unroll
        for (int j = 0; j < 8; j++) v[j] = gelu_t(v[j]);
      } else if (type == 2) {
#pragma unroll
        for (int j = 0; j < 8; j++) v[j] = silu(v[j]);
      } else if (type == 3) {
        float ss = 0.f;
#pragma unroll
        for (int j = 0; j < 8; j++) ss += v[j] * v[j];
        ss = sum8(ss);
        const float rq = rsqrtf(ss * (1.f / 64.f) + EPS) * (0.125f * LOG2E);
#pragma unroll
        for (int j = 0; j < 8; j++) v[j] *= rq * gq[(c8 & 63) + j];
      }
      *(u32x4*)(dst + (long)(r0 + row) * ld + c8) = pack8(v);
      if (c0 >= 2304) {
        float ss = 0.f;
#pragma unroll
        for (int j = 0; j < 8; j++) ss += v[j] * v[j];
        ss = sum16(ss);
        if ((c8 >> 3) == 0) p.ssq[(long)((c0 - 2304) >> 7) * T_ + r0 + row] = ss;
      }
    });
    __syncthreads();
  };
  epi(accP, tn);
  epi(accQ, tn + 1);
}
DI void g1m_tile(const P& p, int l, int tm, int tn, char* smem) {
  bf16_t* sm = (bf16_t*)smem; float* ep = (float*)smem;
  const int r0 = tm * 128, c0 = tn * 128;
  f32x16 acc[2][2]; zero_acc(acc);
  gemm_loop_dma(p.hm + (long)r0 * 1024, 1024, p.WmkvT + (long)c0 * 1024, 1024, 1024, acc, smem);
  acc_to_lds(acc, ep);
  __syncthreads();
  if (tn < 2) {
    const float* gk = p.m_qk_g_k + l * 64;
    rowwise(ep, [&](int row, int c8, float (&v)[8]) {
      float ss = 0.f;
#pragma unroll
      for (int j = 0; j < 8; j++) ss += v[j] * v[j];
      ss = sum8(ss);
      const float rq = rsqrtf(ss * (1.f / 64.f) + EPS);
#pragma unroll
      for (int j = 0; j < 8; j++) v[j] *= rq * gk[(c8 & 63) + j];
      *(u32x4*)(p.memk + (long)(r0 + row) * 256 + c0 + c8) = pack8(v);
    });
  } else {
    const int b = r0 >> 8, m0 = r0 & 255, cv0 = c0 - 256;
    tstore(ep, 0, 128, nullptr, [&](int col) { const int cv = cv0 + col; return p.memvt + ((long)((b * 4 + (cv >> 6)) * 64 + (cv & 63))) * 256 + m0; });
  }
  __syncthreads();
}

DI void g2q_tile(const P& p, int l, int tm, int hh, char* smem) {
  bf16_t* sm = (bf16_t*)smem; float* ep = (float*)smem; float* ssS = (float*)(smem + SM_SS);
  const int r0 = tm * 128;
  f32x4 acc[4][3]; zero_acc4<3>(acc);
  { const int t = tid(); if (t < 128) { float q = 0.f;
#pragma unroll
      for (int j = 0; j < 6; j++) q += p.ssq[(long)j * T_ + r0 + t];
      ssS[t] = rsqrtf(q * (1.f / 768.f) + EPS); } }
  gemm_loop_dma16<3>(p.z2 + (long)r0 * Z2W, Z2W, p.WuqT + (long)hh * 96 * 768, 768, 768, acc, smem);
  acc_to_lds4<3>(acc, ep);
  __syncthreads();
  const float* gq = p.b_qk_g_q + l * 96;
  const float QSC = 0.10206207261596575f * LOG2E;
  rowwise2(ep, [&](int row, int c8) {
    LdRope L;
    const int tc = c8 >> 3;
    if (tc >= 8 && tc < 12) {
      const float* rp = p.rope + ((long)(r0 + row) * 16 + (tc & 1) * 8) * 2;
#pragma unroll
      for (int j = 0; j < 4; j++) L.r[j] = *(const f32x4*)(rp + 4 * j);
    } else {
#pragma unroll
      for (int j = 0; j < 4; j++) { L.r[j].x = 0.f; L.r[j].y = 0.f; L.r[j].z = 0.f; L.r[j].w = 0.f; }
    }
    return L;
  }, [&](int row, int c8, float (&v)[8], const LdRope& L) {
    const float rs = ssS[row];
    float ss = 0.f;
#pragma unroll
    for (int j = 0; j < 8; j++) { v[j] *= rs; ss += v[j] * v[j]; }
    const int tc = c8 >> 3;
    if (tc >= 12) ss = 0.f;
    ss = sum16(ss);
    const float rq = rsqrtf(ss * (1.f / 96.f) + EPS);
    bf16_t* qd = p.qf + (long)(r0 + row) * 768 + hh * 96;
    if (tc < 8) {
#pragma unroll
      for (int j = 0; j < 8; j++) v[j] *= rq * gq[c8 + j] * QSC;
      *(u32x4*)(qd + c8) = pack8(v);
    } else if (tc < 12) {
      const int i0 = (tc & 1) * 8; const bool first = tc < 10;
      const int pc = first ? 80 + i0 : 64 + i0;
      const float csn[16] = {L.r[0].x, L.r[0].y, L.r[0].z, L.r[0].w, L.r[1].x, L.r[1].y, L.r[1].z, L.r[1].w,
                             L.r[2].x, L.r[2].y, L.r[2].z, L.r[2].w, L.r[3].x, L.r[3].y, L.r[3].z, L.r[3].w};
      float o[8];
#pragma unroll
      for (int j = 0; j < 8; j++) {
        const float own = v[j] * rq * gq[c8 + j];
        const float oth = ep[row * EPW + pc + j] * rs * rq * gq[pc + j];
        const float cs = csn[2 * j], sn = csn[2 * j + 1];
        o[j] = (first ? (own * cs - oth * sn) : (own * cs + oth * sn)) * QSC;
      }
      *(u32x4*)(qd + c8) = pack8(o);
    }
  });
  __syncthreads();
}
DI void g2kv_tile(const P& p, int l, int tm, int hh, char* smem) {
  bf16_t* sm = (bf16_t*)smem; float* ep = (float*)smem; float* ssS = (float*)(smem + SM_SS);
  const int r0 = tm * 128;
  f32x16 acc[2][2]; zero_acc(acc);
  { const int t = tid(); if (t < 128) { const float q = p.ssq[(long)6 * T_ + r0 + t] + p.ssq[(long)7 * T_ + r0 + t];
      ssS[t] = rsqrtf(q * (1.f / 256.f) + EPS); } }
  gemm_loop_dma(p.z2 + (long)r0 * Z2W + 768, Z2W, p.WukvT + (long)hh * 128 * 256, 256, 256, acc, smem);
  acc_to_lds(acc, ep);
  __syncthreads();
  const float* gk = p.b_qk_g_k + l * 96;
  rowwise2(ep, [&](int row, int c8) {
    LdKv L;
    const int tc = c8 >> 3;
    const bf16_t* krp = p.z2 + (long)(r0 + row) * Z2W + 1024;
    L.k2 = *(const unsigned*)(krp + 2 * tc);
    if (tc >= 8 && tc < 12) {
      const int i0 = (tc & 1) * 8;
      L.x1 = *(const u32x4*)(krp + i0); L.x2 = *(const u32x4*)(krp + 16 + i0);
      const float* rp = p.rope + ((long)(r0 + row) * 16 + i0) * 2;
#pragma unroll
      for (int j = 0; j < 4; j++) L.r[j] = *(const f32x4*)(rp + 4 * j);
    } else {
      L.x1.x = 0; L.x1.y = 0; L.x1.z = 0; L.x1.w = 0; L.x2 = L.x1;
#pragma unroll
      for (int j = 0; j < 4; j++) { L.r[j].x = 0.f; L.r[j].y = 0.f; L.r[j].z = 0.f; L.r[j].w = 0.f; }
    }
    return L;
  }, [&](int row, int c8, float (&v)[8], const LdKv& L) {
    const float rs = ssS[row];
    const int tc = c8 >> 3;
    const unsigned k2 = L.k2;
    const float ka = __uint_as_float(k2 << 16), kb = __uint_as_float(k2 & 0xffff0000u);
    float ss = ka * ka + kb * kb;
    if (tc < 8) {
#pragma unroll
      for (int j = 0; j < 8; j++) { v[j] *= rs; ss += v[j] * v[j]; }
    }
    ss = sum16(ss);
    const float kn = rsqrtf(ss * (1.f / 96.f) + EPS);
    bf16_t* kd = p.kf + (long)(r0 + row) * 768 + hh * 96;
    if (tc < 8) {
#pragma unroll
      for (int j = 0; j < 8; j++) v[j] *= kn * gk[c8 + j];
      *(u32x4*)(kd + c8) = pack8(v);
    } else if (tc < 12) {
      const int i0 = (tc & 1) * 8; const bool first = tc < 10;
      float x1[8], x2[8], o[8];
      unpack8(L.x1, x1);
      unpack8(L.x2, x2);
      const float csn[16] = {L.r[0].x, L.r[0].y, L.r[0].z, L.r[0].w, L.r[1].x, L.r[1].y, L.r[1].z, L.r[1].w,
                             L.r[2].x, L.r[2].y, L.r[2].z, L.r[2].w, L.r[3].x, L.r[3].y, L.r[3].z, L.r[3].w};
#pragma unroll
      for (int j = 0; j < 8; j++) {
        const float a = x1[j] * kn * gk[64 + i0 + j], b = x2[j] * kn * gk[80 + i0 + j];
        const float cs = csn[2 * j], sn = csn[2 * j + 1];
        o[j] = first ? (a * cs - b * sn) : (b * cs + a * sn);
      }
      *(u32x4*)(kd + (first ? 64 : 80) + i0) = pack8(o);
    }
  });
  {
    const int b = r0 >> 11, s0 = r0 & 2047;
    tstore(ep, 64, 64, ssS, [&](int col) { return p.vt + ((long)((b * 8 + hh) * 64 + col)) * S_ + s0; });
  }
  __syncthreads();
}

template <int DQK, bool CAUSAL>
DI void attn_item(const bf16_t* __restrict__ q, long q_ld, const bf16_t* __restrict__ k, long k_ld, const bf16_t* __restrict__ vt, long vt_ld,
                  bf16_t* og, long o_ld, int q0, int nkt, char* smem, bool dry) {
  constexpr int KS = DQK + 8, NKC = DQK / 8, NKL = (64 * NKC) / 256, NKK = DQK / 16, VS = 68;
  bf16_t* sK = (bf16_t*)smem;
  bf16_t* sV = (bf16_t*)smem + 2 * 64 * KS;
  const int t = tid(), lane = t & 63, w = t >> 6, l31 = lane & 31, h = lane >> 5;
  bf16x8 qfr[NKK];
  {
    const bf16_t* qp = q + (long)(w * 32 + l31) * q_ld + h * 8;
#pragma unroll
    for (int kk = 0; kk < NKK; kk++) qfr[kk] = *(const bf16x8*)(qp + kk * 16);
  }
  u32x4 rk[NKL], rv[2];
  auto gload = [&](int kt) {
#pragma unroll
    for (int i = 0; i < NKL; i++) { const int c = t + 256 * i, key = c / NKC, kc = c % NKC; rk[i] = *(const u32x4*)(k + (long)(kt * 64 + key) * k_ld + kc * 8); }
#pragma unroll
    for (int i = 0; i < 2; i++) { const int c = t + 256 * i, d = c >> 3, kc = c & 7; rv[i] = *(const u32x4*)(vt + (long)d * vt_ld + kt * 64 + kc * 8); }
  };
  auto lstore = [&](int buf) {
    bf16_t* dK = sK + buf * 64 * KS; bf16_t* dV = sV + buf * 64 * VS;
#pragma unroll
    for (int i = 0; i < NKL; i++) { const int c = t + 256 * i, key = c / NKC, kc = c % NKC; *(u32x4*)(dK + key * KS + kc * 8) = rk[i]; }
#pragma unroll
    for (int i = 0; i < 2; i++) { const int c = t + 256 * i, d = c >> 3, kc = c & 7;
      u32x2 lo, hi; lo.x = rv[i].x; lo.y = rv[i].y; hi.x = rv[i].z; hi.y = rv[i].w;
      *(u32x2*)(dV + d * VS + kc * 8) = lo; *(u32x2*)(dV + d * VS + kc * 8 + 4) = hi; }
  };
  f32x16 o[2];
#pragma unroll
  for (int i = 0; i < 16; i++) { o[0][i] = 0.f; o[1][i] = 0.f; }
  float m = -1e30f, lsum = 0.f;
  const int qpos = q0 + w * 32 + l31;
  gload(0); lstore(0);
  if (nkt > 1) gload(1);
  __syncthreads();
  for (int kt = 0; kt < nkt; kt++) {
    if (kt + 1 < nkt) lstore((kt + 1) & 1);
    __builtin_amdgcn_sched_barrier(0);
    if (kt + 2 < nkt) gload(kt + 2);
    __builtin_amdgcn_sched_barrier(0);
    const bool active = !CAUSAL || (kt * 64 <= q0 + w * 32 + 31);
    if (active) {
      const bf16_t* cK = sK + (kt & 1) * 64 * KS; const bf16_t* cV = sV + (kt & 1) * 64 * VS;
      f32x16 s[2];
#pragma unroll
      for (int i = 0; i < 16; i++) { s[0][i] = 0.f; s[1][i] = 0.f; }
      __builtin_amdgcn_s_setprio(1);
#pragma unroll
      for (int kb = 0; kb < 2; kb++)
#pragma unroll
        for (int kk = 0; kk < NKK; kk++) {
          const bf16x8 kf_ = *(const bf16x8*)(cK + (kb * 32 + l31) * KS + kk * 16 + h * 8);
          s[kb] = MFMA(kf_, qfr[kk], s[kb]);
        }
      __builtin_amdgcn_s_setprio(0);
      if (CAUSAL && (kt * 64 + 63 > q0 + w * 32)) {
#pragma unroll
        for (int kb = 0; kb < 2; kb++)
#pragma unroll
          for (int i = 0; i < 16; i++) { const int key = kt * 64 + kb * 32 + crow(i, h); if (key > qpos) s[kb][i] = -1e30f; }
      }
      float mx = s[0][0];
#pragma unroll
      for (int kb = 0; kb < 2; kb++)
#pragma unroll
        for (int i = 0; i < 16; i++) mx = fmaxf(mx, s[kb][i]);
      mx = fmaxf(mx, __shfl_xor(mx, 32));
      const float mnew = fmaxf(m, mx);
      const float alpha = __builtin_amdgcn_exp2f(m - mnew);
      m = mnew;
      float ps = 0.f;
#pragma unroll
      for (int kb = 0; kb < 2; kb++)
#pragma unroll
        for (int i = 0; i < 16; i++) { const float pv = __builtin_amdgcn_exp2f(s[kb][i] - mnew); s[kb][i] = pv; ps += pv; }
      lsum = lsum * alpha + ps;
#pragma unroll
      for (int i = 0; i < 16; i++) { o[0][i] *= alpha; o[1][i] *= alpha; }
      __builtin_amdgcn_s_setprio(1);
#pragma unroll
      for (int kb = 0; kb < 2; kb++)
#pragma unroll
        for (int st = 0; st < 2; st++) {
          u32x4 pp; pp.x = pk2(s[kb][8 * st + 0], s[kb][8 * st + 1]); pp.y = pk2(s[kb][8 * st + 2], s[kb][8 * st + 3]);
          pp.z = pk2(s[kb][8 * st + 4], s[kb][8 * st + 5]); pp.w = pk2(s[kb][8 * st + 6], s[kb][8 * st + 7]);
          const bf16x8 pf = __builtin_bit_cast(bf16x8, pp);
#pragma unroll
          for (int db = 0; db < 2; db++) {
            const bf16_t* vp = cV + (db * 32 + l31) * VS + kb * 32 + st * 16 + 4 * h;
            const u32x2 lo = *(const u32x2*)vp, hi = *(const u32x2*)(vp + 8);
            u32x4 vv; vv.x = lo.x; vv.y = lo.y; vv.z = hi.x; vv.w = hi.y;
            o[db] = MFMA(__builtin_bit_cast(bf16x8, vv), pf, o[db]);
          }
        }
      __builtin_amdgcn_s_setprio(0);
    }
    __syncthreads();
  }
  lsum += __shfl_xor(lsum, 32);
  const float inv = 1.f / lsum;
  bf16_t* op = og + (long)(w * 32 + l31) * o_ld;
#pragma unroll
  for (int db = 0; db < 2; db++)
#pragma unroll
    for (int ig = 0; ig < 4; ig++) {
      const int d = db * 32 + ig * 8 + 4 * h;
      float gt[4]; unpack4(*(const u32x2*)(op + d), gt);
      u32x2 r; r.x = pk2(o[db][4 * ig + 0] * inv * gt[0], o[db][4 * ig + 1] * inv * gt[1]); r.y = pk2(o[db][4 * ig + 2] * inv * gt[2], o[db][4 * ig + 3] * inv * gt[3]);
      if (!dry) *(u32x2*)(op + d) = r;
    }
}
DI void mattn_item(const P& p, int idx, char* smem) {
  const int b = idx >> 6, hh = (idx >> 4) & 3, qt = idx & 15;
  const long tok0 = (long)b * S_ + qt * 128;
  attn_item<64, false>(p.z1 + tok0 * Z1W + 1792 + hh * 64, Z1W, p.memk + (long)b * 256 * 256 + hh * 64, 256,
                       p.memvt + (long)(b * 4 + hh) * 64 * 256, 256, p.z1 + tok0 * Z1W + 2048 + hh * 64, Z1W, 0, 4, smem, p.dry != 0);
}
DI void battn_item(const P& p, int idx, char* smem) {
  const int qt = 15 - (idx >> 6), bh = idx & 63, b = bh >> 3, hh = bh & 7;
  const long tok0 = (long)b * S_ + qt * 128;
  attn_item<96, true>(p.qf + tok0 * 768 + hh * 96, 768, p.kf + (long)b * S_ * 768 + hh * 96, 768,
                      p.vt + (long)(b * 8 + hh) * 64 * S_, S_, p.z1 + tok0 * Z1W + 768 + hh * 64, Z1W, qt * 128, 2 * qt + 2, smem, p.dry != 0);
}

DI void a_item(const P& p, int l, int idx, char* smem) {
  bf16_t* vnT = (bf16_t*)smem;
  float* part = (float*)(smem + 256 * 136 * 2);
  const int t = tid(); const long r0 = (long)idx * 128;
  {
    const int row = t & 127, half = t >> 7;
    const bf16_t* src = p.z1 + (r0 + row) * Z1W + 256 + half * 128;
    float ss = 0.f;
#pragma unroll 4
    for (int i = 0; i < 16; i++) { float f[8]; unpack8(*(const u32x4*)(src + i * 8), f);
#pragma unroll
      for (int j = 0; j < 8; j++) ss += f[j] * f[j]; }
    part[half * 128 + row] = ss;
    __syncthreads();
    const float r = rsqrtf((part[row] + part[128 + row]) * (1.f / 256.f) + EPS);
    const float* gv = p.a_norm_g + l * 256 + half * 128;
#pragma unroll 4
    for (int i = 0; i < 16; i++) { float f[8]; unpack8(*(const u32x4*)(src + i * 8), f);
#pragma unroll
      for (int j = 0; j < 8; j++) vnT[(half * 128 + i * 8 + j) * 136 + row] = f2bf(f[j] * r * gv[i * 8 + j]); }
  }
  __syncthreads();
  const int lane = t & 63, g = t >> 6, l31 = lane & 31, h = lane >> 5;
  const float* W = p.a_w_s + (long)(l * 4 + g) * 128 * 128;
  const float* bs = p.a_b_s + (l * 4 + g) * 128;
#pragma unroll 1
  for (int mh = 0; mh < 2; mh++) {
    f32x16 acc[2][2]; zero_acc(acc);
#pragma unroll 2
    for (int kk = 0; kk < 8; kk++) {
      bf16x8 af[2], bfr[2];
#pragma unroll
      for (int mb = 0; mb < 2; mb++) {
        const int tt = mh * 64 + mb * 32 + l31, s0 = kk * 16 + h * 8;
        const f32x4 w0 = *(const f32x4*)(W + tt * 128 + s0), w1 = *(const f32x4*)(W + tt * 128 + s0 + 4);
        float f[8] = {w0.x, w0.y, w0.z, w0.w, w1.x, w1.y, w1.z, w1.w};
#pragma unroll
        for (int j = 0; j < 8; j++) if (s0 + j > tt) f[j] = 0.f;
        af[mb] = __builtin_bit_cast(bf16x8, pack8(f));
      }
#pragma unroll
      for (int nb = 0; nb < 2; nb++) bfr[nb] = *(const bf16x8*)(vnT + (g * 64 + nb * 32 + l31) * 136 + kk * 16 + h * 8);
#pragma unroll
      for (int mb = 0; mb < 2; mb++)
#pragma unroll
        for (int nb = 0; nb < 2; nb++) acc[mb][nb] = MFMA(af[mb], bfr[nb], acc[mb][nb]);
    }
#pragma unroll
    for (int mb = 0; mb < 2; mb++)
#pragma unroll
      for (int nb = 0; nb < 2; nb++)
#pragma unroll
        for (int i = 0; i < 16; i++) {
          const int tt = mh * 64 + mb * 32 + crow(i, h), col = g * 64 + nb * 32 + l31;
          bf16_t* zp = p.z1 + (r0 + tt) * Z1W;
          const float u = bf2f(zp[col]), gt = bf2f(zp[512 + col]);
          if (!p.dry) zp[col] = f2bf(u * (acc[mb][nb][i] + bs[tt]) * gt);
        }
  }
  __syncthreads();
}

DI void c_setup(const P& p, int l, int g, int lane, float& ar, float& ai, float (&Br)[16], float (&Bi)[16]) {
  const int gi = (l * 16 + g) * 64 + lane;
  const float lre = p.c_a_re[gi], lim = p.c_a_im[gi];
  const float dt = expf(p.c_log_dt[l * 16 + g]);
  const float mag = expf(lre * dt);
  const float angf = lim * dt;
  const double rev = (double)angf * 0.15915494309189535;
  const float rf = (float)((rev - rint(rev)) * 6.283185307179586);
  const float sn = sinf(rf), cs = cosf(rf);
  ar = mag * cs; ai = mag * sn;
  const float xr = ar - 1.f, xi = ai, den = 1.f / (lre * lre + lim * lim);
  const float cr = (xr * lre + xi * lim) * den, ci = (xi * lre - xr * lim) * den;
  const float* bre = p.c_b_re + (long)gi * 16; const float* bim = p.c_b_im + (long)gi * 16;
#pragma unroll
  for (int c4 = 0; c4 < 4; c4++) {
    const f32x4 r4 = *(const f32x4*)(bre + c4 * 4), i4 = *(const f32x4*)(bim + c4 * 4);
    const float rr[4] = {r4.x, r4.y, r4.z, r4.w}, ii[4] = {i4.x, i4.y, i4.z, i4.w};
#pragma unroll
    for (int j = 0; j < 4; j++) { Br[c4 * 4 + j] = cr * rr[j] - ci * ii[j]; Bi[c4 * 4 + j] = cr * ii[j] + ci * rr[j]; }
  }
}
DI void s5c_build_item(const P& p, int it) {
  const int e = it * 256 + tid(), l = e >> 10, g = (e >> 6) & 15, lane = e & 63;
  float ar, ai, Br[16], Bi[16];
  c_setup(p, l, g, lane, ar, ai, Br, Bi);
  float* d = p.s5c + (long)e * 36;
  f32x4 v; v.x = ar; v.y = ai; v.z = 0.f; v.w = 0.f; *(f32x4*)d = v;
#pragma unroll
  for (int c4 = 0; c4 < 4; c4++) {
    v.x = Br[c4 * 4]; v.y = Br[c4 * 4 + 1]; v.z = Br[c4 * 4 + 2]; v.w = Br[c4 * 4 + 3]; *(f32x4*)(d + 4 + c4 * 4) = v;
    v.x = Bi[c4 * 4]; v.y = Bi[c4 * 4 + 1]; v.z = Bi[c4 * 4 + 2]; v.w = Bi[c4 * 4 + 3]; *(f32x4*)(d + 20 + c4 * 4) = v;
  }
}
DI void s5_bfrags(const P& p, int l, int g, int lane, bf16x8 (&bf)[8]) {
  const int r16 = lane & 15, q = lane >> 4;
#pragma unroll
  for (int nb = 0; nb < 8; nb++) {
    u32x4 pk; pk.x = 0u; pk.y = 0u; pk.z = 0u; pk.w = 0u;
    if (q < 2) {
      const float* d = p.s5c + (long)(((l * 16 + g) * 64) + nb * 8 + (r16 >> 1)) * 36 + 4 + (r16 & 1) * 16 + q * 8;
      const f32x4 a = *(const f32x4*)d, b = *(const f32x4*)(d + 4);
      pk.x = pk2(a.x, a.y); pk.y = pk2(a.z, a.w); pk.z = pk2(b.x, b.y); pk.w = pk2(b.z, b.w);
    }
    bf[nb] = __builtin_bit_cast(bf16x8, pk);
  }
}
DI void s5_bu_block(const float* ub, int sb, int lane, const bf16x8 (&bf)[8], float* bu) {
  const int r16 = lane & 15, q = lane >> 4;
  u32x4 ua; ua.x = 0u; ua.y = 0u; ua.z = 0u; ua.w = 0u;
  if (q < 2) {
    const f32x4 a = *(const f32x4*)(ub + (sb * 16 + r16) * 16 + q * 8), b = *(const f32x4*)(ub + (sb * 16 + r16) * 16 + q * 8 + 4);
    ua.x = pk2(a.x, a.y); ua.y = pk2(a.z, a.w); ua.z = pk2(b.x, b.y); ua.w = pk2(b.z, b.w);
  }
  const bf16x8 af = __builtin_bit_cast(bf16x8, ua);
#pragma unroll
  for (int nb = 0; nb < 8; nb++) {
    f32x4 d; d.x = 0.f; d.y = 0.f; d.z = 0.f; d.w = 0.f;
    d = __builtin_amdgcn_mfma_f32_16x16x32_bf16(af, bf[nb], d, 0, 0, 0);
    float* o = bu + (q * 4) * 132 + nb * 16 + r16;
    o[0] = d.x; o[132] = d.y; o[264] = d.z; o[396] = d.w;
  }
}
#define LDS_HANDOFF_() do { asm volatile("s_waitcnt lgkmcnt(0)" ::: "memory"); __builtin_amdgcn_wave_barrier(); } while (0)
DI void c_load_u(const P& p, long tok0, int g, int lane, float* ub) {
  const bf16_t* up = p.z1 + (tok0 + lane) * Z1W + 1280 + g * 16;
  float f0[8], f1[8];
  unpack8(*(const u32x4*)up, f0); unpack8(*(const u32x4*)(up + 8), f1);
  f32x4 a; a.x = f0[0]; a.y = f0[1]; a.z = f0[2]; a.w = f0[3]; *(f32x4*)(ub + lane * 16) = a;
  a.x = f0[4]; a.y = f0[5]; a.z = f0[6]; a.w = f0[7]; *(f32x4*)(ub + lane * 16 + 4) = a;
  a.x = f1[0]; a.y = f1[1]; a.z = f1[2]; a.w = f1[3]; *(f32x4*)(ub + lane * 16 + 8) = a;
  a.x = f1[4]; a.y = f1[5]; a.z = f1[6]; a.w = f1[7]; *(f32x4*)(ub + lane * 16 + 12) = a;
}
DI void c_step(const float* ub, int s, const float (&Br)[16], const float (&Bi)[16], float ar, float ai, float& sr, float& si) {
  float bur = 0.f, bui = 0.f;
#pragma unroll
  for (int c4 = 0; c4 < 4; c4++) {
    const f32x4 u = *(const f32x4*)(ub + s * 16 + c4 * 4);
    bur += Br[c4 * 4] * u.x + Br[c4 * 4 + 1] * u.y + Br[c4 * 4 + 2] * u.z + Br[c4 * 4 + 3] * u.w;
    bui += Bi[c4 * 4] * u.x + Bi[c4 * 4 + 1] * u.y + Bi[c4 * 4 + 2] * u.z + Bi[c4 * 4 + 3] * u.w;
  }
  const float nr = ar * sr - ai * si + bur, ni = ar * si + ai * sr + bui;
  sr = nr; si = ni;
}
DI void c1_item(const P& p, int l, int idx, char* smem) {
  const int t = tid(), lane = t & 63, w = t >> 6;
  const int b = idx >> 7, g = (idx >> 3) & 15, k = (idx & 7) * 4 + w;
  float* ub = (float*)(smem + w * 16896);
  float* bu = (float*)(smem + w * 16896 + 8448);
  const float* cd = p.s5c + (long)(((l * 16 + g) * 64) + lane) * 36;
  const float ar = cd[0], ai = cd[1];
  bf16x8 bf[8];
  s5_bfrags(p, l, g, lane, bf);
  const long tok0 = (long)b * S_ + k * 64;
  c_load_u(p, tok0, g, lane, ub);
  __syncthreads();
  float sr = 0.f, si = 0.f;
#pragma unroll 1
  for (int sb = 0; sb < 4; sb++) {
    s5_bu_block(ub, sb, lane, bf, bu);
    LDS_HANDOFF_();
#pragma unroll 4
    for (int s2 = 0; s2 < 16; s2++) {
      const f32x2 bb = *(const f32x2*)(bu + s2 * 132 + 2 * lane);
      const float nr = ar * sr - ai * si + bb.x, ni = ar * si + ai * sr + bb.y;
      sr = nr; si = ni;
    }
    LDS_HANDOFF_();
  }
  f32x2 e; e.x = sr; e.y = si;
  *(f32x2*)(p.carry + ((long)((b * 16 + g) * 32 + k) * 64 + lane) * 2) = e;
  __syncthreads();
}
DI void c3_item(const P& p, int l, int idx, char* smem) {
  const int t = tid(), lane = t & 63, w = t >> 6;
  const int b = idx >> 7, g = (idx >> 3) & 15, k = (idx & 7) * 4 + w;
  float* ub = (float*)(smem + w * 16896);
  bf16_t* stb = (bf16_t*)(smem + w * 16896 + 4096);
  float* bu = (float*)(smem + w * 16896 + 8448);
  const int c = lane & 15, sq = lane >> 4;
  bf16x8 cfr[4];
  {
    const float* cre = p.c_c_re + (long)(l * 16 + g) * 1024 + c * 64; const float* cim = p.c_c_im + (long)(l * 16 + g) * 1024 + c * 64;
#pragma unroll
    for (int ks = 0; ks < 4; ks++) {
      const f32x4 r4 = *(const f32x4*)(cre + ks * 16 + sq * 4), i4 = *(const f32x4*)(cim + ks * 16 + sq * 4);
      u32x4 pk; pk.x = pk2(r4.x, -i4.x); pk.y = pk2(r4.y, -i4.y); pk.z = pk2(r4.z, -i4.z); pk.w = pk2(r4.w, -i4.w);
      cfr[ks] = __builtin_bit_cast(bf16x8, pk);
    }
  }
  const float* cd = p.s5c + (long)(((l * 16 + g) * 64) + lane) * 36;
  const float ar = cd[0], ai = cd[1];
  bf16x8 bf[8];
  s5_bfrags(p, l, g, lane, bf);
  const long tok0 = (long)b * S_ + k * 64;
  c_load_u(p, tok0, g, lane, ub);
  float lr = ar, li = ai;
#pragma unroll
  for (int i = 0; i < 6; i++) { const float nr = lr * lr - li * li, ni = 2.f * lr * li; lr = nr; li = ni; }
  float sr = 0.f, si = 0.f;
  {
    const float* cp = p.carry + ((long)((b * 16 + g) * 32) * 64 + lane) * 2;
    for (int j0 = 0; j0 < k; j0 += 8) {
      f32x2 e[8];
#pragma unroll
      for (int jj = 0; jj < 8; jj++) { e[jj].x = 0.f; e[jj].y = 0.f; if (j0 + jj < k) e[jj] = *(const f32x2*)(cp + (long)(j0 + jj) * 128); }
#pragma unroll
      for (int jj = 0; jj < 8; jj++) if (j0 + jj < k) { const float nr = lr * sr - li * si + e[jj].x, ni = lr * si + li * sr + e[jj].y; sr = nr; si = ni; }
    }
  }
  __syncthreads();
  const float dsk = p.c_d[l * 256 + g * 16 + c];
#pragma unroll 1
  for (int sb = 0; sb < 4; sb++) {
    s5_bu_block(ub, sb, lane, bf, bu);
    LDS_HANDOFF_();
#pragma unroll 4
    for (int s2 = 0; s2 < 16; s2++) {
      const f32x2 bb = *(const f32x2*)(bu + s2 * 132 + 2 * lane);
      const float nr = ar * sr - ai * si + bb.x, ni = ar * si + ai * sr + bb.y;
      sr = nr; si = ni;
      *(unsigned*)(stb + s2 * 136 + 2 * lane) = pk2(sr, si);
    }
    asm volatile("s_waitcnt lgkmcnt(0)" ::: "memory");
    __builtin_amdgcn_wave_barrier();
    f32x4 y; y.x = 0.f; y.y = 0.f; y.z = 0.f; y.w = 0.f;
#pragma unroll
    for (int ks = 0; ks < 4; ks++) {
      const bf16x8 af = *(const bf16x8*)(stb + c * 136 + ks * 32 + sq * 8);
      y = __builtin_amdgcn_mfma_f32_16x16x32_bf16(af, cfr[ks], y, 0, 0, 0);
    }
    const float yy[4] = {y.x, y.y, y.z, y.w};
#pragma unroll
    for (int qq = 0; qq < 4; qq++) {
      const int sa = sb * 16 + sq * 4 + qq;
      const float yv = gelu_t(yy[qq] + dsk * ub[sa * 16 + c]);
      if (!p.dry) p.z1[(tok0 + sa) * Z1W + 1280 + g * 16 + c] = f2bf(yv);
    }
    asm volatile("s_waitcnt lgkmcnt(0)" ::: "memory");
    __builtin_amdgcn_wave_barrier();
  }
  __syncthreads();
}

DI void glu_tile(const P& p, int l, int tm, int tn, char* smem) {
  bf16_t* sm = (bf16_t*)smem; float* ep = (float*)smem;
  const int r0 = tm * 128, c0 = tn * 128;
  f32x16 acc[2][2]; zero_acc(acc);
  gemm_loop_dma(p.z1 + (long)r0 * Z1W + 1280, Z1W, p.WgluT + (long)c0 * 256, 256, 256, acc, smem);
  acc_to_lds(acc, ep);
  __syncthreads();
  const float* bg = p.c_b_glu + l * 256 + c0;
  rowwise2(ep, [&](int row, int c8) {
    LdGlu L;
    const bf16_t* zp = p.z1 + (long)(r0 + row) * Z1W + c0 + c8;
    L.yg = *(const u32x4*)(zp + 1280); L.gt = *(const u32x4*)(zp + 1536);
    return L;
  }, [&](int row, int c8, float (&v)[8], const LdGlu& L) {
    bf16_t* zp = p.z1 + (long)(r0 + row) * Z1W + c0 + c8;
    float yg[8], gt[8];
    unpack8(L.yg, yg); unpack8(L.gt, gt);
#pragma unroll
    for (int j = 0; j < 8; j++) v[j] = yg[j] * sigm(v[j] + bg[c8 + j]) * gt[j];
    if (!p.dry) *(u32x4*)(zp + 1536) = pack8(v);
  });
  __syncthreads();
}

DI void pf_tile(const P& p, int l, int tm, int tn, char* smem) {
  float* ep = (float*)smem; float* rsS = (float*)(smem + SM_RS);
  const int t = tid(), lane = t & 63, w = t >> 6, wm = w >> 1, wn = w & 1, l31 = lane & 31, h = lane >> 5;
  const int r0 = tm * 128, c0 = tn * 128;
  load_rs(p, r0, rsS);
  unsigned mrgp[2][2][8];
#pragma unroll
  for (int a = 0; a < 2; a++)
#pragma unroll
    for (int b = 0; b < 2; b++)
#pragma unroll
      for (int i = 0; i < 8; i++) mrgp[a][b][i] = 0u;
#pragma unroll 1
  for (int pr = 0; pr < 2; pr++) {
    unsigned gp[2][2][2][8];
    {
      f32x16 accP[2][2], accQ[2][2]; zero_acc(accP); zero_acc(accQ);
      const bf16_t* wg = p.WinT + (long)(3456 + (2 * pr) * 1024 + c0) * 1024;
      gemm_loop_dma2(p.xb + (long)r0 * 1024, 1024, wg, wg + (long)1024 * 1024, 1024, 1024, accP, accQ, smem);
      const float* bm = p.b_merge + l * 4096 + (2 * pr) * 1024 + c0;
#pragma unroll
      for (int mb = 0; mb < 2; mb++)
#pragma unroll
        for (int nb = 0; nb < 2; nb++) {
          const float bias0 = bm[wn * 64 + nb * 32 + l31], bias1 = bm[1024 + wn * 64 + nb * 32 + l31];
#pragma unroll
          for (int i = 0; i < 16; i += 2) {
            const float ra = rsS[wm * 64 + mb * 32 + crow(i, h)], rb = rsS[wm * 64 + mb * 32 + crow(i + 1, h)];
            gp[0][mb][nb][i >> 1] = pk2n(sigm(accP[mb][nb][i] * ra + bias0), sigm(accP[mb][nb][i + 1] * rb + bias0));
            gp[1][mb][nb][i >> 1] = pk2n(sigm(accQ[mb][nb][i] * ra + bias1), sigm(accQ[mb][nb][i + 1] * rb + bias1));
          }
        }
    }
#pragma unroll
    for (int j = 0; j < 2; j++) {
      const int br = 2 * pr + j;
      const int yoff = br == 0 ? 0 : (br == 1 ? 768 : (br == 2 ? 1536 : 2048));
      const int Kb = br == 1 ? 512 : 256;
      const long woff = br == 0 ? 0 : (br == 1 ? 1024 * 256 : (br == 2 ? 1024 * 768 : 1024 * 1024));
      f32x16 acc[2][2]; zero_acc(acc);
      gemm_loop_dma(p.z1 + (long)r0 * Z1W + yoff, Z1W, p.WbrT + woff + (long)c0 * Kb, Kb, Kb, acc, smem);
#pragma unroll
      for (int mb = 0; mb < 2; mb++)
#pragma unroll
        for (int nb = 0; nb < 2; nb++)
#pragma unroll
          for (int i = 0; i < 16; i += 2) {
            const unsigned g2 = gp[j][mb][nb][i >> 1], m2 = mrgp[mb][nb][i >> 1];
            const float m0 = __uint_as_float(m2 << 16) + __uint_as_float(g2 << 16) * acc[mb][nb][i];
            const float m1 = __uint_as_float(m2 & 0xffff0000u) + __uint_as_float(g2 & 0xffff0000u) * acc[mb][nb][i + 1];
            mrgp[mb][nb][i >> 1] = pk2(m0, m1);
          }
    }
  }
  {
    f32x16 mrg[2][2];
#pragma unroll
    for (int a = 0; a < 2; a++)
#pragma unroll
      for (int b = 0; b < 2; b++)
#pragma unroll
        for (int i = 0; i < 16; i += 2) { const unsigned m2 = mrgp[a][b][i >> 1]; mrg[a][b][i] = __uint_as_float(m2 << 16); mrg[a][b][i + 1] = __uint_as_float(m2 & 0xffff0000u); }
    acc_to_lds(mrg, ep);
  }
  __syncthreads();
  rowwise(ep, [&](int row, int c8, float (&v)[8]) { *(u32x4*)(p.mg + (long)(r0 + row) * 1024 + c0 + c8) = pack8(v); });
  __syncthreads();
}

DI void out_tile(const P& p, int l, int tm, int tn, char* smem) {
  bf16_t* sm = (bf16_t*)smem; float* ep = (float*)smem;
  const int r0 = tm * 128, c0 = tn * 128;
  f32x16 acc[2][2]; zero_acc(acc);
  gemm_loop_dma(p.mg + (long)r0 * 1024, 1024, p.WoutT + (long)l * 1024 * 1024 + (long)c0 * 1024, 1024, 1024, acc, smem);
  acc_to_lds(acc, ep);
  __syncthreads();
  const float* xin = (l == 0) ? p.x : p.out;
  rowwise2(ep, [&](int row, int c8) {
    LdX L;
    const long off = (long)(r0 + row) * 1024 + c0 + c8;
    L.a = *(const f32x4*)(xin + off); L.b = *(const f32x4*)(xin + off + 4);
    return L;
  }, [&](int row, int c8, float (&v)[8], const LdX& L) {
    const long off = (long)(r0 + row) * 1024 + c0 + c8;
    const f32x4 a = L.a, b = L.b;
    v[0] += a.x; v[1] += a.y; v[2] += a.z; v[3] += a.w; v[4] += b.x; v[5] += b.y; v[6] += b.z; v[7] += b.w;
    f32x4 oa, ob; oa.x = v[0]; oa.y = v[1]; oa.z = v[2]; oa.w = v[3]; ob.x = v[4]; ob.y = v[5]; ob.z = v[6]; ob.w = v[7];
    if (!p.dry) {
      if (l == 1) { __builtin_nontemporal_store(oa, (f32x4*)(p.out + off)); __builtin_nontemporal_store(ob, (f32x4*)(p.out + off + 4)); }
      else { *(f32x4*)(p.out + off) = oa; *(f32x4*)(p.out + off + 4) = ob; }
    }
    if (l == 0) {
      *(u32x4*)(p.xb + off) = pack8(v);
      float ss = 0.f;
#pragma unroll
      for (int j = 0; j < 8; j++) ss += v[j] * v[j];
      ss = sum16(ss);
      if ((c8 >> 3) == 0) p.ssp[(long)tn * T_ + r0 + row] = ss;
    }
  });
  __syncthreads();
}

DI void out_tile2(const P& p, int l, int tm, int tn2, char* smem) {
  float* ep = (float*)smem;
  const int r0 = tm * 128;
  f32x16 accP[2][2], accQ[2][2]; zero_acc(accP); zero_acc(accQ);
  const bf16_t* w0 = p.WoutT + (long)l * 1024 * 1024 + (long)(tn2 * 256) * 1024;
  gemm_loop_dma2(p.mg + (long)r0 * 1024, 1024, w0, w0 + (long)128 * 1024, 1024, 1024, accP, accQ, smem);
  const float* xin = (l == 0) ? p.x : p.out;
  auto epi = [&](const f32x16 (&acc)[2][2], int tn) {
    const int c0 = tn * 128;
    acc_to_lds(acc, ep);
    __syncthreads();
    rowwise2(ep, [&](int row, int c8) {
      LdX L;
      const long off = (long)(r0 + row) * 1024 + c0 + c8;
      L.a = *(const f32x4*)(xin + off); L.b = *(const f32x4*)(xin + off + 4);
      return L;
    }, [&](int row, int c8, float (&v)[8], const LdX& L) {
      const long off = (long)(r0 + row) * 1024 + c0 + c8;
      const f32x4 a = L.a, b = L.b;
      v[0] += a.x; v[1] += a.y; v[2] += a.z; v[3] += a.w; v[4] += b.x; v[5] += b.y; v[6] += b.z; v[7] += b.w;
      f32x4 oa, ob; oa.x = v[0]; oa.y = v[1]; oa.z = v[2]; oa.w = v[3]; ob.x = v[4]; ob.y = v[5]; ob.z = v[6]; ob.w = v[7];
      if (!p.dry) {
        if (l == 1) { __builtin_nontemporal_store(oa, (f32x4*)(p.out + off)); __builtin_nontemporal_store(ob, (f32x4*)(p.out + off + 4)); }
        else { *(f32x4*)(p.out + off) = oa; *(f32x4*)(p.out + off + 4) = ob; }
      }
      if (l == 0) {
        *(u32x4*)(p.xb + off) = pack8(v);
        float ss = 0.f;
#pragma unroll
        for (int j = 0; j < 8; j++) ss += v[j] * v[j];
        ss = sum16(ss);
        if ((c8 >> 3) == 0) p.ssp[(long)tn * T_ + r0 + row] = ss;
      }
    });
    __syncthreads();
  };
  epi(accP, 2 * tn2);
  epi(accQ, 2 * tn2 + 1);
}

DI void run_phase(const P& p, int ph, char* smem, int vb) {
  const int G = gridDim.x, bid = blockIdx.x;
  int* slot = (int*)(smem + SM_MISC);
  if (ph == 0) {
    conv_all(p, 0, smem);
    for (int it = NCONV + bid; it < NAUX; it += G) aux_item(p, 0, it, smem);
    for (int it = bid; it < 2048; it += G) p0_xrow_item(p, it);
    for (int it = bid; it < 1024; it += G) p0_rope_item(p, it);
    for (int it = bid; it < 8; it += G) s5c_build_item(p, it);
    return;
  }
  const int l = (ph - 1) / 6, s = (ph - 1) % 6;
  if (s == 0) {
    const int nd = 128 * 12, nrd = (nd + G - 1) / G;
    for (int r = 0; r < nrd; r++) { const int L = static_L(r, vb); if (L >= nd) continue; int tm, tp; tile_from_linear(L, 12, tm, tp); g1_tile2(p, l, tm, 2 * tp, smem); }
    for (int L = vb; L < 384 + 64; L += G) {
      int tm, tn;
      if (L < 384) { tile_from_linear(L, 3, tm, tn); g1_tile(p, l, tm, 24 + tn, smem); }
      else { tile_from_linear(L - 384, 4, tm, tn); g1m_tile(p, l, tm, tn, smem); }
    }
  } else if (s == 1) {
    const long dm = p.dry;
    {
      const int total = 1024, nr = (total + G - 1) / G;
      if (!dm || (dm & 2)) for (int r = 0; r < nr; r++) { const int L = static_L(r, vb); if (L >= total) continue; int tm, tn; tile_from_linear(L, 8, tm, tn); g2q_tile(p, l, tm, tn, smem); }
      if (!dm || (dm & 8)) for (int r = 0; r < nr; r++) { const int L = static_L(r, vb); if (L >= total) continue; int tm, tn; tile_from_linear(L, 8, tm, tn); g2kv_tile(p, l, tm, tn, smem); }
    }
    if (!dm || (dm & 4)) for (int it = vb; it < 512; it += G) mattn_item(p, it, smem);
    {
      const bool split = (G >= 256);
      if (!dm || (dm & 16)) { const int a1 = split ? 128 : 128; for (int it = vb; it < a1; it += G) a_item(p, l, it, smem); }
      const int cstep = split ? (vb < 128 ? 1024 : G - 128) : G;
      if (!dm || (dm & 32)) {
#pragma unroll 1
        for (int it = vb; it < 1024; it += cstep) c1_item(p, l, it, smem);
      }
    }
  } else if (s == 2) {
    const long dm = p.dry;
    if (G == 512) {
#pragma unroll 1
      for (int j = 0; j < 4; j++) {
        if (j < 2) { if (dm && !(dm & 2)) continue; battn_item(p, j ? 1023 - vb : vb, smem); }
        else { if (dm && !(dm & 4)) continue; c3_item(p, l, vb + (j - 2) * 512, smem); }
      }
    } else {
#pragma unroll 1
      for (int it = vb; it < 2048; it += G) {
        if (it < 1024) { if (dm && !(dm & 2)) continue; battn_item(p, it, smem); } else { if (dm && !(dm & 4)) continue; c3_item(p, l, it - 1024, smem); }
      }
    }
  } else if (s == 3) {
    for (int it = bid; it < 256; it += G) glu_tile(p, l, it >> 1, it & 1, smem);
  } else if (s == 4) {
    const int total = 1024, nr = (total + G - 1) / G;
    for (int r = 0; r < nr; r++) { const int L = static_L(r, vb); if (L >= total) continue; int tm, tn; tile_from_linear(L, 8, tm, tn); pf_tile(p, l, tm, tn, smem); }
  } else {
    const int nr2 = (512 + G - 1) / G;
    for (int r = 0; r < nr2; r++) { const int L = static_L(r, vb); if (L >= 512) continue; int tm, tn; tile_from_linear(L, 4, tm, tn); out_tile2(p, l, tm, tn, smem); }
    if (l == 0) { conv_all(p, 1, smem); for (int it = NCONV + bid; it < NAUX; it += G) aux_item(p, 1, it, smem); }
  }
}

DI unsigned xb_ld(unsigned* q) { return __hip_atomic_load(q, __ATOMIC_RELAXED, __HIP_MEMORY_SCOPE_AGENT); }
DI unsigned xb_add(unsigned* q, unsigned v) { return __hip_atomic_fetch_add(q, v, __ATOMIC_RELAXED, __HIP_MEMORY_SCOPE_AGENT); }
DI void gbar(unsigned* bar, const int* st) {
  asm volatile("s_waitcnt vmcnt(0)" ::: "memory");
  __syncthreads();
  if (threadIdx.x == 0) {
    __builtin_amdgcn_s_waitcnt(0);
    const unsigned x = (unsigned)st[0], nloc = (unsigned)st[1], nx = (unsigned)st[2];
    const unsigned old = xb_add(&bar[1024 + 64 * x], 1u);
    const unsigned gen = old / nloc;
    if (old + 1u == (gen + 1u) * nloc) {
      __builtin_amdgcn_fence(__ATOMIC_RELEASE, "agent");
      asm volatile("s_waitcnt vmcnt(0)" ::: "memory");
      const unsigned og = xb_add(&bar[3072], 1u);
      const unsigned tg = og / nx;
      if (og + 1u == (tg + 1u) * nx) xb_add(&bar[3136], 1u);
      else while (xb_ld(&bar[3136]) == tg) __builtin_amdgcn_s_sleep(1);
      __builtin_amdgcn_fence(__ATOMIC_ACQUIRE, "agent");
      xb_add(&bar[2048 + 64 * x], 1u);
      asm volatile("s_waitcnt vmcnt(0)" ::: "memory");
    } else {
      while (xb_ld(&bar[2048 + 64 * x]) == gen) __builtin_amdgcn_s_sleep(1);
      __builtin_amdgcn_fence(__ATOMIC_ACQUIRE, "agent");
      asm volatile("s_waitcnt vmcnt(0)" ::: "memory");
    }
  }
  __syncthreads();
}

#if MK_MULTI
__global__ void __launch_bounds__(256, 2) hyb_phase(P p, int ph) {
  __shared__ __attribute__((aligned(16))) char smem[SM_TOTAL];
  run_phase(p, ph, smem, blockIdx.x);
}
#else
__global__ void __launch_bounds__(256, 2) hyb_mega(P p) {
  __shared__ __attribute__((aligned(16))) char smem[SM_TOTAL];
  cg::grid_group grid = cg::this_grid();
  if (p.dry == 0x7fffffff) grid.sync();
  int vb;
  {
    int* sl = (int*)(smem + SM_MISC) + 2;
    if (threadIdx.x == 0) {
      const unsigned xcc = (unsigned)__builtin_amdgcn_s_getreg((3 << 11) | 20) & 7u;
      const unsigned loc = xb_add(p.ctr + 40 + xcc, 1u);
      const unsigned Gx = gridDim.x >> 3;
      *sl = (loc < Gx) ? (int)(loc * 8 + xcc) : -1;
      unsigned sum, cnt, mine;
      for (;;) {
        sum = 0u; cnt = 0u; mine = 0u;
        for (unsigned j = 0; j < 8; ++j) { const unsigned c = xb_ld(p.ctr + 40 + j); sum += c; cnt += (c > 0u) ? 1u : 0u; mine = (j == xcc) ? c : mine; }
        if (sum == gridDim.x) break;
        __builtin_amdgcn_s_sleep(1);
      }
      sl[2] = (int)xcc; sl[3] = (int)mine; sl[4] = (int)cnt;
    }
    __syncthreads();
    vb = blockIdx.x;
  }
  const int* bst = (const int*)(smem + SM_MISC) + 4;
#ifdef DRY_PH
  P pd = p; { int one = DRY_MASK; asm volatile("" : "+s"(one)); pd.dry = one; }
#endif
#pragma unroll 1
  for (int ph = 0; ph < 13; ph++) {
#ifdef DRY_PH
    if (ph == DRY_PH) { run_phase(pd, ph, smem, vb); gbar(p.bar, bst); }
#endif
    run_phase(p, ph, smem, vb);
    if (ph < 12) gbar(p.bar, bst);
  }
}
#endif

extern "C" void kernel_launch(void* const* d_in, const int* in_sizes, int n_in, void* d_out, int out_size, void* d_ws, size_t ws_size, hipStream_t stream) {
  P p{};
  p.x = (const float*)d_in[0]; p.mem = (const float*)d_in[1]; p.pos = (const int*)d_in[2];
  p.norm_g = (const float*)d_in[3]; p.w_in = (const float*)d_in[4]; p.b_merge = (const float*)d_in[5];
  p.a_norm_g = (const float*)d_in[6]; p.a_w_s = (const float*)d_in[7]; p.a_b_s = (const float*)d_in[8];
  p.b_q_norm_g = (const float*)d_in[9]; p.b_kv_norm_g = (const float*)d_in[10]; p.b_w_uq = (const float*)d_in[11]; p.b_w_ukv = (const float*)d_in[12];
  p.b_qk_g_q = (const float*)d_in[13]; p.b_qk_g_k = (const float*)d_in[14];
  p.c_a_re = (const float*)d_in[15]; p.c_a_im = (const float*)d_in[16]; p.c_log_dt = (const float*)d_in[17];
  p.c_b_re = (const float*)d_in[18]; p.c_b_im = (const float*)d_in[19]; p.c_c_re = (const float*)d_in[20]; p.c_c_im = (const float*)d_in[21];
  p.c_d = (const float*)d_in[22]; p.c_w_glu = (const float*)d_in[23]; p.c_b_glu = (const float*)d_in[24];
  p.m_norm_g = (const float*)d_in[25]; p.m_w_kv = (const float*)d_in[26]; p.m_qk_g_q = (const float*)d_in[27]; p.m_qk_g_k = (const float*)d_in[28];
  p.w_br_a = (const float*)d_in[29]; p.w_br_b = (const float*)d_in[30]; p.w_br_c = (const float*)d_in[31]; p.w_br_m = (const float*)d_in[32];
  p.w_out = (const float*)d_in[33];
  p.out = (float*)d_out;
  char* ws = (char*)d_ws; size_t off = 0;
  auto take = [&](size_t bytes) { char* r = ws + off; off += (bytes + 255) & ~(size_t)255; return r; };
  p.z1 = (bf16_t*)take((size_t)T_ * Z1W * 2);
  p.z2 = (bf16_t*)take((size_t)T_ * Z2W * 2);
  p.xb = (bf16_t*)take((size_t)T_ * 1024 * 2);
  p.qf = (bf16_t*)take((size_t)T_ * 768 * 2);
  p.kf = (bf16_t*)take((size_t)T_ * 768 * 2);
  p.mg = p.qf;
  p.vt = (bf16_t*)take((size_t)8 * 8 * 64 * S_ * 2);
  p.hm = (bf16_t*)take((size_t)2048 * 1024 * 2);
  p.memk = (bf16_t*)take((size_t)2048 * 256 * 2);
  p.memvt = (bf16_t*)take((size_t)2048 * 256 * 2);
  p.WinT = (bf16_t*)take((size_t)NWIN * 1024 * 2);
  p.WuqT = (bf16_t*)take((size_t)1024 * 768 * 2);
  p.WukvT = (bf16_t*)take((size_t)1024 * 256 * 2);
  p.WgluT = (bf16_t*)take((size_t)256 * 256 * 2);
  p.WbrT = (bf16_t*)take((size_t)1024 * 1280 * 2);
  p.WoutT = (bf16_t*)take((size_t)2 * 1024 * 1024 * 2);
  p.WmkvT = (bf16_t*)take((size_t)512 * 1024 * 2);
  p.ssp = (float*)take((size_t)8 * T_ * 4);
  p.ssq = (float*)take((size_t)9 * T_ * 4);
  p.rope = (float*)take((size_t)T_ * 32 * 4);
  p.carry = (float*)take((size_t)8 * 16 * 32 * 64 * 2 * 4);
  p.s5c = (float*)take((size_t)2 * 16 * 64 * 36 * 4);
  p.ctr = (unsigned*)take(256);
  p.bar = (unsigned*)take(16384);
  if (off > ws_size) { fprintf(stderr, "workspace too small: need %zu have %zu\n", off, ws_size); return; }

  static int grid_blocks = 0;
  if (!grid_blocks) {
    int dev = 0, cus = 0, per_cu = 0;
    hipGetDevice(&dev);
    hipDeviceGetAttribute(&cus, hipDeviceAttributeMultiprocessorCount, dev);
#if MK_MULTI
    hipOccupancyMaxActiveBlocksPerMultiprocessor(&per_cu, hyb_phase, 256, 0);
#else
    hipOccupancyMaxActiveBlocksPerMultiprocessor(&per_cu, hyb_mega, 256, 0);
#endif
    if (per_cu > 2) per_cu = 2;
    if (per_cu < 1) per_cu = 1;
    grid_blocks = cus * per_cu;
    grid_blocks &= ~7;
  }
#if MK_MULTI
  for (int ph = 0; ph < 13; ph++) hipLaunchKernelGGL(hyb_phase, dim3(grid_blocks), dim3(256), 0, stream, p, ph);
#else
  hipMemsetAsync(p.ctr, 0, 256 + 16384, stream);
  void* args[] = {&p};
  hipError_t e = hipLaunchCooperativeKernel((void*)hyb_mega, dim3(grid_blocks), dim3(256), args, 0, stream);
  if (e != hipSuccess) fprintf(stderr, "cooperative launch failed: %s (grid %d)\n", hipGetErrorString(e), grid_blocks);
#endif
}
```

```cpp
#include <hip/hip_runtime.h>
#include <hip/hip_cooperative_groups.h>
#include <stdint.h>
#include <stdio.h>
#include <type_traits>
namespace cg = cooperative_groups;

#ifndef MK_MULTI
#define MK_MULTI 0
#endif

typedef unsigned short bf16_t;
typedef short bf16x8 __attribute__((ext_vector_type(8)));
typedef short s16x4 __attribute__((ext_vector_type(4)));
typedef float f32x16 __attribute__((ext_vector_type(16)));
typedef float f32x4 __attribute__((ext_vector_type(4)));
typedef float f32x2 __attribute__((ext_vector_type(2)));
typedef unsigned u32x4 __attribute__((ext_vector_type(4)));
typedef unsigned u32x2 __attribute__((ext_vector_type(2)));
#define DI __device__ __forceinline__
#define MFMA(a, b, c) __builtin_amdgcn_mfma_f32_32x32x16_bf16((a), (b), (c), 0, 0, 0)

constexpr int T_ = 16384, S_ = 2048;
constexpr int INW = 7456;
constexpr int Z1W = 2304, Z2W = 1152;
constexpr int NWIN = 7552;
constexpr float EPS = 1e-6f;
constexpr float LOG2E = 1.4426950408889634f;
constexpr int LDT = 72;
constexpr int EPW = 132;
constexpr int SM_MAIN = 4 * 128 * LDT * 2;
constexpr int SM_RS = SM_MAIN;
constexpr int SM_SS = SM_MAIN + 512;
constexpr int SM_MISC = SM_MAIN + 1024;
constexpr int SM_TOTAL = SM_MAIN + 1024 + 64;

struct P {
  const float* x; const float* mem; const int* pos;
  const float* norm_g; const float* w_in; const float* b_merge; const float* a_norm_g; const float* a_w_s; const float* a_b_s;
  const float* b_q_norm_g; const float* b_kv_norm_g; const float* b_w_uq; const float* b_w_ukv; const float* b_qk_g_q; const float* b_qk_g_k;
  const float* c_a_re; const float* c_a_im; const float* c_log_dt; const float* c_b_re; const float* c_b_im; const float* c_c_re; const float* c_c_im;
  const float* c_d; const float* c_w_glu; const float* c_b_glu;
  const float* m_norm_g; const float* m_w_kv; const float* m_qk_g_q; const float* m_qk_g_k;
  const float* w_br_a; const float* w_br_b; const float* w_br_c; const float* w_br_m; const float* w_out;
  float* out;
  bf16_t* z1; bf16_t* z2; bf16_t* xb; bf16_t* qf; bf16_t* kf; bf16_t* mg; bf16_t* vt; bf16_t* hm; bf16_t* memk; bf16_t* memvt;
  bf16_t* WinT; bf16_t* WuqT; bf16_t* WukvT; bf16_t* WgluT; bf16_t* WbrT; bf16_t* WoutT; bf16_t* WmkvT;
  float* ssp; float* ssq; float* rope; float* carry; float* s5c; unsigned* ctr; unsigned* bar;
  long dry;
};

DI int tid() { int t = threadIdx.x; asm volatile("" : "+v"(t)); return t; }
DI float bf2f(bf16_t b) { return __uint_as_float(((unsigned)b) << 16); }
DI unsigned pk2(float lo, float hi) { unsigned r; asm("v_cvt_pk_bf16_f32 %0, %1, %2" : "=v"(r) : "v"(lo), "v"(hi)); return r; }
DI unsigned pk2n(float lo, float hi) { unsigned r; asm("s_nop 1\n\tv_cvt_pk_bf16_f32 %0, %1, %2" : "=v"(r) : "v"(lo), "v"(hi)); return r; }
DI bf16_t f2bf(float x) { return (bf16_t)(pk2(x, 0.f) & 0xffffu); }
DI void unpack8(u32x4 v, float (&f)[8]) {
  f[0] = __uint_as_float(v.x << 16); f[1] = __uint_as_float(v.x & 0xffff0000u);
  f[2] = __uint_as_float(v.y << 16); f[3] = __uint_as_float(v.y & 0xffff0000u);
  f[4] = __uint_as_float(v.z << 16); f[5] = __uint_as_float(v.z & 0xffff0000u);
  f[6] = __uint_as_float(v.w << 16); f[7] = __uint_as_float(v.w & 0xffff0000u);
}
DI void unpack4(u32x2 v, float (&f)[4]) {
  f[0] = __uint_as_float(v.x << 16); f[1] = __uint_as_float(v.x & 0xffff0000u);
  f[2] = __uint_as_float(v.y << 16); f[3] = __uint_as_float(v.y & 0xffff0000u);
}
DI u32x4 pack8(const float (&f)[8]) { u32x4 r; r.x = pk2(f[0], f[1]); r.y = pk2(f[2], f[3]); r.z = pk2(f[4], f[5]); r.w = pk2(f[6], f[7]); return r; }
DI float sigm(float x) { return __builtin_amdgcn_rcpf(1.f + __expf(-x)); }
DI float silu(float x) { return x * sigm(x); }
DI float gelu_t(float x) { return x * sigm(1.5957691216057308f * (x + 0.044715f * x * x * x)); }
DI float sum16(float v) { v += __shfl_xor(v, 1); v += __shfl_xor(v, 2); v += __shfl_xor(v, 4); v += __shfl_xor(v, 8); return v; }
DI float sum8(float v) { v += __shfl_xor(v, 1); v += __shfl_xor(v, 2); v += __shfl_xor(v, 4); return v; }
DI float sum64(float v) { v = sum16(v); v += __shfl_xor(v, 16); v += __shfl_xor(v, 32); return v; }
DI int crow(int i, int h) { return (i & 3) + 8 * (i >> 2) + 4 * h; }
#define MFMA16(a, b, c) __builtin_amdgcn_mfma_f32_16x16x32_bf16((a), (b), (c), 0, 0, 0)
template <int NB>
DI void zero_acc4(f32x4 (&acc)[4][NB]) {
#pragma unroll
  for (int a = 0; a < 4; a++)
#pragma unroll
    for (int b = 0; b < NB; b++) { acc[a][b].x = 0.f; acc[a][b].y = 0.f; acc[a][b].z = 0.f; acc[a][b].w = 0.f; }
}
DI void zero_acc(f32x16 (&acc)[2][2]) {
#pragma unroll
  for (int a = 0; a < 2; a++)
#pragma unroll
    for (int b = 0; b < 2; b++)
#pragma unroll
      for (int i = 0; i < 16; i++) acc[a][b][i] = 0.f;
}

template <bool SS>
DI void gemm_loop(const bf16_t* __restrict__ A, long lda, const bf16_t* __restrict__ B, long ldb, int K,
                  f32x16 (&acc)[2][2], bf16_t* sm, float* ssS) {
  const int t = tid(), lane = t & 63, w = t >> 6, wm = w >> 1, wn = w & 1, l31 = lane & 31, h = lane >> 5;
  const int lr = t >> 3, lc = (t & 7) * 8;
  const bf16_t* ap = A + (long)lr * lda + lc;
  const bf16_t* bp = B + (long)lr * ldb + lc;
  bf16_t* wp = sm + lr * LDT + lc;
  const bf16_t* rA = sm + (wm * 64 + l31) * LDT + h * 8;
  const bf16_t* rB = sm + 2 * 128 * LDT + (wn * 64 + l31) * LDT + h * 8;
  u32x4 ra[4], rb[4];
  float ss[4] = {0.f, 0.f, 0.f, 0.f};
  const int nk = K >> 6;
  auto gl = [&](int ko) {
#pragma unroll
    for (int i = 0; i < 4; i++) { ra[i] = *(const u32x4*)(ap + (long)(32 * i) * lda + ko); rb[i] = *(const u32x4*)(bp + (long)(32 * i) * ldb + ko); }
  };
  auto st = [&](auto BUF) {
    constexpr int buf = decltype(BUF)::value;
#pragma unroll
    for (int i = 0; i < 4; i++) {
      *(u32x4*)(wp + buf * 128 * LDT + 32 * i * LDT) = ra[i];
      *(u32x4*)(wp + 2 * 128 * LDT + buf * 128 * LDT + 32 * i * LDT) = rb[i];
      if (SS) { float f[8]; unpack8(ra[i], f);
#pragma unroll
        for (int j = 0; j < 8; j++) ss[i] += f[j] * f[j]; }
    }
  };
  auto comp = [&](auto BUF) {
    constexpr int buf = decltype(BUF)::value;
#pragma unroll
    for (int kk = 0; kk < 4; kk++) {
      bf16x8 af[2], bfr[2];
#pragma unroll
      for (int mb = 0; mb < 2; mb++) af[mb] = *(const bf16x8*)(rA + buf * 128 * LDT + mb * 32 * LDT + kk * 16);
#pragma unroll
      for (int nb = 0; nb < 2; nb++) bfr[nb] = *(const bf16x8*)(rB + buf * 128 * LDT + nb * 32 * LDT + kk * 16);
#pragma unroll
      for (int mb = 0; mb < 2; mb++)
#pragma unroll
        for (int nb = 0; nb < 2; nb++) acc[mb][nb] = MFMA(af[mb], bfr[nb], acc[mb][nb]);
    }
  };
  using B0 = std::integral_constant<int, 0>; using B1 = std::integral_constant<int, 1>;
  gl(0);
  st(B0{});
  gl(64);
  __syncthreads();
  for (int ks = 0; ks < nk; ks += 2) {
    st(B1{});
    __builtin_amdgcn_sched_barrier(0);
    if (ks + 2 < nk) gl((ks + 2) * 64);
    __builtin_amdgcn_sched_barrier(0);
    comp(B0{});
    __syncthreads();
    if (ks + 2 < nk) st(B0{});
    __builtin_amdgcn_sched_barrier(0);
    if (ks + 3 < nk) gl((ks + 3) * 64);
    __builtin_amdgcn_sched_barrier(0);
    comp(B1{});
    __syncthreads();
  }
  if (SS) {
    const float inv = 1.0f / (float)K;
#pragma unroll
    for (int i = 0; i < 4; i++) { float s = sum8(ss[i]); if ((t & 7) == 0) ssS[lr + 32 * i] = rsqrtf(s * inv + EPS); }
  }
}

#define LAS3 __attribute__((address_space(3)))
struct GDesc { const bf16_t* A; long lda; const bf16_t* B; long ldb; };
DI void gemm_dma_stage0(const GDesc& d, char* smc) {
  const int t = tid(), lane = t & 63, w = t >> 6;
  const unsigned wdst = (unsigned)(uintptr_t)smc + (unsigned)w * 4096u;
#pragma unroll
  for (int i = 0; i < 4; i++) {
    const int row = 32 * w + 8 * i + (lane >> 3), c = (lane & 7) ^ ((row >> 1) & 7);
    __builtin_amdgcn_global_load_lds((const unsigned*)(d.A + row * d.lda + c * 8), (LAS3 unsigned*)(uintptr_t)(wdst + i * 1024), 16, 0, 0);
    __builtin_amdgcn_global_load_lds((const unsigned*)(d.B + row * d.ldb + c * 8), (LAS3 unsigned*)(uintptr_t)(wdst + 16384 + i * 1024), 16, 0, 0);
  }
}
DI void gemm_loop_dma(const bf16_t* __restrict__ A, long lda, const bf16_t* __restrict__ B, long ldb, int K, f32x16 (&acc)[2][2], char* smc,
                      bool started = false, bool has_next = false, GDesc next = GDesc{nullptr, 0, nullptr, 0}) {
  const int t = tid(), lane = t & 63, w = t >> 6, wm = w >> 1, wn = w & 1, l31 = lane & 31, h = lane >> 5;
  unsigned aoff[4], boff[4];
#pragma unroll
  for (int i = 0; i < 4; i++) {
    const int row = 32 * w + 8 * i + (lane >> 3), c = (lane & 7) ^ ((row >> 1) & 7);
    aoff[i] = (unsigned)((row * lda + c * 8) * 2); boff[i] = (unsigned)((row * ldb + c * 8) * 2);
  }
  const char* Ab = (const char*)A; const char* Bb = (const char*)B;
  const unsigned lbase = (unsigned)(uintptr_t)smc;
  const unsigned wdst = lbase + (unsigned)w * 4096u;
  const int swz = (l31 >> 1) & 7;
  unsigned fo[4];
#pragma unroll
  for (int kk = 0; kk < 4; kk++) fo[kk] = (unsigned)(((2 * kk + h) ^ swz) * 16);
  const char* rA = smc + (wm * 64 + l31) * 128;
  const char* rB = smc + 16384 + (wn * 64 + l31) * 128;
  const int nk = K >> 6;
  auto issue = [&](auto BUF, int ko) {
    constexpr int buf = decltype(BUF)::value;
#pragma unroll
    for (int i = 0; i < 4; i++) {
      __builtin_amdgcn_global_load_lds((const unsigned*)(Ab + (size_t)ko * 2 + aoff[i]), (LAS3 unsigned*)(uintptr_t)(wdst + buf * 32768 + i * 1024), 16, 0, 0);
      __builtin_amdgcn_global_load_lds((const unsigned*)(Bb + (size_t)ko * 2 + boff[i]), (LAS3 unsigned*)(uintptr_t)(wdst + buf * 32768 + 16384 + i * 1024), 16, 0, 0);
    }
  };
  auto comp = [&](auto BUF) {
    constexpr int buf = decltype(BUF)::value;
#pragma unroll
    for (int kk = 0; kk < 4; kk++) {
      bf16x8 af[2], bfr[2];
#pragma unroll
      for (int mb = 0; mb < 2; mb++) af[mb] = *(const bf16x8*)(rA + buf * 32768 + mb * 32 * 128 + fo[kk]);
#pragma unroll
      for (int nb = 0; nb < 2; nb++) bfr[nb] = *(const bf16x8*)(rB + buf * 32768 + nb * 32 * 128 + fo[kk]);
#pragma unroll
      for (int mb = 0; mb < 2; mb++)
#pragma unroll
        for (int nb = 0; nb < 2; nb++) acc[mb][nb] = MFMA(af[mb], bfr[nb], acc[mb][nb]);
    }
  };
  using B0 = std::integral_constant<int, 0>; using B1 = std::integral_constant<int, 1>;
  if (!started) issue(B0{}, 0);
  __syncthreads();
  for (int ks = 0; ks < nk; ks += 2) {
    issue(B1{}, (ks + 1) * 64);
    __builtin_amdgcn_sched_barrier(0);
    comp(B0{});
    __syncthreads();
    if (ks + 2 < nk) issue(B0{}, (ks + 2) * 64);
    else if (has_next) gemm_dma_stage0(next, smc);
    __builtin_amdgcn_sched_barrier(0);
    comp(B1{});
    __syncthreads();
  }
}

template <int NB>
DI void gemm_loop_dma16(const bf16_t* __restrict__ A, long lda, const bf16_t* __restrict__ B, long ldb, int K, f32x4 (&acc)[4][NB], char* smc,
                      bool started = false, bool has_next = false, GDesc next = GDesc{nullptr, 0, nullptr, 0}) {
  const int t = tid(), lane = t & 63, w = t >> 6, wm = w >> 1, wn = w & 1, r16 = lane & 15, q = lane >> 4;
  unsigned aoff[4], boff[NB];
#pragma unroll
  for (int i = 0; i < 4; i++) {
    const int row = 32 * w + 8 * i + (lane >> 3), c = (lane & 7) ^ ((row >> 1) & 7);
    aoff[i] = (unsigned)((row * lda + c * 8) * 2);
  }
#pragma unroll
  for (int i = 0; i < NB; i++) {
    const int row = 8 * (NB * w + i) + (lane >> 3), c = (lane & 7) ^ ((row >> 1) & 7);
    boff[i] = (unsigned)((row * ldb + c * 8) * 2);
  }
  const char* Ab = (const char*)A; const char* Bb = (const char*)B;
  const unsigned lbase = (unsigned)(uintptr_t)smc;
  const unsigned wdst = lbase + (unsigned)w * 4096u;
  const int swz = (r16 >> 1) & 7;
  unsigned fo[2];
#pragma unroll
  for (int k32 = 0; k32 < 2; k32++) fo[k32] = (unsigned)(((4 * k32 + q) ^ swz) * 16);
  const char* rA = smc + (wm * 64 + r16) * 128;
  const char* rB = smc + 16384 + (wn * 16 * NB + r16) * 128;
  const int nk = K >> 6;
  auto issue = [&](auto BUF, int ko) {
    constexpr int buf = decltype(BUF)::value;
#pragma unroll
    for (int i = 0; i < 4; i++)
      __builtin_amdgcn_global_load_lds((const unsigned*)(Ab + (size_t)ko * 2 + aoff[i]), (LAS3 unsigned*)(uintptr_t)(wdst + buf * 32768 + i * 1024), 16, 0, 0);
#pragma unroll
    for (int i = 0; i < NB; i++)
      __builtin_amdgcn_global_load_lds((const unsigned*)(Bb + (size_t)ko * 2 + boff[i]), (LAS3 unsigned*)(uintptr_t)(lbase + buf * 32768 + 16384 + (NB * w + i) * 1024), 16, 0, 0);
  };
  auto comp = [&](auto BUF) {
    constexpr int buf = decltype(BUF)::value;
#pragma unroll
    for (int k32 = 0; k32 < 2; k32++) {
      bf16x8 af[4], bq[NB];
#pragma unroll
      for (int mb = 0; mb < 4; mb++) af[mb] = *(const bf16x8*)(rA + buf * 32768 + mb * 16 * 128 + fo[k32]);
#pragma unroll
      for (int nb = 0; nb < NB; nb++) bq[nb] = *(const bf16x8*)(rB + buf * 32768 + nb * 16 * 128 + fo[k32]);
#pragma unroll
      for (int mb = 0; mb < 4; mb++)
#pragma unroll
        for (int nb = 0; nb < NB; nb++) acc[mb][nb] = MFMA16(af[mb], bq[nb], acc[mb][nb]);
    }
  };
  using B0 = std::integral_constant<int, 0>; using B1 = std::integral_constant<int, 1>;
  if (!started) issue(B0{}, 0);
  __syncthreads();
  for (int ks = 0; ks < nk; ks += 2) {
    issue(B1{}, (ks + 1) * 64); __builtin_amdgcn_sched_barrier(0);
    comp(B0{});
    __syncthreads();
    if (ks + 2 < nk) issue(B0{}, (ks + 2) * 64);
    else if (has_next) gemm_dma_stage0(next, smc);
    __builtin_amdgcn_sched_barrier(0);
    comp(B1{});
    __syncthreads();
  }
}

DI void gemm_loop_dma2(const bf16_t* __restrict__ A, long lda, const bf16_t* __restrict__ B0, const bf16_t* __restrict__ B1, long ldb, int K,
                       f32x16 (&accP)[2][2], f32x16 (&accQ)[2][2], char* smc) {
  const int t = tid(), lane = t & 63, w = t >> 6, wm = w >> 1, wn = w & 1, l31 = lane & 31, h = lane >> 5;
  unsigned aoff[2], boff[2];
#pragma unroll
  for (int i = 0; i < 2; i++) {
    const int row = 16 * (2 * w + i) + (lane >> 2), c = (lane & 3) ^ ((row >> 2) & 3);
    aoff[i] = (unsigned)((row * lda + c * 8) * 2); boff[i] = (unsigned)((row * ldb + c * 8) * 2);
  }
  const char* Ab = (const char*)A; const char* B0b = (const char*)B0; const char* B1b = (const char*)B1;
  const unsigned wdst = (unsigned)(uintptr_t)smc + (unsigned)w * 2048u;
  const int swz = (l31 >> 2) & 3;
  unsigned fo[2];
#pragma unroll
  for (int kk = 0; kk < 2; kk++) fo[kk] = (unsigned)(((2 * kk + h) ^ swz) * 16);
  const char* rA = smc + (wm * 64 + l31) * 64;
  const char* rB0 = smc + 8192 + (wn * 64 + l31) * 64;
  const char* rB1 = smc + 16384 + (wn * 64 + l31) * 64;
  const int nk = K >> 5;
  auto issue = [&](auto BUF, int ko) {
    constexpr int buf = decltype(BUF)::value;
#pragma unroll
    for (int i = 0; i < 2; i++) {
      __builtin_amdgcn_global_load_lds((const unsigned*)(Ab + (size_t)ko * 2 + aoff[i]), (LAS3 unsigned*)(uintptr_t)(wdst + buf * 24576 + i * 1024), 16, 0, 0);
      __builtin_amdgcn_global_load_lds((const unsigned*)(B0b + (size_t)ko * 2 + boff[i]), (LAS3 unsigned*)(uintptr_t)(wdst + buf * 24576 + 8192 + i * 1024), 16, 0, 0);
      __builtin_amdgcn_global_load_lds((const unsigned*)(B1b + (size_t)ko * 2 + boff[i]), (LAS3 unsigned*)(uintptr_t)(wdst + buf * 24576 + 16384 + i * 1024), 16, 0, 0);
    }
  };
  auto comp = [&](auto BUF) {
    constexpr int buf = decltype(BUF)::value;
#pragma unroll
    for (int kk = 0; kk < 2; kk++) {
      bf16x8 af[2], b0[2], b1[2];
#pragma unroll
      for (int mb = 0; mb < 2; mb++) af[mb] = *(const bf16x8*)(rA + buf * 24576 + mb * 32 * 64 + fo[kk]);
#pragma unroll
      for (int nb = 0; nb < 2; nb++) { b0[nb] = *(const bf16x8*)(rB0 + buf * 24576 + nb * 32 * 64 + fo[kk]); b1[nb] = *(const bf16x8*)(rB1 + buf * 24576 + nb * 32 * 64 + fo[kk]); }
#pragma unroll
      for (int mb = 0; mb < 2; mb++)
#pragma unroll
        for (int nb = 0; nb < 2; nb++) { accP[mb][nb] = MFMA(af[mb], b0[nb], accP[mb][nb]); accQ[mb][nb] = MFMA(af[mb], b1[nb], accQ[mb][nb]); }
    }
  };
  using S0 = std::integral_constant<int, 0>; using S1 = std::integral_constant<int, 1>;
  issue(S0{}, 0);
  __syncthreads();
  for (int ks = 0; ks < nk; ks += 2) {
    issue(S1{}, (ks + 1) * 32);
    __builtin_amdgcn_sched_barrier(0);
    comp(S0{});
    __syncthreads();
    if (ks + 2 < nk) issue(S0{}, (ks + 2) * 32);
    __builtin_amdgcn_sched_barrier(0);
    comp(S1{});
    __syncthreads();
  }
}

DI void acc_to_lds(const f32x16 (&acc)[2][2], float* ep) {
  const int t = tid(), lane = t & 63, w = t >> 6, wm = w >> 1, wn = w & 1, l31 = lane & 31, h = lane >> 5;
#pragma unroll
  for (int mb = 0; mb < 2; mb++)
#pragma unroll
    for (int nb = 0; nb < 2; nb++)
#pragma unroll
      for (int i = 0; i < 16; i++) ep[(wm * 64 + mb * 32 + crow(i, h)) * EPW + wn * 64 + nb * 32 + l31] = acc[mb][nb][i];
}
template <int NB>
DI void acc_to_lds4(const f32x4 (&acc)[4][NB], float* ep) {
  const int t = tid(), lane = t & 63, w = t >> 6, wm = w >> 1, wn = w & 1, r16 = lane & 15, q = lane >> 4;
#pragma unroll
  for (int mb = 0; mb < 4; mb++)
#pragma unroll
    for (int nb = 0; nb < NB; nb++) {
      float* d = ep + (wm * 64 + mb * 16 + q * 4) * EPW + wn * 16 * NB + nb * 16 + r16;
      d[0] = acc[mb][nb].x; d[EPW] = acc[mb][nb].y; d[2 * EPW] = acc[mb][nb].z; d[3 * EPW] = acc[mb][nb].w;
    }
}
template <class F>
DI void rowwise(const float* ep, F f) {
  const int t = tid();
#pragma unroll 1
  for (int ps = 0; ps < 8; ps++) {
    const int row = ps * 16 + (t >> 4), c8 = (t & 15) * 8;
    float v[8];
    const f32x4 a = *(const f32x4*)(ep + row * EPW + c8), b = *(const f32x4*)(ep + row * EPW + c8 + 4);
    v[0] = a.x; v[1] = a.y; v[2] = a.z; v[3] = a.w; v[4] = b.x; v[5] = b.y; v[6] = b.z; v[7] = b.w;
    f(row, c8, v);
  }
}
template <class L, class F>
DI void rowwise2(const float* ep, L pre, F f) {
  const int t = tid();
  const int c8 = (t & 15) * 8;
#pragma unroll 1
  for (int g = 0; g < 2; g++) {
    decltype(pre(0, 0)) ld[4];
#pragma unroll
    for (int q = 0; q < 4; q++) ld[q] = pre((g * 4 + q) * 16 + (t >> 4), c8);
#pragma unroll
    for (int q = 0; q < 4; q++) {
      const int row = (g * 4 + q) * 16 + (t >> 4);
      float v[8];
      const f32x4 a = *(const f32x4*)(ep + row * EPW + c8), b = *(const f32x4*)(ep + row * EPW + c8 + 4);
      v[0] = a.x; v[1] = a.y; v[2] = a.z; v[3] = a.w; v[4] = b.x; v[5] = b.y; v[6] = b.z; v[7] = b.w;
      f(row, c8, v, ld[q]);
    }
  }
}
struct LdRope { f32x4 r[4]; };
struct LdKv { unsigned k2; u32x4 x1, x2; f32x4 r[4]; };
struct LdX { f32x4 a, b; };
struct LdGlu { u32x4 yg, gt; };
template <class F>
DI void tstore(const float* ep, int cb, int nc, const float* rowscale, F dst) {
  const int t = tid();
  const int ntask = nc * 16;
  for (int e = t; e < ntask; e += 256) {
    const int col = e % nc, rg = e / nc;
    float v[8];
#pragma unroll
    for (int j = 0; j < 8; j++) { float x = ep[(rg * 8 + j) * EPW + cb + col]; if (rowscale) x *= rowscale[rg * 8 + j]; v[j] = x; }
    *(u32x4*)(dst(col) + rg * 8) = pack8(v);
  }
}

DI void tile_from_linear(int L, int nN, int& tm, int& tn) { const int band = L / (8 * nN), rr = L % (8 * nN); tn = rr >> 3; tm = band * 8 + (rr & 7); }
DI int static_L(int round, int vb) { const int Gx = gridDim.x >> 3; return (round * 8 + (vb & 7)) * Gx + (vb >> 3); }
DI int next_item(unsigned* ctr, int* slot) {
  __syncthreads();
  if (threadIdx.x == 0) *slot = (int)atomicAdd(ctr, 1u);
  __syncthreads();
  return *slot;
}

DI int colmap(int mode, int n) {
  if (mode == 0) return n;
  if (mode == 1) { if (n < 768) return n; if (n < 2304) return n + 1056; if (n < 3360) return n - 1536; if (n < 3456) return -1; return n - 96; }
  { const int hh = n >> 7, j = n & 127; return j < 96 ? hh * 96 + j : -1; }
}
struct CDesc { const float* src; const float* g; bf16_t* dst; int ld, K, mode, it; };
DI void conv_load(const CDesc& d, f32x4 (&v)[8]) {
  const int t = tid();
  const int nkt = d.K >> 6, kt = d.it % nkt, nt = d.it / nkt, k0 = kt * 64, n0 = nt * 128;
  const int n4 = (t & 31) * 4, c = colmap(d.mode, n0 + n4);
#pragma unroll
  for (int i = 0; i < 8; i++) {
    const int kk = (t >> 5) + 8 * i;
    if (c >= 0) v[i] = __builtin_nontemporal_load((const f32x4*)(d.src + (long)(k0 + kk) * d.ld + c)); else { v[i].x = 0.f; v[i].y = 0.f; v[i].z = 0.f; v[i].w = 0.f; }
  }
}
DI void conv_finish(const CDesc& d, f32x4 (&v)[8], float* sm) {
  const int t = tid();
  const int nkt = d.K >> 6, kt = d.it % nkt, nt = d.it / nkt, k0 = kt * 64, n0 = nt * 128;
  const int n4 = (t & 31) * 4;
#pragma unroll
  for (int i = 0; i < 8; i++) {
    const int kk = (t >> 5) + 8 * i;
    if (d.g) { const float gg = d.g[k0 + kk]; v[i].x *= gg; v[i].y *= gg; v[i].z *= gg; v[i].w *= gg; }
    *(f32x4*)(sm + kk * 132 + n4) = v[i];
  }
  __syncthreads();
#pragma unroll
  for (int i = 0; i < 2; i++) {
    const int nn = (t >> 2) + 64 * i, ks = (t & 3) * 16;
    float f[16];
#pragma unroll
    for (int j = 0; j < 16; j++) f[j] = sm[(ks + j) * 132 + nn];
    u32x4 o0, o1;
    o0.x = pk2(f[0], f[1]); o0.y = pk2(f[2], f[3]); o0.z = pk2(f[4], f[5]); o0.w = pk2(f[6], f[7]);
    o1.x = pk2(f[8], f[9]); o1.y = pk2(f[10], f[11]); o1.z = pk2(f[12], f[13]); o1.w = pk2(f[14], f[15]);
    bf16_t* dd = d.dst + (long)(n0 + nn) * d.K + k0 + ks;
    *(u32x4*)dd = o0; *(u32x4*)(dd + 8) = o1;
  }
  __syncthreads();
}
constexpr int NCONV = 944 + 72 + 32 + 8 + 32 + 64 + 32 + 32 + 128 + 64;
constexpr int NAUX = NCONV + 512;
DI CDesc conv_desc(const P& p, int l, int it) {
  CDesc d; d.g = nullptr; d.mode = 0;
  if (it < 944) { d.src = p.w_in + (long)l * 1024 * INW; d.ld = INW; d.K = 1024; d.mode = 1; d.g = p.norm_g + l * 1024; d.dst = p.WinT; d.it = it; return d; }
  it -= 944;
  if (it < 72) { d.src = p.b_w_uq + (long)l * 768 * 768; d.ld = 768; d.K = 768; d.g = p.b_q_norm_g + l * 768; d.dst = p.WuqT; d.it = it; return d; }
  it -= 72;
  if (it < 32) { d.src = p.b_w_ukv + (long)l * 256 * 1024; d.ld = 1024; d.K = 256; d.g = p.b_kv_norm_g + l * 256; d.dst = p.WukvT; d.it = it; return d; }
  it -= 32;
  if (it < 8) { d.src = p.c_w_glu + (long)l * 256 * 256; d.ld = 256; d.K = 256; d.dst = p.WgluT; d.it = it; return d; }
  it -= 8;
  if (it < 32) { d.src = p.w_br_a + (long)l * 256 * 1024; d.ld = 1024; d.K = 256; d.dst = p.WbrT; d.it = it; return d; }
  it -= 32;
  if (it < 64) { d.src = p.w_br_b + (long)l * 512 * 1024; d.ld = 1024; d.K = 512; d.dst = p.WbrT + 1024 * 256; d.it = it; return d; }
  it -= 64;
  if (it < 32) { d.src = p.w_br_c + (long)l * 256 * 1024; d.ld = 1024; d.K = 256; d.dst = p.WbrT + 1024 * 768; d.it = it; return d; }
  it -= 32;
  if (it < 32) { d.src = p.w_br_m + (long)l * 256 * 1024; d.ld = 1024; d.K = 256; d.dst = p.WbrT + 1024 * 1024; d.it = it; return d; }
  it -= 32;
  if (it < 128) { d.src = p.w_out + (long)l * 1024 * 1024; d.ld = 1024; d.K = 1024; d.dst = p.WoutT + (long)l * 1024 * 1024; d.it = it; return d; }
  it -= 128;
  d.src = p.m_w_kv + (long)l * 1024 * 512; d.ld = 512; d.K = 1024; d.dst = p.WmkvT; d.it = it; return d;
}
DI void conv_all(const P& p, int l, char* smem) {
  const int G = gridDim.x, bid = blockIdx.x;
  float* sm = (float*)smem;
  if (bid >= NCONV) return;
  f32x4 va[8], vb[8];
  CDesc da = conv_desc(p, l, bid), db = da;
  conv_load(da, va);
#pragma unroll 1
  for (int it = bid; it < NCONV; it += 2 * G) {
    const bool h1 = it + G < NCONV;
    if (h1) { db = conv_desc(p, l, it + G); conv_load(db, vb); }
    conv_finish(da, va, sm);
    const bool h2 = it + 2 * G < NCONV;
    if (h2) { da = conv_desc(p, l, it + 2 * G); conv_load(da, va); }
    if (h1) conv_finish(db, vb, sm);
  }
}
DI void aux_item(const P& p, int l, int it, char* smem) {
  it -= NCONV;
  {
    const int t = tid(), lane = t & 63, row = it * 4 + (t >> 6);
    const float* src = p.mem + (long)row * 1024; const float* g = p.m_norm_g + l * 1024;
    f32x4 v[4]; float ss = 0.f;
#pragma unroll
    for (int i = 0; i < 4; i++) { v[i] = *(const f32x4*)(src + (lane + 64 * i) * 4); ss += v[i].x * v[i].x + v[i].y * v[i].y + v[i].z * v[i].z + v[i].w * v[i].w; }
    ss = sum64(ss);
    const float r = rsqrtf(ss * (1.f / 1024.f) + EPS);
#pragma unroll
    for (int i = 0; i < 4; i++) {
      const f32x4 gg = *(const f32x4*)(g + (lane + 64 * i) * 4);
      u32x2 o; o.x = pk2(v[i].x * r * gg.x, v[i].y * r * gg.y); o.y = pk2(v[i].z * r * gg.z, v[i].w * r * gg.w);
      *(u32x2*)(p.hm + (long)row * 1024 + (lane + 64 * i) * 4) = o;
    }
  }
}

DI void p0_xrow_item(const P& p, int it) {
  const int t = tid(), lane = t & 63;
  f32x4 v[2][4];
#pragma unroll
  for (int r = 0; r < 2; r++) {
    const float* src = p.x + (long)(it * 8 + (t >> 6) * 2 + r) * 1024;
#pragma unroll
    for (int i = 0; i < 4; i++) v[r][i] = __builtin_nontemporal_load((const f32x4*)(src + (lane + 64 * i) * 4));
  }
#pragma unroll
  for (int r = 0; r < 2; r++) {
    const int row = it * 8 + (t >> 6) * 2 + r;
    float ss = 0.f;
#pragma unroll
    for (int i = 0; i < 4; i++) ss += v[r][i].x * v[r][i].x + v[r][i].y * v[r][i].y + v[r][i].z * v[r][i].z + v[r][i].w * v[r][i].w;
    ss = sum64(ss);
#pragma unroll
    for (int i = 0; i < 4; i++) { u32x2 o; o.x = pk2(v[r][i].x, v[r][i].y); o.y = pk2(v[r][i].z, v[r][i].w); *(u32x2*)(p.xb + (long)row * 1024 + (lane + 64 * i) * 4) = o; }
    if (lane < 8) p.ssp[(long)lane * T_ + row] = (lane == 0) ? ss : 0.f;
  }
}
DI void p0_rope_item(const P& p, int it) {
  const int e = it * 256 + threadIdx.x, tok = e >> 4, i = e & 15;
  const float inv_freq = exp2f(-(float)i * (13.287712379549449f / 16.f));
  const float ang = (float)p.pos[tok] * inv_freq;
  const double rev = (double)ang * 0.15915494309189535;
  const float fr = (float)(rev - rint(rev));
  p.rope[(long)e * 2] = __builtin_amdgcn_cosf(fr);
  p.rope[(long)e * 2 + 1] = __builtin_amdgcn_sinf(fr);
}

DI void load_rs(const P& p, int r0, float* rsS) {
  const int t = tid();
  if (t < 128) { float s = 0.f;
#pragma unroll
    for (int j = 0; j < 8; j++) s += p.ssp[(long)j * T_ + r0 + t];
    rsS[t] = rsqrtf(s * (1.f / 1024.f) + EPS); }
}
DI void g1_tile(const P& p, int l, int tm, int tn, char* smem) {
  bf16_t* sm = (bf16_t*)smem; float* ep = (float*)smem; float* rsS = (float*)(smem + SM_RS);
  const int r0 = tm * 128, c0 = tn * 128;
  load_rs(p, r0, rsS);
  f32x16 acc[2][2]; zero_acc(acc);
  gemm_loop_dma(p.xb + (long)r0 * 1024, 1024, p.WinT + (long)c0 * 1024, 1024, 1024, acc, smem);
  acc_to_lds(acc, ep);
  __syncthreads();
  int type; bf16_t* dst; int ld;
  if (c0 < 2304) { dst = p.z1 + c0; ld = Z1W;
    if (c0 < 512) type = 1; else if (c0 < 1280) type = 2; else if (c0 < 1536) type = 0; else if (c0 < 1792) type = 2; else if (c0 < 2048) type = 3; else type = 2;
  } else { dst = p.z2 + (c0 - 2304); ld = Z2W; type = 0; }
  const float* gq = p.m_qk_g_q + l * 64;
  rowwise(ep, [&](int row, int c8, float (&v)[8]) {
    const float r = rsS[row];
#pragma unroll
    for (int j = 0; j < 8; j++) v[j] *= r;
    if (type == 1) {
#pragma unroll
      for (int j = 0; j < 8; j++) v[j] = gelu_t(v[j]);
    } else if (type == 2) {
#pragma unroll
      for (int j = 0; j < 8; j++) v[j] = silu(v[j]);
    } else if (type == 3) {
      float ss = 0.f;
#pragma unroll
      for (int j = 0; j < 8; j++) ss += v[j] * v[j];
      ss = sum8(ss);
      const float rq = rsqrtf(ss * (1.f / 64.f) + EPS) * (0.125f * LOG2E);
#pragma unroll
      for (int j = 0; j < 8; j++) v[j] *= rq * gq[(c8 & 63) + j];
    }
    *(u32x4*)(dst + (long)(r0 + row) * ld + c8) = pack8(v);
    if (c0 >= 2304) {
      float ss = 0.f;
#pragma unroll
      for (int j = 0; j < 8; j++) ss += v[j] * v[j];
      ss = sum16(ss);
      if ((c8 >> 3) == 0) p.ssq[(long)((c0 - 2304) >> 7) * T_ + r0 + row] = ss;
    }
  });
  __syncthreads();
}
DI void g1_tile2(const P& p, int l, int tm, int tn, char* smem) {
  float* ep = (float*)smem; float* rsS = (float*)(smem + SM_RS);
  const int r0 = tm * 128;
  load_rs(p, r0, rsS);
  f32x16 accP[2][2], accQ[2][2]; zero_acc(accP); zero_acc(accQ);
  const bf16_t* w0 = p.WinT + (long)(tn * 128) * 1024;
  gemm_loop_dma2(p.xb + (long)r0 * 1024, 1024, w0, w0 + (long)128 * 1024, 1024, 1024, accP, accQ, smem);
  auto epi = [&](const f32x16 (&acc)[2][2], int tnn) {
    const int c0 = tnn * 128;
    acc_to_lds(acc, ep);
    __syncthreads();
    int type; bf16_t* dst; int ld;
    if (c0 < 2304) { dst = p.z1 + c0; ld = Z1W;
      if (c0 < 512) type = 1; else if (c0 < 1280) type = 2; else if (c0 < 1536) type = 0; else if (c0 < 1792) type = 2; else if (c0 < 2048) type = 3; else type = 2;
    } else { dst = p.z2 + (c0 - 2304); ld = Z2W; type = 0; }
    const float* gq = p.m_qk_g_q + l * 64;
    rowwise(ep, [&](int row, int c8, float (&v)[8]) {
      const float r = rsS[row];
#pragma unroll
      for (int j = 0; j < 8; j++) v[j] *= r;
      if (type == 1) {
#pragma unroll
        for (int j = 0; j < 8; j++) v[j] = gelu_t(v[j]);
      } else if (type == 2) {
#pragma unroll
        for (int j = 0; j < 8; j++) v[j] = silu(v[j]);
      } else if (type == 3) {
        float ss = 0.f;
#pragma unroll
        for (int j = 0; j < 8; j++) ss += v[j] * v[j];
        ss = sum8(ss);
        const float rq = rsqrtf(ss * (1.f / 64.f) + EPS) * (0.125f * LOG2E);
#pragma unroll
        for (int j = 0; j < 8; j++) v[j] *= rq * gq[(c8 & 63) + j];
      }
      *(u32x4*)(dst + (long)(r0 + row) * ld + c8) = pack8(v);
      if (c0 >= 2304) {
        float ss = 0.f;
#pragma unroll
        for (int j = 0; j < 8; j++) ss += v[j] * v[j];
        ss = sum16(ss);
        if ((c8 >> 3) == 0) p.ssq[(long)((c0 - 2304) >> 7) * T_ + r0 + row] = ss;
      }
    });
    __syncthreads();
  };
  epi(accP, tn);
  epi(accQ, tn + 1);
}
DI void g1m_tile(const P& p, int l, int tm, int tn, char* smem) {
  bf16_t* sm = (bf16_t*)smem; float* ep = (float*)smem;
  const int r0 = tm * 128, c0 = tn * 128;
  f32x16 acc[2][2]; zero_acc(acc);
  gemm_loop_dma(p.hm + (long)r0 * 1024, 1024, p.WmkvT + (long)c0 * 1024, 1024, 1024, acc, smem);
  acc_to_lds(acc, ep);
  __syncthreads();
  if (tn < 2) {
    const float* gk = p.m_qk_g_k + l * 64;
    rowwise(ep, [&](int row, int c8, float (&v)[8]) {
      float ss = 0.f;
#pragma unroll
      for (int j = 0; j < 8; j++) ss += v[j] * v[j];
      ss = sum8(ss);
      const float rq = rsqrtf(ss * (1.f / 64.f) + EPS);
#pragma unroll
      for (int j = 0; j < 8; j++) v[j] *= rq * gk[(c8 & 63) + j];
      *(u32x4*)(p.memk + (long)(r0 + row) * 256 + c0 + c8) = pack8(v);
    });
  } else {
    const int b = r0 >> 8, m0 = r0 & 255, cv0 = c0 - 256;
    tstore(ep, 0, 128, nullptr, [&](int col) { const int cv = cv0 + col; return p.memvt + ((long)((b * 4 + (cv >> 6)) * 64 + (cv & 63))) * 256 + m0; });
  }
  __syncthreads();
}

DI void g2q_tile(const P& p, int l, int tm, int hh, char* smem) {
  bf16_t* sm = (bf16_t*)smem; float* ep = (float*)smem; float* ssS = (float*)(smem + SM_SS);
  const int r0 = tm * 128;
  f32x4 acc[4][3]; zero_acc4<3>(acc);
  { const int t = tid(); if (t < 128) { float q = 0.f;
#pragma unroll
      for (int j = 0; j < 6; j++) q += p.ssq[(long)j * T_ + r0 + t];
      ssS[t] = rsqrtf(q * (1.f / 768.f) + EPS); } }
  gemm_loop_dma16<3>(p.z2 + (long)r0 * Z2W, Z2W, p.WuqT + (long)hh * 96 * 768, 768, 768, acc, smem);
  acc_to_lds4<3>(acc, ep);
  __syncthreads();
  const float* gq = p.b_qk_g_q + l * 96;
  const float QSC = 0.10206207261596575f * LOG2E;
  rowwise2(ep, [&](int row, int c8) {
    LdRope L;
    const int tc = c8 >> 3;
    if (tc >= 8 && tc < 12) {
      const float* rp = p.rope + ((long)(r0 + row) * 16 + (tc & 1) * 8) * 2;
#pragma unroll
      for (int j = 0; j < 4; j++) L.r[j] = *(const f32x4*)(rp + 4 * j);
    } else {
#pragma unroll
      for (int j = 0; j < 4; j++) { L.r[j].x = 0.f; L.r[j].y = 0.f; L.r[j].z = 0.f; L.r[j].w = 0.f; }
    }
    return L;
  }, [&](int row, int c8, float (&v)[8], const LdRope& L) {
    const float rs = ssS[row];
    float ss = 0.f;
#pragma unroll
    for (int j = 0; j < 8; j++) { v[j] *= rs; ss += v[j] * v[j]; }
    const int tc = c8 >> 3;
    if (tc >= 12) ss = 0.f;
    ss = sum16(ss);
    const float rq = rsqrtf(ss * (1.f / 96.f) + EPS);
    bf16_t* qd = p.qf + (long)(r0 + row) * 768 + hh * 96;
    if (tc < 8) {
#pragma unroll
      for (int j = 0; j < 8; j++) v[j] *= rq * gq[c8 + j] * QSC;
      *(u32x4*)(qd + c8) = pack8(v);
    } else if (tc < 12) {
      const int i0 = (tc & 1) * 8; const bool first = tc < 10;
      const int pc = first ? 80 + i0 : 64 + i0;
      const float csn[16] = {L.r[0].x, L.r[0].y, L.r[0].z, L.r[0].w, L.r[1].x, L.r[1].y, L.r[1].z, L.r[1].w,
                             L.r[2].x, L.r[2].y, L.r[2].z, L.r[2].w, L.r[3].x, L.r[3].y, L.r[3].z, L.r[3].w};
      float o[8];
#pragma unroll
      for (int j = 0; j < 8; j++) {
        const float own = v[j] * rq * gq[c8 + j];
        const float oth = ep[row * EPW + pc + j] * rs * rq * gq[pc + j];
        const float cs = csn[2 * j], sn = csn[2 * j + 1];
        o[j] = (first ? (own * cs - oth * sn) : (own * cs + oth * sn)) * QSC;
      }
      *(u32x4*)(qd + c8) = pack8(o);
    }
  });
  __syncthreads();
}
DI void g2kv_tile(const P& p, int l, int tm, int hh, char* smem) {
  bf16_t* sm = (bf16_t*)smem; float* ep = (float*)smem; float* ssS = (float*)(smem + SM_SS);
  const int r0 = tm * 128;
  f32x16 acc[2][2]; zero_acc(acc);
  { const int t = tid(); if (t < 128) { const float q = p.ssq[(long)6 * T_ + r0 + t] + p.ssq[(long)7 * T_ + r0 + t];
      ssS[t] = rsqrtf(q * (1.f / 256.f) + EPS); } }
  gemm_loop_dma(p.z2 + (long)r0 * Z2W + 768, Z2W, p.WukvT + (long)hh * 128 * 256, 256, 256, acc, smem);
  acc_to_lds(acc, ep);
  __syncthreads();
  const float* gk = p.b_qk_g_k + l * 96;
  rowwise2(ep, [&](int row, int c8) {
    LdKv L;
    const int tc = c8 >> 3;
    const bf16_t* krp = p.z2 + (long)(r0 + row) * Z2W + 1024;
    L.k2 = *(const unsigned*)(krp + 2 * tc);
    if (tc >= 8 && tc < 12) {
      const int i0 = (tc & 1) * 8;
      L.x1 = *(const u32x4*)(krp + i0); L.x2 = *(const u32x4*)(krp + 16 + i0);
      const float* rp = p.rope + ((long)(r0 + row) * 16 + i0) * 2;
#pragma unroll
      for (int j = 0; j < 4; j++) L.r[j] = *(const f32x4*)(rp + 4 * j);
    } else {
      L.x1.x = 0; L.x1.y = 0; L.x1.z = 0; L.x1.w = 0; L.x2 = L.x1;
#pragma unroll
      for (int j = 0; j < 4; j++) { L.r[j].x = 0.f; L.r[j].y = 0.f; L.r[j].z = 0.f; L.r[j].w = 0.f; }
    }
    return L;
  }, [&](int row, int c8, float (&v)[8], const LdKv& L) {
    const float rs = ssS[row];
    const int tc = c8 >> 3;
    const unsigned k2 = L.k2;
    const float ka = __uint_as_float(k2 << 16), kb = __uint_as_float(k2 & 0xffff0000u);
    float ss = ka * ka + kb * kb;
    if (tc < 8) {
#pragma unroll
      for (int j = 0; j < 8; j++) { v[j] *= rs; ss += v[j] * v[j]; }
    }
    ss = sum16(ss);
    const float kn = rsqrtf(ss * (1.f / 96.f) + EPS);
    bf16_t* kd = p.kf + (long)(r0 + row) * 768 + hh * 96;
    if (tc < 8) {
#pragma unroll
      for (int j = 0; j < 8; j++) v[j] *= kn * gk[c8 + j];
      *(u32x4*)(kd + c8) = pack8(v);
    } else if (tc < 12) {
      const int i0 = (tc & 1) * 8; const bool first = tc < 10;
      float x1[8], x2[8], o[8];
      unpack8(L.x1, x1);
      unpack8(L.x2, x2);
      const float csn[16] = {L.r[0].x, L.r[0].y, L.r[0].z, L.r[0].w, L.r[1].x, L.r[1].y, L.r[1].z, L.r[1].w,
                             L.r[2].x, L.r[2].y, L.r[2].z, L.r[2].w, L.r[3].x, L.r[3].y, L.r[3].z, L.r[3].w};
#pragma unroll
      for (int j = 0; j < 8; j++) {
        const float a = x1[j] * kn * gk[64 + i0 + j], b = x2[j] * kn * gk[80 + i0 + j];
        const float cs = csn[2 * j], sn = csn[2 * j + 1];
        o[j] = first ? (a * cs - b * sn) : (b * cs + a * sn);
      }
      *(u32x4*)(kd + (first ? 64 : 80) + i0) = pack8(o);
    }
  });
  {
    const int b = r0 >> 11, s0 = r0 & 2047;
    tstore(ep, 64, 64, ssS, [&](int col) { return p.vt + ((long)((b * 8 + hh) * 64 + col)) * S_ + s0; });
  }
  __syncthreads();
}

template <int DQK, bool CAUSAL>
DI void attn_item(const bf16_t* __restrict__ q, long q_ld, const bf16_t* __restrict__ k, long k_ld, const bf16_t* __restrict__ vt, long vt_ld,
                  bf16_t* og, long o_ld, int q0, int nkt, char* smem, bool dry) {
  constexpr int KS = DQK + 8, NKC = DQK / 8, NKL = (64 * NKC) / 256, NKK = DQK / 16, VS = 68;
  bf16_t* sK = (bf16_t*)smem;
  bf16_t* sV = (bf16_t*)smem + 2 * 64 * KS;
  const int t = tid(), lane = t & 63, w = t >> 6, l31 = lane & 31, h = lane >> 5;
  bf16x8 qfr[NKK];
  {
    const bf16_t* qp = q + (long)(w * 32 + l31) * q_ld + h * 8;
#pragma unroll
    for (int kk = 0; kk < NKK; kk++) qfr[kk] = *(const bf16x8*)(qp + kk * 16);
  }
  u32x4 rk[NKL], rv[2];
  auto gload = [&](int kt) {
#pragma unroll
    for (int i = 0; i < NKL; i++) { const int c = t + 256 * i, key = c / NKC, kc = c % NKC; rk[i] = *(const u32x4*)(k + (long)(kt * 64 + key) * k_ld + kc * 8); }
#pragma unroll
    for (int i = 0; i < 2; i++) { const int c = t + 256 * i, d = c >> 3, kc = c & 7; rv[i] = *(const u32x4*)(vt + (long)d * vt_ld + kt * 64 + kc * 8); }
  };
  auto lstore = [&](int buf) {
    bf16_t* dK = sK + buf * 64 * KS; bf16_t* dV = sV + buf * 64 * VS;
#pragma unroll
    for (int i = 0; i < NKL; i++) { const int c = t + 256 * i, key = c / NKC, kc = c % NKC; *(u32x4*)(dK + key * KS + kc * 8) = rk[i]; }
#pragma unroll
    for (int i = 0; i < 2; i++) { const int c = t + 256 * i, d = c >> 3, kc = c & 7;
      u32x2 lo, hi; lo.x = rv[i].x; lo.y = rv[i].y; hi.x = rv[i].z; hi.y = rv[i].w;
      *(u32x2*)(dV + d * VS + kc * 8) = lo; *(u32x2*)(dV + d * VS + kc * 8 + 4) = hi; }
  };
  f32x16 o[2];
#pragma unroll
  for (int i = 0; i < 16; i++) { o[0][i] = 0.f; o[1][i] = 0.f; }
  float m = -1e30f, lsum = 0.f;
  const int qpos = q0 + w * 32 + l31;
  gload(0); lstore(0);
  if (nkt > 1) gload(1);
  __syncthreads();
  for (int kt = 0; kt < nkt; kt++) {
    if (kt + 1 < nkt) lstore((kt + 1) & 1);
    __builtin_amdgcn_sched_barrier(0);
    if (kt + 2 < nkt) gload(kt + 2);
    __builtin_amdgcn_sched_barrier(0);
    const bool active = !CAUSAL || (kt * 64 <= q0 + w * 32 + 31);
    if (active) {
      const bf16_t* cK = sK + (kt & 1) * 64 * KS; const bf16_t* cV = sV + (kt & 1) * 64 * VS;
      f32x16 s[2];
#pragma unroll
      for (int i = 0; i < 16; i++) { s[0][i] = 0.f; s[1][i] = 0.f; }
      __builtin_amdgcn_s_setprio(1);
#pragma unroll
      for (int kb = 0; kb < 2; kb++)
#pragma unroll
        for (int kk = 0; kk < NKK; kk++) {
          const bf16x8 kf_ = *(const bf16x8*)(cK + (kb * 32 + l31) * KS + kk * 16 + h * 8);
          s[kb] = MFMA(kf_, qfr[kk], s[kb]);
        }
      __builtin_amdgcn_s_setprio(0);
      if (CAUSAL && (kt * 64 + 63 > q0 + w * 32)) {
#pragma unroll
        for (int kb = 0; kb < 2; kb++)
#pragma unroll
          for (int i = 0; i < 16; i++) { const int key = kt * 64 + kb * 32 + crow(i, h); if (key > qpos) s[kb][i] = -1e30f; }
      }
      float mx = s[0][0];
#pragma unroll
      for (int kb = 0; kb < 2; kb++)
#pragma unroll
        for (int i = 0; i < 16; i++) mx = fmaxf(mx, s[kb][i]);
      mx = fmaxf(mx, __shfl_xor(mx, 32));
      const float mnew = fmaxf(m, mx);
      const float alpha = __builtin_amdgcn_exp2f(m - mnew);
      m = mnew;
      float ps = 0.f;
#pragma unroll
      for (int kb = 0; kb < 2; kb++)
#pragma unroll
        for (int i = 0; i < 16; i++) { const float pv = __builtin_amdgcn_exp2f(s[kb][i] - mnew); s[kb][i] = pv; ps += pv; }
      lsum = lsum * alpha + ps;
#pragma unroll
      for (int i = 0; i < 16; i++) { o[0][i] *= alpha; o[1][i] *= alpha; }
      __builtin_amdgcn_s_setprio(1);
#pragma unroll
      for (int kb = 0; kb < 2; kb++)
#pragma unroll
        for (int st = 0; st < 2; st++) {
          u32x4 pp; pp.x = pk2(s[kb][8 * st + 0], s[kb][8 * st + 1]); pp.y = pk2(s[kb][8 * st + 2], s[kb][8 * st + 3]);
          pp.z = pk2(s[kb][8 * st + 4], s[kb][8 * st + 5]); pp.w = pk2(s[kb][8 * st + 6], s[kb][8 * st + 7]);
          const bf16x8 pf = __builtin_bit_cast(bf16x8, pp);
#pragma unroll
          for (int db = 0; db < 2; db++) {
            const bf16_t* vp = cV + (db * 32 + l31) * VS + kb * 32 + st * 16 + 4 * h;
            const u32x2 lo = *(const u32x2*)vp, hi = *(const u32x2*)(vp + 8);
            u32x4 vv; vv.x = lo.x; vv.y = lo.y; vv.z = hi.x; vv.w = hi.y;
            o[db] = MFMA(__builtin_bit_cast(bf16x8, vv), pf, o[db]);
          }
        }
      __builtin_amdgcn_s_setprio(0);
    }
    __syncthreads();
  }
  lsum += __shfl_xor(lsum, 32);
  const float inv = 1.f / lsum;
  bf16_t* op = og + (long)(w * 32 + l31) * o_ld;
#pragma unroll
  for (int db = 0; db < 2; db++)
#pragma unroll
    for (int ig = 0; ig < 4; ig++) {
      const int d = db * 32 + ig * 8 + 4 * h;
      float gt[4]; unpack4(*(const u32x2*)(op + d), gt);
      u32x2 r; r.x = pk2(o[db][4 * ig + 0] * inv * gt[0], o[db][4 * ig + 1] * inv * gt[1]); r.y = pk2(o[db][4 * ig + 2] * inv * gt[2], o[db][4 * ig + 3] * inv * gt[3]);
      if (!dry) *(u32x2*)(op + d) = r;
    }
}
DI void mattn_item(const P& p, int idx, char* smem) {
  const int b = idx >> 6, hh = (idx >> 4) & 3, qt = idx & 15;
  const long tok0 = (long)b * S_ + qt * 128;
  attn_item<64, false>(p.z1 + tok0 * Z1W + 1792 + hh * 64, Z1W, p.memk + (long)b * 256 * 256 + hh * 64, 256,
                       p.memvt + (long)(b * 4 + hh) * 64 * 256, 256, p.z1 + tok0 * Z1W + 2048 + hh * 64, Z1W, 0, 4, smem, p.dry != 0);
}
DI void battn_item(const P& p, int idx, char* smem) {
  const int qt = 15 - (idx >> 6), bh = idx & 63, b = bh >> 3, hh = bh & 7;
  const long tok0 = (long)b * S_ + qt * 128;
  attn_item<96, true>(p.qf + tok0 * 768 + hh * 96, 768, p.kf + (long)b * S_ * 768 + hh * 96, 768,
                      p.vt + (long)(b * 8 + hh) * 64 * S_, S_, p.z1 + tok0 * Z1W + 768 + hh * 64, Z1W, qt * 128, 2 * qt + 2, smem, p.dry != 0);
}

DI void a_item(const P& p, int l, int idx, char* smem) {
  bf16_t* vnT = (bf16_t*)smem;
  float* part = (float*)(smem + 256 * 136 * 2);
  const int t = tid(); const long r0 = (long)idx * 128;
  {
    const int row = t & 127, half = t >> 7;
    const bf16_t* src = p.z1 + (r0 + row) * Z1W + 256 + half * 128;
    float ss = 0.f;
#pragma unroll 4
    for (int i = 0; i < 16; i++) { float f[8]; unpack8(*(const u32x4*)(src + i * 8), f);
#pragma unroll
      for (int j = 0; j < 8; j++) ss += f[j] * f[j]; }
    part[half * 128 + row] = ss;
    __syncthreads();
    const float r = rsqrtf((part[row] + part[128 + row]) * (1.f / 256.f) + EPS);
    const float* gv = p.a_norm_g + l * 256 + half * 128;
#pragma unroll 4
    for (int i = 0; i < 16; i++) { float f[8]; unpack8(*(const u32x4*)(src + i * 8), f);
#pragma unroll
      for (int j = 0; j < 8; j++) vnT[(half * 128 + i * 8 + j) * 136 + row] = f2bf(f[j] * r * gv[i * 8 + j]); }
  }
  __syncthreads();
  const int lane = t & 63, g = t >> 6, l31 = lane & 31, h = lane >> 5;
  const float* W = p.a_w_s + (long)(l * 4 + g) * 128 * 128;
  const float* bs = p.a_b_s + (l * 4 + g) * 128;
#pragma unroll 1
  for (int mh = 0; mh < 2; mh++) {
    f32x16 acc[2][2]; zero_acc(acc);
#pragma unroll 2
    for (int kk = 0; kk < 8; kk++) {
      bf16x8 af[2], bfr[2];
#pragma unroll
      for (int mb = 0; mb < 2; mb++) {
        const int tt = mh * 64 + mb * 32 + l31, s0 = kk * 16 + h * 8;
        const f32x4 w0 = *(const f32x4*)(W + tt * 128 + s0), w1 = *(const f32x4*)(W + tt * 128 + s0 + 4);
        float f[8] = {w0.x, w0.y, w0.z, w0.w, w1.x, w1.y, w1.z, w1.w};
#pragma unroll
        for (int j = 0; j < 8; j++) if (s0 + j > tt) f[j] = 0.f;
        af[mb] = __builtin_bit_cast(bf16x8, pack8(f));
      }
#pragma unroll
      for (int nb = 0; nb < 2; nb++) bfr[nb] = *(const bf16x8*)(vnT + (g * 64 + nb * 32 + l31) * 136 + kk * 16 + h * 8);
#pragma unroll
      for (int mb = 0; mb < 2; mb++)
#pragma unroll
        for (int nb = 0; nb < 2; nb++) acc[mb][nb] = MFMA(af[mb], bfr[nb], acc[mb][nb]);
    }
#pragma unroll
    for (int mb = 0; mb < 2; mb++)
#pragma unroll
      for (int nb = 0; nb < 2; nb++)
#pragma unroll
        for (int i = 0; i < 16; i++) {
          const int tt = mh * 64 + mb * 32 + crow(i, h), col = g * 64 + nb * 32 + l31;
          bf16_t* zp = p.z1 + (r0 + tt) * Z1W;
          const float u = bf2f(zp[col]), gt = bf2f(zp[512 + col]);
          if (!p.dry) zp[col] = f2bf(u * (acc[mb][nb][i] + bs[tt]) * gt);
        }
  }
  __syncthreads();
}

DI void c_setup(const P& p, int l, int g, int lane, float& ar, float& ai, float (&Br)[16], float (&Bi)[16]) {
  const int gi = (l * 16 + g) * 64 + lane;
  const float lre = p.c_a_re[gi], lim = p.c_a_im[gi];
  const float dt = expf(p.c_log_dt[l * 16 + g]);
  const float mag = expf(lre * dt);
  const float angf = lim * dt;
  const double rev = (double)angf * 0.15915494309189535;
  const float rf = (float)((rev - rint(rev)) * 6.283185307179586);
  const float sn = sinf(rf), cs = cosf(rf);
  ar = mag * cs; ai = mag * sn;
  const float xr = ar - 1.f, xi = ai, den = 1.f / (lre * lre + lim * lim);
  const float cr = (xr * lre + xi * lim) * den, ci = (xi * lre - xr * lim) * den;
  const float* bre = p.c_b_re + (long)gi * 16; const float* bim = p.c_b_im + (long)gi * 16;
#pragma unroll
  for (int c4 = 0; c4 < 4; c4++) {
    const f32x4 r4 = *(const f32x4*)(bre + c4 * 4), i4 = *(const f32x4*)(bim + c4 * 4);
    const float rr[4] = {r4.x, r4.y, r4.z, r4.w}, ii[4] = {i4.x, i4.y, i4.z, i4.w};
#pragma unroll
    for (int j = 0; j < 4; j++) { Br[c4 * 4 + j] = cr * rr[j] - ci * ii[j]; Bi[c4 * 4 + j] = cr * ii[j] + ci * rr[j]; }
  }
}
DI void s5c_build_item(const P& p, int it) {
  const int e = it * 256 + tid(), l = e >> 10, g = (e >> 6) & 15, lane = e & 63;
  float ar, ai, Br[16], Bi[16];
  c_setup(p, l, g, lane, ar, ai, Br, Bi);
  float* d = p.s5c + (long)e * 36;
  f32x4 v; v.x = ar; v.y = ai; v.z = 0.f; v.w = 0.f; *(f32x4*)d = v;
#pragma unroll
  for (int c4 = 0; c4 < 4; c4++) {
    v.x = Br[c4 * 4]; v.y = Br[c4 * 4 + 1]; v.z = Br[c4 * 4 + 2]; v.w = Br[c4 * 4 + 3]; *(f32x4*)(d + 4 + c4 * 4) = v;
    v.x = Bi[c4 * 4]; v.y = Bi[c4 * 4 + 1]; v.z = Bi[c4 * 4 + 2]; v.w = Bi[c4 * 4 + 3]; *(f32x4*)(d + 20 + c4 * 4) = v;
  }
}
DI void s5_bfrags(const P& p, int l, int g, int lane, bf16x8 (&bf)[8]) {
  const int r16 = lane & 15, q = lane >> 4;
#pragma unroll
  for (int nb = 0; nb < 8; nb++) {
    u32x4 pk; pk.x = 0u; pk.y = 0u; pk.z = 0u; pk.w = 0u;
    if (q < 2) {
      const float* d = p.s5c + (long)(((l * 16 + g) * 64) + nb * 8 + (r16 >> 1)) * 36 + 4 + (r16 & 1) * 16 + q * 8;
      const f32x4 a = *(const f32x4*)d, b = *(const f32x4*)(d + 4);
      pk.x = pk2(a.x, a.y); pk.y = pk2(a.z, a.w); pk.z = pk2(b.x, b.y); pk.w = pk2(b.z, b.w);
    }
    bf[nb] = __builtin_bit_cast(bf16x8, pk);
  }
}
DI void s5_bu_block(const float* ub, int sb, int lane, const bf16x8 (&bf)[8], float* bu) {
  const int r16 = lane & 15, q = lane >> 4;
  u32x4 ua; ua.x = 0u; ua.y = 0u; ua.z = 0u; ua.w = 0u;
  if (q < 2) {
    const f32x4 a = *(const f32x4*)(ub + (sb * 16 + r16) * 16 + q * 8), b = *(const f32x4*)(ub + (sb * 16 + r16) * 16 + q * 8 + 4);
    ua.x = pk2(a.x, a.y); ua.y = pk2(a.z, a.w); ua.z = pk2(b.x, b.y); ua.w = pk2(b.z, b.w);
  }
  const bf16x8 af = __builtin_bit_cast(bf16x8, ua);
#pragma unroll
  for (int nb = 0; nb < 8; nb++) {
    f32x4 d; d.x = 0.f; d.y = 0.f; d.z = 0.f; d.w = 0.f;
    d = __builtin_amdgcn_mfma_f32_16x16x32_bf16(af, bf[nb], d, 0, 0, 0);
    float* o = bu + (q * 4) * 132 + nb * 16 + r16;
    o[0] = d.x; o[132] = d.y; o[264] = d.z; o[396] = d.w;
  }
}
#define LDS_HANDOFF_() do { asm volatile("s_waitcnt lgkmcnt(0)" ::: "memory"); __builtin_amdgcn_wave_barrier(); } while (0)
DI void c_load_u(const P& p, long tok0, int g, int lane, float* ub) {
  const bf16_t* up = p.z1 + (tok0 + lane) * Z1W + 1280 + g * 16;
  float f0[8], f1[8];
  unpack8(*(const u32x4*)up, f0); unpack8(*(const u32x4*)(up + 8), f1);
  f32x4 a; a.x = f0[0]; a.y = f0[1]; a.z = f0[2]; a.w = f0[3]; *(f32x4*)(ub + lane * 16) = a;
  a.x = f0[4]; a.y = f0[5]; a.z = f0[6]; a.w = f0[7]; *(f32x4*)(ub + lane * 16 + 4) = a;
  a.x = f1[0]; a.y = f1[1]; a.z = f1[2]; a.w = f1[3]; *(f32x4*)(ub + lane * 16 + 8) = a;
  a.x = f1[4]; a.y = f1[5]; a.z = f1[6]; a.w = f1[7]; *(f32x4*)(ub + lane * 16 + 12) = a;
}
DI void c_step(const float* ub, int s, const float (&Br)[16], const float (&Bi)[16], float ar, float ai, float& sr, float& si) {
  float bur = 0.f, bui = 0.f;
#pragma unroll
  for (int c4 = 0; c4 < 4; c4++) {
    const f32x4 u = *(const f32x4*)(ub + s * 16 + c4 * 4);
    bur += Br[c4 * 4] * u.x + Br[c4 * 4 + 1] * u.y + Br[c4 * 4 + 2] * u.z + Br[c4 * 4 + 3] * u.w;
    bui += Bi[c4 * 4] * u.x + Bi[c4 * 4 + 1] * u.y + Bi[c4 * 4 + 2] * u.z + Bi[c4 * 4 + 3] * u.w;
  }
  const float nr = ar * sr - ai * si + bur, ni = ar * si + ai * sr + bui;
  sr = nr; si = ni;
}
DI void c1_item(const P& p, int l, int idx, char* smem) {
  const int t = tid(), lane = t & 63, w = t >> 6;
  const int b = idx >> 7, g = (idx >> 3) & 15, k = (idx & 7) * 4 + w;
  float* ub = (float*)(smem + w * 16896);
  float* bu = (float*)(smem + w * 16896 + 8448);
  const float* cd = p.s5c + (long)(((l * 16 + g) * 64) + lane) * 36;
  const float ar = cd[0], ai = cd[1];
  bf16x8 bf[8];
  s5_bfrags(p, l, g, lane, bf);
  const long tok0 = (long)b * S_ + k * 64;
  c_load_u(p, tok0, g, lane, ub);
  __syncthreads();
  float sr = 0.f, si = 0.f;
#pragma unroll 1
  for (int sb = 0; sb < 4; sb++) {
    s5_bu_block(ub, sb, lane, bf, bu);
    LDS_HANDOFF_();
#pragma unroll 4
    for (int s2 = 0; s2 < 16; s2++) {
      const f32x2 bb = *(const f32x2*)(bu + s2 * 132 + 2 * lane);
      const float nr = ar * sr - ai * si + bb.x, ni = ar * si + ai * sr + bb.y;
      sr = nr; si = ni;
    }
    LDS_HANDOFF_();
  }
  f32x2 e; e.x = sr; e.y = si;
  *(f32x2*)(p.carry + ((long)((b * 16 + g) * 32 + k) * 64 + lane) * 2) = e;
  __syncthreads();
}
DI void c3_item(const P& p, int l, int idx, char* smem) {
  const int t = tid(), lane = t & 63, w = t >> 6;
  const int b = idx >> 7, g = (idx >> 3) & 15, k = (idx & 7) * 4 + w;
  float* ub = (float*)(smem + w * 16896);
  bf16_t* stb = (bf16_t*)(smem + w * 16896 + 4096);
  float* bu = (float*)(smem + w * 16896 + 8448);
  const int c = lane & 15, sq = lane >> 4;
  bf16x8 cfr[4];
  {
    const float* cre = p.c_c_re + (long)(l * 16 + g) * 1024 + c * 64; const float* cim = p.c_c_im + (long)(l * 16 + g) * 1024 + c * 64;
#pragma unroll
    for (int ks = 0; ks < 4; ks++) {
      const f32x4 r4 = *(const f32x4*)(cre + ks * 16 + sq * 4), i4 = *(const f32x4*)(cim + ks * 16 + sq * 4);
      u32x4 pk; pk.x = pk2(r4.x, -i4.x); pk.y = pk2(r4.y, -i4.y); pk.z = pk2(r4.z, -i4.z); pk.w = pk2(r4.w, -i4.w);
      cfr[ks] = __builtin_bit_cast(bf16x8, pk);
    }
  }
  const float* cd = p.s5c + (long)(((l * 16 + g) * 64) + lane) * 36;
  const float ar = cd[0], ai = cd[1];
  bf16x8 bf[8];
  s5_bfrags(p, l, g, lane, bf);
  const long tok0 = (long)b * S_ + k * 64;
  c_load_u(p, tok0, g, lane, ub);
  float lr = ar, li = ai;
#pragma unroll
  for (int i = 0; i < 6; i++) { const float nr = lr * lr - li * li, ni = 2.f * lr * li; lr = nr; li = ni; }
  float sr = 0.f, si = 0.f;
  {
    const float* cp = p.carry + ((long)((b * 16 + g) * 32) * 64 + lane) * 2;
    for (int j0 = 0; j0 < k; j0 += 16) {
      f32x2 e[16];
#pragma unroll
      for (int jj = 0; jj < 16; jj++) { e[jj].x = 0.f; e[jj].y = 0.f; if (j0 + jj < k) e[jj] = *(const f32x2*)(cp + (long)(j0 + jj) * 128); }
#pragma unroll
      for (int jj = 0; jj < 16; jj++) if (j0 + jj < k) { const float nr = lr * sr - li * si + e[jj].x, ni = lr * si + li * sr + e[jj].y; sr = nr; si = ni; }
    }
  }
  __syncthreads();
  const float dsk = p.c_d[l * 256 + g * 16 + c];
#pragma unroll 1
  for (int sb = 0; sb < 4; sb++) {
    s5_bu_block(ub, sb, lane, bf, bu);
    LDS_HANDOFF_();
#pragma unroll 4
    for (int s2 = 0; s2 < 16; s2++) {
      const f32x2 bb = *(const f32x2*)(bu + s2 * 132 + 2 * lane);
      const float nr = ar * sr - ai * si + bb.x, ni = ar * si + ai * sr + bb.y;
      sr = nr; si = ni;
      *(unsigned*)(stb + s2 * 136 + 2 * lane) = pk2(sr, si);
    }
    asm volatile("s_waitcnt lgkmcnt(0)" ::: "memory");
    __builtin_amdgcn_wave_barrier();
    f32x4 y; y.x = 0.f; y.y = 0.f; y.z = 0.f; y.w = 0.f;
#pragma unroll
    for (int ks = 0; ks < 4; ks++) {
      const bf16x8 af = *(const bf16x8*)(stb + c * 136 + ks * 32 + sq * 8);
      y = __builtin_amdgcn_mfma_f32_16x16x32_bf16(af, cfr[ks], y, 0, 0, 0);
    }
    const float yy[4] = {y.x, y.y, y.z, y.w};
#pragma unroll
    for (int qq = 0; qq < 4; qq++) {
      const int sa = sb * 16 + sq * 4 + qq;
      const float yv = gelu_t(yy[qq] + dsk * ub[sa * 16 + c]);
      if (!p.dry) p.z1[(tok0 + sa) * Z1W + 1280 + g * 16 + c] = f2bf(yv);
    }
    asm volatile("s_waitcnt lgkmcnt(0)" ::: "memory");
    __builtin_amdgcn_wave_barrier();
  }
  __syncthreads();
}

DI void glu_tile(const P& p, int l, int tm, int tn, char* smem) {
  bf16_t* sm = (bf16_t*)smem; float* ep = (float*)smem;
  const int r0 = tm * 128, c0 = tn * 128;
  f32x16 acc[2][2]; zero_acc(acc);
  gemm_loop_dma(p.z1 + (long)r0 * Z1W + 1280, Z1W, p.WgluT + (long)c0 * 256, 256, 256, acc, smem);
  acc_to_lds(acc, ep);
  __syncthreads();
  const float* bg = p.c_b_glu + l * 256 + c0;
  rowwise2(ep, [&](int row, int c8) {
    LdGlu L;
    const bf16_t* zp = p.z1 + (long)(r0 + row) * Z1W + c0 + c8;
    L.yg = *(const u32x4*)(zp + 1280); L.gt = *(const u32x4*)(zp + 1536);
    return L;
  }, [&](int row, int c8, float (&v)[8], const LdGlu& L) {
    bf16_t* zp = p.z1 + (long)(r0 + row) * Z1W + c0 + c8;
    float yg[8], gt[8];
    unpack8(L.yg, yg); unpack8(L.gt, gt);
#pragma unroll
    for (int j = 0; j < 8; j++) v[j] = yg[j] * sigm(v[j] + bg[c8 + j]) * gt[j];
    if (!p.dry) *(u32x4*)(zp + 1536) = pack8(v);
  });
  __syncthreads();
}

DI void pf_tile(const P& p, int l, int tm, int tn, char* smem) {
  float* ep = (float*)smem; float* rsS = (float*)(smem + SM_RS);
  const int t = tid(), lane = t & 63, w = t >> 6, wm = w >> 1, wn = w & 1, l31 = lane & 31, h = lane >> 5;
  const int r0 = tm * 128, c0 = tn * 128;
  load_rs(p, r0, rsS);
  unsigned mrgp[2][2][8];
#pragma unroll
  for (int a = 0; a < 2; a++)
#pragma unroll
    for (int b = 0; b < 2; b++)
#pragma unroll
      for (int i = 0; i < 8; i++) mrgp[a][b][i] = 0u;
#pragma unroll 1
  for (int pr = 0; pr < 2; pr++) {
    unsigned gp[2][2][2][8];
    {
      f32x16 accP[2][2], accQ[2][2]; zero_acc(accP); zero_acc(accQ);
      const bf16_t* wg = p.WinT + (long)(3456 + (2 * pr) * 1024 + c0) * 1024;
      gemm_loop_dma2(p.xb + (long)r0 * 1024, 1024, wg, wg + (long)1024 * 1024, 1024, 1024, accP, accQ, smem);
      const float* bm = p.b_merge + l * 4096 + (2 * pr) * 1024 + c0;
#pragma unroll
      for (int mb = 0; mb < 2; mb++)
#pragma unroll
        for (int nb = 0; nb < 2; nb++) {
          const float bias0 = bm[wn * 64 + nb * 32 + l31], bias1 = bm[1024 + wn * 64 + nb * 32 + l31];
#pragma unroll
          for (int i = 0; i < 16; i += 2) {
            const float ra = rsS[wm * 64 + mb * 32 + crow(i, h)], rb = rsS[wm * 64 + mb * 32 + crow(i + 1, h)];
            gp[0][mb][nb][i >> 1] = pk2n(sigm(accP[mb][nb][i] * ra + bias0), sigm(accP[mb][nb][i + 1] * rb + bias0));
            gp[1][mb][nb][i >> 1] = pk2n(sigm(accQ[mb][nb][i] * ra + bias1), sigm(accQ[mb][nb][i + 1] * rb + bias1));
          }
        }
    }
#pragma unroll
    for (int j = 0; j < 2; j++) {
      const int br = 2 * pr + j;
      const int yoff = br == 0 ? 0 : (br == 1 ? 768 : (br == 2 ? 1536 : 2048));
      const int Kb = br == 1 ? 512 : 256;
      const long woff = br == 0 ? 0 : (br == 1 ? 1024 * 256 : (br == 2 ? 1024 * 768 : 1024 * 1024));
      f32x16 acc[2][2]; zero_acc(acc);
      gemm_loop_dma(p.z1 + (long)r0 * Z1W + yoff, Z1W, p.WbrT + woff + (long)c0 * Kb, Kb, Kb, acc, smem);
#pragma unroll
      for (int mb = 0; mb < 2; mb++)
#pragma unroll
        for (int nb = 0; nb < 2; nb++)
#pragma unroll
          for (int i = 0; i < 16; i += 2) {
            const unsigned g2 = gp[j][mb][nb][i >> 1], m2 = mrgp[mb][nb][i >> 1];
            const float m0 = __uint_as_float(m2 << 16) + __uint_as_float(g2 << 16) * acc[mb][nb][i];
            const float m1 = __uint_as_float(m2 & 0xffff0000u) + __uint_as_float(g2 & 0xffff0000u) * acc[mb][nb][i + 1];
            mrgp[mb][nb][i >> 1] = pk2(m0, m1);
          }
    }
  }
  {
    f32x16 mrg[2][2];
#pragma unroll
    for (int a = 0; a < 2; a++)
#pragma unroll
      for (int b = 0; b < 2; b++)
#pragma unroll
        for (int i = 0; i < 16; i += 2) { const unsigned m2 = mrgp[a][b][i >> 1]; mrg[a][b][i] = __uint_as_float(m2 << 16); mrg[a][b][i + 1] = __uint_as_float(m2 & 0xffff0000u); }
    acc_to_lds(mrg, ep);
  }
  __syncthreads();
  rowwise(ep, [&](int row, int c8, float (&v)[8]) { *(u32x4*)(p.mg + (long)(r0 + row) * 1024 + c0 + c8) = pack8(v); });
  __syncthreads();
}

DI void out_tile(const P& p, int l, int tm, int tn, char* smem) {
  bf16_t* sm = (bf16_t*)smem; float* ep = (float*)smem;
  const int r0 = tm * 128, c0 = tn * 128;
  f32x16 acc[2][2]; zero_acc(acc);
  gemm_loop_dma(p.mg + (long)r0 * 1024, 1024, p.WoutT + (long)l * 1024 * 1024 + (long)c0 * 1024, 1024, 1024, acc, smem);
  acc_to_lds(acc, ep);
  __syncthreads();
  const float* xin = (l == 0) ? p.x : p.out;
  rowwise2(ep, [&](int row, int c8) {
    LdX L;
    const long off = (long)(r0 + row) * 1024 + c0 + c8;
    L.a = *(const f32x4*)(xin + off); L.b = *(const f32x4*)(xin + off + 4);
    return L;
  }, [&](int row, int c8, float (&v)[8], const LdX& L) {
    const long off = (long)(r0 + row) * 1024 + c0 + c8;
    const f32x4 a = L.a, b = L.b;
    v[0] += a.x; v[1] += a.y; v[2] += a.z; v[3] += a.w; v[4] += b.x; v[5] += b.y; v[6] += b.z; v[7] += b.w;
    f32x4 oa, ob; oa.x = v[0]; oa.y = v[1]; oa.z = v[2]; oa.w = v[3]; ob.x = v[4]; ob.y = v[5]; ob.z = v[6]; ob.w = v[7];
    if (!p.dry) {
      if (l == 1) { __builtin_nontemporal_store(oa, (f32x4*)(p.out + off)); __builtin_nontemporal_store(ob, (f32x4*)(p.out + off + 4)); }
      else { *(f32x4*)(p.out + off) = oa; *(f32x4*)(p.out + off + 4) = ob; }
    }
    if (l == 0) {
      *(u32x4*)(p.xb + off) = pack8(v);
      float ss = 0.f;
#pragma unroll
      for (int j = 0; j < 8; j++) ss += v[j] * v[j];
      ss = sum16(ss);
      if ((c8 >> 3) == 0) p.ssp[(long)tn * T_ + r0 + row] = ss;
    }
  });
  __syncthreads();
}

DI void out_tile2(const P& p, int l, int tm, int tn2, char* smem) {
  float* ep = (float*)smem;
  const int r0 = tm * 128;
  f32x16 accP[2][2], accQ[2][2]; zero_acc(accP); zero_acc(accQ);
  const bf16_t* w0 = p.WoutT + (long)l * 1024 * 1024 + (long)(tn2 * 256) * 1024;
  gemm_loop_dma2(p.mg + (long)r0 * 1024, 1024, w0, w0 + (long)128 * 1024, 1024, 1024, accP, accQ, smem);
  const float* xin = (l == 0) ? p.x : p.out;
  auto epi = [&](const f32x16 (&acc)[2][2], int tn) {
    const int c0 = tn * 128;
    acc_to_lds(acc, ep);
    __syncthreads();
    rowwise2(ep, [&](int row, int c8) {
      LdX L;
      const long off = (long)(r0 + row) * 1024 + c0 + c8;
      L.a = *(const f32x4*)(xin + off); L.b = *(const f32x4*)(xin + off + 4);
      return L;
    }, [&](int row, int c8, float (&v)[8], const LdX& L) {
      const long off = (long)(r0 + row) * 1024 + c0 + c8;
      const f32x4 a = L.a, b = L.b;
      v[0] += a.x; v[1] += a.y; v[2] += a.z; v[3] += a.w; v[4] += b.x; v[5] += b.y; v[6] += b.z; v[7] += b.w;
      f32x4 oa, ob; oa.x = v[0]; oa.y = v[1]; oa.z = v[2]; oa.w = v[3]; ob.x = v[4]; ob.y = v[5]; ob.z = v[6]; ob.w = v[7];
      if (!p.dry) {
        if (l == 1) { __builtin_nontemporal_store(oa, (f32x4*)(p.out + off)); __builtin_nontemporal_store(ob, (f32x4*)(p.out + off + 4)); }
        else { *(f32x4*)(p.out + off) = oa; *(f32x4*)(p.out + off + 4) = ob; }
      }
      if (l == 0) {
        *(u32x4*)(p.xb + off) = pack8(v);
        float ss = 0.f;
#pragma unroll
        for (int j = 0; j < 8; j++) ss += v[j] * v[j];
        ss = sum16(ss);
        if ((c8 >> 3) == 0) p.ssp[(long)tn * T_ + r0 + row] = ss;
      }
    });
    __syncthreads();
  };
  epi(accP, 2 * tn2);
  epi(accQ, 2 * tn2 + 1);
}

DI void run_phase(const P& p, int ph, char* smem, int vb) {
  const int G = gridDim.x, bid = blockIdx.x;
  int* slot = (int*)(smem + SM_MISC);
  if (ph == 0) {
    conv_all(p, 0, smem);
    for (int it = NCONV + bid; it < NAUX; it += G) aux_item(p, 0, it, smem);
    for (int it = bid; it < 2048; it += G) p0_xrow_item(p, it);
    for (int it = bid; it < 1024; it += G) p0_rope_item(p, it);
    for (int it = bid; it < 8; it += G) s5c_build_item(p, it);
    return;
  }
  const int l = (ph - 1) / 6, s = (ph - 1) % 6;
  if (s == 0) {
    const int nd = 128 * 12, nrd = (nd + G - 1) / G;
    for (int r = 0; r < nrd; r++) { const int L = static_L(r, vb); if (L >= nd) continue; int tm, tp; tile_from_linear(L, 12, tm, tp); g1_tile2(p, l, tm, 2 * tp, smem); }
    for (int L = vb; L < 384 + 64; L += G) {
      int tm, tn;
      if (L < 384) { tile_from_linear(L, 3, tm, tn); g1_tile(p, l, tm, 24 + tn, smem); }
      else { tile_from_linear(L - 384, 4, tm, tn); g1m_tile(p, l, tm, tn, smem); }
    }
  } else if (s == 1) {
    const long dm = p.dry;
    {
      const int total = 1024, nr = (total + G - 1) / G;
      if (!dm || (dm & 2)) for (int r = 0; r < nr; r++) { const int L = static_L(r, vb); if (L >= total) continue; int tm, tn; tile_from_linear(L, 8, tm, tn); g2q_tile(p, l, tm, tn, smem); }
      if (!dm || (dm & 8)) for (int r = 0; r < nr; r++) { const int L = static_L(r, vb); if (L >= total) continue; int tm, tn; tile_from_linear(L, 8, tm, tn); g2kv_tile(p, l, tm, tn, smem); }
    }
    if (!dm || (dm & 4)) for (int it = vb; it < 512; it += G) mattn_item(p, it, smem);
    {
      const bool split = (G >= 256);
      if (!dm || (dm & 16)) { const int a1 = split ? 128 : 128; for (int it = vb; it < a1; it += G) a_item(p, l, it, smem); }
      const int cstep = split ? (vb < 128 ? 1024 : G - 128) : G;
      if (!dm || (dm & 32)) {
#pragma unroll 1
        for (int it = vb; it < 1024; it += cstep) c1_item(p, l, it, smem);
      }
    }
  } else if (s == 2) {
    const long dm = p.dry;
    if (G == 512) {
#pragma unroll 1
      for (int j = 0; j < 4; j++) {
        if (j < 2) { if (dm && !(dm & 2)) continue; battn_item(p, j ? 1023 - vb : vb, smem); }
        else { if (dm && !(dm & 4)) continue; c3_item(p, l, vb + (j - 2) * 512, smem); }
      }
    } else {
#pragma unroll 1
      for (int it = vb; it < 2048; it += G) {
        if (it < 1024) { if (dm && !(dm & 2)) continue; battn_item(p, it, smem); } else { if (dm && !(dm & 4)) continue; c3_item(p, l, it - 1024, smem); }
      }
    }
  } else if (s == 3) {
    for (int it = bid; it < 256; it += G) glu_tile(p, l, it >> 1, it & 1, smem);
  } else if (s == 4) {
    const int total = 1024, nr = (total + G - 1) / G;
    for (int r = 0; r < nr; r++) { const int L = static_L(r, vb); if (L >= total) continue; int tm, tn; tile_from_linear(L, 8, tm, tn); pf_tile(p, l, tm, tn, smem); }
  } else {
    const int nr2 = (512 + G - 1) / G;
    for (int r = 0; r < nr2; r++) { const int L = static_L(r, vb); if (L >= 512) continue; int tm, tn; tile_from_linear(L, 4, tm, tn); out_tile2(p, l, tm, tn, smem); }
    if (l == 0) { conv_all(p, 1, smem); for (int it = NCONV + bid; it < NAUX; it += G) aux_item(p, 1, it, smem); }
  }
}

DI unsigned xb_ld(unsigned* q) { return __hip_atomic_load(q, __ATOMIC_RELAXED, __HIP_MEMORY_SCOPE_AGENT); }
DI unsigned xb_add(unsigned* q, unsigned v) { return __hip_atomic_fetch_add(q, v, __ATOMIC_RELAXED, __HIP_MEMORY_SCOPE_AGENT); }
DI void gbar(unsigned* bar, const int* st) {
  asm volatile("s_waitcnt vmcnt(0)" ::: "memory");
  __syncthreads();
  if (threadIdx.x == 0) {
    __builtin_amdgcn_s_waitcnt(0);
    const unsigned x = (unsigned)st[0], nloc = (unsigned)st[1], nx = (unsigned)st[2];
    const unsigned old = xb_add(&bar[1024 + 64 * x], 1u);
    const unsigned gen = old / nloc;
    if (old + 1u == (gen + 1u) * nloc) {
      __builtin_amdgcn_fence(__ATOMIC_RELEASE, "agent");
      asm volatile("s_waitcnt vmcnt(0)" ::: "memory");
      const unsigned og = xb_add(&bar[3072], 1u);
      const unsigned tg = og / nx;
      if (og + 1u == (tg + 1u) * nx) xb_add(&bar[3136], 1u);
      else while (xb_ld(&bar[3136]) == tg) __builtin_amdgcn_s_sleep(1);
      __builtin_amdgcn_fence(__ATOMIC_ACQUIRE, "agent");
      xb_add(&bar[2048 + 64 * x], 1u);
      asm volatile("s_waitcnt vmcnt(0)" ::: "memory");
    } else {
      while (xb_ld(&bar[2048 + 64 * x]) == gen) __builtin_amdgcn_s_sleep(1);
      __builtin_amdgcn_fence(__ATOMIC_ACQUIRE, "agent");
      asm volatile("s_waitcnt vmcnt(0)" ::: "memory");
    }
  }
  __syncthreads();
}

#if MK_MULTI
__global__ void __launch_bounds__(256, 2) hyb_phase(P p, int ph) {
  __shared__ __attribute__((aligned(16))) char smem[SM_TOTAL];
  run_phase(p, ph, smem, blockIdx.x);
}
#else
__global__ void __launch_bounds__(256, 2) hyb_mega(P p) {
  __shared__ __attribute__((aligned(16))) char smem[SM_TOTAL];
  cg::grid_group grid = cg::this_grid();
  if (p.dry == 0x7fffffff) grid.sync();
  int vb;
  {
    int* sl = (int*)(smem + SM_MISC) + 2;
    if (threadIdx.x == 0) {
      const unsigned xcc = (unsigned)__builtin_amdgcn_s_getreg((3 << 11) | 20) & 7u;
      const unsigned loc = xb_add(p.ctr + 40 + xcc, 1u);
      const unsigned Gx = gridDim.x >> 3;
      *sl = (loc < Gx) ? (int)(loc * 8 + xcc) : -1;
      unsigned sum, cnt, mine;
      for (;;) {
        sum = 0u; cnt = 0u; mine = 0u;
        for (unsigned j = 0; j < 8; ++j) { const unsigned c = xb_ld(p.ctr + 40 + j); sum += c; cnt += (c > 0u) ? 1u : 0u; mine = (j == xcc) ? c : mine; }
        if (sum == gridDim.x) break;
        __builtin_amdgcn_s_sleep(1);
      }
      sl[2] = (int)xcc; sl[3] = (int)mine; sl[4] = (int)cnt;
    }
    __syncthreads();
    vb = blockIdx.x;
  }
  const int* bst = (const int*)(smem + SM_MISC) + 4;
#ifdef DRY_PH
  P pd = p; { int one = DRY_MASK; asm volatile("" : "+s"(one)); pd.dry = one; }
#endif
#pragma unroll 1
  for (int ph = 0; ph < 13; ph++) {
#ifdef DRY_PH
    if (ph == DRY_PH) { run_phase(pd, ph, smem, vb); gbar(p.bar, bst); }
#endif
    run_phase(p, ph, smem, vb);
    if (ph < 12) gbar(p.bar, bst);
  }
}
#endif

extern "C" void kernel_launch(void* const* d_in, const int* in_sizes, int n_in, void* d_out, int out_size, void* d_ws, size_t ws_size, hipStream_t stream) {
  P p{};
  p.x = (const float*)d_in[0]; p.mem = (const float*)d_in[1]; p.pos = (const int*)d_in[2];
  p.norm_g = (const float*)d_in[3]; p.w_in = (const float*)d_in[4]; p.b_merge = (const float*)d_in[5];
  p.a_norm_g = (const float*)d_in[6]; p.a_w_s = (const float*)d_in[7]; p.a_b_s = (const float*)d_in[8];
  p.b_q_norm_g = (const float*)d_in[9]; p.b_kv_norm_g = (const float*)d_in[10]; p.b_w_uq = (const float*)d_in[11]; p.b_w_ukv = (const float*)d_in[12];
  p.b_qk_g_q = (const float*)d_in[13]; p.b_qk_g_k = (const float*)d_in[14];
  p.c_a_re = (const float*)d_in[15]; p.c_a_im = (const float*)d_in[16]; p.c_log_dt = (const float*)d_in[17];
  p.c_b_re = (const float*)d_in[18]; p.c_b_im = (const float*)d_in[19]; p.c_c_re = (const float*)d_in[20]; p.c_c_im = (const float*)d_in[21];
  p.c_d = (const float*)d_in[22]; p.c_w_glu = (const float*)d_in[23]; p.c_b_glu = (const float*)d_in[24];
  p.m_norm_g = (const float*)d_in[25]; p.m_w_kv = (const float*)d_in[26]; p.m_qk_g_q = (const float*)d_in[27]; p.m_qk_g_k = (const float*)d_in[28];
  p.w_br_a = (const float*)d_in[29]; p.w_br_b = (const float*)d_in[30]; p.w_br_c = (const float*)d_in[31]; p.w_br_m = (const float*)d_in[32];
  p.w_out = (const float*)d_in[33];
  p.out = (float*)d_out;
  char* ws = (char*)d_ws; size_t off = 0;
  auto take = [&](size_t bytes) { char* r = ws + off; off += (bytes + 255) & ~(size_t)255; return r; };
  p.z1 = (bf16_t*)take((size_t)T_ * Z1W * 2);
  p.z2 = (bf16_t*)take((size_t)T_ * Z2W * 2);
  p.xb = (bf16_t*)take((size_t)T_ * 1024 * 2);
  p.qf = (bf16_t*)take((size_t)T_ * 768 * 2);
  p.kf = (bf16_t*)take((size_t)T_ * 768 * 2);
  p.mg = p.qf;
  p.vt = (bf16_t*)take((size_t)8 * 8 * 64 * S_ * 2);
  p.hm = (bf16_t*)take((size_t)2048 * 1024 * 2);
  p.memk = (bf16_t*)take((size_t)2048 * 256 * 2);
  p.memvt = (bf16_t*)take((size_t)2048 * 256 * 2);
  p.WinT = (bf16_t*)take((size_t)NWIN * 1024 * 2);
  p.WuqT = (bf16_t*)take((size_t)1024 * 768 * 2);
  p.WukvT = (bf16_t*)take((size_t)1024 * 256 * 2);
  p.WgluT = (bf16_t*)take((size_t)256 * 256 * 2);
  p.WbrT = (bf16_t*)take((size_t)1024 * 1280 * 2);
  p.WoutT = (bf16_t*)take((size_t)2 * 1024 * 1024 * 2);
  p.WmkvT = (bf16_t*)take((size_t)512 * 1024 * 2);
  p.ssp = (float*)take((size_t)8 * T_ * 4);
  p.ssq = (float*)take((size_t)9 * T_ * 4);
  p.rope = (float*)take((size_t)T_ * 32 * 4);
  p.carry = (float*)take((size_t)8 * 16 * 32 * 64 * 2 * 4);
  p.s5c = (float*)take((size_t)2 * 16 * 64 * 36 * 4);
  p.ctr = (unsigned*)take(256);
  p.bar = (unsigned*)take(16384);
  if (off > ws_size) { fprintf(stderr, "workspace too small: need %zu have %zu\n", off, ws_size); return; }

  static int grid_blocks = 0;
  if (!grid_blocks) {
    int dev = 0, cus = 0, per_cu = 0;
    hipGetDevice(&dev);
    hipDeviceGetAttribute(&cus, hipDeviceAttributeMultiprocessorCount, dev);
#if MK_MULTI
    hipOccupancyMaxActiveBlocksPerMultiprocessor(&per_cu, hyb_phase, 256, 0);
#else
    hipOccupancyMaxActiveBlocksPerMultiprocessor(&per_cu, hyb_mega, 256, 0);
#endif
    if (per_cu > 2) per_cu = 2;
    if (per_cu < 1) per_cu = 1;
    grid_blocks = cus * per_cu;
    grid_blocks &= ~7;
  }
#if MK_MULTI
  for (int ph = 0; ph < 13; ph++) hipLaunchKernelGGL(hyb_phase, dim3(grid_blocks), dim3(256), 0, stream, p, ph);
#else
  hipMemsetAsync(p.ctr, 0, 256 + 16384, stream);
  void* args[] = {&p};
  hipError_t e = hipLaunchCooperativeKernel((void*)hyb_mega, dim3(grid_blocks), dim3(256), args, 0, stream);
  if (e != hipSuccess) fprintf(stderr, "cooperative launch failed: %s (grid %d)\n", hipGetErrorString(e), grid_blocks);
#endif
}
```

```cpp
#include <hip/hip_runtime.h>
#include <hip/hip_cooperative_groups.h>
#include <stdint.h>
#include <stdio.h>
#include <type_traits>
namespace cg = cooperative_groups;

#ifndef MK_MULTI
#define MK_MULTI 0
#endif

typedef unsigned short bf16_t;
typedef short bf16x8 __attribute__((ext_vector_type(8)));
typedef short s16x4 __attribute__((ext_vector_type(4)));
typedef float f32x16 __attribute__((ext_vector_type(16)));
typedef float f32x4 __attribute__((ext_vector_type(4)));
typedef float f32x2 __attribute__((ext_vector_type(2)));
typedef unsigned u32x4 __attribute__((ext_vector_type(4)));
typedef unsigned u32x2 __attribute__((ext_vector_type(2)));
#define DI __device__ __forceinline__
#define MFMA(a, b, c) __builtin_amdgcn_mfma_f32_32x32x16_bf16((a), (b), (c), 0, 0, 0)

constexpr int T_ = 16384, S_ = 2048;
constexpr int INW = 7456;
constexpr int Z1W = 2304, Z2W = 1152;
constexpr int NWIN = 7552;
constexpr float EPS = 1e-6f;
constexpr float LOG2E = 1.4426950408889634f;
constexpr int LDT = 72;
constexpr int EPW = 132;
constexpr int SM_MAIN = 4 * 128 * LDT * 2;
constexpr int SM_RS = SM_MAIN;
constexpr int SM_SS = SM_MAIN + 512;
constexpr int SM_MISC = SM_MAIN + 1024;
constexpr int SM_TOTAL = SM_MAIN + 1024 + 64;

struct P {
  const float* x; const float* mem; const int* pos;
  const float* norm_g; const float* w_in; const float* b_merge; const float* a_norm_g; const float* a_w_s; const float* a_b_s;
  const float* b_q_norm_g; const float* b_kv_norm_g; const float* b_w_uq; const float* b_w_ukv; const float* b_qk_g_q; const float* b_qk_g_k;
  const float* c_a_re; const float* c_a_im; const float* c_log_dt; const float* c_b_re; const float* c_b_im; const float* c_c_re; const float* c_c_im;
  const float* c_d; const float* c_w_glu; const float* c_b_glu;
  const float* m_norm_g; const float* m_w_kv; const float* m_qk_g_q; const float* m_qk_g_k;
  const float* w_br_a; const float* w_br_b; const float* w_br_c; const float* w_br_m; const float* w_out;
  float* out;
  bf16_t* z1; bf16_t* z2; bf16_t* xb; bf16_t* qf; bf16_t* kf; bf16_t* mg; bf16_t* vt; bf16_t* hm; bf16_t* memk; bf16_t* memvt;
  bf16_t* WinT; bf16_t* WuqT; bf16_t* WukvT; bf16_t* WgluT; bf16_t* WbrT; bf16_t* WoutT; bf16_t* WmkvT;
  float* ssp; float* ssq; float* rope; float* carry; float* s5c; unsigned* ctr; unsigned* bar;
  long dry;
};

DI int tid() { int t = threadIdx.x; asm volatile("" : "+v"(t)); return t; }
DI float bf2f(bf16_t b) { return __uint_as_float(((unsigned)b) << 16); }
DI unsigned pk2(float lo, float hi) { unsigned r; asm("v_cvt_pk_bf16_f32 %0, %1, %2" : "=v"(r) : "v"(lo), "v"(hi)); return r; }
DI unsigned pk2n(float lo, float hi) { unsigned r; asm("s_nop 1\n\tv_cvt_pk_bf16_f32 %0, %1, %2" : "=v"(r) : "v"(lo), "v"(hi)); return r; }
DI bf16_t f2bf(float x) { return (bf16_t)(pk2(x, 0.f) & 0xffffu); }
DI void unpack8(u32x4 v, float (&f)[8]) {
  f[0] = __uint_as_float(v.x << 16); f[1] = __uint_as_float(v.x & 0xffff0000u);
  f[2] = __uint_as_float(v.y << 16); f[3] = __uint_as_float(v.y & 0xffff0000u);
  f[4] = __uint_as_float(v.z << 16); f[5] = __uint_as_float(v.z & 0xffff0000u);
  f[6] = __uint_as_float(v.w << 16); f[7] = __uint_as_float(v.w & 0xffff0000u);
}
DI void unpack4(u32x2 v, float (&f)[4]) {
  f[0] = __uint_as_float(v.x << 16); f[1] = __uint_as_float(v.x & 0xffff0000u);
  f[2] = __uint_as_float(v.y << 16); f[3] = __uint_as_float(v.y & 0xffff0000u);
}
DI u32x4 pack8(const float (&f)[8]) { u32x4 r; r.x = pk2(f[0], f[1]); r.y = pk2(f[2], f[3]); r.z = pk2(f[4], f[5]); r.w = pk2(f[6], f[7]); return r; }
DI float sigm(float x) { return __builtin_amdgcn_rcpf(1.f + __expf(-x)); }
DI float silu(float x) { return x * sigm(x); }
DI float gelu_t(float x) { return x * sigm(1.5957691216057308f * (x + 0.044715f * x * x * x)); }
DI float sum16(float v) { v += __shfl_xor(v, 1); v += __shfl_xor(v, 2); v += __shfl_xor(v, 4); v += __shfl_xor(v, 8); return v; }
DI float sum8(float v) { v += __shfl_xor(v, 1); v += __shfl_xor(v, 2); v += __shfl_xor(v, 4); return v; }
DI float sum64(float v) { v = sum16(v); v += __shfl_xor(v, 16); v += __shfl_xor(v, 32); return v; }
DI int crow(int i, int h) { return (i & 3) + 8 * (i >> 2) + 4 * h; }
#define MFMA16(a, b, c) __builtin_amdgcn_mfma_f32_16x16x32_bf16((a), (b), (c), 0, 0, 0)
template <int NB>
DI void zero_acc4(f32x4 (&acc)[4][NB]) {
#pragma unroll
  for (int a = 0; a < 4; a++)
#pragma unroll
    for (int b = 0; b < NB; b++) { acc[a][b].x = 0.f; acc[a][b].y = 0.f; acc[a][b].z = 0.f; acc[a][b].w = 0.f; }
}
DI void zero_acc(f32x16 (&acc)[2][2]) {
#pragma unroll
  for (int a = 0; a < 2; a++)
#pragma unroll
    for (int b = 0; b < 2; b++)
#pragma unroll
      for (int i = 0; i < 16; i++) acc[a][b][i] = 0.f;
}

template <bool SS>
DI void gemm_loop(const bf16_t* __restrict__ A, long lda, const bf16_t* __restrict__ B, long ldb, int K,
                  f32x16 (&acc)[2][2], bf16_t* sm, float* ssS) {
  const int t = tid(), lane = t & 63, w = t >> 6, wm = w >> 1, wn = w & 1, l31 = lane & 31, h = lane >> 5;
  const int lr = t >> 3, lc = (t & 7) * 8;
  const bf16_t* ap = A + (long)lr * lda + lc;
  const bf16_t* bp = B + (long)lr * ldb + lc;
  bf16_t* wp = sm + lr * LDT + lc;
  const bf16_t* rA = sm + (wm * 64 + l31) * LDT + h * 8;
  const bf16_t* rB = sm + 2 * 128 * LDT + (wn * 64 + l31) * LDT + h * 8;
  u32x4 ra[4], rb[4];
  float ss[4] = {0.f, 0.f, 0.f, 0.f};
  const int nk = K >> 6;
  auto gl = [&](int ko) {
#pragma unroll
    for (int i = 0; i < 4; i++) { ra[i] = *(const u32x4*)(ap + (long)(32 * i) * lda + ko); rb[i] = *(const u32x4*)(bp + (long)(32 * i) * ldb + ko); }
  };
  auto st = [&](auto BUF) {
    constexpr int buf = decltype(BUF)::value;
#pragma unroll
    for (int i = 0; i < 4; i++) {
      *(u32x4*)(wp + buf * 128 * LDT + 32 * i * LDT) = ra[i];
      *(u32x4*)(wp + 2 * 128 * LDT + buf * 128 * LDT + 32 * i * LDT) = rb[i];
      if (SS) { float f[8]; unpack8(ra[i], f);
#pragma unroll
        for (int j = 0; j < 8; j++) ss[i] += f[j] * f[j]; }
    }
  };
  auto comp = [&](auto BUF) {
    constexpr int buf = decltype(BUF)::value;
#pragma unroll
    for (int kk = 0; kk < 4; kk++) {
      bf16x8 af[2], bfr[2];
#pragma unroll
      for (int mb = 0; mb < 2; mb++) af[mb] = *(const bf16x8*)(rA + buf * 128 * LDT + mb * 32 * LDT + kk * 16);
#pragma unroll
      for (int nb = 0; nb < 2; nb++) bfr[nb] = *(const bf16x8*)(rB + buf * 128 * LDT + nb * 32 * LDT + kk * 16);
#pragma unroll
      for (int mb = 0; mb < 2; mb++)
#pragma unroll
        for (int nb = 0; nb < 2; nb++) acc[mb][nb] = MFMA(af[mb], bfr[nb], acc[mb][nb]);
    }
  };
  using B0 = std::integral_constant<int, 0>; using B1 = std::integral_constant<int, 1>;
  gl(0);
  st(B0{});
  gl(64);
  __syncthreads();
  for (int ks = 0; ks < nk; ks += 2) {
    st(B1{});
    __builtin_amdgcn_sched_barrier(0);
    if (ks + 2 < nk) gl((ks + 2) * 64);
    __builtin_amdgcn_sched_barrier(0);
    comp(B0{});
    __syncthreads();
    if (ks + 2 < nk) st(B0{});
    __builtin_amdgcn_sched_barrier(0);
    if (ks + 3 < nk) gl((ks + 3) * 64);
    __builtin_amdgcn_sched_barrier(0);
    comp(B1{});
    __syncthreads();
  }
  if (SS) {
    const float inv = 1.0f / (float)K;
#pragma unroll
    for (int i = 0; i < 4; i++) { float s = sum8(ss[i]); if ((t & 7) == 0) ssS[lr + 32 * i] = rsqrtf(s * inv + EPS); }
  }
}

#define LAS3 __attribute__((address_space(3)))
struct GDesc { const bf16_t* A; long lda; const bf16_t* B; long ldb; };
DI void gemm_dma_stage0(const GDesc& d, char* smc) {
  const int t = tid(), lane = t & 63, w = t >> 6;
  const unsigned wdst = (unsigned)(uintptr_t)smc + (unsigned)w * 4096u;
#pragma unroll
  for (int i = 0; i < 4; i++) {
    const int row = 32 * w + 8 * i + (lane >> 3), c = (lane & 7) ^ ((row >> 1) & 7);
    __builtin_amdgcn_global_load_lds((const unsigned*)(d.A + row * d.lda + c * 8), (LAS3 unsigned*)(uintptr_t)(wdst + i * 1024), 16, 0, 0);
    __builtin_amdgcn_global_load_lds((const unsigned*)(d.B + row * d.ldb + c * 8), (LAS3 unsigned*)(uintptr_t)(wdst + 16384 + i * 1024), 16, 0, 0);
  }
}
DI void gemm_loop_dma(const bf16_t* __restrict__ A, long lda, const bf16_t* __restrict__ B, long ldb, int K, f32x16 (&acc)[2][2], char* smc,
                      bool started = false, bool has_next = false, GDesc next = GDesc{nullptr, 0, nullptr, 0}) {
  const int t = tid(), lane = t & 63, w = t >> 6, wm = w >> 1, wn = w & 1, l31 = lane & 31, h = lane >> 5;
  unsigned aoff[4], boff[4];
#pragma unroll
  for (int i = 0; i < 4; i++) {
    const int row = 32 * w + 8 * i + (lane >> 3), c = (lane & 7) ^ ((row >> 1) & 7);
    aoff[i] = (unsigned)((row * lda + c * 8) * 2); boff[i] = (unsigned)((row * ldb + c * 8) * 2);
  }
  const char* Ab = (const char*)A; const char* Bb = (const char*)B;
  const unsigned lbase = (unsigned)(uintptr_t)smc;
  const unsigned wdst = lbase + (unsigned)w * 4096u;
  const int swz = (l31 >> 1) & 7;
  unsigned fo[4];
#pragma unroll
  for (int kk = 0; kk < 4; kk++) fo[kk] = (unsigned)(((2 * kk + h) ^ swz) * 16);
  const char* rA = smc + (wm * 64 + l31) * 128;
  const char* rB = smc + 16384 + (wn * 64 + l31) * 128;
  const int nk = K >> 6;
  auto issue = [&](auto BUF, int ko) {
    constexpr int buf = decltype(BUF)::value;
#pragma unroll
    for (int i = 0; i < 4; i++) {
      __builtin_amdgcn_global_load_lds((const unsigned*)(Ab + (size_t)ko * 2 + aoff[i]), (LAS3 unsigned*)(uintptr_t)(wdst + buf * 32768 + i * 1024), 16, 0, 0);
      __builtin_amdgcn_global_load_lds((const unsigned*)(Bb + (size_t)ko * 2 + boff[i]), (LAS3 unsigned*)(uintptr_t)(wdst + buf * 32768 + 16384 + i * 1024), 16, 0, 0);
    }
  };
  auto comp = [&](auto BUF) {
    constexpr int buf = decltype(BUF)::value;
#pragma unroll
    for (int kk = 0; kk < 4; kk++) {
      bf16x8 af[2], bfr[2];
#pragma unroll
      for (int mb = 0; mb < 2; mb++) af[mb] = *(const bf16x8*)(rA + buf * 32768 + mb * 32 * 128 + fo[kk]);
#pragma unroll
      for (int nb = 0; nb < 2; nb++) bfr[nb] = *(const bf16x8*)(rB + buf * 32768 + nb * 32 * 128 + fo[kk]);
#pragma unroll
      for (int mb = 0; mb < 2; mb++)
#pragma unroll
        for (int nb = 0; nb < 2; nb++) acc[mb][nb] = MFMA(af[mb], bfr[nb], acc[mb][nb]);
    }
  };
  using B0 = std::integral_constant<int, 0>; using B1 = std::integral_constant<int, 1>;
  if (!started) issue(B0{}, 0);
  __syncthreads();
  for (int ks = 0; ks < nk; ks += 2) {
    issue(B1{}, (ks + 1) * 64);
    __builtin_amdgcn_sched_barrier(0);
    comp(B0{});
    __syncthreads();
    if (ks + 2 < nk) issue(B0{}, (ks + 2) * 64);
    else if (has_next) gemm_dma_stage0(next, smc);
    __builtin_amdgcn_sched_barrier(0);
    comp(B1{});
    __syncthreads();
  }
}

template <int NB>
DI void gemm_loop_dma16(const bf16_t* __restrict__ A, long lda, const bf16_t* __restrict__ B, long ldb, int K, f32x4 (&acc)[4][NB], char* smc,
                      bool started = false, bool has_next = false, GDesc next = GDesc{nullptr, 0, nullptr, 0}) {
  const int t = tid(), lane = t & 63, w = t >> 6, wm = w >> 1, wn = w & 1, r16 = lane & 15, q = lane >> 4;
  unsigned aoff[4], boff[NB];
#pragma unroll
  for (int i = 0; i < 4; i++) {
    const int row = 32 * w + 8 * i + (lane >> 3), c = (lane & 7) ^ ((row >> 1) & 7);
    aoff[i] = (unsigned)((row * lda + c * 8) * 2);
  }
#pragma unroll
  for (int i = 0; i < NB; i++) {
    const int row = 8 * (NB * w + i) + (lane >> 3), c = (lane & 7) ^ ((row >> 1) & 7);
    boff[i] = (unsigned)((row * ldb + c * 8) * 2);
  }
  const char* Ab = (const char*)A; const char* Bb = (const char*)B;
  const unsigned lbase = (unsigned)(uintptr_t)smc;
  const unsigned wdst = lbase + (unsigned)w * 4096u;
  const int swz = (r16 >> 1) & 7;
  unsigned fo[2];
#pragma unroll
  for (int k32 = 0; k32 < 2; k32++) fo[k32] = (unsigned)(((4 * k32 + q) ^ swz) * 16);
  const char* rA = smc + (wm * 64 + r16) * 128;
  const char* rB = smc + 16384 + (wn * 16 * NB + r16) * 128;
  const int nk = K >> 6;
  auto issue = [&](auto BUF, int ko) {
    constexpr int buf = decltype(BUF)::value;
#pragma unroll
    for (int i = 0; i < 4; i++)
      __builtin_amdgcn_global_load_lds((const unsigned*)(Ab + (size_t)ko * 2 + aoff[i]), (LAS3 unsigned*)(uintptr_t)(wdst + buf * 32768 + i * 1024), 16, 0, 0);
#pragma unroll
    for (int i = 0; i < NB; i++)
      __builtin_amdgcn_global_load_lds((const unsigned*)(Bb + (size_t)ko * 2 + boff[i]), (LAS3 unsigned*)(uintptr_t)(lbase + buf * 32768 + 16384 + (NB * w + i) * 1024), 16, 0, 0);
  };
  auto comp = [&](auto BUF) {
    constexpr int buf = decltype(BUF)::value;
#pragma unroll
    for (int k32 = 0; k32 < 2; k32++) {
      bf16x8 af[4], bq[NB];
#pragma unroll
      for (int mb = 0; mb < 4; mb++) af[mb] = *(const bf16x8*)(rA + buf * 32768 + mb * 16 * 128 + fo[k32]);
#pragma unroll
      for (int nb = 0; nb < NB; nb++) bq[nb] = *(const bf16x8*)(rB + buf * 32768 + nb * 16 * 128 + fo[k32]);
#pragma unroll
      for (int mb = 0; mb < 4; mb++)
#pragma unroll
        for (int nb = 0; nb < NB; nb++) acc[mb][nb] = MFMA16(af[mb], bq[nb], acc[mb][nb]);
    }
  };
  using B0 = std::integral_constant<int, 0>; using B1 = std::integral_constant<int, 1>;
  if (!started) issue(B0{}, 0);
  __syncthreads();
  for (int ks = 0; ks < nk; ks += 2) {
    issue(B1{}, (ks + 1) * 64); __builtin_amdgcn_sched_barrier(0);
    comp(B0{});
    __syncthreads();
    if (ks + 2 < nk) issue(B0{}, (ks + 2) * 64);
    else if (has_next) gemm_dma_stage0(next, smc);
    __builtin_amdgcn_sched_barrier(0);
    comp(B1{});
    __syncthreads();
  }
}

DI void gemm_loop_dma2(const bf16_t* __restrict__ A, long lda, const bf16_t* __restrict__ B0, const bf16_t* __restrict__ B1, long ldb, int K,
                       f32x16 (&accP)[2][2], f32x16 (&accQ)[2][2], char* smc) {
  const int t = tid(), lane = t & 63, w = t >> 6, wm = w >> 1, wn = w & 1, l31 = lane & 31, h = lane >> 5;
  unsigned aoff[2], boff[2];
#pragma unroll
  for (int i = 0; i < 2; i++) {
    const int row = 16 * (2 * w + i) + (lane >> 2), c = (lane & 3) ^ ((row >> 2) & 3);
    aoff[i] = (unsigned)((row * lda + c * 8) * 2); boff[i] = (unsigned)((row * ldb + c * 8) * 2);
  }
  const char* Ab = (const char*)A; const char* B0b = (const char*)B0; const char* B1b = (const char*)B1;
  const unsigned wdst = (unsigned)(uintptr_t)smc + (unsigned)w * 2048u;
  const int swz = (l31 >> 2) & 3;
  unsigned fo[2];
#pragma unroll
  for (int kk = 0; kk < 2; kk++) fo[kk] = (unsigned)(((2 * kk + h) ^ swz) * 16);
  const char* rA = smc + (wm * 64 + l31) * 64;
  const char* rB0 = smc + 8192 + (wn * 64 + l31) * 64;
  const char* rB1 = smc + 16384 + (wn * 64 + l31) * 64;
  const int nk = K >> 5;
  auto issue = [&](auto BUF, int ko) {
    constexpr int buf = decltype(BUF)::value;
#pragma unroll
    for (int i = 0; i < 2; i++) {
      __builtin_amdgcn_global_load_lds((const unsigned*)(Ab + (size_t)ko * 2 + aoff[i]), (LAS3 unsigned*)(uintptr_t)(wdst + buf * 24576 + i * 1024), 16, 0, 0);
      __builtin_amdgcn_global_load_lds((const unsigned*)(B0b + (size_t)ko * 2 + boff[i]), (LAS3 unsigned*)(uintptr_t)(wdst + buf * 24576 + 8192 + i * 1024), 16, 0, 0);
      __builtin_amdgcn_global_load_lds((const unsigned*)(B1b + (size_t)ko * 2 + boff[i]), (LAS3 unsigned*)(uintptr_t)(wdst + buf * 24576 + 16384 + i * 1024), 16, 0, 0);
    }
  };
  auto comp = [&](auto BUF) {
    constexpr int buf = decltype(BUF)::value;
#pragma unroll
    for (int kk = 0; kk < 2; kk++) {
      bf16x8 af[2], b0[2], b1[2];
#pragma unroll
      for (int mb = 0; mb < 2; mb++) af[mb] = *(const bf16x8*)(rA + buf * 24576 + mb * 32 * 64 + fo[kk]);
#pragma unroll
      for (int nb = 0; nb < 2; nb++) { b0[nb] = *(const bf16x8*)(rB0 + buf * 24576 + nb * 32 * 64 + fo[kk]); b1[nb] = *(const bf16x8*)(rB1 + buf * 24576 + nb * 32 * 64 + fo[kk]); }
#pragma unroll
      for (int mb = 0; mb < 2; mb++)
#pragma unroll
        for (int nb = 0; nb < 2; nb++) { accP[mb][nb] = MFMA(af[mb], b0[nb], accP[mb][nb]); accQ[mb][nb] = MFMA(af[mb], b1[nb], accQ[mb][nb]); }
    }
  };
  using S0 = std::integral_constant<int, 0>; using S1 = std::integral_constant<int, 1>;
  issue(S0{}, 0);
  __syncthreads();
  for (int ks = 0; ks < nk; ks += 2) {
    issue(S1{}, (ks + 1) * 32);
    __builtin_amdgcn_sched_barrier(0);
    comp(S0{});
    __syncthreads();
    if (ks + 2 < nk) issue(S0{}, (ks + 2) * 32);
    __builtin_amdgcn_sched_barrier(0);
    comp(S1{});
    __syncthreads();
  }
}

DI void acc_to_lds(const f32x16 (&acc)[2][2], float* ep) {
  const int t = tid(), lane = t & 63, w = t >> 6, wm = w >> 1, wn = w & 1, l31 = lane & 31, h = lane >> 5;
#pragma unroll
  for (int mb = 0; mb < 2; mb++)
#pragma unroll
    for (int nb = 0; nb < 2; nb++)
#pragma unroll
      for (int i = 0; i < 16; i++) ep[(wm * 64 + mb * 32 + crow(i, h)) * EPW + wn * 64 + nb * 32 + l31] = acc[mb][nb][i];
}
template <int NB>
DI void acc_to_lds4(const f32x4 (&acc)[4][NB], float* ep) {
  const int t = tid(), lane = t & 63, w = t >> 6, wm = w >> 1, wn = w & 1, r16 = lane & 15, q = lane >> 4;
#pragma unroll
  for (int mb = 0; mb < 4; mb++)
#pragma unroll
    for (int nb = 0; nb < NB; nb++) {
      float* d = ep + (wm * 64 + mb * 16 + q * 4) * EPW + wn * 16 * NB + nb * 16 + r16;
      d[0] = acc[mb][nb].x; d[EPW] = acc[mb][nb].y; d[2 * EPW] = acc[mb][nb].z; d[3 * EPW] = acc[mb][nb].w;
    }
}
template <class F>
DI void rowwise(const float* ep, F f) {
  const int t = tid();
#pragma unroll 1
  for (int ps = 0; ps < 8; ps++) {
    const int row = ps * 16 + (t >> 4), c8 = (t & 15) * 8;
    float v[8];
    const f32x4 a = *(const f32x4*)(ep + row * EPW + c8), b = *(const f32x4*)(ep + row * EPW + c8 + 4);
    v[0] = a.x; v[1] = a.y; v[2] = a.z; v[3] = a.w; v[4] = b.x; v[5] = b.y; v[6] = b.z; v[7] = b.w;
    f(row, c8, v);
  }
}
template <class L, class F>
DI void rowwise2(const float* ep, L pre, F f) {
  const int t = tid();
  const int c8 = (t & 15) * 8;
#pragma unroll 1
  for (int g = 0; g < 2; g++) {
    decltype(pre(0, 0)) ld[4];
#pragma unroll
    for (int q = 0; q < 4; q++) ld[q] = pre((g * 4 + q) * 16 + (t >> 4), c8);
#pragma unroll
    for (int q = 0; q < 4; q++) {
      const int row = (g * 4 + q) * 16 + (t >> 4);
      float v[8];
      const f32x4 a = *(const f32x4*)(ep + row * EPW + c8), b = *(const f32x4*)(ep + row * EPW + c8 + 4);
      v[0] = a.x; v[1] = a.y; v[2] = a.z; v[3] = a.w; v[4] = b.x; v[5] = b.y; v[6] = b.z; v[7] = b.w;
      f(row, c8, v, ld[q]);
    }
  }
}
struct LdRope { f32x4 r[4]; };
struct LdKv { unsigned k2; u32x4 x1, x2; f32x4 r[4]; };
struct LdX { f32x4 a, b; };
struct LdGlu { u32x4 yg, gt; };
template <class F>
DI void tstore(const float* ep, int cb, int nc, const float* rowscale, F dst) {
  const int t = tid();
  const int ntask = nc * 16;
  for (int e = t; e < ntask; e += 256) {
    const int col = e % nc, rg = e / nc;
    float v[8];
#pragma unroll
    for (int j = 0; j < 8; j++) { float x = ep[(rg * 8 + j) * EPW + cb + col]; if (rowscale) x *= rowscale[rg * 8 + j]; v[j] = x; }
    *(u32x4*)(dst(col) + rg * 8) = pack8(v);
  }
}

DI void tile_from_linear(int L, int nN, int& tm, int& tn) { const int band = L / (8 * nN), rr = L % (8 * nN); tn = rr >> 3; tm = band * 8 + (rr & 7); }
DI int static_L(int round, int vb) { const int Gx = gridDim.x >> 3; return (round * 8 + (vb & 7)) * Gx + (vb >> 3); }
DI int next_item(unsigned* ctr, int* slot) {
  __syncthreads();
  if (threadIdx.x == 0) *slot = (int)atomicAdd(ctr, 1u);
  __syncthreads();
  return *slot;
}

DI int colmap(int mode, int n) {
  if (mode == 0) return n;
  if (mode == 1) { if (n < 768) return n; if (n < 2304) return n + 1056; if (n < 3360) return n - 1536; if (n < 3456) return -1; return n - 96; }
  { const int hh = n >> 7, j = n & 127; return j < 96 ? hh * 96 + j : -1; }
}
struct CDesc { const float* src; const float* g; bf16_t* dst; int ld, K, mode, it; };
DI void conv_load(const CDesc& d, f32x4 (&v)[8]) {
  const int t = tid();
  const int nkt = d.K >> 6, kt = d.it % nkt, nt = d.it / nkt, k0 = kt * 64, n0 = nt * 128;
  const int n4 = (t & 31) * 4, c = colmap(d.mode, n0 + n4);
#pragma unroll
  for (int i = 0; i < 8; i++) {
    const int kk = (t >> 5) + 8 * i;
    if (c >= 0) v[i] = __builtin_nontemporal_load((const f32x4*)(d.src + (long)(k0 + kk) * d.ld + c)); else { v[i].x = 0.f; v[i].y = 0.f; v[i].z = 0.f; v[i].w = 0.f; }
  }
}
DI void conv_finish(const CDesc& d, f32x4 (&v)[8], float* sm) {
  const int t = tid();
  const int nkt = d.K >> 6, kt = d.it % nkt, nt = d.it / nkt, k0 = kt * 64, n0 = nt * 128;
  const int n4 = (t & 31) * 4;
#pragma unroll
  for (int i = 0; i < 8; i++) {
    const int kk = (t >> 5) + 8 * i;
    if (d.g) { const float gg = d.g[k0 + kk]; v[i].x *= gg; v[i].y *= gg; v[i].z *= gg; v[i].w *= gg; }
    *(f32x4*)(sm + kk * 132 + n4) = v[i];
  }
  __syncthreads();
#pragma unroll
  for (int i = 0; i < 2; i++) {
    const int nn = (t >> 2) + 64 * i, ks = (t & 3) * 16;
    float f[16];
#pragma unroll
    for (int j = 0; j < 16; j++) f[j] = sm[(ks + j) * 132 + nn];
    u32x4 o0, o1;
    o0.x = pk2(f[0], f[1]); o0.y = pk2(f[2], f[3]); o0.z = pk2(f[4], f[5]); o0.w = pk2(f[6], f[7]);
    o1.x = pk2(f[8], f[9]); o1.y = pk2(f[10], f[11]); o1.z = pk2(f[12], f[13]); o1.w = pk2(f[14], f[15]);
    bf16_t* dd = d.dst + (long)(n0 + nn) * d.K + k0 + ks;
    *(u32x4*)dd = o0; *(u32x4*)(dd + 8) = o1;
  }
  __syncthreads();
}
constexpr int NCONV = 944 + 72 + 32 + 8 + 32 + 64 + 32 + 32 + 128 + 64;
constexpr int NAUX = NCONV + 512;
DI CDesc conv_desc(const P& p, int l, int it) {
  CDesc d; d.g = nullptr; d.mode = 0;
  if (it < 944) { d.src = p.w_in + (long)l * 1024 * INW; d.ld = INW; d.K = 1024; d.mode = 1; d.g = p.norm_g + l * 1024; d.dst = p.WinT; d.it = it; return d; }
  it -= 944;
  if (it < 72) { d.src = p.b_w_uq + (long)l * 768 * 768; d.ld = 768; d.K = 768; d.g = p.b_q_norm_g + l * 768; d.dst = p.WuqT; d.it = it; return d; }
  it -= 72;
  if (it < 32) { d.src = p.b_w_ukv + (long)l * 256 * 1024; d.ld = 1024; d.K = 256; d.g = p.b_kv_norm_g + l * 256; d.dst = p.WukvT; d.it = it; return d; }
  it -= 32;
  if (it < 8) { d.src = p.c_w_glu + (long)l * 256 * 256; d.ld = 256; d.K = 256; d.dst = p.WgluT; d.it = it; return d; }
  it -= 8;
  if (it < 32) { d.src = p.w_br_a + (long)l * 256 * 1024; d.ld = 1024; d.K = 256; d.dst = p.WbrT; d.it = it; return d; }
  it -= 32;
  if (it < 64) { d.src = p.w_br_b + (long)l * 512 * 1024; d.ld = 1024; d.K = 512; d.dst = p.WbrT + 1024 * 256; d.it = it; return d; }
  it -= 64;
  if (it < 32) { d.src = p.w_br_c + (long)l * 256 * 1024; d.ld = 1024; d.K = 256; d.dst = p.WbrT + 1024 * 768; d.it = it; return d; }
  it -= 32;
  if (it < 32) { d.src = p.w_br_m + (long)l * 256 * 1024; d.ld = 1024; d.K = 256; d.dst = p.WbrT + 1024 * 1024; d.it = it; return d; }
  it -= 32;
  if (it < 128) { d.src = p.w_out + (long)l * 1024 * 1024; d.ld = 1024; d.K = 1024; d.dst = p.WoutT + (long)l * 1024 * 1024; d.it = it; return d; }
  it -= 128;
  d.src = p.m_w_kv + (long)l * 1024 * 512; d.ld = 512; d.K = 1024; d.dst = p.WmkvT; d.it = it; return d;
}
DI void conv_all(const P& p, int l, char* smem) {
  const int G = gridDim.x, bid = blockIdx.x;
  float* sm = (float*)smem;
  if (bid >= NCONV) return;
  f32x4 va[8], vb[8];
  CDesc da = conv_desc(p, l, bid), db = da;
  conv_load(da, va);
#pragma unroll 1
  for (int it = bid; it < NCONV; it += 2 * G) {
    const bool h1 = it + G < NCONV;
    if (h1) { db = conv_desc(p, l, it + G); conv_load(db, vb); }
    conv_finish(da, va, sm);
    const bool h2 = it + 2 * G < NCONV;
    if (h2) { da = conv_desc(p, l, it + 2 * G); conv_load(da, va); }
    if (h1) conv_finish(db, vb, sm);
  }
}
DI void aux_item(const P& p, int l, int it, char* smem) {
  it -= NCONV;
  {
    const int t = tid(), lane = t & 63, row = it * 4 + (t >> 6);
    const float* src = p.mem + (long)row * 1024; const float* g = p.m_norm_g + l * 1024;
    f32x4 v[4]; float ss = 0.f;
#pragma unroll
    for (int i = 0; i < 4; i++) { v[i] = *(const f32x4*)(src + (lane + 64 * i) * 4); ss += v[i].x * v[i].x + v[i].y * v[i].y + v[i].z * v[i].z + v[i].w * v[i].w; }
    ss = sum64(ss);
    const float r = rsqrtf(ss * (1.f / 1024.f) + EPS);
#pragma unroll
    for (int i = 0; i < 4; i++) {
      const f32x4 gg = *(const f32x4*)(g + (lane + 64 * i) * 4);
      u32x2 o; o.x = pk2(v[i].x * r * gg.x, v[i].y * r * gg.y); o.y = pk2(v[i].z * r * gg.z, v[i].w * r * gg.w);
      *(u32x2*)(p.hm + (long)row * 1024 + (lane + 64 * i) * 4) = o;
    }
  }
}

DI void p0_xrow_item(const P& p, int it) {
  const int t = tid(), lane = t & 63;
  f32x4 v[2][4];
#pragma unroll
  for (int r = 0; r < 2; r++) {
    const float* src = p.x + (long)(it * 8 + (t >> 6) * 2 + r) * 1024;
#pragma unroll
    for (int i = 0; i < 4; i++) v[r][i] = __builtin_nontemporal_load((const f32x4*)(src + (lane + 64 * i) * 4));
  }
#pragma unroll
  for (int r = 0; r < 2; r++) {
    const int row = it * 8 + (t >> 6) * 2 + r;
    float ss = 0.f;
#pragma unroll
    for (int i = 0; i < 4; i++) ss += v[r][i].x * v[r][i].x + v[r][i].y * v[r][i].y + v[r][i].z * v[r][i].z + v[r][i].w * v[r][i].w;
    ss = sum64(ss);
#pragma unroll
    for (int i = 0; i < 4; i++) { u32x2 o; o.x = pk2(v[r][i].x, v[r][i].y); o.y = pk2(v[r][i].z, v[r][i].w); *(u32x2*)(p.xb + (long)row * 1024 + (lane + 64 * i) * 4) = o; }
    if (lane < 8) p.ssp[(long)lane * T_ + row] = (lane == 0) ? ss : 0.f;
  }
}
DI void p0_rope_item(const P& p, int it) {
  const int e = it * 256 + threadIdx.x, tok = e >> 4, i = e & 15;
  const float inv_freq = exp2f(-(float)i * (13.287712379549449f / 16.f));
  const float ang = (float)p.pos[tok] * inv_freq;
  const double rev = (double)ang * 0.15915494309189535;
  const float fr = (float)(rev - rint(rev));
  p.rope[(long)e * 2] = __builtin_amdgcn_cosf(fr);
  p.rope[(long)e * 2 + 1] = __builtin_amdgcn_sinf(fr);
}

DI void load_rs(const P& p, int r0, float* rsS) {
  const int t = tid();
  if (t < 128) { float s = 0.f;
#pragma unroll
    for (int j = 0; j < 8; j++) s += p.ssp[(long)j * T_ + r0 + t];
    rsS[t] = rsqrtf(s * (1.f / 1024.f) + EPS); }
}
DI void g1_tile(const P& p, int l, int tm, int tn, char* smem) {
  bf16_t* sm = (bf16_t*)smem; float* ep = (float*)smem; float* rsS = (float*)(smem + SM_RS);
  const int r0 = tm * 128, c0 = tn * 128;
  load_rs(p, r0, rsS);
  f32x16 acc[2][2]; zero_acc(acc);
  gemm_loop_dma(p.xb + (long)r0 * 1024, 1024, p.WinT + (long)c0 * 1024, 1024, 1024, acc, smem);
  acc_to_lds(acc, ep);
  __syncthreads();
  int type; bf16_t* dst; int ld;
  if (c0 < 2304) { dst = p.z1 + c0; ld = Z1W;
    if (c0 < 512) type = 1; else if (c0 < 1280) type = 2; else if (c0 < 1536) type = 0; else if (c0 < 1792) type = 2; else if (c0 < 2048) type = 3; else type = 2;
  } else { dst = p.z2 + (c0 - 2304); ld = Z2W; type = 0; }
  const float* gq = p.m_qk_g_q + l * 64;
  rowwise(ep, [&](int row, int c8, float (&v)[8]) {
    const float r = rsS[row];
#pragma unroll
    for (int j = 0; j < 8; j++) v[j] *= r;
    if (type == 1) {
#pragma unroll
      for (int j = 0; j < 8; j++) v[j] = gelu_t(v[j]);
    } else if (type == 2) {
#pragma unroll
      for (int j = 0; j < 8; j++) v[j] = silu(v[j]);
    } else if (type == 3) {
      float ss = 0.f;
#pragma unroll
      for (int j = 0; j < 8; j++) ss += v[j] * v[j];
      ss = sum8(ss);
      const float rq = rsqrtf(ss * (1.f / 64.f) + EPS) * (0.125f * LOG2E);
#pragma unroll
      for (int j = 0; j < 8; j++) v[j] *= rq * gq[(c8 & 63) + j];
    }
    *(u32x4*)(dst + (long)(r0 + row) * ld + c8) = pack8(v);
    if (c0 >= 2304) {
      float ss = 0.f;
#pragma unroll
      for (int j = 0; j < 8; j++) ss += v[j] * v[j];
      ss = sum16(ss);
      if ((c8 >> 3) == 0) p.ssq[(long)((c0 - 2304) >> 7) * T_ + r0 + row] = ss;
    }
  });
  __syncthreads();
}
DI void g1_tile2(const P& p, int l, int tm, int tn, char* smem) {
  float* ep = (float*)smem; float* rsS = (float*)(smem + SM_RS);
  const int r0 = tm * 128;
  load_rs(p, r0, rsS);
  f32x16 accP[2][2], accQ[2][2]; zero_acc(accP); zero_acc(accQ);
  const bf16_t* w0 = p.WinT + (long)(tn * 128) * 1024;
  gemm_loop_dma2(p.xb + (long)r0 * 1024, 1024, w0, w0 + (long)128 * 1024, 1024, 1024, accP, accQ, smem);
  auto epi = [&](const f32x16 (&acc)[2][2], int tnn) {
    const int c0 = tnn * 128;
    acc_to_lds(acc, ep);
    __syncthreads();
    int type; bf16_t* dst; int ld;
    if (c0 < 2304) { dst = p.z1 + c0; ld = Z1W;
      if (c0 < 512) type = 1; else if (c0 < 1280) type = 2; else if (c0 < 1536) type = 0; else if (c0 < 1792) type = 2; else if (c0 < 2048) type = 3; else type = 2;
    } else { dst = p.z2 + (c0 - 2304); ld = Z2W; type = 0; }
    const float* gq = p.m_qk_g_q + l * 64;
    rowwise(ep, [&](int row, int c8, float (&v)[8]) {
      const float r = rsS[row];
#pragma unroll
      for (int j = 0; j < 8; j++) v[j] *= r;
      if (type == 1) {
#pragma unroll
        for (int j = 0; j < 8; j++) v[j] = gelu_t(v[j]);
      } else if (type == 2) {
#pragma unroll
        for (int j = 0; j < 8; j++) v[j] = silu(v[j]);
      } else if (type == 3) {
        float ss = 0.f;
#pragma unroll
        for (int j = 0; j < 8; j++) ss += v[j] * v[j];
        ss = sum8(ss);
        const float rq = rsqrtf(ss * (1.f / 64.f) + EPS) * (0.125f * LOG2E);
#pragma unroll
        for (int j = 0; j < 8; j++) v[j] *= rq * gq[(c8 & 63) + j];
      }
      *(u32x4*)(dst + (long)(r0 + row) * ld + c8) = pack8(v);
      if (c0 >= 2304) {
        float ss = 0.f;
#pragma unroll
        for (int j = 0; j < 8; j++) ss += v[j] * v[j];
        ss = sum16(ss);
        if ((c8 >> 3) == 0) p.ssq[(long)((c0 - 2304) >> 7) * T_ + r0 + row] = ss;
      }
    });
    __syncthreads();
  };
  epi(accP, tn);
  epi(accQ, tn + 1);
}
DI void g1m_tile(const P& p, int l, int tm, int tn, char* smem) {
  bf16_t* sm = (bf16_t*)smem; float* ep = (float*)smem;
  const int r0 = tm * 128, c0 = tn * 128;
  f32x16 acc[2][2]; zero_acc(acc);
  gemm_loop_dma(p.hm + (long)r0 * 1024, 1024, p.WmkvT + (long)c0 * 1024, 1024, 1024, acc, smem);
  acc_to_lds(acc, ep);
  __syncthreads();
  if (tn < 2) {
    const float* gk = p.m_qk_g_k + l * 64;
    rowwise(ep, [&](int row, int c8, float (&v)[8]) {
      float ss = 0.f;
#pragma unroll
      for (int j = 0; j < 8; j++) ss += v[j] * v[j];
      ss = sum8(ss);
      const float rq = rsqrtf(ss * (1.f / 64.f) + EPS);
#pragma unroll
      for (int j = 0; j < 8; j++) v[j] *= rq * gk[(c8 & 63) + j];
      *(u32x4*)(p.memk + (long)(r0 + row) * 256 + c0 + c8) = pack8(v);
    });
  } else {
    const int b = r0 >> 8, m0 = r0 & 255, cv0 = c0 - 256;
    tstore(ep, 0, 128, nullptr, [&](int col) { const int cv = cv0 + col; return p.memvt + ((long)((b * 4 + (cv >> 6)) * 64 + (cv & 63))) * 256 + m0; });
  }
  __syncthreads();
}

DI void g2q_tile(const P& p, int l, int tm, int hh, char* smem) {
  bf16_t* sm = (bf16_t*)smem; float* ep = (float*)smem; float* ssS = (float*)(smem + SM_SS);
  const int r0 = tm * 128;
  f32x4 acc[4][3]; zero_acc4<3>(acc);
  { const int t = tid(); if (t < 128) { float q = 0.f;
#pragma unroll
      for (int j = 0; j < 6; j++) q += p.ssq[(long)j * T_ + r0 + t];
      ssS[t] = rsqrtf(q * (1.f / 768.f) + EPS); } }
  gemm_loop_dma16<3>(p.z2 + (long)r0 * Z2W, Z2W, p.WuqT + (long)hh * 96 * 768, 768, 768, acc, smem);
  acc_to_lds4<3>(acc, ep);
  __syncthreads();
  const float* gq = p.b_qk_g_q + l * 96;
  const float QSC = 0.10206207261596575f * LOG2E;
  rowwise2(ep, [&](int row, int c8) {
    LdRope L;
    const int tc = c8 >> 3;
    if (tc >= 8 && tc < 12) {
      const float* rp = p.rope + ((long)(r0 + row) * 16 + (tc & 1) * 8) * 2;
#pragma unroll
      for (int j = 0; j < 4; j++) L.r[j] = *(const f32x4*)(rp + 4 * j);
    } else {
#pragma unroll
      for (int j = 0; j < 4; j++) { L.r[j].x = 0.f; L.r[j].y = 0.f; L.r[j].z = 0.f; L.r[j].w = 0.f; }
    }
    return L;
  }, [&](int row, int c8, float (&v)[8], const LdRope& L) {
    const float rs = ssS[row];
    float ss = 0.f;
#pragma unroll
    for (int j = 0; j < 8; j++) { v[j] *= rs; ss += v[j] * v[j]; }
    const int tc = c8 >> 3;
    if (tc >= 12) ss = 0.f;
    ss = sum16(ss);
    const float rq = rsqrtf(ss * (1.f / 96.f) + EPS);
    bf16_t* qd = p.qf + (long)(r0 + row) * 768 + hh * 96;
    if (tc < 8) {
#pragma unroll
      for (int j = 0; j < 8; j++) v[j] *= rq * gq[c8 + j] * QSC;
      *(u32x4*)(qd + c8) = pack8(v);
    } else if (tc < 12) {
      const int i0 = (tc & 1) * 8; const bool first = tc < 10;
      const int pc = first ? 80 + i0 : 64 + i0;
      const float csn[16] = {L.r[0].x, L.r[0].y, L.r[0].z, L.r[0].w, L.r[1].x, L.r[1].y, L.r[1].z, L.r[1].w,
                             L.r[2].x, L.r[2].y, L.r[2].z, L.r[2].w, L.r[3].x, L.r[3].y, L.r[3].z, L.r[3].w};
      float o[8];
#pragma unroll
      for (int j = 0; j < 8; j++) {
        const float own = v[j] * rq * gq[c8 + j];
        const float oth = ep[row * EPW + pc + j] * rs * rq * gq[pc + j];
        const float cs = csn[2 * j], sn = csn[2 * j + 1];
        o[j] = (first ? (own * cs - oth * sn) : (own * cs + oth * sn)) * QSC;
      }
      *(u32x4*)(qd + c8) = pack8(o);
    }
  });
  __syncthreads();
}
DI void g2kv_tile(const P& p, int l, int tm, int hh, char* smem) {
  bf16_t* sm = (bf16_t*)smem; float* ep = (float*)smem; float* ssS = (float*)(smem + SM_SS);
  const int r0 = tm * 128;
  f32x16 acc[2][2]; zero_acc(acc);
  { const int t = tid(); if (t < 128) { const float q = p.ssq[(long)6 * T_ + r0 + t] + p.ssq[(long)7 * T_ + r0 + t];
      ssS[t] = rsqrtf(q * (1.f / 256.f) + EPS); } }
  gemm_loop_dma(p.z2 + (long)r0 * Z2W + 768, Z2W, p.WukvT + (long)hh * 128 * 256, 256, 256, acc, smem);
  acc_to_lds(acc, ep);
  __syncthreads();
  const float* gk = p.b_qk_g_k + l * 96;
  rowwise2(ep, [&](int row, int c8) {
    LdKv L;
    const int tc = c8 >> 3;
    const bf16_t* krp = p.z2 + (long)(r0 + row) * Z2W + 1024;
    L.k2 = *(const unsigned*)(krp + 2 * tc);
    if (tc >= 8 && tc < 12) {
      const int i0 = (tc & 1) * 8;
      L.x1 = *(const u32x4*)(krp + i0); L.x2 = *(const u32x4*)(krp + 16 + i0);
      const float* rp = p.rope + ((long)(r0 + row) * 16 + i0) * 2;
#pragma unroll
      for (int j = 0; j < 4; j++) L.r[j] = *(const f32x4*)(rp + 4 * j);
    } else {
      L.x1.x = 0; L.x1.y = 0; L.x1.z = 0; L.x1.w = 0; L.x2 = L.x1;
#pragma unroll
      for (int j = 0; j < 4; j++) { L.r[j].x = 0.f; L.r[j].y = 0.f; L.r[j].z = 0.f; L.r[j].w = 0.f; }
    }
    return L;
  }, [&](int row, int c8, float (&v)[8], const LdKv& L) {
    const float rs = ssS[row];
    const int tc = c8 >> 3;
    const unsigned k2 = L.k2;
    const float ka = __uint_as_float(k2 << 16), kb = __uint_as_float(k2 & 0xffff0000u);
    float ss = ka * ka + kb * kb;
    if (tc < 8) {
#pragma unroll
      for (int j = 0; j < 8; j++) { v[j] *= rs; ss += v[j] * v[j]; }
    }
    ss = sum16(ss);
    const float kn = rsqrtf(ss * (1.f / 96.f) + EPS);
    bf16_t* kd = p.kf + (long)(r0 + row) * 768 + hh * 96;
    if (tc < 8) {
#pragma unroll
      for (int j = 0; j < 8; j++) v[j] *= kn * gk[c8 + j];
      *(u32x4*)(kd + c8) = pack8(v);
    } else if (tc < 12) {
      const int i0 = (tc & 1) * 8; const bool first = tc < 10;
      float x1[8], x2[8], o[8];
      unpack8(L.x1, x1);
      unpack8(L.x2, x2);
      const float csn[16] = {L.r[0].x, L.r[0].y, L.r[0].z, L.r[0].w, L.r[1].x, L.r[1].y, L.r[1].z, L.r[1].w,
                             L.r[2].x, L.r[2].y, L.r[2].z, L.r[2].w, L.r[3].x, L.r[3].y, L.r[3].z, L.r[3].w};
#pragma unroll
      for (int j = 0; j < 8; j++) {
        const float a = x1[j] * kn * gk[64 + i0 + j], b = x2[j] * kn * gk[80 + i0 + j];
        const float cs = csn[2 * j], sn = csn[2 * j + 1];
        o[j] = first ? (a * cs - b * sn) : (b * cs + a * sn);
      }
      *(u32x4*)(kd + (first ? 64 : 80) + i0) = pack8(o);
    }
  });
  {
    const int b = r0 >> 11, s0 = r0 & 2047;
    tstore(ep, 64, 64, ssS, [&](int col) { return p.vt + ((long)((b * 8 + hh) * 64 + col)) * S_ + s0; });
  }
  __syncthreads();
}

template <int DQK, bool CAUSAL>
DI void attn_item(const bf16_t* __restrict__ q, long q_ld, const bf16_t* __restrict__ k, long k_ld, const bf16_t* __restrict__ vt, long vt_ld,
                  bf16_t* og, long o_ld, int q0, int nkt, char* smem, bool dry) {
  constexpr int KS = DQK + 8, NKC = DQK / 8, NKL = (64 * NKC) / 256, NKK = DQK / 16, VS = 68;
  bf16_t* sK = (bf16_t*)smem;
  bf16_t* sV = (bf16_t*)smem + 2 * 64 * KS;
  const int t = tid(), lane = t & 63, w = t >> 6, l31 = lane & 31, h = lane >> 5;
  bf16x8 qfr[NKK];
  {
    const bf16_t* qp = q + (long)(w * 32 + l31) * q_ld + h * 8;
#pragma unroll
    for (int kk = 0; kk < NKK; kk++) qfr[kk] = *(const bf16x8*)(qp + kk * 16);
  }
  u32x4 rk[NKL], rv[2];
  auto gload = [&](int kt) {
#pragma unroll
    for (int i = 0; i < NKL; i++) { const int c = t + 256 * i, key = c / NKC, kc = c % NKC; rk[i] = *(const u32x4*)(k + (long)(kt * 64 + key) * k_ld + kc * 8); }
#pragma unroll
    for (int i = 0; i < 2; i++) { const int c = t + 256 * i, d = c >> 3, kc = c & 7; rv[i] = *(const u32x4*)(vt + (long)d * vt_ld + kt * 64 + kc * 8); }
  };
  auto lstore = [&](int buf) {
    bf16_t* dK = sK + buf * 64 * KS; bf16_t* dV = sV + buf * 64 * VS;
#pragma unroll
    for (int i = 0; i < NKL; i++) { const int c = t + 256 * i, key = c / NKC, kc = c % NKC; *(u32x4*)(dK + key * KS + kc * 8) = rk[i]; }
#pragma unroll
    for (int i = 0; i < 2; i++) { const int c = t + 256 * i, d = c >> 3, kc = c & 7;
      u32x2 lo, hi; lo.x = rv[i].x; lo.y = rv[i].y; hi.x = rv[i].z; hi.y = rv[i].w;
      *(u32x2*)(dV + d * VS + kc * 8) = lo; *(u32x2*)(dV + d * VS + kc * 8 + 4) = hi; }
  };
  f32x16 o[2];
#pragma unroll
  for (int i = 0; i < 16; i++) { o[0][i] = 0.f; o[1][i] = 0.f; }
  float m = -1e30f, lsum = 0.f;
  const int qpos = q0 + w * 32 + l31;
  gload(0); lstore(0);
  if (nkt > 1) gload(1);
  __syncthreads();
  for (int kt = 0; kt < nkt; kt++) {
    if (kt + 1 < nkt) lstore((kt + 1) & 1);
    __builtin_amdgcn_sched_barrier(0);
    if (kt + 2 < nkt) gload(kt + 2);
    __builtin_amdgcn_sched_barrier(0);
    const bool active = !CAUSAL || (kt * 64 <= q0 + w * 32 + 31);
    if (active) {
      const bf16_t* cK = sK + (kt & 1) * 64 * KS; const bf16_t* cV = sV + (kt & 1) * 64 * VS;
      f32x16 s[2];
#pragma unroll
      for (int i = 0; i < 16; i++) { s[0][i] = 0.f; s[1][i] = 0.f; }
      __builtin_amdgcn_s_setprio(1);
#pragma unroll
      for (int kb = 0; kb < 2; kb++)
#pragma unroll
        for (int kk = 0; kk < NKK; kk++) {
          const bf16x8 kf_ = *(const bf16x8*)(cK + (kb * 32 + l31) * KS + kk * 16 + h * 8);
          s[kb] = MFMA(kf_, qfr[kk], s[kb]);
        }
      __builtin_amdgcn_s_setprio(0);
      if (CAUSAL && (kt * 64 + 63 > q0 + w * 32)) {
#pragma unroll
        for (int kb = 0; kb < 2; kb++)
#pragma unroll
          for (int i = 0; i < 16; i++) { const int key = kt * 64 + kb * 32 + crow(i, h); if (key > qpos) s[kb][i] = -1e30f; }
      }
      float mx = s[0][0];
#pragma unroll
      for (int kb = 0; kb < 2; kb++)
#pragma unroll
        for (int i = 0; i < 16; i++) mx = fmaxf(mx, s[kb][i]);
      mx = fmaxf(mx, __shfl_xor(mx, 32));
      const float mnew = fmaxf(m, mx);
      const float alpha = __builtin_amdgcn_exp2f(m - mnew);
      m = mnew;
      float ps = 0.f;
#pragma unroll
      for (int kb = 0; kb < 2; kb++)
#pragma unroll
        for (int i = 0; i < 16; i++) { const float pv = __builtin_amdgcn_exp2f(s[kb][i] - mnew); s[kb][i] = pv; ps += pv; }
      lsum = lsum * alpha + ps;
#pragma unroll
      for (int i = 0; i < 16; i++) { o[0][i] *= alpha; o[1][i] *= alpha; }
      __builtin_amdgcn_s_setprio(1);
#pragma unroll
      for (int kb = 0; kb < 2; kb++)
#pragma unroll
        for (int st = 0; st < 2; st++) {
          u32x4 pp; pp.x = pk2(s[kb][8 * st + 0], s[kb][8 * st + 1]); pp.y = pk2(s[kb][8 * st + 2], s[kb][8 * st + 3]);
          pp.z = pk2(s[kb][8 * st + 4], s[kb][8 * st + 5]); pp.w = pk2(s[kb][8 * st + 6], s[kb][8 * st + 7]);
          const bf16x8 pf = __builtin_bit_cast(bf16x8, pp);
#pragma unroll
          for (int db = 0; db < 2; db++) {
            const bf16_t* vp = cV + (db * 32 + l31) * VS + kb * 32 + st * 16 + 4 * h;
            const u32x2 lo = *(const u32x2*)vp, hi = *(const u32x2*)(vp + 8);
            u32x4 vv; vv.x = lo.x; vv.y = lo.y; vv.z = hi.x; vv.w = hi.y;
            o[db] = MFMA(__builtin_bit_cast(bf16x8, vv), pf, o[db]);
          }
        }
      __builtin_amdgcn_s_setprio(0);
    }
    __syncthreads();
  }
  lsum += __shfl_xor(lsum, 32);
  const float inv = 1.f / lsum;
  bf16_t* op = og + (long)(w * 32 + l31) * o_ld;
#pragma unroll
  for (int db = 0; db < 2; db++)
#pragma unroll
    for (int ig = 0; ig < 4; ig++) {
      const int d = db * 32 + ig * 8 + 4 * h;
      float gt[4]; unpack4(*(const u32x2*)(op + d), gt);
      u32x2 r; r.x = pk2(o[db][4 * ig + 0] * inv * gt[0], o[db][4 * ig + 1] * inv * gt[1]); r.y = pk2(o[db][4 * ig + 2] * inv * gt[2], o[db][4 * ig + 3] * inv * gt[3]);
      if (!dry) *(u32x2*)(op + d) = r;
    }
}
DI void mattn_item(const P& p, int idx, char* smem) {
  const int b = idx >> 6, hh = (idx >> 4) & 3, qt = idx & 15;
  const long tok0 = (long)b * S_ + qt * 128;
  attn_item<64, false>(p.z1 + tok0 * Z1W + 1792 + hh * 64, Z1W, p.memk + (long)b * 256 * 256 + hh * 64, 256,
                       p.memvt + (long)(b * 4 + hh) * 64 * 256, 256, p.z1 + tok0 * Z1W + 2048 + hh * 64, Z1W, 0, 4, smem, p.dry != 0);
}
DI void battn_item(const P& p, int idx, char* smem) {
  const int qt = 15 - (idx >> 6), bh = idx & 63, b = bh >> 3, hh = bh & 7;
  const long tok0 = (long)b * S_ + qt * 128;
  attn_item<96, true>(p.qf + tok0 * 768 + hh * 96, 768, p.kf + (long)b * S_ * 768 + hh * 96, 768,
                      p.vt + (long)(b * 8 + hh) * 64 * S_, S_, p.z1 + tok0 * Z1W + 768 + hh * 64, Z1W, qt * 128, 2 * qt + 2, smem, p.dry != 0);
}

DI void a_item(const P& p, int l, int idx, int mh, char* smem) {
  bf16_t* vnT = (bf16_t*)smem;
  float* part = (float*)(smem + 256 * 136 * 2);
  const int t = tid(); const long r0 = (long)idx * 128;
  {
    const int row = t & 127, half = t >> 7;
    const bf16_t* src = p.z1 + (r0 + row) * Z1W + 256 + half * 128;
    float ss = 0.f;
#pragma unroll 4
    for (int i = 0; i < 16; i++) { float f[8]; unpack8(*(const u32x4*)(src + i * 8), f);
#pragma unroll
      for (int j = 0; j < 8; j++) ss += f[j] * f[j]; }
    part[half * 128 + row] = ss;
    __syncthreads();
    const float r = rsqrtf((part[row] + part[128 + row]) * (1.f / 256.f) + EPS);
    const float* gv = p.a_norm_g + l * 256 + half * 128;
#pragma unroll 4
    for (int i = 0; i < 16; i++) { float f[8]; unpack8(*(const u32x4*)(src + i * 8), f);
#pragma unroll
      for (int j = 0; j < 8; j++) vnT[(half * 128 + i * 8 + j) * 136 + row] = f2bf(f[j] * r * gv[i * 8 + j]); }
  }
  __syncthreads();
  const int lane = t & 63, g = t >> 6, l31 = lane & 31, h = lane >> 5;
  const float* W = p.a_w_s + (long)(l * 4 + g) * 128 * 128;
  const float* bs = p.a_b_s + (l * 4 + g) * 128;
  {
    f32x16 acc[2][2]; zero_acc(acc);
#pragma unroll 2
    for (int kk = 0; kk < 8; kk++) {
      bf16x8 af[2], bfr[2];
#pragma unroll
      for (int mb = 0; mb < 2; mb++) {
        const int tt = mh * 64 + mb * 32 + l31, s0 = kk * 16 + h * 8;
        const f32x4 w0 = *(const f32x4*)(W + tt * 128 + s0), w1 = *(const f32x4*)(W + tt * 128 + s0 + 4);
        float f[8] = {w0.x, w0.y, w0.z, w0.w, w1.x, w1.y, w1.z, w1.w};
#pragma unroll
        for (int j = 0; j < 8; j++) if (s0 + j > tt) f[j] = 0.f;
        af[mb] = __builtin_bit_cast(bf16x8, pack8(f));
      }
#pragma unroll
      for (int nb = 0; nb < 2; nb++) bfr[nb] = *(const bf16x8*)(vnT + (g * 64 + nb * 32 + l31) * 136 + kk * 16 + h * 8);
#pragma unroll
      for (int mb = 0; mb < 2; mb++)
#pragma unroll
        for (int nb = 0; nb < 2; nb++) acc[mb][nb] = MFMA(af[mb], bfr[nb], acc[mb][nb]);
    }
#pragma unroll
    for (int mb = 0; mb < 2; mb++)
#pragma unroll
      for (int nb = 0; nb < 2; nb++)
#pragma unroll
        for (int i = 0; i < 16; i++) {
          const int tt = mh * 64 + mb * 32 + crow(i, h), col = g * 64 + nb * 32 + l31;
          bf16_t* zp = p.z1 + (r0 + tt) * Z1W;
          const float u = bf2f(zp[col]), gt = bf2f(zp[512 + col]);
          if (!p.dry) zp[col] = f2bf(u * (acc[mb][nb][i] + bs[tt]) * gt);
        }
  }
  __syncthreads();
}

DI void c_setup(const P& p, int l, int g, int lane, float& ar, float& ai, float (&Br)[16], float (&Bi)[16]) {
  const int gi = (l * 16 + g) * 64 + lane;
  const float lre = p.c_a_re[gi], lim = p.c_a_im[gi];
  const float dt = expf(p.c_log_dt[l * 16 + g]);
  const float mag = expf(lre * dt);
  const float angf = lim * dt;
  const double rev = (double)angf * 0.15915494309189535;
  const float rf = (float)((rev - rint(rev)) * 6.283185307179586);
  const float sn = sinf(rf), cs = cosf(rf);
  ar = mag * cs; ai = mag * sn;
  const float xr = ar - 1.f, xi = ai, den = 1.f / (lre * lre + lim * lim);
  const float cr = (xr * lre + xi * lim) * den, ci = (xi * lre - xr * lim) * den;
  const float* bre = p.c_b_re + (long)gi * 16; const float* bim = p.c_b_im + (long)gi * 16;
#pragma unroll
  for (int c4 = 0; c4 < 4; c4++) {
    const f32x4 r4 = *(const f32x4*)(bre + c4 * 4), i4 = *(const f32x4*)(bim + c4 * 4);
    const float rr[4] = {r4.x, r4.y, r4.z, r4.w}, ii[4] = {i4.x, i4.y, i4.z, i4.w};
#pragma unroll
    for (int j = 0; j < 4; j++) { Br[c4 * 4 + j] = cr * rr[j] - ci * ii[j]; Bi[c4 * 4 + j] = cr * ii[j] + ci * rr[j]; }
  }
}
DI void s5c_build_item(const P& p, int it) {
  const int e = it * 256 + tid(), l = e >> 10, g = (e >> 6) & 15, lane = e & 63;
  float ar, ai, Br[16], Bi[16];
  c_setup(p, l, g, lane, ar, ai, Br, Bi);
  float* d = p.s5c + (long)e * 36;
  f32x4 v; v.x = ar; v.y = ai; v.z = 0.f; v.w = 0.f; *(f32x4*)d = v;
#pragma unroll
  for (int c4 = 0; c4 < 4; c4++) {
    v.x = Br[c4 * 4]; v.y = Br[c4 * 4 + 1]; v.z = Br[c4 * 4 + 2]; v.w = Br[c4 * 4 + 3]; *(f32x4*)(d + 4 + c4 * 4) = v;
    v.x = Bi[c4 * 4]; v.y = Bi[c4 * 4 + 1]; v.z = Bi[c4 * 4 + 2]; v.w = Bi[c4 * 4 + 3]; *(f32x4*)(d + 20 + c4 * 4) = v;
  }
}
DI void s5_bfrags(const P& p, int l, int g, int lane, bf16x8 (&bf)[8]) {
  const int r16 = lane & 15, q = lane >> 4;
#pragma unroll
  for (int nb = 0; nb < 8; nb++) {
    u32x4 pk; pk.x = 0u; pk.y = 0u; pk.z = 0u; pk.w = 0u;
    if (q < 2) {
      const float* d = p.s5c + (long)(((l * 16 + g) * 64) + nb * 8 + (r16 >> 1)) * 36 + 4 + (r16 & 1) * 16 + q * 8;
      const f32x4 a = *(const f32x4*)d, b = *(const f32x4*)(d + 4);
      pk.x = pk2(a.x, a.y); pk.y = pk2(a.z, a.w); pk.z = pk2(b.x, b.y); pk.w = pk2(b.z, b.w);
    }
    bf[nb] = __builtin_bit_cast(bf16x8, pk);
  }
}
DI void s5_bu_block(const float* ub, int sb, int lane, const bf16x8 (&bf)[8], float* bu) {
  const int r16 = lane & 15, q = lane >> 4;
  u32x4 ua; ua.x = 0u; ua.y = 0u; ua.z = 0u; ua.w = 0u;
  if (q < 2) {
    const f32x4 a = *(const f32x4*)(ub + (sb * 16 + r16) * 16 + q * 8), b = *(const f32x4*)(ub + (sb * 16 + r16) * 16 + q * 8 + 4);
    ua.x = pk2(a.x, a.y); ua.y = pk2(a.z, a.w); ua.z = pk2(b.x, b.y); ua.w = pk2(b.z, b.w);
  }
  const bf16x8 af = __builtin_bit_cast(bf16x8, ua);
#pragma unroll
  for (int nb = 0; nb < 8; nb++) {
    f32x4 d; d.x = 0.f; d.y = 0.f; d.z = 0.f; d.w = 0.f;
    d = __builtin_amdgcn_mfma_f32_16x16x32_bf16(af, bf[nb], d, 0, 0, 0);
    float* o = bu + (q * 4) * 132 + nb * 16 + r16;
    o[0] = d.x; o[132] = d.y; o[264] = d.z; o[396] = d.w;
  }
}
#define LDS_HANDOFF_() do { asm volatile("s_waitcnt lgkmcnt(0)" ::: "memory"); __builtin_amdgcn_wave_barrier(); } while (0)
DI void c_load_u(const P& p, long tok0, int g, int lane, float* ub) {
  const bf16_t* up = p.z1 + (tok0 + lane) * Z1W + 1280 + g * 16;
  float f0[8], f1[8];
  unpack8(*(const u32x4*)up, f0); unpack8(*(const u32x4*)(up + 8), f1);
  f32x4 a; a.x = f0[0]; a.y = f0[1]; a.z = f0[2]; a.w = f0[3]; *(f32x4*)(ub + lane * 16) = a;
  a.x = f0[4]; a.y = f0[5]; a.z = f0[6]; a.w = f0[7]; *(f32x4*)(ub + lane * 16 + 4) = a;
  a.x = f1[0]; a.y = f1[1]; a.z = f1[2]; a.w = f1[3]; *(f32x4*)(ub + lane * 16 + 8) = a;
  a.x = f1[4]; a.y = f1[5]; a.z = f1[6]; a.w = f1[7]; *(f32x4*)(ub + lane * 16 + 12) = a;
}
DI void c_step(const float* ub, int s, const float (&Br)[16], const float (&Bi)[16], float ar, float ai, float& sr, float& si) {
  float bur = 0.f, bui = 0.f;
#pragma unroll
  for (int c4 = 0; c4 < 4; c4++) {
    const f32x4 u = *(const f32x4*)(ub + s * 16 + c4 * 4);
    bur += Br[c4 * 4] * u.x + Br[c4 * 4 + 1] * u.y + Br[c4 * 4 + 2] * u.z + Br[c4 * 4 + 3] * u.w;
    bui += Bi[c4 * 4] * u.x + Bi[c4 * 4 + 1] * u.y + Bi[c4 * 4 + 2] * u.z + Bi[c4 * 4 + 3] * u.w;
  }
  const float nr = ar * sr - ai * si + bur, ni = ar * si + ai * sr + bui;
  sr = nr; si = ni;
}
DI void c1_item(const P& p, int l, int idx, char* smem) {
  const int t = tid(), lane = t & 63, w = t >> 6;
  const int b = idx >> 7, g = (idx >> 3) & 15, k = (idx & 7) * 4 + w;
  float* ub = (float*)(smem + w * 16896);
  float* bu = (float*)(smem + w * 16896 + 8448);
  const float* cd = p.s5c + (long)(((l * 16 + g) * 64) + lane) * 36;
  const float ar = cd[0], ai = cd[1];
  bf16x8 bf[8];
  s5_bfrags(p, l, g, lane, bf);
  const long tok0 = (long)b * S_ + k * 64;
  c_load_u(p, tok0, g, lane, ub);
  __syncthreads();
  float sr = 0.f, si = 0.f;
#pragma unroll 1
  for (int sb = 0; sb < 4; sb++) {
    s5_bu_block(ub, sb, lane, bf, bu);
    LDS_HANDOFF_();
#pragma unroll 4
    for (int s2 = 0; s2 < 16; s2++) {
      const f32x2 bb = *(const f32x2*)(bu + s2 * 132 + 2 * lane);
      const float nr = ar * sr - ai * si + bb.x, ni = ar * si + ai * sr + bb.y;
      sr = nr; si = ni;
    }
    LDS_HANDOFF_();
  }
  f32x2 e; e.x = sr; e.y = si;
  *(f32x2*)(p.carry + ((long)((b * 16 + g) * 32 + k) * 64 + lane) * 2) = e;
  __syncthreads();
}
DI void c3_item(const P& p, int l, int idx, char* smem) {
  const int t = tid(), lane = t & 63, w = t >> 6;
  const int b = idx >> 7, g = (idx >> 3) & 15, k = (idx & 7) * 4 + w;
  float* ub = (float*)(smem + w * 16896);
  bf16_t* stb = (bf16_t*)(smem + w * 16896 + 4096);
  float* bu = (float*)(smem + w * 16896 + 8448);
  const int c = lane & 15, sq = lane >> 4;
  bf16x8 cfr[4];
  {
    const float* cre = p.c_c_re + (long)(l * 16 + g) * 1024 + c * 64; const float* cim = p.c_c_im + (long)(l * 16 + g) * 1024 + c * 64;
#pragma unroll
    for (int ks = 0; ks < 4; ks++) {
      const f32x4 r4 = *(const f32x4*)(cre + ks * 16 + sq * 4), i4 = *(const f32x4*)(cim + ks * 16 + sq * 4);
      u32x4 pk; pk.x = pk2(r4.x, -i4.x); pk.y = pk2(r4.y, -i4.y); pk.z = pk2(r4.z, -i4.z); pk.w = pk2(r4.w, -i4.w);
      cfr[ks] = __builtin_bit_cast(bf16x8, pk);
    }
  }
  const float* cd = p.s5c + (long)(((l * 16 + g) * 64) + lane) * 36;
  const float ar = cd[0], ai = cd[1];
  bf16x8 bf[8];
  s5_bfrags(p, l, g, lane, bf);
  const long tok0 = (long)b * S_ + k * 64;
  c_load_u(p, tok0, g, lane, ub);
  float lr = ar, li = ai;
#pragma unroll
  for (int i = 0; i < 6; i++) { const float nr = lr * lr - li * li, ni = 2.f * lr * li; lr = nr; li = ni; }
  float sr = 0.f, si = 0.f;
  {
    const float* cp = p.carry + ((long)((b * 16 + g) * 32) * 64 + lane) * 2;
    for (int j0 = 0; j0 < k; j0 += 16) {
      f32x2 e[16];
#pragma unroll
      for (int jj = 0; jj < 16; jj++) { e[jj].x = 0.f; e[jj].y = 0.f; if (j0 + jj < k) e[jj] = *(const f32x2*)(cp + (long)(j0 + jj) * 128); }
#pragma unroll
      for (int jj = 0; jj < 16; jj++) if (j0 + jj < k) { const float nr = lr * sr - li * si + e[jj].x, ni = lr * si + li * sr + e[jj].y; sr = nr; si = ni; }
    }
  }
  __syncthreads();
  const float dsk = p.c_d[l * 256 + g * 16 + c];
#pragma unroll 1
  for (int sb = 0; sb < 4; sb++) {
    s5_bu_block(ub, sb, lane, bf, bu);
    LDS_HANDOFF_();
#pragma unroll 4
    for (int s2 = 0; s2 < 16; s2++) {
      const f32x2 bb = *(const f32x2*)(bu + s2 * 132 + 2 * lane);
      const float nr = ar * sr - ai * si + bb.x, ni = ar * si + ai * sr + bb.y;
      sr = nr; si = ni;
      *(unsigned*)(stb + s2 * 136 + 2 * lane) = pk2(sr, si);
    }
    asm volatile("s_waitcnt lgkmcnt(0)" ::: "memory");
    __builtin_amdgcn_wave_barrier();
    f32x4 y; y.x = 0.f; y.y = 0.f; y.z = 0.f; y.w = 0.f;
#pragma unroll
    for (int ks = 0; ks < 4; ks++) {
      const bf16x8 af = *(const bf16x8*)(stb + c * 136 + ks * 32 + sq * 8);
      y = __builtin_amdgcn_mfma_f32_16x16x32_bf16(af, cfr[ks], y, 0, 0, 0);
    }
    const float yy[4] = {y.x, y.y, y.z, y.w};
#pragma unroll
    for (int qq = 0; qq < 4; qq++) {
      const int sa = sb * 16 + sq * 4 + qq;
      const float yv = gelu_t(yy[qq] + dsk * ub[sa * 16 + c]);
      if (!p.dry) p.z1[(tok0 + sa) * Z1W + 1280 + g * 16 + c] = f2bf(yv);
    }
    asm volatile("s_waitcnt lgkmcnt(0)" ::: "memory");
    __builtin_amdgcn_wave_barrier();
  }
  __syncthreads();
}

DI void glu_tile(const P& p, int l, int tm, int tn, char* smem) {
  bf16_t* sm = (bf16_t*)smem; float* ep = (float*)smem;
  const int r0 = tm * 128, c0 = tn * 128;
  f32x16 acc[2][2]; zero_acc(acc);
  gemm_loop_dma(p.z1 + (long)r0 * Z1W + 1280, Z1W, p.WgluT + (long)c0 * 256, 256, 256, acc, smem);
  acc_to_lds(acc, ep);
  __syncthreads();
  const float* bg = p.c_b_glu + l * 256 + c0;
  rowwise2(ep, [&](int row, int c8) {
    LdGlu L;
    const bf16_t* zp = p.z1 + (long)(r0 + row) * Z1W + c0 + c8;
    L.yg = *(const u32x4*)(zp + 1280); L.gt = *(const u32x4*)(zp + 1536);
    return L;
  }, [&](int row, int c8, float (&v)[8], const LdGlu& L) {
    bf16_t* zp = p.z1 + (long)(r0 + row) * Z1W + c0 + c8;
    float yg[8], gt[8];
    unpack8(L.yg, yg); unpack8(L.gt, gt);
#pragma unroll
    for (int j = 0; j < 8; j++) v[j] = yg[j] * sigm(v[j] + bg[c8 + j]) * gt[j];
    if (!p.dry) *(u32x4*)(zp + 1536) = pack8(v);
  });
  __syncthreads();
}

DI void pf_tile(const P& p, int l, int tm, int tn, char* smem) {
  float* ep = (float*)smem; float* rsS = (float*)(smem + SM_RS);
  const int t = tid(), lane = t & 63, w = t >> 6, wm = w >> 1, wn = w & 1, l31 = lane & 31, h = lane >> 5;
  const int r0 = tm * 128, c0 = tn * 128;
  load_rs(p, r0, rsS);
  unsigned mrgp[2][2][8];
#pragma unroll
  for (int a = 0; a < 2; a++)
#pragma unroll
    for (int b = 0; b < 2; b++)
#pragma unroll
      for (int i = 0; i < 8; i++) mrgp[a][b][i] = 0u;
#pragma unroll 1
  for (int pr = 0; pr < 2; pr++) {
    unsigned gp[2][2][2][8];
    {
      f32x16 accP[2][2], accQ[2][2]; zero_acc(accP); zero_acc(accQ);
      const bf16_t* wg = p.WinT + (long)(3456 + (2 * pr) * 1024 + c0) * 1024;
      gemm_loop_dma2(p.xb + (long)r0 * 1024, 1024, wg, wg + (long)1024 * 1024, 1024, 1024, accP, accQ, smem);
      const float* bm = p.b_merge + l * 4096 + (2 * pr) * 1024 + c0;
#pragma unroll
      for (int mb = 0; mb < 2; mb++)
#pragma unroll
        for (int nb = 0; nb < 2; nb++) {
          const float bias0 = bm[wn * 64 + nb * 32 + l31], bias1 = bm[1024 + wn * 64 + nb * 32 + l31];
#pragma unroll
          for (int i = 0; i < 16; i += 2) {
            const float ra = rsS[wm * 64 + mb * 32 + crow(i, h)], rb = rsS[wm * 64 + mb * 32 + crow(i + 1, h)];
            gp[0][mb][nb][i >> 1] = pk2n(sigm(accP[mb][nb][i] * ra + bias0), sigm(accP[mb][nb][i + 1] * rb + bias0));
            gp[1][mb][nb][i >> 1] = pk2n(sigm(accQ[mb][nb][i] * ra + bias1), sigm(accQ[mb][nb][i + 1] * rb + bias1));
          }
        }
    }
#pragma unroll
    for (int j = 0; j < 2; j++) {
      const int br = 2 * pr + j;
      const int yoff = br == 0 ? 0 : (br == 1 ? 768 : (br == 2 ? 1536 : 2048));
      const int Kb = br == 1 ? 512 : 256;
      const long woff = br == 0 ? 0 : (br == 1 ? 1024 * 256 : (br == 2 ? 1024 * 768 : 1024 * 1024));
      f32x16 acc[2][2]; zero_acc(acc);
      gemm_loop_dma(p.z1 + (long)r0 * Z1W + yoff, Z1W, p.WbrT + woff + (long)c0 * Kb, Kb, Kb, acc, smem);
#pragma unroll
      for (int mb = 0; mb < 2; mb++)
#pragma unroll
        for (int nb = 0; nb < 2; nb++)
#pragma unroll
          for (int i = 0; i < 16; i += 2) {
            const unsigned g2 = gp[j][mb][nb][i >> 1], m2 = mrgp[mb][nb][i >> 1];
            const float m0 = __uint_as_float(m2 << 16) + __uint_as_float(g2 << 16) * acc[mb][nb][i];
            const float m1 = __uint_as_float(m2 & 0xffff0000u) + __uint_as_float(g2 & 0xffff0000u) * acc[mb][nb][i + 1];
            mrgp[mb][nb][i >> 1] = pk2(m0, m1);
          }
    }
  }
  {
    f32x16 mrg[2][2];
#pragma unroll
    for (int a = 0; a < 2; a++)
#pragma unroll
      for (int b = 0; b < 2; b++)
#pragma unroll
        for (int i = 0; i < 16; i += 2) { const unsigned m2 = mrgp[a][b][i >> 1]; mrg[a][b][i] = __uint_as_float(m2 << 16); mrg[a][b][i + 1] = __uint_as_float(m2 & 0xffff0000u); }
    acc_to_lds(mrg, ep);
  }
  __syncthreads();
  rowwise(ep, [&](int row, int c8, float (&v)[8]) { *(u32x4*)(p.mg + (long)(r0 + row) * 1024 + c0 + c8) = pack8(v); });
  __syncthreads();
}

DI void out_tile(const P& p, int l, int tm, int tn, char* smem) {
  bf16_t* sm = (bf16_t*)smem; float* ep = (float*)smem;
  const int r0 = tm * 128, c0 = tn * 128;
  f32x16 acc[2][2]; zero_acc(acc);
  gemm_loop_dma(p.mg + (long)r0 * 1024, 1024, p.WoutT + (long)l * 1024 * 1024 + (long)c0 * 1024, 1024, 1024, acc, smem);
  acc_to_lds(acc, ep);
  __syncthreads();
  const float* xin = (l == 0) ? p.x : p.out;
  rowwise2(ep, [&](int row, int c8) {
    LdX L;
    const long off = (long)(r0 + row) * 1024 + c0 + c8;
    L.a = *(const f32x4*)(xin + off); L.b = *(const f32x4*)(xin + off + 4);
    return L;
  }, [&](int row, int c8, float (&v)[8], const LdX& L) {
    const long off = (long)(r0 + row) * 1024 + c0 + c8;
    const f32x4 a = L.a, b = L.b;
    v[0] += a.x; v[1] += a.y; v[2] += a.z; v[3] += a.w; v[4] += b.x; v[5] += b.y; v[6] += b.z; v[7] += b.w;
    f32x4 oa, ob; oa.x = v[0]; oa.y = v[1]; oa.z = v[2]; oa.w = v[3]; ob.x = v[4]; ob.y = v[5]; ob.z = v[6]; ob.w = v[7];
    if (!p.dry) {
      if (l == 1) { __builtin_nontemporal_store(oa, (f32x4*)(p.out + off)); __builtin_nontemporal_store(ob, (f32x4*)(p.out + off + 4)); }
      else { *(f32x4*)(p.out + off) = oa; *(f32x4*)(p.out + off + 4) = ob; }
    }
    if (l == 0) {
      *(u32x4*)(p.xb + off) = pack8(v);
      float ss = 0.f;
#pragma unroll
      for (int j = 0; j < 8; j++) ss += v[j] * v[j];
      ss = sum16(ss);
      if ((c8 >> 3) == 0) p.ssp[(long)tn * T_ + r0 + row] = ss;
    }
  });
  __syncthreads();
}

DI void out_tile2(const P& p, int l, int tm, int tn2, char* smem) {
  float* ep = (float*)smem;
  const int r0 = tm * 128;
  f32x16 accP[2][2], accQ[2][2]; zero_acc(accP); zero_acc(accQ);
  const bf16_t* w0 = p.WoutT + (long)l * 1024 * 1024 + (long)(tn2 * 256) * 1024;
  gemm_loop_dma2(p.mg + (long)r0 * 1024, 1024, w0, w0 + (long)128 * 1024, 1024, 1024, accP, accQ, smem);
  const float* xin = (l == 0) ? p.x : p.out;
  auto epi = [&](const f32x16 (&acc)[2][2], int tn) {
    const int c0 = tn * 128;
    acc_to_lds(acc, ep);
    __syncthreads();
    rowwise2(ep, [&](int row, int c8) {
      LdX L;
      const long off = (long)(r0 + row) * 1024 + c0 + c8;
      L.a = *(const f32x4*)(xin + off); L.b = *(const f32x4*)(xin + off + 4);
      return L;
    }, [&](int row, int c8, float (&v)[8], const LdX& L) {
      const long off = (long)(r0 + row) * 1024 + c0 + c8;
      const f32x4 a = L.a, b = L.b;
      v[0] += a.x; v[1] += a.y; v[2] += a.z; v[3] += a.w; v[4] += b.x; v[5] += b.y; v[6] += b.z; v[7] += b.w;
      f32x4 oa, ob; oa.x = v[0]; oa.y = v[1]; oa.z = v[2]; oa.w = v[3]; ob.x = v[4]; ob.y = v[5]; ob.z = v[6]; ob.w = v[7];
      if (!p.dry) {
        if (l == 1) { __builtin_nontemporal_store(oa, (f32x4*)(p.out + off)); __builtin_nontemporal_store(ob, (f32x4*)(p.out + off + 4)); }
        else { *(f32x4*)(p.out + off) = oa; *(f32x4*)(p.out + off + 4) = ob; }
      }
      if (l == 0) {
        *(u32x4*)(p.xb + off) = pack8(v);
        float ss = 0.f;
#pragma unroll
        for (int j = 0; j < 8; j++) ss += v[j] * v[j];
        ss = sum16(ss);
        if ((c8 >> 3) == 0) p.ssp[(long)tn * T_ + r0 + row] = ss;
      }
    });
    __syncthreads();
  };
  epi(accP, 2 * tn2);
  epi(accQ, 2 * tn2 + 1);
}

DI void run_phase(const P& p, int ph, char* smem, int vb) {
  const int G = gridDim.x, bid = blockIdx.x;
  int* slot = (int*)(smem + SM_MISC);
  if (ph == 0) {
    conv_all(p, 0, smem);
    for (int it = NCONV + bid; it < NAUX; it += G) aux_item(p, 0, it, smem);
    for (int it = bid; it < 2048; it += G) p0_xrow_item(p, it);
    for (int it = bid; it < 1024; it += G) p0_rope_item(p, it);
    for (int it = bid; it < 8; it += G) s5c_build_item(p, it);
    return;
  }
  const int l = (ph - 1) / 6, s = (ph - 1) % 6;
  if (s == 0) {
    const int nd = 128 * 12, nrd = (nd + G - 1) / G;
    for (int r = 0; r < nrd; r++) { const int L = static_L(r, vb); if (L >= nd) continue; int tm, tp; tile_from_linear(L, 12, tm, tp); g1_tile2(p, l, tm, 2 * tp, smem); }
    for (int L = vb; L < 384 + 64; L += G) {
      int tm, tn;
      if (L < 384) { tile_from_linear(L, 3, tm, tn); g1_tile(p, l, tm, 24 + tn, smem); }
      else { tile_from_linear(L - 384, 4, tm, tn); g1m_tile(p, l, tm, tn, smem); }
    }
  } else if (s == 1) {
    const long dm = p.dry;
    {
      const int total = 1024, nr = (total + G - 1) / G;
      if (!dm || (dm & 2)) for (int r = 0; r < nr; r++) { const int L = static_L(r, vb); if (L >= total) continue; int tm, tn; tile_from_linear(L, 8, tm, tn); g2q_tile(p, l, tm, tn, smem); }
      if (!dm || (dm & 8)) for (int r = 0; r < nr; r++) { const int L = static_L(r, vb); if (L >= total) continue; int tm, tn; tile_from_linear(L, 8, tm, tn); g2kv_tile(p, l, tm, tn, smem); }
    }
    if (!dm || (dm & 4)) for (int it = vb; it < 512; it += G) mattn_item(p, it, smem);
    {
      if (G >= 512) {
        if (vb < 256) { if (!dm || (dm & 16)) a_item(p, l, vb >> 1, vb & 1, smem); }
        else if (!dm || (dm & 32)) {
#pragma unroll 1
          for (int it = vb - 256; it < 1024; it += G - 256) c1_item(p, l, it, smem);
        }
      } else {
        if (!dm || (dm & 16)) for (int it = vb; it < 256; it += G) a_item(p, l, it >> 1, it & 1, smem);
        if (!dm || (dm & 32)) {
#pragma unroll 1
          for (int it = vb; it < 1024; it += G) c1_item(p, l, it, smem);
        }
      }
    }
  } else if (s == 2) {
    const long dm = p.dry;
    if (G == 512) {
#pragma unroll 1
      for (int j = 0; j < 4; j++) {
        if (j < 2) { if (dm && !(dm & 2)) continue; battn_item(p, j ? 1023 - vb : vb, smem); }
        else { if (dm && !(dm & 4)) continue; c3_item(p, l, vb + (j - 2) * 512, smem); }
      }
    } else {
#pragma unroll 1
      for (int it = vb; it < 2048; it += G) {
        if (it < 1024) { if (dm && !(dm & 2)) continue; battn_item(p, it, smem); } else { if (dm && !(dm & 4)) continue; c3_item(p, l, it - 1024, smem); }
      }
    }
  } else if (s == 3) {
    for (int it = bid; it < 256; it += G) glu_tile(p, l, it >> 1, it & 1, smem);
  } else if (s == 4) {
    const int total = 1024, nr = (total + G - 1) / G;
    for (int r = 0; r < nr; r++) { const int L = static_L(r, vb); if (L >= total) continue; int tm, tn; tile_from_linear(L, 8, tm, tn); pf_tile(p, l, tm, tn, smem); }
  } else {
    const int nr2 = (512 + G - 1) / G;
    for (int r = 0; r < nr2; r++) { const int L = static_L(r, vb); if (L >= 512) continue; int tm, tn; tile_from_linear(L, 4, tm, tn); out_tile2(p, l, tm, tn, smem); }
    if (l == 0) { conv_all(p, 1, smem); for (int it = NCONV + bid; it < NAUX; it += G) aux_item(p, 1, it, smem); }
  }
}

DI unsigned xb_ld(unsigned* q) { return __hip_atomic_load(q, __ATOMIC_RELAXED, __HIP_MEMORY_SCOPE_AGENT); }
DI unsigned xb_add(unsigned* q, unsigned v) { return __hip_atomic_fetch_add(q, v, __ATOMIC_RELAXED, __HIP_MEMORY_SCOPE_AGENT); }
DI void gbar(unsigned* bar, const int* st) {
  asm volatile("s_waitcnt vmcnt(0)" ::: "memory");
  __syncthreads();
  if (threadIdx.x == 0) {
    __builtin_amdgcn_s_waitcnt(0);
    const unsigned x = (unsigned)st[0], nloc = (unsigned)st[1], nx = (unsigned)st[2];
    const unsigned old = xb_add(&bar[1024 + 64 * x], 1u);
    const unsigned gen = old / nloc;
    if (old + 1u == (gen + 1u) * nloc) {
      __builtin_amdgcn_fence(__ATOMIC_RELEASE, "agent");
      asm volatile("s_waitcnt vmcnt(0)" ::: "memory");
      const unsigned og = xb_add(&bar[3072], 1u);
      const unsigned tg = og / nx;
      if (og + 1u == (tg + 1u) * nx) xb_add(&bar[3136], 1u);
      else while (xb_ld(&bar[3136]) == tg) __builtin_amdgcn_s_sleep(1);
      __builtin_amdgcn_fence(__ATOMIC_ACQUIRE, "agent");
      xb_add(&bar[2048 + 64 * x], 1u);
      asm volatile("s_waitcnt vmcnt(0)" ::: "memory");
    } else {
      while (xb_ld(&bar[2048 + 64 * x]) == gen) __builtin_amdgcn_s_sleep(1);
      __builtin_amdgcn_fence(__ATOMIC_ACQUIRE, "agent");
      asm volatile("s_waitcnt vmcnt(0)" ::: "memory");
    }
  }
  __syncthreads();
}

#if MK_MULTI
__global__ void __launch_bounds__(256, 2) hyb_phase(P p, int ph) {
  __shared__ __attribute__((aligned(16))) char smem[SM_TOTAL];
  run_phase(p, ph, smem, blockIdx.x);
}
#else
__global__ void __launch_bounds__(256, 2) hyb_mega(P p) {
  __shared__ __attribute__((aligned(16))) char smem[SM_TOTAL];
  cg::grid_group grid = cg::this_grid();
  if (p.dry == 0x7fffffff) grid.sync();
  int vb;
  {
    int* sl = (int*)(smem + SM_MISC) + 2;
    if (threadIdx.x == 0) {
      const unsigned xcc = (unsigned)__builtin_amdgcn_s_getreg((3 << 11) | 20) & 7u;
      const unsigned loc = xb_add(p.ctr + 40 + xcc, 1u);
      const unsigned Gx = gridDim.x >> 3;
      *sl = (loc < Gx) ? (int)(loc * 8 + xcc) : -1;
      unsigned sum, cnt, mine;
      for (;;) {
        sum = 0u; cnt = 0u; mine = 0u;
        for (unsigned j = 0; j < 8; ++j) { const unsigned c = xb_ld(p.ctr + 40 + j); sum += c; cnt += (c > 0u) ? 1u : 0u; mine = (j == xcc) ? c : mine; }
        if (sum == gridDim.x) break;
        __builtin_amdgcn_s_sleep(1);
      }
      sl[2] = (int)xcc; sl[3] = (int)mine; sl[4] = (int)cnt;
    }
    __syncthreads();
    vb = blockIdx.x;
  }
  const int* bst = (const int*)(smem + SM_MISC) + 4;
#ifdef DRY_PH
  P pd = p; { int one = DRY_MASK; asm volatile("" : "+s"(one)); pd.dry = one; }
#endif
#pragma unroll 1
  for (int ph = 0; ph < 13; ph++) {
#ifdef DRY_PH
    if (ph == DRY_PH) { run_phase(pd, ph, smem, vb); gbar(p.bar, bst); }
#endif
    run_phase(p, ph, smem, vb);
    if (ph < 12) gbar(p.bar, bst);
  }
}
#endif

extern "C" void kernel_launch(void* const* d_in, const int* in_sizes, int n_in, void* d_out, int out_size, void* d_ws, size_t ws_size, hipStream_t stream) {
  P p{};
  p.x = (const float*)d_in[0]; p.mem = (const float*)d_in[1]; p.pos = (const int*)d_in[2];
  p.norm_g = (const float*)d_in[3]; p.w_in = (const float*)d_in[4]; p.b_merge = (const float*)d_in[5];
  p.a_norm_g = (const float*)d_in[6]; p.a_w_s = (const float*)d_in[7]; p.a_b_s = (const float*)d_in[8];
  p.b_q_norm_g = (const float*)d_in[9]; p.b_kv_norm_g = (const float*)d_in[10]; p.b_w_uq = (const float*)d_in[11]; p.b_w_ukv = (const float*)d_in[12];
  p.b_qk_g_q = (const float*)d_in[13]; p.b_qk_g_k = (const float*)d_in[14];
  p.c_a_re = (const float*)d_in[15]; p.c_a_im = (const float*)d_in[16]; p.c_log_dt = (const float*)d_in[17];
  p.c_b_re = (const float*)d_in[18]; p.c_b_im = (const float*)d_in[19]; p.c_c_re = (const float*)d_in[20]; p.c_c_im = (const float*)d_in[21];
  p.c_d = (const float*)d_in[22]; p.c_w_glu = (const float*)d_in[23]; p.c_b_glu = (const float*)d_in[24];
  p.m_norm_g = (const float*)d_in[25]; p.m_w_kv = (const float*)d_in[26]; p.m_qk_g_q = (const float*)d_in[27]; p.m_qk_g_k = (const float*)d_in[28];
  p.w_br_a = (const float*)d_in[29]; p.w_br_b = (const float*)d_in[30]; p.w_br_c = (const float*)d_in[31]; p.w_br_m = (const float*)d_in[32];
  p.w_out = (const float*)d_in[33];
  p.out = (float*)d_out;
  char* ws = (char*)d_ws; size_t off = 0;
  auto take = [&](size_t bytes) { char* r = ws + off; off += (bytes + 255) & ~(size_t)255; return r; };
  p.z1 = (bf16_t*)take((size_t)T_ * Z1W * 2);
  p.z2 = (bf16_t*)take((size_t)T_ * Z2W * 2);
  p.xb = (bf16_t*)take((size_t)T_ * 1024 * 2);
  p.qf = (bf16_t*)take((size_t)T_ * 768 * 2);
  p.kf = (bf16_t*)take((size_t)T_ * 768 * 2);
  p.mg = p.qf;
  p.vt = (bf16_t*)take((size_t)8 * 8 * 64 * S_ * 2);
  p.hm = (bf16_t*)take((size_t)2048 * 1024 * 2);
  p.memk = (bf16_t*)take((size_t)2048 * 256 * 2);
  p.memvt = (bf16_t*)take((size_t)2048 * 256 * 2);
  p.WinT = (bf16_t*)take((size_t)NWIN * 1024 * 2);
  p.WuqT = (bf16_t*)take((size_t)1024 * 768 * 2);
  p.WukvT = (bf16_t*)take((size_t)1024 * 256 * 2);
  p.WgluT = (bf16_t*)take((size_t)256 * 256 * 2);
  p.WbrT = (bf16_t*)take((size_t)1024 * 1280 * 2);
  p.WoutT = (bf16_t*)take((size_t)2 * 1024 * 1024 * 2);
  p.WmkvT = (bf16_t*)take((size_t)512 * 1024 * 2);
  p.ssp = (float*)take((size_t)8 * T_ * 4);
  p.ssq = (float*)take((size_t)9 * T_ * 4);
  p.rope = (float*)take((size_t)T_ * 32 * 4);
  p.carry = (float*)take((size_t)8 * 16 * 32 * 64 * 2 * 4);
  p.s5c = (float*)take((size_t)2 * 16 * 64 * 36 * 4);
  p.ctr = (unsigned*)take(256);
  p.bar = (unsigned*)take(16384);
  if (off > ws_size) { fprintf(stderr, "workspace too small: need %zu have %zu\n", off, ws_size); return; }

  static int grid_blocks = 0;
  if (!grid_blocks) {
    int dev = 0, cus = 0, per_cu = 0;
    hipGetDevice(&dev);
    hipDeviceGetAttribute(&cus, hipDeviceAttributeMultiprocessorCount, dev);
#if MK_MULTI
    hipOccupancyMaxActiveBlocksPerMultiprocessor(&per_cu, hyb_phase, 256, 0);
#else
    hipOccupancyMaxActiveBlocksPerMultiprocessor(&per_cu, hyb_mega, 256, 0);
#endif
    if (per_cu > 2) per_cu = 2;
    if (per_cu < 1) per_cu = 1;
    grid_blocks = cus * per_cu;
    grid_blocks &= ~7;
  }
#if MK_MULTI
  for (int ph = 0; ph < 13; ph++) hipLaunchKernelGGL(hyb_phase, dim3(grid_blocks), dim3(256), 0, stream, p, ph);
#else
  hipMemsetAsync(p.ctr, 0, 256 + 16384, stream);
  void* args[] = {&p};
  hipError_t e = hipLaunchCooperativeKernel((void*)hyb_mega, dim3(grid_blocks), dim3(256), args, 0, stream);
  if (e != hipSuccess) fprintf(stderr, "cooperative launch failed: %s (grid %d)\n", hipGetErrorString(e), grid_blocks);
#endif
}
```
